# Optimizing an MI355X kernel written in HIP

```python
import math
import jax
import jax.numpy as jnp
from jax import lax
import numpy as np

D_MODEL = 2048
BATCH = 4
SEQ = 4096
DEPTH = 2

GRID_W = 64
CTX_LEN = 256

DA_HEADS = 4
DA_HALF = 64
DA_V = 2 * DA_HALF
ML_HEADS = 4
ML_DK = 128
ML_DV = 128
ML_CHUNK = 64
ML_CONV = 3
MLA_HEADS = 8
MLA_Q_RANK = 512
MLA_KV_RANK = 256
MLA_NOPE = 128
MLA_ROPE = 64
MLA_V = 128
MLA_QK = MLA_NOPE + MLA_ROPE

ROPE_DIM = 64
ROPE_BASE = 10000.0
Q_BLOCK = 128
EPS = 1e-6

MIX_W = DA_HEADS * DA_V + ML_HEADS * ML_DV + MLA_HEADS * MLA_V
FF_HIDDEN = -(-8 * D_MODEL // (3 * 256)) * 256
IN_SIZES = (
    DA_HEADS * 2 * DA_HALF, DA_HEADS * 2 * DA_HALF, DA_HEADS * DA_V,
    ML_HEADS * ML_DK, ML_HEADS * ML_DK, ML_HEADS * ML_DV, ML_HEADS * ML_DV,
    4 * ML_HEADS,
    MLA_Q_RANK, MLA_KV_RANK, MLA_ROPE,
)
IN_W = sum(IN_SIZES)

kernel_name = 'hybrid_diffattn_mlstm_mla_dit'


def rms_norm(x, g):
    xf = x.astype(jnp.float32)
    y = xf * lax.rsqrt(jnp.mean(xf * xf, axis=-1, keepdims=True) + EPS)
    return (y * g.astype(jnp.float32)).astype(x.dtype)


def modulate(x, g, shift, scale):
    return rms_norm(x, g) * (1.0 + scale) + shift


def split_cols(p):
    parts, off = [], 0
    for size in IN_SIZES:
        parts.append(p[..., off:off + size])
        off += size
    return parts


def to_heads(t, n_heads):
    b, t_len, _ = t.shape
    return t.reshape(b, t_len, n_heads, -1).transpose(0, 2, 1, 3)


def from_heads(t):
    b, h, t_len, d = t.shape
    return t.transpose(0, 2, 1, 3).reshape(b, t_len, h * d)


def rope_tables(n_lat):
    rows = n_lat // GRID_W
    r, col = jnp.meshgrid(jnp.arange(rows, dtype=jnp.float32),
                          jnp.arange(GRID_W, dtype=jnp.float32), indexing='ij')
    half = ROPE_DIM // 4
    inv = ROPE_BASE ** (-jnp.arange(half, dtype=jnp.float32) / half)
    ang_r = r.reshape(-1)[:, None] * inv
    ang_c = col.reshape(-1)[:, None] * inv
    return (jnp.cos(ang_r), jnp.sin(ang_r), jnp.cos(ang_c), jnp.sin(ang_c))


def _rotate(x, cos, sin):
    x1, x2 = jnp.split(x, 2, axis=-1)
    return jnp.concatenate([x1 * cos - x2 * sin, x2 * cos + x1 * sin], axis=-1)


def rope_2d(x, tabs):
    cr, sr, cc, sc = tabs
    xr, xc = jnp.split(x, 2, axis=-1)
    return jnp.concatenate([_rotate(xr, cr, sr), _rotate(xc, cc, sc)], axis=-1)


def sweep_query_blocks(fn, q):
    *lead, t_len, d = q.shape
    nb = t_len // Q_BLOCK
    qb = jnp.moveaxis(q.reshape(*lead, nb, Q_BLOCK, d), -3, 0)
    out = jnp.moveaxis(lax.map(fn, qb), 0, -3)
    return out.reshape(*out.shape[:-3], nb * Q_BLOCK, out.shape[-1])


def dwconv_centred(x, w, b):
    k = w.shape[0]
    pad = k // 2
    t_len = x.shape[1]
    xp = jnp.pad(x, ((0, 0), (pad, pad), (0, 0)))
    y = b
    for j in range(k):
        y = y + xp[:, j:j + t_len] * w[j]
    return y


def swiglu(h, w_gu, w_down):
    gate, up = jnp.split(h @ w_gu, 2, axis=-1)
    return (jax.nn.silu(gate) * up) @ w_down


def mlstm_chunkwise(q, k, v, ig, lf, state):
    b_sz, h_sz, t_len, _ = q.shape
    dv = v.shape[-1]
    nc = t_len // ML_CHUNK

    def chunks(t):
        return jnp.moveaxis(t.reshape(b_sz, h_sz, nc, ML_CHUNK, *t.shape[3:]), 2, 0)

    lower = jnp.tril(jnp.ones((ML_CHUNK, ML_CHUNK), dtype=bool))

    def step(carry, inp):
        c_mat, n_vec, m = carry
        qc, kc, vc, igc, lfc = inp
        bcum = jnp.cumsum(lfc, axis=-1)
        log_d = jnp.where(lower, bcum[..., :, None] - bcum[..., None, :] + igc[..., None, :], -jnp.inf)
        log_prev = bcum + m[..., None]
        m_t = jnp.maximum(log_prev, jnp.max(log_d, axis=-1))
        dmat = jnp.exp(log_d - m_t[..., None])
        w_prev = jnp.exp(log_prev - m_t)
        s = jnp.einsum('bhtd,bhsd->bhts', qc, kc) * dmat
        num = jnp.einsum('bhts,bhsv->bhtv', s, vc) + w_prev[..., None] * jnp.einsum('bhtd,bhdv->bhtv', qc, c_mat)
        den = jnp.sum(s, axis=-1) + w_prev * jnp.einsum('bhtd,bhd->bht', qc, n_vec)
        h = num / jnp.maximum(jnp.abs(den), jnp.exp(-m_t))[..., None]
        m_new = m_t[..., -1]
        w_s = jnp.exp(bcum[..., -1:] - bcum + igc - m_new[..., None])
        decay = jnp.exp(bcum[..., -1] + m - m_new)
        c_new = decay[..., None, None] * c_mat + jnp.einsum('bhs,bhsd,bhsv->bhdv', w_s, kc, vc)
        n_new = decay[..., None] * n_vec + jnp.einsum('bhs,bhsd->bhd', w_s, kc)
        return (c_new, n_new, m_new), h

    final, h = lax.scan(step, state, tuple(chunks(t) for t in (q, k, v, ig, lf)))
    h = jnp.moveaxis(h, 0, 2).reshape(b_sz, h_sz, t_len, dv)
    return h, final


def diff_attention(lat, ctx_p, qk_g, lam_p, out_g, lam_init, tabs, need_ctx):
    (ql, kl, vl), (qc, kc, vc) = lat, ctx_p

    def prep(t, g, rope):
        b_sz, t_len, _ = t.shape
        t = t.reshape(b_sz, t_len, DA_HEADS, 2, DA_HALF).transpose(0, 2, 3, 1, 4).astype(jnp.float32)
        t = rms_norm(t, g)
        return rope_2d(t, tabs) if rope else t

    lam = (jnp.exp(jnp.sum(lam_p[0] * lam_p[1])) - jnp.exp(jnp.sum(lam_p[2] * lam_p[3])) + lam_init).astype(jnp.float32)
    scale = DA_HALF ** -0.5

    def attend(qb, k, v):
        p = jax.nn.softmax(jnp.einsum('bhmqd,bhmkd->bhmqk', qb, k) * scale, axis=-1)
        return jnp.einsum('bhqk,bhkv->bhqv', p[:, :, 0] - lam * p[:, :, 1], v)

    k_ctx = prep(kc, qk_g[1], False)
    v_ctx = to_heads(vc, DA_HEADS).astype(jnp.float32)
    k_all = jnp.concatenate([k_ctx, prep(kl, qk_g[1], True)], axis=-2)
    v_all = jnp.concatenate([v_ctx, to_heads(vl, DA_HEADS).astype(jnp.float32)], axis=-2)
    o_lat = sweep_query_blocks(lambda qb: attend(qb, k_all, v_all), prep(ql, qk_g[0], True))

    def post(o):
        return from_heads(rms_norm(o, out_g) * (1.0 - lam_init))

    out_ctx = post(attend(prep(qc, qk_g[0], False), k_ctx, v_ctx)) if need_ctx else None
    return post(o_lat), out_ctx


def mlstm(lat, ctx_p, conv_w, conv_b, gate_b, out_g, need_ctx):
    hh = ML_HEADS

    def prep(q, k, v, o, g):
        qk = jax.nn.silu(dwconv_centred(jnp.concatenate([q, k], axis=-1), conv_w, conv_b))
        q, k = jnp.split(qk, 2, axis=-1)
        q = to_heads(q, hh).astype(jnp.float32)
        k = to_heads(k, hh).astype(jnp.float32) * ML_DK ** -0.5
        v = to_heads(v, hh).astype(jnp.float32)
        g = (g + gate_b).astype(jnp.float32).transpose(0, 2, 1)
        fwd = (g[:, 0:hh], jax.nn.log_sigmoid(g[:, hh:2 * hh]))
        bwd = (g[:, 2 * hh:3 * hh], jax.nn.log_sigmoid(g[:, 3 * hh:]))
        return (q, k, v), fwd, bwd, o

    lat_qkv, lat_f, lat_b, lat_o = prep(*lat)
    ctx_qkv, ctx_f, ctx_b, ctx_o = prep(*ctx_p)
    b_sz = lat_qkv[0].shape[0]
    s0 = (jnp.zeros((b_sz, hh, ML_DK, ML_DV), jnp.float32),
          jnp.zeros((b_sz, hh, ML_DK), jnp.float32),
          jnp.zeros((b_sz, hh), jnp.float32))

    def flip(ts):
        return tuple(jnp.flip(t, axis=2) for t in ts)

    h_cf, st_f = mlstm_chunkwise(*ctx_qkv, *ctx_f, s0)
    h_lf, _ = mlstm_chunkwise(*lat_qkv, *lat_f, st_f)
    h_cb, st_b = mlstm_chunkwise(*flip(ctx_qkv), *flip(ctx_b), s0)
    h_lb, _ = mlstm_chunkwise(*flip(lat_qkv), *flip(lat_b), st_b)
    gain = out_g.reshape(hh, 1, ML_DV)

    def post(h, o):
        return from_heads(rms_norm(h, gain)) * jax.nn.sigmoid(o.astype(jnp.float32))

    out_ctx = post(h_cf + jnp.flip(h_cb, axis=2), ctx_o) if need_ctx else None
    return post(h_lf + jnp.flip(h_lb, axis=2), lat_o), out_ctx


def mla(lat, ctx_p, q_norm_g, kv_norm_g, w_uq, w_ukv, qk_g, tabs, need_ctx):
    (cql, ckvl, kpel), (cqc, ckvc, kpec) = lat, ctx_p

    def rope_tail(t):
        return jnp.concatenate([t[..., :MLA_NOPE], rope_2d(t[..., MLA_NOPE:], tabs)], axis=-1)

    def queries(cq, rope):
        q = to_heads(rms_norm(cq, q_norm_g) @ w_uq, MLA_HEADS).astype(jnp.float32)
        q = rms_norm(q, qk_g[0])
        return rope_tail(q) if rope else q

    def keys_values(ckv, kpe, rope):
        b_sz, t_len, _ = ckv.shape
        kv = to_heads(rms_norm(ckv, kv_norm_g) @ w_ukv, MLA_HEADS).astype(jnp.float32)
        k_pe = jnp.broadcast_to(kpe.astype(jnp.float32)[:, None], (b_sz, MLA_HEADS, t_len, MLA_ROPE))
        k = rms_norm(jnp.concatenate([kv[..., :MLA_NOPE], k_pe], axis=-1), qk_g[1])
        return (rope_tail(k) if rope else k), kv[..., MLA_NOPE:]

    scale = MLA_QK ** -0.5

    def attend(qb, k, v):
        p = jax.nn.softmax(jnp.einsum('bhqd,bhkd->bhqk', qb, k) * scale, axis=-1)
        return jnp.einsum('bhqk,bhkv->bhqv', p, v)

    k_ctx, v_ctx = keys_values(ckvc, kpec, False)
    k_lat, v_lat = keys_values(ckvl, kpel, True)
    k_all = jnp.concatenate([k_ctx, k_lat], axis=-2)
    v_all = jnp.concatenate([v_ctx, v_lat], axis=-2)
    o_lat = sweep_query_blocks(lambda qb: attend(qb, k_all, v_all), queries(cql, True))
    out_ctx = from_heads(attend(queries(cqc, False), k_ctx, v_ctx)) if need_ctx else None
    return from_heads(o_lat), out_ctx


def hybrid_layer(x, xc, mod_lat, mod_ctx, layer_idx, need_ctx, tabs,
                 norm1_g, norm2_g, w_in, da_qk_g, da_lambda, da_out_g,
                 ml_conv_w, ml_conv_b, ml_gate_b, ml_out_g,
                 mla_q_norm_g, mla_kv_norm_g, mla_w_uq, mla_w_ukv, mla_qk_g,
                 w_out, ffn_w_gu, ffn_w_down):
    sh1, sc1, gt1, sh2, sc2, gt2 = jnp.split(mod_lat[:, None, :], 6, axis=-1)
    csh1, csc1, cgt1, csh2, csc2, cgt2 = jnp.split(mod_ctx, 6, axis=-1)
    pl = split_cols(modulate(x, norm1_g, sh1, sc1) @ w_in)
    pc = split_cols(modulate(xc, norm1_g, csh1, csc1) @ w_in)
    lam_init = 0.8 - 0.6 * math.exp(-0.3 * layer_idx)
    da_l, da_c = diff_attention(pl[0:3], pc[0:3], da_qk_g, da_lambda, da_out_g, lam_init, tabs, need_ctx)
    ml_l, ml_c = mlstm(pl[3:8], pc[3:8], ml_conv_w, ml_conv_b, ml_gate_b, ml_out_g, need_ctx)
    mla_l, mla_c = mla(pl[8:11], pc[8:11], mla_q_norm_g, mla_kv_norm_g, mla_w_uq, mla_w_ukv,
                       mla_qk_g, tabs, need_ctx)

    def finish(h, mix, g1, s2, c2, g2):
        h = h + g1 * (jnp.concatenate(mix, axis=-1).astype(h.dtype) @ w_out)
        return h + g2 * swiglu(modulate(h, norm2_g, s2, c2), ffn_w_gu, ffn_w_down)

    x = finish(x, [da_l, ml_l, mla_l], gt1, sh2, sc2, gt2)
    if need_ctx:
        xc = finish(xc, [da_c, ml_c, mla_c], cgt1, csh2, csc2, cgt2)
    return x, xc


def setup_inputs(seed: int = 0) -> dict:
    key = jax.random.key(seed)
    ks = jax.random.split(key, 32)
    f32 = jnp.float32

    def w(k, shape, fan_in):
        return jax.random.normal(k, shape, f32) * fan_in ** -0.5

    def gain(k, shape):
        return 1.0 + 0.05 * jax.random.normal(k, shape, f32)

    def small(k, shape, s=0.02):
        return s * jax.random.normal(k, shape, f32)

    ig_b = small(ks[14], (DEPTH, 2, ML_HEADS), 0.1)
    fg_b = jnp.linspace(3.0, 6.0, ML_HEADS, dtype=f32) + small(ks[15], (DEPTH, 2, ML_HEADS), 0.1)
    ml_gate_b = jnp.stack([ig_b, fg_b], axis=2).reshape(DEPTH, 4 * ML_HEADS)
    return {
        'x': jax.random.normal(ks[0], (BATCH, SEQ, D_MODEL), f32),
        'c': jax.random.normal(ks[1], (BATCH, D_MODEL), f32),
        'ctx': jax.random.normal(ks[2], (BATCH, CTX_LEN, D_MODEL), f32),
        'c_ctx': jax.random.normal(ks[3], (D_MODEL,), f32),
        'mod_w': w(ks[4], (DEPTH, D_MODEL, 6 * D_MODEL), D_MODEL),
        'mod_b': small(ks[5], (DEPTH, 6 * D_MODEL)),
        'norm1_g': gain(ks[6], (DEPTH, D_MODEL)),
        'norm2_g': gain(ks[7], (DEPTH, D_MODEL)),
        'w_in': w(ks[8], (DEPTH, D_MODEL, IN_W), D_MODEL),
        'da_qk_g': gain(ks[9], (DEPTH, 2, DA_HALF)),
        'da_lambda': small(ks[10], (DEPTH, 4, DA_HALF), 0.1),
        'da_out_g': gain(ks[11], (DEPTH, DA_V)),
        'ml_conv_w': w(ks[12], (DEPTH, ML_CONV, 2 * ML_HEADS * ML_DK), ML_CONV),
        'ml_conv_b': small(ks[13], (DEPTH, 2 * ML_HEADS * ML_DK)),
        'ml_gate_b': ml_gate_b,
        'ml_out_g': gain(ks[16], (DEPTH, ML_HEADS * ML_DV)),
        'mla_q_norm_g': gain(ks[17], (DEPTH, MLA_Q_RANK)),
        'mla_kv_norm_g': gain(ks[18], (DEPTH, MLA_KV_RANK)),
        'mla_w_uq': w(ks[19], (DEPTH, MLA_Q_RANK, MLA_HEADS * MLA_QK), MLA_Q_RANK),
        'mla_w_ukv': w(ks[20], (DEPTH, MLA_KV_RANK, MLA_HEADS * (MLA_NOPE + MLA_V)), MLA_KV_RANK),
        'mla_qk_g': gain(ks[21], (DEPTH, 2, MLA_QK)),
        'w_out': w(ks[22], (DEPTH, MIX_W, D_MODEL), MIX_W),
        'ffn_w_gu': w(ks[23], (DEPTH, D_MODEL, 2 * FF_HIDDEN), D_MODEL),
        'ffn_w_down': w(ks[24], (DEPTH, FF_HIDDEN, D_MODEL), FF_HIDDEN),
    }


def reference(x, c, ctx, c_ctx, mod_w, mod_b, norm1_g, norm2_g, w_in, da_qk_g, da_lambda,
              da_out_g, ml_conv_w, ml_conv_b, ml_gate_b, ml_out_g, mla_q_norm_g, mla_kv_norm_g,
              mla_w_uq, mla_w_ukv, mla_qk_g, w_out, ffn_w_gu, ffn_w_down):
    in_dtype = x.dtype
    tabs = rope_tables(x.shape[1])
    xc = ctx
    for l in range(DEPTH):
        mod_lat = jax.nn.silu(c) @ mod_w[l] + mod_b[l]
        mod_ctx = jax.nn.silu(c_ctx) @ mod_w[l] + mod_b[l]
        x, xc = hybrid_layer(
            x, xc, mod_lat, mod_ctx, l, l < DEPTH - 1, tabs,
            norm1_g[l], norm2_g[l], w_in[l], da_qk_g[l], da_lambda[l], da_out_g[l],
            ml_conv_w[l], ml_conv_b[l], ml_gate_b[l], ml_out_g[l],
            mla_q_norm_g[l], mla_kv_norm_g[l], mla_w_uq[l], mla_w_ukv[l], mla_qk_g[l],
            w_out[l], ffn_w_gu[l], ffn_w_down[l])
    return x.astype(in_dtype)
```

```cpp
#include <hip/hip_runtime.h>
#include <hip/hip_cooperative_groups.h>
#include <cstdio>
#include <cstdint>
namespace cg = cooperative_groups;

#define LAS __attribute__((address_space(3)))
typedef unsigned short bf16_t;
typedef short bf16x8 __attribute__((ext_vector_type(8)));
typedef float f32x4 __attribute__((ext_vector_type(4)));
typedef float f32x16 __attribute__((ext_vector_type(16)));
typedef unsigned u32x4 __attribute__((ext_vector_type(4)));
typedef unsigned u32x2 __attribute__((ext_vector_type(2)));

constexpr int DM = 2048, BATCH = 4, SEQ = 4096, CTXL = 256, DEPTH = 2;
constexpr int M_LAT = BATCH * SEQ, M_CTX = BATCH * CTXL, M_ALL = M_LAT + M_CTX;
constexpr int TK = CTXL + SEQ;
constexpr int NCH = TK / 64;
constexpr int IN_W = 4432, NPROJ = 4608, FF = 5632;
constexpr int C_DAQ = 0, C_DAK = 512, C_DAV = 1024, C_MLQ = 1536, C_MLK = 2048, C_MLV = 2560, C_MLO = 3072, C_GATE = 3584, C_CQ = 3600, C_CKV = 4112, C_KPE = 4368;
constexpr float EPS = 1e-6f;
constexpr float LOG2E = 1.4426950408889634f;

constexpr size_t MiB = 1u << 20;
constexpr size_t WS_WIN = 0, WS_WOUT = 18 * MiB, WS_WGU = 26 * MiB, WS_WDN = 70 * MiB, WS_WUQ = 92 * MiB, WS_WUKV = 94 * MiB, WS_MOD = 95 * MiB, WS_RCTX = 96 * MiB;
constexpr size_t WS_AB = 104 * MiB;
constexpr size_t WS_PROJ = 172 * MiB;
constexpr size_t WS_QUP = 172 * MiB, WS_KVUP = 223 * MiB, WS_HID = 172 * MiB;
constexpr size_t WS_GATES = 325 * MiB, WS_CQN = 327 * MiB, WS_CKVN = 344 * MiB, WS_KPE = 353 * MiB, WS_OCOPY = 356 * MiB;
constexpr size_t WS_QDA = 373 * MiB, WS_KDA = 390 * MiB, WS_VTDA = 407 * MiB, WS_QML = 424 * MiB, WS_KML = 441 * MiB, WS_KTML = 458 * MiB, WS_VTML = 475 * MiB;
constexpr size_t WS_QM = 492 * MiB, WS_KM = 543 * MiB, WS_VTM = 594 * MiB, WS_CSNAP = 628 * MiB, WS_NSNAP = 696 * MiB, WS_NU = 698 * MiB, WS_CSTAT = 700 * MiB, WS_END = 701 * MiB;
static_assert((size_t)NPROJ * DM * 2 <= 18 * MiB && (size_t)2 * FF * DM * 2 <= 44 * MiB && (size_t)M_ALL * NPROJ * 2 <= 153 * MiB, "ws map");
static_assert(WS_HID + (size_t)M_ALL * FF * 2 <= WS_QDA, "hid overlay");
static_assert(WS_END <= 768 * MiB, "ws fits the guaranteed minimum");

constexpr int LDS_BYTES = 140 * 1024;
#ifndef PH_EN
#define PH_EN 0xFFFF
#endif
#define EN(k) ((PH_EN >> (k)) & 1)

__device__ __forceinline__ unsigned f2bf(float f) { unsigned u = __builtin_bit_cast(unsigned, f); return (u + 0x7fffu + ((u >> 16) & 1u)) >> 16; }
__device__ __forceinline__ unsigned pk2(float lo, float hi) { return f2bf(lo) | (f2bf(hi) << 16); }
__device__ __forceinline__ float bflo(unsigned w) { return __builtin_bit_cast(float, w << 16); }
__device__ __forceinline__ float bfhi(unsigned w) { return __builtin_bit_cast(float, w & 0xffff0000u); }
__device__ __forceinline__ float bf1(bf16_t h) { return __builtin_bit_cast(float, (unsigned)h << 16); }
__device__ __forceinline__ void unpack8(const u32x4 w, float* v) { v[0] = bflo(w.x); v[1] = bfhi(w.x); v[2] = bflo(w.y); v[3] = bfhi(w.y); v[4] = bflo(w.z); v[5] = bfhi(w.z); v[6] = bflo(w.w); v[7] = bfhi(w.w); }
__device__ __forceinline__ u32x4 pack8(const float* v) { u32x4 w; w.x = pk2(v[0], v[1]); w.y = pk2(v[2], v[3]); w.z = pk2(v[4], v[5]); w.w = pk2(v[6], v[7]); return w; }
__device__ __forceinline__ float wave_sum(float v) {
#pragma unroll
    for (int o = 1; o < 64; o <<= 1) v += __shfl_xor(v, o);
    return v;
}
__device__ __forceinline__ float wave_max(float v) {
#pragma unroll
    for (int o = 1; o < 64; o <<= 1) v = fmaxf(v, __shfl_xor(v, o));
    return v;
}
__device__ __forceinline__ float siluf(float x) { return x / (1.f + __expf(-x)); }
__device__ __forceinline__ float sigmf(float x) { return 1.f / (1.f + __expf(-x)); }
__device__ __forceinline__ int crow(int r, int hi) { return (r & 3) + 8 * (r >> 2) + 4 * hi; }
__device__ __forceinline__ int perm_off(int p) { const int h = p >> 3, j = p & 7; return 8 * (j >> 2) + 4 * h + (j & 3); }
__device__ __forceinline__ int mod_batch(int row) { return row < M_LAT ? (row >> 12) : 4; }

namespace pg8 {
constexpr int BM = 256, BK = 64, HALF = 128, HTB = HALF * BK * 2, STAGE_BYTES = 8 * HTB, NXCD = 8, WGM = 8;
__host__ __device__ __forceinline__ int lds_byte(int r, int c) { const int st = (r >> 4) * 2 + (c >> 5), rr = r & 15, cc = c & 31, ob = rr * 64 + cc * 2; return st * 1024 + (ob ^ (((ob >> 9) & 1) << 5)); }
__host__ __device__ __forceinline__ void stage_rc(int b, int& R, int& C) { const int st = b / 1024, sb = b % 1024, swz = sb ^ (((sb >> 9) & 1) << 5); R = (st >> 1) * 16 + swz / 64; C = (st & 1) * 32 + (swz % 64) / 2; }
__host__ __device__ __forceinline__ int perm32(int rho) { const int n = rho >> 4, i = rho & 15; return 8 * (i >> 2) + 4 * n + (i & 3); }

struct Unit { int pm, pn; };
struct Gemm { const bf16_t* A; const bf16_t* Bt; int M, N, K; };

struct StaticOrder {
    int nM, nN, nwg, G, c;
    __device__ void init(int M, int N, int G_, int c_) { nM = M / BM; nN = N / BM; nwg = nM * nN; G = G_; c = c_; }
    __device__ bool next(int i, Unit& u) const {
        const long L = (long)i * G + c; if (L >= nwg) return false;
        int wgid = (int)L; { const int q = nwg / NXCD, r = nwg % NXCD, xcd = wgid % NXCD, off = wgid / NXCD; wgid = (xcd < r ? xcd * (q + 1) : r * (q + 1) + (xcd - r) * q) + off; }
        const int nig = WGM * nN, gid = wgid / nig, fm = gid * WGM, gsz = (nM - fm) < WGM ? (nM - fm) : WGM;
        u.pm = fm + ((wgid % nig) % gsz); u.pn = (wgid % nig) / gsz; return true;
    }
};

struct EpiBf16 {
    static constexpr bool PERM = true;
    bf16_t* O; int ldc; float* gates; int gate_pn;
    __device__ __forceinline__ void operator()(const f32x4 (&acc)[2][2][4][2], const Unit& u, int wr, int wc, int fr, int fq) const {
        const int row0 = u.pm * BM + wr * 64 + fr; const int col0 = u.pn * BM + wc * 32 + 8 * fq;
        const bool g = gates != nullptr && u.pn == gate_pn && wc == 0 && fq < 2;
#pragma unroll
        for (int ai = 0; ai < 2; ++ai)
#pragma unroll
            for (int m = 0; m < 4; ++m) { const int row = row0 + ai * HALF + m * 16; bf16_t* rowp = O + (size_t)row * ldc + col0;
#pragma unroll
                for (int bj = 0; bj < 2; ++bj) { const f32x4 v0 = acc[ai][bj][m][0], v1 = acc[ai][bj][m][1];
                    u32x4 w; w.x = pk2(v0[0], v0[1]); w.y = pk2(v0[2], v0[3]); w.z = pk2(v1[0], v1[1]); w.w = pk2(v1[2], v1[3]);
                    *(u32x4*)(rowp + bj * HALF) = w;
                    if (bj == 0 && g) { *(f32x4*)(gates + (size_t)row * 16 + 8 * fq) = v0; *(f32x4*)(gates + (size_t)row * 16 + 8 * fq + 4) = v1; } } }
    }
};
struct EpiSwiGLU {
    static constexpr bool PERM = true;
    bf16_t* O; int ldc;
    __device__ __forceinline__ void operator()(const f32x4 (&acc)[2][2][4][2], const Unit& u, int wr, int wc, int fr, int fq) const {
        const int row0 = u.pm * BM + wr * 64 + fr; const int col0 = u.pn * HALF + wc * 32 + 8 * fq;
#pragma unroll
        for (int ai = 0; ai < 2; ++ai)
#pragma unroll
            for (int m = 0; m < 4; ++m) { const int row = row0 + ai * HALF + m * 16;
                float o[8];
#pragma unroll
                for (int n = 0; n < 2; ++n)
#pragma unroll
                    for (int i = 0; i < 4; ++i) { const float gt = acc[ai][0][m][n][i], up = acc[ai][1][m][n][i]; o[4 * n + i] = siluf(gt) * up; }
                *(u32x4*)(O + (size_t)row * ldc + col0) = pack8(o); }
    }
};
struct EpiRes {
    static constexpr bool PERM = false;
    const float* res_lat; const float* res_ctx; float* out_lat; float* out_ctx; const float* gate;
    __device__ __forceinline__ void operator()(const f32x4 (&acc)[2][2][4][2], const Unit& u, int wr, int wc, int fr, int fq) const {
        const int row0 = u.pm * BM + wr * 64 + fr; const int col0 = u.pn * BM + wc * 32 + 4 * fq;
#pragma unroll
        for (int ai = 0; ai < 2; ++ai)
#pragma unroll
            for (int m = 0; m < 4; ++m) { const int row = row0 + ai * HALF + m * 16;
                const float* rp = row < M_LAT ? res_lat + (size_t)row * DM : res_ctx + (size_t)(row - M_LAT) * DM;
                float* op = row < M_LAT ? out_lat + (size_t)row * DM : out_ctx + (size_t)(row - M_LAT) * DM;
                const float* gp = gate + (size_t)mod_batch(row) * 6 * DM;
#pragma unroll
                for (int bj = 0; bj < 2; ++bj)
#pragma unroll
                    for (int n = 0; n < 2; ++n) { const int c = col0 + bj * HALF + n * 16;
                        const f32x4 r = *(const f32x4*)(rp + c), g = *(const f32x4*)(gp + c);
                        *(f32x4*)(op + c) = r + g * acc[ai][bj][m][n]; } }
    }
};

template <class Epi, bool ALIGN_EPI = true>
__device__ __forceinline__ void gemm_phase(LAS unsigned char* lds, const Gemm g, const StaticOrder& S, const Epi& E) {
    int tid = threadIdx.x; asm volatile("" : "+v"(tid)); const int wid = __builtin_amdgcn_readfirstlane(tid >> 6), lane = tid & 63, wr = wid >> 2, wc = wid & 3, fr = lane & 15, fq = lane >> 4;
    int K = g.K; asm volatile("" : "+s"(K)); const int nt = K / BK;
    unsigned voffA[2], voffB[2];
#pragma unroll
    for (int i = 0; i < 2; ++i) { int R, C; stage_rc(tid * 16 + i * 8192, R, C); const int Rb = Epi::PERM ? ((R & ~31) + perm32(R & 31)) : R;
        voffA[i] = (unsigned)(R * K + C) * 2u; voffB[i] = (unsigned)(Rb * K + C) * 2u; }
    const size_t kstep = (size_t)(BK * 2);
    const size_t hstep = (size_t)HALF * K * 2;
    const size_t tstep = 2 * hstep;
    const unsigned ldsw = (unsigned)wid * 1024u;
    const int aoff = lds_byte(wr * 64 + fr, fq * 8), boff = lds_byte(wc * 32 + fr, fq * 8);
#define PG8_SA(b, h) (((b) * 2 + (h)) * HTB)
#define PG8_SB(b, h) ((4 + (b) * 2 + (h)) * HTB)
#define PG8_STAGE(bufoff, gbase, voff) do { _Pragma("unroll") for (int _i = 0; _i < 2; ++_i) \
        __builtin_amdgcn_global_load_lds((const unsigned*)((const char*)(gbase) + (voff)[_i]), (LAS unsigned*)(lds + (bufoff) + ldsw + _i * 8192), 16, 0, 0); } while (0)
#define PG8_LDA(dst, b, h) do { _Pragma("unroll") for (int m = 0; m < 4; ++m) _Pragma("unroll") for (int k = 0; k < 2; ++k) dst[m][k] = *(const LAS bf16x8*)(lds + PG8_SA(b, h) + aoff + m * 2048 + k * 1024); } while (0)
#define PG8_LDB(dst, b, h) do { _Pragma("unroll") for (int n = 0; n < 2; ++n) _Pragma("unroll") for (int k = 0; k < 2; ++k) dst[n][k] = *(const LAS bf16x8*)(lds + PG8_SB(b, h) + boff + n * 2048 + k * 1024); } while (0)
#define PG8_MMA(ai, bj, At, Bt) do { __builtin_amdgcn_s_setprio(1); _Pragma("unroll") for (int m = 0; m < 4; ++m) _Pragma("unroll") for (int n = 0; n < 2; ++n) _Pragma("unroll") for (int k = 0; k < 2; ++k) \
        acc[ai][bj][m][n] = __builtin_amdgcn_mfma_f32_16x16x32_bf16(Bt[n][k], At[m][k], acc[ai][bj][m][n], 0, 0, 0); __builtin_amdgcn_s_setprio(0); } while (0)
#define PG8_WAIT_V(n) asm volatile("s_waitcnt vmcnt(" #n ")" ::: "memory")
#define PG8_WAIT_L(n) asm volatile("s_waitcnt lgkmcnt(" #n ")" ::: "memory")
#define PG8_BAR __builtin_amdgcn_s_barrier()
#define PG8_SCHED __builtin_amdgcn_sched_barrier(0)
    Unit cur, nxt; int ui = 0;
    if (!S.next(0, cur)) return;
    f32x4 acc[2][2][4][2];
#pragma unroll
    for (int a = 0; a < 2; ++a)
#pragma unroll
        for (int b = 0; b < 2; ++b)
#pragma unroll
            for (int m = 0; m < 4; ++m)
#pragma unroll
                for (int n = 0; n < 2; ++n) acc[a][b][m][n] = (f32x4){0.f, 0.f, 0.f, 0.f};
    bf16x8 At[4][2], B0[2][2], B1[2][2];
    const char* cA = (const char*)g.A + (size_t)cur.pm * tstep; const char* cB = (const char*)g.Bt + (size_t)cur.pn * tstep;
    PG8_STAGE(PG8_SB(0, 0), cB, voffB); PG8_STAGE(PG8_SB(0, 1), cB + hstep, voffB); PG8_STAGE(PG8_SA(0, 0), cA, voffA); PG8_STAGE(PG8_SA(0, 1), cA + hstep, voffA);
    if (wr == 1) PG8_BAR;
    PG8_WAIT_V(2); PG8_BAR;
    PG8_STAGE(PG8_SB(1, 0), cB + kstep, voffB); PG8_STAGE(PG8_SA(1, 0), cA + kstep, voffA); PG8_STAGE(PG8_SB(1, 1), cB + hstep + kstep, voffB);
    PG8_WAIT_V(6); PG8_BAR;
    for (;;) {
        const bool has_next = S.next(ui + 1, nxt);
        const char* nA = has_next ? (const char*)g.A + (size_t)nxt.pm * tstep : cA; const char* nB = has_next ? (const char*)g.Bt + (size_t)nxt.pn * tstep : cB;
        for (int t = 0; t < nt; t += 2) {
            const bool last = (t == nt - 2);
            const char* a1 = cA + (size_t)(t + 1) * kstep;
            const char* a2 = last ? nA : cA + (size_t)(t + 2) * kstep; const char* b2 = last ? nB : cB + (size_t)(t + 2) * kstep;
            const char* a3 = a2 + kstep; const char* b3 = b2 + kstep;
            PG8_LDB(B0, 0, 0); PG8_LDB(B1, 0, 1); PG8_SCHED; PG8_LDA(At, 0, 0); PG8_STAGE(PG8_SA(1, 1), a1 + hstep, voffA);
            PG8_WAIT_V(8); PG8_WAIT_L(0); PG8_BAR; PG8_MMA(0, 0, At, B0); PG8_MMA(0, 1, At, B1); PG8_BAR; PG8_SCHED;
            PG8_LDA(At, 0, 1); PG8_STAGE(PG8_SB(0, 0), b2, voffB); PG8_STAGE(PG8_SB(0, 1), b2 + hstep, voffB); PG8_STAGE(PG8_SA(0, 0), a2, voffA);
            PG8_WAIT_V(8); PG8_WAIT_L(0); PG8_BAR; PG8_MMA(1, 0, At, B0); PG8_MMA(1, 1, At, B1); PG8_BAR; PG8_SCHED;
            PG8_LDB(B0, 1, 0); PG8_LDB(B1, 1, 1); PG8_SCHED; PG8_LDA(At, 1, 0); PG8_STAGE(PG8_SA(0, 1), a2 + hstep, voffA);
            PG8_WAIT_V(8); PG8_WAIT_L(0); PG8_BAR; PG8_MMA(0, 0, At, B0); PG8_MMA(0, 1, At, B1); PG8_BAR; PG8_SCHED;
            PG8_LDA(At, 1, 1); PG8_STAGE(PG8_SB(1, 0), b3, voffB); PG8_STAGE(PG8_SB(1, 1), b3 + hstep, voffB); PG8_STAGE(PG8_SA(1, 0), a3, voffA);
            PG8_WAIT_V(8); PG8_WAIT_L(0); PG8_BAR; PG8_MMA(1, 0, At, B0); PG8_MMA(1, 1, At, B1); PG8_BAR; PG8_SCHED;
        }
        if constexpr (ALIGN_EPI) { if (wr == 0) PG8_BAR; }
        E(acc, cur, wr, wc, fr, fq);
        if (!has_next) break;
#pragma unroll
        for (int a = 0; a < 2; ++a)
#pragma unroll
            for (int b = 0; b < 2; ++b)
#pragma unroll
                for (int m = 0; m < 4; ++m)
#pragma unroll
                    for (int n = 0; n < 2; ++n) acc[a][b][m][n] = (f32x4){0.f, 0.f, 0.f, 0.f};
        cur = nxt; cA = nA; cB = nB; ++ui;
        if constexpr (ALIGN_EPI) { if (wr == 1) PG8_BAR; }
    }
    PG8_WAIT_V(0);
    if constexpr (!ALIGN_EPI) { if (wr == 0) PG8_BAR; }
    PG8_BAR;
#undef PG8_SA
#undef PG8_SB
#undef PG8_STAGE
#undef PG8_LDA
#undef PG8_LDB
#undef PG8_MMA
#undef PG8_WAIT_V
#undef PG8_WAIT_L
#undef PG8_BAR
#undef PG8_SCHED
}
}

struct Params { const float* in[24]; float* out; unsigned char* ws; };
enum { I_X = 0, I_C, I_CTX, I_CCTX, I_MODW, I_MODB, I_N1G, I_N2G, I_WIN, I_DAQKG, I_DALAM, I_DAOUTG, I_CONVW, I_CONVB, I_GATEB, I_MLOUTG, I_QNG, I_KVNG, I_WUQ, I_WUKV, I_MLAQKG, I_WOUT, I_WGU, I_WDN };

struct Ctx {
    unsigned char* lds;
    int tid, lane, wave, gw, ngw, nwg, wg;
};

__device__ __forceinline__ Ctx fresh(const Ctx& X) {
    Ctx Y = X; int t = X.tid; asm volatile("" : "+v"(t)); Y.tid = t; Y.lane = t & 63; Y.wave = __builtin_amdgcn_readfirstlane(t >> 6); return Y;
}
template <int MODE>
__device__ __forceinline__ void transpose_item(const float* W, int K, int N, bf16_t* WT, float* scr, int item, int nblk, int lane) {
    const int kb = item / nblk, nb = item % nblk, k0 = 64 * kb, n0 = 32 * nb;
    const int ncol = n0 + (lane & 31); const bool ok = ncol < N;
#pragma unroll 8
    for (int i = 0; i < 32; ++i) { const int kk = 2 * i + (lane >> 5); scr[kk * 33 + (lane & 31)] = ok ? W[(size_t)(k0 + kk) * N + ncol] : 0.f; }
    asm volatile("s_waitcnt lgkmcnt(0)" ::: "memory");
    const int c = lane & 7;
#pragma unroll
    for (int j = 0; j < 4; ++j) { const int n = (lane >> 3) + 8 * j; const float* s = scr + (8 * c) * 33 + n;
        u32x4 o; o.x = pk2(s[0 * 33], s[1 * 33]); o.y = pk2(s[2 * 33], s[3 * 33]); o.z = pk2(s[4 * 33], s[5 * 33]); o.w = pk2(s[6 * 33], s[7 * 33]);
        int nn = n0 + n;
        if (MODE == 1) { const int up = nn >= FF ? 1 : 0; const int hcol = nn - up * FF; nn = (hcol >> 7) * 256 + up * 128 + (hcol & 127); }
        *(u32x4*)(WT + (size_t)nn * K + k0 + 8 * c) = o; }
    asm volatile("s_waitcnt lgkmcnt(0)" ::: "memory");
}
__device__ __forceinline__ void convert_weights(const Ctx& X0, const Params& P, int l) {
    const Ctx X = fresh(X0);
    float* scr = (float*)(X.lds + X.wave * 16384);
    unsigned char* ws = P.ws;
    constexpr int I_IN = (DM / 64) * (NPROJ / 32), I_OUT = (DM / 64) * (DM / 32), I_GU = (DM / 64) * (2 * FF / 32), I_DN = (FF / 64) * (DM / 32), I_UQ = (512 / 64) * (1536 / 32), I_UKV = (256 / 64) * (2048 / 32);
    constexpr int NITEMS = I_IN + I_OUT + I_GU + I_DN + I_UQ + I_UKV;
    for (int it = X.gw; it < NITEMS; it += X.ngw) {
        int r = it;
        if (r < I_IN) { transpose_item<0>(P.in[I_WIN] + (size_t)l * DM * IN_W, DM, IN_W, (bf16_t*)(ws + WS_WIN), scr, r, NPROJ / 32, X.lane); continue; } r -= I_IN;
        if (r < I_OUT) { transpose_item<0>(P.in[I_WOUT] + (size_t)l * DM * DM, DM, DM, (bf16_t*)(ws + WS_WOUT), scr, r, DM / 32, X.lane); continue; } r -= I_OUT;
        if (r < I_GU) { transpose_item<1>(P.in[I_WGU] + (size_t)l * DM * 2 * FF, DM, 2 * FF, (bf16_t*)(ws + WS_WGU), scr, r, 2 * FF / 32, X.lane); continue; } r -= I_GU;
        if (r < I_DN) { transpose_item<0>(P.in[I_WDN] + (size_t)l * FF * DM, FF, DM, (bf16_t*)(ws + WS_WDN), scr, r, DM / 32, X.lane); continue; } r -= I_DN;
        if (r < I_UQ) { transpose_item<0>(P.in[I_WUQ] + (size_t)l * 512 * 1536, 512, 1536, (bf16_t*)(ws + WS_WUQ), scr, r, 1536 / 32, X.lane); continue; } r -= I_UQ;
        transpose_item<0>(P.in[I_WUKV] + (size_t)l * 256 * 2048, 256, 2048, (bf16_t*)(ws + WS_WUKV), scr, r, 2048 / 32, X.lane);
    }
}
__device__ __forceinline__ void mod_gemv(const Ctx& X0, const Params& P) {
    const Ctx X = fresh(X0);
    float* sc = (float*)X.lds;
    float* red = (float*)(X.lds + 40960);
    for (int i = X.tid; i < 5 * DM; i += 512) { const int mb = i / DM, k = i % DM; const float v = mb < 4 ? P.in[I_C][mb * DM + k] : P.in[I_CCTX][k]; sc[i] = siluf(v); }
    __syncthreads();
    float* mod = (float*)(P.ws + WS_MOD);
    const int kq = X.tid >> 4, c4 = X.tid & 15;
    for (int task = X.wg; task < DEPTH * 192; task += X.nwg) {
        const int l = task / 192, n0 = (task % 192) * 64;
        const float* W = P.in[I_MODW] + (size_t)l * DM * 6 * DM + n0 + 4 * c4;
        f32x4 a[5];
#pragma unroll
        for (int mb = 0; mb < 5; ++mb) a[mb] = (f32x4){0.f, 0.f, 0.f, 0.f};
#pragma unroll 8
        for (int i = 0; i < 64; ++i) { const int k = kq + 32 * i; const f32x4 w = *(const f32x4*)(W + (size_t)k * 6 * DM);
#pragma unroll
            for (int mb = 0; mb < 5; ++mb) a[mb] += w * sc[mb * DM + k]; }
#pragma unroll
        for (int mb = 0; mb < 5; ++mb) *(f32x4*)(red + (kq * 5 + mb) * 64 + 4 * c4) = a[mb];
        __syncthreads();
        if (X.tid < 320) { const int mb = X.tid >> 6, cc = X.tid & 63; float s = 0.f;
#pragma unroll 8
            for (int q = 0; q < 32; ++q) s += red[(q * 5 + mb) * 64 + cc];
            mod[((size_t)l * 5 + mb) * 6 * DM + n0 + cc] = s + P.in[I_MODB][(size_t)l * 6 * DM + n0 + cc]; }
        __syncthreads();
    }
}

__device__ __forceinline__ void modulate_phase(const Ctx& X0, const float* src_lat, const float* src_ctx, const float* g, const float* modl, int shift_off, int scale_off, bf16_t* A, int nrows) {
    const Ctx X = fresh(X0);
    for (int row = X.gw; row < nrows; row += X.ngw) {
        const float* src = row < M_LAT ? src_lat + (size_t)row * DM : src_ctx + (size_t)(row - M_LAT) * DM;
        f32x4 v[8]; float ss = 0.f;
#pragma unroll
        for (int j = 0; j < 8; ++j) { v[j] = *(const f32x4*)(src + X.lane * 4 + 256 * j); ss += (v[j][0] * v[j][0] + v[j][1] * v[j][1]) + (v[j][2] * v[j][2] + v[j][3] * v[j][3]); }
        const float rstd = rsqrtf(wave_sum(ss) * (1.f / DM) + EPS);
        const float* mp = modl + (size_t)mod_batch(row) * 6 * DM;
#pragma unroll
        for (int j = 0; j < 8; ++j) { const int col = X.lane * 4 + 256 * j;
            const f32x4 gg = *(const f32x4*)(g + col), sc = *(const f32x4*)(mp + scale_off + col), sh = *(const f32x4*)(mp + shift_off + col);
            const f32x4 y = (v[j] * rstd) * gg * (sc + 1.0f) + sh;
            u32x2 w; w.x = pk2(y[0], y[1]); w.y = pk2(y[2], y[3]);
            *(u32x2*)(A + (size_t)row * DM + col) = w; }
    }
}

struct ChunkId { int b, j, row0, tok0, is_lat, seglen; };
__device__ __forceinline__ ChunkId chunk_of_unit(int u) {
    ChunkId c;
    if (u < 256) { c.b = u >> 6; c.j = u & 63; c.row0 = c.b * SEQ + 64 * c.j; c.tok0 = CTXL + 64 * c.j; c.is_lat = 1; c.seglen = SEQ; }
    else { const int uu = u - 256; c.b = uu >> 2; c.j = uu & 3; c.row0 = M_LAT + c.b * CTXL + 64 * c.j; c.tok0 = 64 * c.j; c.is_lat = 0; c.seglen = CTXL; }
    return c;
}
__device__ __forceinline__ int row_of_tokchunk(int b, int jt) { return jt < 4 ? M_LAT + b * CTXL + 64 * jt : b * SEQ + 64 * (jt - 4); }

constexpr int TSTR = 520;
__device__ __forceinline__ void write_vt(const Ctx& X, const bf16_t* tile, bf16_t* img, size_t img_row0, int tok0) {
#pragma unroll 2
    for (int it = 0; it < 8; ++it) { const int task = it * 512 + X.tid; const int k = task & 7, c = task >> 3;
        float v[8];
#pragma unroll
        for (int jj = 0; jj < 8; ++jj) { const int i = 16 * (k >> 1) + 8 * (jj >> 2) + 4 * (k & 1) + (jj & 3); v[jj] = bf1(tile[i * TSTR + c]); }
        *(u32x4*)(img + (img_row0 + c) * TK + tok0 + 8 * k) = pack8(v); }
}
template <class F>
__device__ __forceinline__ void load_tile(const Ctx& X, bf16_t* tile, const bf16_t* src, size_t rstride, F colmap) {
#pragma unroll 4
    for (int it = 0; it < 8; ++it) { const int ch = it * 512 + X.tid; const int i = ch >> 6, cc = ch & 63;
        const u32x4 w = *(const u32x4*)(src + (size_t)i * rstride + colmap(cc));
        *(u32x4*)(tile + i * TSTR + 8 * cc) = w; }
}

__device__ __forceinline__ void rope_cs(int sub, int prow, int pcol, float* cs, float* sn) {
    const float pos = (float)((sub < 4) ? prow : pcol);
#pragma unroll
    for (int e = 0; e < 8; ++e) { const int fi = (sub & 1) * 8 + e; const float inv = exp2f(-(float)fi * (13.287712379549449f / 16.0f)); const float a = pos * inv; cs[e] = __cosf(a); sn[e] = __sinf(a); }
}
__device__ __forceinline__ void rope_apply(int sub, float* y, const float* cs, const float* sn) {
#pragma unroll
    for (int e = 0; e < 8; ++e) { const float p = __shfl_xor(y[e], 2); y[e] = (sub & 2) ? (y[e] * cs[e] + p * sn[e]) : (y[e] * cs[e] - p * sn[e]); }
}

__device__ __forceinline__ void prep_phase(const Ctx& X0, const Params& P, int l) {
    const Ctx X = fresh(X0);
    unsigned char* ws = P.ws;
    const bf16_t* proj = (const bf16_t*)(ws + WS_PROJ);
    bf16_t* tile = (bf16_t*)X.lds;
    const float* qkg = P.in[I_DAQKG] + l * 128;
    const float* convw = P.in[I_CONVW] + (size_t)l * 3 * 1024; const float* convb = P.in[I_CONVB] + l * 1024;
    const float* qng = P.in[I_QNG] + l * 512; const float* kvng = P.in[I_KVNG] + l * 256;
    const int lane = X.lane, sub = lane & 7;
    const float qscale = 0.125f * LOG2E;
    for (int u = X.wg; u < 272; u += X.nwg) {
        const ChunkId c = chunk_of_unit(u);
        for (int i = X.wave; i < 64; i += 8) {
            const int row = c.row0 + i, tseg = 64 * c.j + i, tok = c.tok0 + i;
            const bf16_t* pr = proj + (size_t)row * NPROJ;
            float cs[8], sn[8];
            if (c.is_lat) rope_cs(sub, c.j, i, cs, sn);
#pragma unroll
            for (int qk = 0; qk < 2; ++qk) {
                float y[8]; unpack8(*(const u32x4*)(pr + (qk ? C_DAK : C_DAQ) + 8 * lane), y);
                float ss = 0.f;
#pragma unroll
                for (int e = 0; e < 8; ++e) ss += y[e] * y[e];
                ss += __shfl_xor(ss, 1); ss += __shfl_xor(ss, 2); ss += __shfl_xor(ss, 4);
                const float rstd = rsqrtf(ss * (1.f / 64.f) + EPS);
#pragma unroll
                for (int e = 0; e < 8; ++e) y[e] = y[e] * rstd * qkg[qk * 64 + 8 * sub + e];
                if (c.is_lat) rope_apply(sub, y, cs, sn);
                const int head = lane >> 4, comp = (lane >> 3) & 1;
                if (qk == 0) {
#pragma unroll
                    for (int e = 0; e < 8; ++e) y[e] *= qscale;
                    *(u32x4*)((bf16_t*)(ws + WS_QDA) + ((size_t)head * M_ALL + row) * 128 + comp * 64 + 8 * sub) = pack8(y);
                } else {
                    *(u32x4*)((bf16_t*)(ws + WS_KDA) + ((size_t)(c.b * 4 + head) * TK + tok) * 128 + comp * 64 + 8 * sub) = pack8(y);
                }
            }
            {
                float y[8]; unpack8(*(const u32x4*)(pr + C_CQ + 8 * lane), y);
                float ss = 0.f;
#pragma unroll
                for (int e = 0; e < 8; ++e) ss += y[e] * y[e];
                const float rstd = rsqrtf(wave_sum(ss) * (1.f / 512.f) + EPS);
#pragma unroll
                for (int e = 0; e < 8; ++e) y[e] = y[e] * rstd * qng[8 * lane + e];
                *(u32x4*)((bf16_t*)(ws + WS_CQN) + (size_t)row * 512 + 8 * lane) = pack8(y);
            }
            {
                float y[8];
                if (lane < 32) unpack8(*(const u32x4*)(pr + C_CKV + 8 * lane), y);
                else {
#pragma unroll
                    for (int e = 0; e < 8; ++e) y[e] = 0.f;
                }
                float ss = 0.f;
#pragma unroll
                for (int e = 0; e < 8; ++e) ss += y[e] * y[e];
                const float rstd = rsqrtf(wave_sum(ss) * (1.f / 256.f) + EPS);
                if (lane < 32) {
#pragma unroll
                    for (int e = 0; e < 8; ++e) y[e] = y[e] * rstd * kvng[8 * lane + e];
                    *(u32x4*)((bf16_t*)(ws + WS_CKVN) + (size_t)row * 256 + 8 * lane) = pack8(y);
                }
            }
            if (lane < 8) *(u32x4*)((bf16_t*)(ws + WS_KPE) + (size_t)row * 64 + 8 * lane) = *(const u32x4*)(pr + C_KPE + 8 * lane);
            *(u32x4*)((bf16_t*)(ws + WS_OCOPY) + (size_t)row * 512 + 8 * lane) = *(const u32x4*)(pr + C_MLO + 8 * lane);
#pragma unroll
            for (int qk = 0; qk < 2; ++qk) {
                const int ch0 = qk * 512 + 8 * lane;
                float xm[8], x0[8], xp[8];
                unpack8(*(const u32x4*)(pr + C_MLQ + ch0), x0);
                if (tseg > 0) unpack8(*(const u32x4*)(pr - NPROJ + C_MLQ + ch0), xm);
                else {
#pragma unroll
                    for (int e = 0; e < 8; ++e) xm[e] = 0.f;
                }
                if (tseg < c.seglen - 1) unpack8(*(const u32x4*)(pr + NPROJ + C_MLQ + ch0), xp);
                else {
#pragma unroll
                    for (int e = 0; e < 8; ++e) xp[e] = 0.f;
                }
                float y[8];
#pragma unroll
                for (int e = 0; e < 8; ++e) { const float v = convb[ch0 + e] + convw[ch0 + e] * xm[e] + convw[1024 + ch0 + e] * x0[e] + convw[2048 + ch0 + e] * xp[e]; y[e] = siluf(v) * (qk ? 0.08838834764831845f : 1.0f); }
                const int head = lane >> 4, d = 8 * (lane & 15);
                const u32x4 w = pack8(y);
                *(u32x4*)((bf16_t*)(ws + (qk ? WS_KML : WS_QML)) + ((size_t)(c.b * 4 + head) * TK + tok) * 128 + d) = w;
                if (qk) *(u32x4*)(tile + i * TSTR + 8 * lane) = w;
            }
        }
        __syncthreads();
        write_vt(X, tile, (bf16_t*)(ws + WS_KTML), (size_t)c.b * 512, c.tok0);
        __syncthreads();
        load_tile(X, tile, proj + (size_t)c.row0 * NPROJ, NPROJ, [](int cc) { return C_DAV + 8 * cc; });
        __syncthreads();
        write_vt(X, tile, (bf16_t*)(ws + WS_VTDA), (size_t)c.b * 512, c.tok0);
        __syncthreads();
        load_tile(X, tile, proj + (size_t)c.row0 * NPROJ, NPROJ, [](int cc) { return C_MLV + 8 * cc; });
        __syncthreads();
        write_vt(X, tile, (bf16_t*)(ws + WS_VTML), (size_t)c.b * 512, c.tok0);
        __syncthreads();
    }
}

__device__ __forceinline__ void mla_prep_phase(const Ctx& X0, const Params& P, int l) {
    const Ctx X = fresh(X0);
    unsigned char* ws = P.ws;
    const bf16_t* qup = (const bf16_t*)(ws + WS_QUP); const bf16_t* kvup = (const bf16_t*)(ws + WS_KVUP); const bf16_t* kpe = (const bf16_t*)(ws + WS_KPE);
    bf16_t* tile = (bf16_t*)X.lds;
    const float* g = P.in[I_MLAQKG] + l * 2 * 192;
    const int lane = X.lane, sub = lane & 7, head = lane >> 3;
    const float qscale = 0.07216878364870322f * LOG2E;
    for (int u = X.wg; u < 272; u += X.nwg) {
        const ChunkId c = chunk_of_unit(u);
        for (int i = X.wave; i < 64; i += 8) {
            const int row = c.row0 + i, tok = c.tok0 + i;
            float cs[8], sn[8];
            if (c.is_lat) rope_cs(sub, c.j, i, cs, sn);
#pragma unroll
            for (int qk = 0; qk < 2; ++qk) {
                float y[3][8];
                if (qk == 0) {
#pragma unroll
                    for (int cc = 0; cc < 3; ++cc) unpack8(*(const u32x4*)(qup + (size_t)row * 1536 + head * 192 + 64 * cc + 8 * sub), y[cc]);
                } else {
#pragma unroll
                    for (int cc = 0; cc < 2; ++cc) unpack8(*(const u32x4*)(kvup + (size_t)row * 2048 + head * 256 + 64 * cc + 8 * sub), y[cc]);
                    unpack8(*(const u32x4*)(kpe + (size_t)row * 64 + 8 * sub), y[2]);
                }
                float ss = 0.f;
#pragma unroll
                for (int cc = 0; cc < 3; ++cc)
#pragma unroll
                    for (int e = 0; e < 8; ++e) ss += y[cc][e] * y[cc][e];
                ss += __shfl_xor(ss, 1); ss += __shfl_xor(ss, 2); ss += __shfl_xor(ss, 4);
                const float rstd = rsqrtf(ss * (1.f / 192.f) + EPS);
#pragma unroll
                for (int cc = 0; cc < 3; ++cc)
#pragma unroll
                    for (int e = 0; e < 8; ++e) y[cc][e] = y[cc][e] * rstd * g[qk * 192 + 64 * cc + 8 * sub + e];
                if (c.is_lat) rope_apply(sub, y[2], cs, sn);
                bf16_t* dst;
                if (qk == 0) {
#pragma unroll
                    for (int cc = 0; cc < 3; ++cc)
#pragma unroll
                        for (int e = 0; e < 8; ++e) y[cc][e] *= qscale;
                    dst = (bf16_t*)(ws + WS_QM) + ((size_t)head * M_ALL + row) * 192;
                } else dst = (bf16_t*)(ws + WS_KM) + ((size_t)(c.b * 8 + head) * TK + tok) * 192;
#pragma unroll
                for (int cc = 0; cc < 3; ++cc) *(u32x4*)(dst + 64 * cc + 8 * sub) = pack8(y[cc]);
            }
        }
        for (int p = 0; p < 2; ++p) {
            __syncthreads();
            load_tile(X, tile, kvup + (size_t)c.row0 * 2048, 2048, [p](int cc) { return (4 * p + (cc >> 4)) * 256 + 128 + 8 * (cc & 15); });
            __syncthreads();
            write_vt(X, tile, (bf16_t*)(ws + WS_VTM), (size_t)(c.b * 8 + 4 * p) * 128, c.tok0);
        }
        __syncthreads();
    }
}

__device__ __forceinline__ void ml_gates(const float* gates, const float* gb, int b, int jt, int dir, int h, int lane, float& ig, float& lf, float& pre, float& total) {
    const int row = row_of_tokchunk(b, jt) + lane;
    ig = gates[(size_t)row * 16 + dir * 8 + h] + gb[dir * 8 + h];
    const float fg = gates[(size_t)row * 16 + dir * 8 + 4 + h] + gb[dir * 8 + 4 + h];
    lf = fminf(fg, 0.f) - log1pf(__expf(-fabsf(fg)));
    float s = lf;
#pragma unroll
    for (int o = 1; o < 64; o <<= 1) { const float t = __shfl_up(s, o); if (lane >= o) s += t; }
    pre = s; total = __shfl(s, 63);
}
constexpr int KSTR = 72;
constexpr int QSTR = 136;
__device__ __forceinline__ void mlstm_a_phase(const Ctx& X0, const Params& P, int l) {
    const Ctx X = fresh(X0);
    unsigned char* ws = P.ws;
    const float* gates = (const float*)(ws + WS_GATES); const float* gb = P.in[I_GATEB] + l * 16;
    bf16_t* Kt = (bf16_t*)X.lds;
    bf16_t* Vw = (bf16_t*)(X.lds + 128 * KSTR * 2);
    float* wtab = (float*)(X.lds + 3 * 128 * KSTR * 2);
    const int lane = X.lane, r32 = lane & 31, hi = lane >> 5;
    for (int u = X.wg; u < 16 * NCH; u += X.nwg) {
        const int bh = u / NCH, jt = u % NCH, b = bh >> 2, h = bh & 3, tok0 = 64 * jt;
        if (X.wave < 2) {
            const int dir = X.wave; float ig, lf, pre, total; ml_gates(gates, gb, b, jt, dir, h, lane, ig, lf, pre, total);
            const float cum = dir == 0 ? pre : total - pre + lf;
            const float wlog = total - cum + ig; const float mloc = wave_max(wlog);
            wtab[dir * 64 + lane] = __expf(wlog - mloc);
            if (lane == 0) { float* cs = (float*)(ws + WS_CSTAT) + ((size_t)(bh * 2 + dir) * NCH + jt) * 4; cs[0] = total; cs[1] = mloc; }
        }
        u32x4 vr[2];
#pragma unroll
        for (int it = 0; it < 2; ++it) { const int ch = it * 512 + X.tid; const int rr = ch >> 3, k = ch & 7;
            *(u32x4*)(Kt + rr * KSTR + 8 * k) = *(const u32x4*)((const bf16_t*)(ws + WS_KTML) + ((size_t)bh * 128 + rr) * TK + tok0 + 8 * k);
            vr[it] = *(const u32x4*)((const bf16_t*)(ws + WS_VTML) + ((size_t)bh * 128 + rr) * TK + tok0 + 8 * k); }
        __syncthreads();
#pragma unroll
        for (int it = 0; it < 2; ++it) { const int ch = it * 512 + X.tid; const int rr = ch >> 3, k = ch & 7;
            float v[8]; unpack8(vr[it], v);
#pragma unroll
            for (int dir = 0; dir < 2; ++dir) { float o[8];
#pragma unroll
                for (int jj = 0; jj < 8; ++jj) { const int i = 16 * (k >> 1) + 8 * (jj >> 2) + 4 * (k & 1) + (jj & 3); o[jj] = v[jj] * wtab[dir * 64 + i]; }
                *(u32x4*)(Vw + (dir * 128 + rr) * KSTR + 8 * k) = pack8(o); } }
        __syncthreads();
        {
            const int dir = X.wave >> 2, dvb = X.wave & 3;
            bf16_t* U = (bf16_t*)(ws + WS_AB) + ((size_t)(bh * 2 + dir) * NCH + jt) * 16384;
            bf16x8 a[4];
#pragma unroll
            for (int ks = 0; ks < 4; ++ks) a[ks] = *(const bf16x8*)(Vw + (dir * 128 + 32 * dvb + r32) * KSTR + 16 * ks + 8 * hi);
            for (int dkb = 0; dkb < 4; ++dkb) {
                f32x16 acc;
#pragma unroll
                for (int r = 0; r < 16; ++r) acc[r] = 0.f;
#pragma unroll
                for (int ks = 0; ks < 4; ++ks) { const bf16x8 bb = *(const bf16x8*)(Kt + (32 * dkb + r32) * KSTR + 16 * ks + 8 * hi); acc = __builtin_amdgcn_mfma_f32_32x32x16_bf16(a[ks], bb, acc, 0, 0, 0); }
#pragma unroll
                for (int r = 0; r < 16; ++r) U[(32 * dvb + crow(r, hi)) * 128 + 32 * dkb + r32] = (bf16_t)f2bf(acc[r]);
            }
        }
        if (X.tid < 256) { const int dir = X.tid >> 7, dk = X.tid & 127; float s = 0.f;
#pragma unroll 8
            for (int p = 0; p < 64; ++p) { const int i = (p & ~15) + perm_off(p & 15); s += wtab[dir * 64 + i] * bf1(Kt[dk * KSTR + p]); }
            ((float*)(ws + WS_NU))[((size_t)(bh * 2 + dir) * NCH + jt) * 128 + dk] = s; }
        __syncthreads();
    }
}
__device__ __forceinline__ int ml_jmap(int dir, int c) { return dir == 0 ? c : (c < 4 ? 3 - c : 71 - c); }
__device__ __forceinline__ void mlstm_scan_phase(const Ctx& X0, const Params& P) {
    const Ctx X = fresh(X0);
    unsigned char* ws = P.ws;
    float* cstat = (float*)(ws + WS_CSTAT);
    const int gtid = X.wg * 512 + X.tid, nthr = X.nwg * 512;
    for (int task = gtid; task < 32 * 4128; task += nthr) {
        const int seq = task / 4128, e = task % 4128, dir = seq & 1;
        float m = 0.f; f32x4 C = (f32x4){0.f, 0.f, 0.f, 0.f};
        if (e < 4096) {
            const bf16_t* U = (const bf16_t*)(ws + WS_AB); bf16_t* S = (bf16_t*)(ws + WS_CSNAP);
#pragma unroll 4
            for (int c = 0; c < NCH; ++c) { const size_t base = (size_t)seq * NCH + ml_jmap(dir, c);
                u32x2 w; w.x = pk2(C[0], C[1]); w.y = pk2(C[2], C[3]); *(u32x2*)(S + base * 16384 + 4 * e) = w;
                const float total = cstat[base * 4], mloc = cstat[base * 4 + 1];
                if (e == 0) cstat[base * 4 + 2] = m;
                const float mn = fmaxf(total + m, mloc); const float dec = __expf(total + m - mn), sc = __expf(mloc - mn);
                const u32x2 uu = *(const u32x2*)(U + base * 16384 + 4 * e);
                C = C * dec + (f32x4){bflo(uu.x), bfhi(uu.x), bflo(uu.y), bfhi(uu.y)} * sc; m = mn; }
        } else {
            const int e4 = e - 4096; const float* NU = (const float*)(ws + WS_NU); float* NS = (float*)(ws + WS_NSNAP);
#pragma unroll 4
            for (int c = 0; c < NCH; ++c) { const size_t base = (size_t)seq * NCH + ml_jmap(dir, c);
                *(f32x4*)(NS + base * 128 + 4 * e4) = C;
                const float total = cstat[base * 4], mloc = cstat[base * 4 + 1];
                const float mn = fmaxf(total + m, mloc); const float dec = __expf(total + m - mn), sc = __expf(mloc - mn);
                C = C * dec + *(const f32x4*)(NU + base * 128 + 4 * e4) * sc; m = mn; }
        }
    }
}
__device__ __forceinline__ void mlstm_c_unit(const Ctx& X0, const Params& P, int l, int u) {
    const Ctx X = fresh(X0);
    unsigned char* ws = P.ws;
    const float* gates = (const float*)(ws + WS_GATES); const float* gb = P.in[I_GATEB] + l * 16;
    const float* cstat = (const float*)(ws + WS_CSTAT);
    bf16_t* Qt = (bf16_t*)X.lds;
    bf16_t* Kn = (bf16_t*)(X.lds + 64 * QSTR * 2);
    bf16_t* Vt = (bf16_t*)(X.lds + 2 * 64 * QSTR * 2);
    float* tab = (float*)(X.lds + 2 * 64 * QSTR * 2 + 128 * KSTR * 2);
    float* t_a = tab, *t_c1 = tab + 128, *t_wp = tab + 256, *t_em = tab + 384, *t_n = tab + 512, *t_red = tab + 768;
    const int lane = X.lane, r32 = lane & 31, hi = lane >> 5;
    const int bh = u / NCH, jt = u % NCH, b = bh >> 2, h = bh & 3, tok0 = 64 * jt;
    if (X.wave < 2) {
        const int dir = X.wave; float ig, lf, pre, total; ml_gates(gates, gb, b, jt, dir, h, lane, ig, lf, pre, total);
        const float cum = dir == 0 ? pre : total - pre + lf;
        const float a = ig - cum; float pm = a;
#pragma unroll
        for (int o = 1; o < 64; o <<= 1) { const float t = dir == 0 ? __shfl_up(pm, o) : __shfl_down(pm, o); const bool ok = dir == 0 ? (lane >= o) : (lane + o < 64); if (ok) pm = fmaxf(pm, t); }
        const float mc = cstat[((size_t)(bh * 2 + dir) * NCH + jt) * 4 + 2];
        const float mt = cum + fmaxf(mc, pm);
        t_a[dir * 64 + lane] = a; t_c1[dir * 64 + lane] = cum - mt; t_wp[dir * 64 + lane] = __expf(cum + mc - mt); t_em[dir * 64 + lane] = __expf(-mt);
    }
#pragma unroll
    for (int it = 0; it < 2; ++it) { const int ch = it * 512 + X.tid;
        { const int i = ch >> 4, k = ch & 15;
          *(u32x4*)(Qt + i * QSTR + 8 * k) = *(const u32x4*)((const bf16_t*)(ws + WS_QML) + ((size_t)bh * TK + tok0 + i) * 128 + 8 * k);
          *(u32x4*)(Kn + i * QSTR + 8 * k) = *(const u32x4*)((const bf16_t*)(ws + WS_KML) + ((size_t)bh * TK + tok0 + i) * 128 + 8 * k); }
        { const int rr = ch >> 3, k = ch & 7;
          *(u32x4*)(Vt + rr * KSTR + 8 * k) = *(const u32x4*)((const bf16_t*)(ws + WS_VTML) + ((size_t)bh * 128 + rr) * TK + tok0 + 8 * k); } }
    if (X.tid < 256) t_n[X.tid] = ((const float*)(ws + WS_NSNAP))[((size_t)(bh * 2 + (X.tid >> 7)) * NCH + jt) * 128 + (X.tid & 127)];
    __syncthreads();
    const int tb = X.wave & 1, db = X.wave >> 1, t = 32 * tb + r32;
    bf16x8 qf[8];
#pragma unroll
    for (int ks = 0; ks < 8; ++ks) qf[ks] = *(const bf16x8*)(Qt + t * QSTR + 16 * ks + 8 * hi);
    f32x16 st[2];
#pragma unroll
    for (int sb = 0; sb < 2; ++sb) {
#pragma unroll
        for (int r = 0; r < 16; ++r) st[sb][r] = 0.f;
#pragma unroll
        for (int ks = 0; ks < 8; ++ks) { const bf16x8 kf = *(const bf16x8*)(Kn + (32 * sb + r32) * QSTR + 16 * ks + 8 * hi); st[sb] = __builtin_amdgcn_mfma_f32_32x32x16_bf16(kf, qf[ks], st[sb], 0, 0, 0); }
    }
    f32x16 hsum;
#pragma unroll
    for (int r = 0; r < 16; ++r) hsum[r] = 0.f;
#pragma unroll
    for (int dir = 0; dir < 2; ++dir) {
        const float c1 = t_c1[dir * 64 + t], wp = t_wp[dir * 64 + t], em = t_em[dir * 64 + t];
        float rs = 0.f; u32x4 pw[2][2];
#pragma unroll
        for (int sb = 0; sb < 2; ++sb) { float p[16];
#pragma unroll
            for (int r = 0; r < 16; ++r) { const int s = 32 * sb + crow(r, hi); const bool ok = dir == 0 ? (s <= t) : (s >= t);
                const float dm = ok ? __expf(t_a[dir * 64 + s] + c1) : 0.f; p[r] = st[sb][r] * dm; rs += p[r]; }
            pw[sb][0] = pack8(p); pw[sb][1] = pack8(p + 8); }
        rs += __shfl_xor(rs, 32);
        float qn = 0.f;
#pragma unroll
        for (int ks = 0; ks < 8; ++ks) { float q8[8]; unpack8(__builtin_bit_cast(u32x4, qf[ks]), q8);
#pragma unroll
            for (int e = 0; e < 8; ++e) qn += q8[e] * t_n[dir * 128 + 16 * ks + 8 * hi + e]; }
        qn += __shfl_xor(qn, 32);
        const float den = rs + wp * qn; const float rden = 1.f / fmaxf(fabsf(den), em);
        f32x16 acc;
#pragma unroll
        for (int r = 0; r < 16; ++r) acc[r] = 0.f;
        const bf16_t* Cs = (const bf16_t*)(ws + WS_CSNAP) + ((size_t)(bh * 2 + dir) * NCH + jt) * 16384 + (size_t)(32 * db + r32) * 128;
#pragma unroll
        for (int ks = 0; ks < 8; ++ks) { const bf16x8 cf = *(const bf16x8*)(Cs + 16 * ks + 8 * hi); acc = __builtin_amdgcn_mfma_f32_32x32x16_bf16(cf, qf[ks], acc, 0, 0, 0); }
#pragma unroll
        for (int r = 0; r < 16; ++r) acc[r] *= wp;
#pragma unroll
        for (int sb = 0; sb < 2; ++sb)
#pragma unroll
            for (int s2 = 0; s2 < 2; ++s2) { const bf16x8 vf = *(const bf16x8*)(Vt + (32 * db + r32) * KSTR + 32 * sb + 16 * s2 + 8 * hi);
                acc = __builtin_amdgcn_mfma_f32_32x32x16_bf16(vf, __builtin_bit_cast(bf16x8, pw[sb][s2]), acc, 0, 0, 0); }
#pragma unroll
        for (int r = 0; r < 16; ++r) hsum[r] += acc[r] * rden;
    }
    float ss = 0.f;
#pragma unroll
    for (int r = 0; r < 16; ++r) ss += hsum[r] * hsum[r];
    ss += __shfl_xor(ss, 32);
    if (hi == 0) t_red[(tb * 4 + db) * 32 + r32] = ss;
    __syncthreads();
    const float tot = t_red[(tb * 4 + 0) * 32 + r32] + t_red[(tb * 4 + 1) * 32 + r32] + t_red[(tb * 4 + 2) * 32 + r32] + t_red[(tb * 4 + 3) * 32 + r32];
    const float rstd = rsqrtf(tot * (1.f / 128.f) + EPS);
    const int row = row_of_tokchunk(b, jt) + t;
    const float* og = P.in[I_MLOUTG] + l * 512 + h * 128;
    const bf16_t* oc = (const bf16_t*)(ws + WS_OCOPY) + (size_t)row * 512 + h * 128;
    bf16_t* mix = (bf16_t*)(ws + WS_AB) + (size_t)row * DM + 512 + h * 128;
#pragma unroll
    for (int q = 0; q < 4; ++q) { const int dv = 32 * db + 8 * q + 4 * hi;
        const u32x2 ow = *(const u32x2*)(oc + dv); const f32x4 gg = *(const f32x4*)(og + dv);
        const float o0 = hsum[4 * q + 0] * rstd * gg[0] * sigmf(bflo(ow.x)), o1 = hsum[4 * q + 1] * rstd * gg[1] * sigmf(bfhi(ow.x));
        const float o2 = hsum[4 * q + 2] * rstd * gg[2] * sigmf(bflo(ow.y)), o3 = hsum[4 * q + 3] * rstd * gg[3] * sigmf(bfhi(ow.y));
        u32x2 w; w.x = pk2(o0, o1); w.y = pk2(o2, o3); *(u32x2*)(mix + dv) = w; }
    __syncthreads();
}

template <int DQK, int KROW>
struct AttnCore {
    static constexpr int KS = KROW + 8, KT_B = 64 * KS * 2, VT_B = 128 * KSTR * 2, BUF_B = KT_B + VT_B, NKC = KROW / 8, NKR = (64 * NKC) / 512;
    static __device__ __forceinline__ void run(const Ctx& X, const bf16_t* Qrow  , int kcol  ,
                                               const bf16_t* K, const bf16_t* Vt, int nt, f32x16 (&o)[4]) {
        const int lane = X.lane, r32 = lane & 31, hi = lane >> 5;
        bf16x8 qf[DQK / 16];
#pragma unroll
        for (int ks = 0; ks < DQK / 16; ++ks) qf[ks] = *(const bf16x8*)(Qrow + 16 * ks + 8 * hi);
#pragma unroll
        for (int d = 0; d < 4; ++d)
#pragma unroll
            for (int r = 0; r < 16; ++r) o[d][r] = 0.f;
        float mrun = -1e30f, lrun = 0.f;
        u32x4 kr[NKR], vr[2];
        auto gload = [&](int t) {
#pragma unroll
            for (int it = 0; it < NKR; ++it) { const int ch = it * 512 + X.tid; const int i = ch / NKC, k = ch % NKC; kr[it] = *(const u32x4*)(K + (size_t)(64 * t + i) * KROW + 8 * k); }
#pragma unroll
            for (int it = 0; it < 2; ++it) { const int ch = it * 512 + X.tid; const int rr = ch >> 3, k = ch & 7; vr[it] = *(const u32x4*)(Vt + (size_t)rr * TK + 64 * t + 8 * k); }
        };
        auto lstore = [&](int buf) {
            bf16_t* kt = (bf16_t*)(X.lds + buf * BUF_B); bf16_t* vt = (bf16_t*)(X.lds + buf * BUF_B + KT_B);
#pragma unroll
            for (int it = 0; it < NKR; ++it) { const int ch = it * 512 + X.tid; const int i = ch / NKC, k = ch % NKC; *(u32x4*)(kt + i * KS + 8 * k) = kr[it]; }
#pragma unroll
            for (int it = 0; it < 2; ++it) { const int ch = it * 512 + X.tid; const int rr = ch >> 3, k = ch & 7; *(u32x4*)(vt + rr * KSTR + 8 * k) = vr[it]; }
        };
        gload(0); lstore(0); __syncthreads();
        for (int t = 0; t < nt; ++t) {
            if (t + 1 < nt) gload(t + 1);
            const bf16_t* kt = (const bf16_t*)(X.lds + (t & 1) * BUF_B); const bf16_t* vt = (const bf16_t*)(X.lds + (t & 1) * BUF_B + KT_B);
            f32x16 s0, s1;
#pragma unroll
            for (int r = 0; r < 16; ++r) { s0[r] = 0.f; s1[r] = 0.f; }
#pragma unroll
            for (int ks = 0; ks < DQK / 16; ++ks) {
                const bf16x8 a0 = *(const bf16x8*)(kt + r32 * KS + kcol + 16 * ks + 8 * hi);
                const bf16x8 a1 = *(const bf16x8*)(kt + (32 + r32) * KS + kcol + 16 * ks + 8 * hi);
                s0 = __builtin_amdgcn_mfma_f32_32x32x16_bf16(a0, qf[ks], s0, 0, 0, 0);
                s1 = __builtin_amdgcn_mfma_f32_32x32x16_bf16(a1, qf[ks], s1, 0, 0, 0);
            }
            float mx = fmaxf(s0[0], s1[0]);
#pragma unroll
            for (int r = 1; r < 16; ++r) mx = fmaxf(mx, fmaxf(s0[r], s1[r]));
            mx = fmaxf(mx, __shfl_xor(mx, 32));
            const float mnew = fmaxf(mrun, mx); const float alpha = exp2f(mrun - mnew); mrun = mnew;
            float rs = 0.f;
#pragma unroll
            for (int r = 0; r < 16; ++r) { s0[r] = exp2f(s0[r] - mnew); s1[r] = exp2f(s1[r] - mnew); rs += s0[r] + s1[r]; }
            lrun = lrun * alpha + rs;
            if (__any(alpha != 1.f)) {
#pragma unroll
                for (int d = 0; d < 4; ++d)
#pragma unroll
                    for (int r = 0; r < 16; ++r) o[d][r] *= alpha;
            }
            bf16x8 pf[2][2];
            { float p[16];
#pragma unroll
              for (int r = 0; r < 16; ++r) p[r] = s0[r];
              pf[0][0] = __builtin_bit_cast(bf16x8, pack8(p)); pf[0][1] = __builtin_bit_cast(bf16x8, pack8(p + 8));
#pragma unroll
              for (int r = 0; r < 16; ++r) p[r] = s1[r];
              pf[1][0] = __builtin_bit_cast(bf16x8, pack8(p)); pf[1][1] = __builtin_bit_cast(bf16x8, pack8(p + 8)); }
#pragma unroll
            for (int d = 0; d < 4; ++d)
#pragma unroll
                for (int kb = 0; kb < 2; ++kb)
#pragma unroll
                    for (int s2 = 0; s2 < 2; ++s2) { const bf16x8 vf = *(const bf16x8*)(vt + (32 * d + r32) * KSTR + 32 * kb + 16 * s2 + 8 * hi);
                        o[d] = __builtin_amdgcn_mfma_f32_32x32x16_bf16(vf, pf[kb][s2], o[d], 0, 0, 0); }
            if (t + 1 < nt) lstore((t + 1) & 1);
            __syncthreads();
        }
        lrun += __shfl_xor(lrun, 32);
        const float rl = 1.f / lrun;
#pragma unroll
        for (int d = 0; d < 4; ++d)
#pragma unroll
            for (int r = 0; r < 16; ++r) o[d][r] *= rl;
    }
};

__device__ __forceinline__ void mla_attn_unit(const Ctx& X0, const Params& P, int b, int h, int q0, int is_ctx) {
    const Ctx X = fresh(X0);
    unsigned char* ws = P.ws;
    const int lane = X.lane, r32 = lane & 31, hi = lane >> 5;
    const int row = (is_ctx ? M_LAT + b * CTXL : b * SEQ) + q0 + 32 * X.wave + r32;
    const bf16_t* Q = (const bf16_t*)(ws + WS_QM) + ((size_t)h * M_ALL + row) * 192;
    const bf16_t* K = (const bf16_t*)(ws + WS_KM) + (size_t)(b * 8 + h) * TK * 192;
    const bf16_t* Vt = (const bf16_t*)(ws + WS_VTM) + (size_t)(b * 8 + h) * 128 * TK;
    f32x16 o[4];
    AttnCore<192, 192>::run(X, Q, 0, K, Vt, is_ctx ? 4 : NCH, o);
    bf16_t* mix = (bf16_t*)(ws + WS_AB) + (size_t)row * DM + 1024 + h * 128;
#pragma unroll
    for (int d = 0; d < 4; ++d)
#pragma unroll
        for (int q = 0; q < 4; ++q) { u32x2 w; w.x = pk2(o[d][4 * q], o[d][4 * q + 1]); w.y = pk2(o[d][4 * q + 2], o[d][4 * q + 3]); *(u32x2*)(mix + 32 * d + 8 * q + 4 * hi) = w; }
}
__device__ __forceinline__ void da_attn_unit(const Ctx& X0, const Params& P, int l, int b, int h, int q0, int is_ctx, float lam, float lam_init) {
    const Ctx X = fresh(X0);
    unsigned char* ws = P.ws;
    const int lane = X.lane, r32 = lane & 31, hi = lane >> 5;
    const int comp = X.wave >> 2, qs = X.wave & 3;
    const int row = (is_ctx ? M_LAT + b * CTXL : b * SEQ) + q0 + 32 * qs + r32;
    const bf16_t* Q = (const bf16_t*)(ws + WS_QDA) + ((size_t)h * M_ALL + row) * 128 + comp * 64;
    const bf16_t* K = (const bf16_t*)(ws + WS_KDA) + (size_t)(b * 4 + h) * TK * 128;
    const bf16_t* Vt = (const bf16_t*)(ws + WS_VTDA) + (size_t)(b * 4 + h) * 128 * TK;
    f32x16 o[4];
    AttnCore<64, 128>::run(X, Q, comp * 64, K, Vt, is_ctx ? 4 : NCH, o);
    float* xch = (float*)X.lds;
    if (comp == 1) {
#pragma unroll
        for (int d = 0; d < 4; ++d)
#pragma unroll
            for (int r = 0; r < 16; ++r) xch[(qs * 64 + d * 16 + r) * 64 + lane] = o[d][r];
    }
    __syncthreads();
    if (comp == 0) {
        float ss = 0.f;
#pragma unroll
        for (int d = 0; d < 4; ++d)
#pragma unroll
            for (int r = 0; r < 16; ++r) { o[d][r] -= lam * xch[(qs * 64 + d * 16 + r) * 64 + lane]; ss += o[d][r] * o[d][r]; }
        ss += __shfl_xor(ss, 32);
        const float rstd = rsqrtf(ss * (1.f / 128.f) + EPS) * (1.f - lam_init);
        const float* og = P.in[I_DAOUTG] + l * 128;
        bf16_t* mix = (bf16_t*)(ws + WS_AB) + (size_t)row * DM + h * 128;
#pragma unroll
        for (int d = 0; d < 4; ++d)
#pragma unroll
            for (int q = 0; q < 4; ++q) { const int dv = 32 * d + 8 * q + 4 * hi; const f32x4 gg = *(const f32x4*)(og + dv);
                u32x2 w; w.x = pk2(o[d][4 * q] * rstd * gg[0], o[d][4 * q + 1] * rstd * gg[1]); w.y = pk2(o[d][4 * q + 2] * rstd * gg[2], o[d][4 * q + 3] * rstd * gg[3]);
                *(u32x2*)(mix + dv) = w; }
    }
    __syncthreads();
}

__device__ __forceinline__ void mixer_phase(const Ctx& X, const Params& P, int l) {
    const float* lp = P.in[I_DALAM] + l * 256;
    float s1 = 0.f, s2 = 0.f;
    for (int i = 0; i < 64; ++i) { s1 += lp[i] * lp[64 + i]; s2 += lp[128 + i] * lp[192 + i]; }
    const float lam_init = 0.8f - 0.6f * expf(-0.3f * (float)l);
    const float lam = expf(s1) - expf(s2) + lam_init;
    const bool need_ctx = l < DEPTH - 1;
    if (EN(13)) for (int u = X.wg; u < 512; u += X.nwg) mla_attn_unit(X, P, u >> 7, (u >> 4) & 7, (u & 15) * 256, 0);
    if (EN(14)) for (int v = X.wg; v < 512; v += X.nwg) da_attn_unit(X, P, l, v >> 7, (v >> 5) & 3, (v & 31) * 128, 0, lam, lam_init);
    if (EN(15)) for (int u = X.wg; u < 16 * NCH; u += X.nwg) mlstm_c_unit(X, P, l, u);
    if (need_ctx) {
        if (EN(13)) for (int v = X.wg; v < 32; v += X.nwg) mla_attn_unit(X, P, v >> 3, v & 7, 0, 1);
        if (EN(14)) for (int v = X.nwg - 1 - X.wg; v < 32; v += X.nwg) da_attn_unit(X, P, l, v >> 3, (v >> 1) & 3, (v & 1) * 128, 1, lam, lam_init);
    }
}

__global__ void __launch_bounds__(512, 2) fwd_megakernel(Params P) {
    extern __shared__ __attribute__((aligned(16))) unsigned char lds[];
    cg::grid_group grid = cg::this_grid();
    Ctx X; X.lds = lds; X.tid = threadIdx.x; X.lane = X.tid & 63; X.wave = __builtin_amdgcn_readfirstlane(X.tid >> 6);
    X.nwg = gridDim.x; X.wg = blockIdx.x; X.gw = X.wg * 8 + X.wave; X.ngw = X.nwg * 8;
    LAS unsigned char* lds3 = (LAS unsigned char*)lds;
    unsigned char* ws = P.ws;
    float* R_lat = P.out; float* R_ctx = (float*)(ws + WS_RCTX);
    bf16_t* AB = (bf16_t*)(ws + WS_AB);

    if (EN(0)) mod_gemv(X, P);
    if (EN(1)) convert_weights(X, P, 0);
    grid.sync();
    for (int l = 0; l < DEPTH; ++l) {
        const float* modl = (const float*)(ws + WS_MOD) + (size_t)l * 5 * 6 * DM;
        const float* xin_lat = l == 0 ? P.in[I_X] : R_lat; const float* xin_ctx = l == 0 ? P.in[I_CTX] : R_ctx;
        const int Mfin = l < DEPTH - 1 ? M_ALL : M_LAT;
        if (EN(2)) modulate_phase(X, xin_lat, xin_ctx, P.in[I_N1G] + l * DM, modl, 0 * DM, 1 * DM, AB, M_ALL);
        if (EN(1)) if (l > 0) convert_weights(X, P, l);
        grid.sync();
        if (EN(3)) { pg8::Gemm g{AB, (const bf16_t*)(ws + WS_WIN), M_ALL, NPROJ, DM}; pg8::StaticOrder S; S.init(M_ALL, NPROJ, X.nwg, X.wg);
          pg8::EpiBf16 E{(bf16_t*)(ws + WS_PROJ), NPROJ, (float*)(ws + WS_GATES), C_GATE / 256};
          pg8::gemm_phase<pg8::EpiBf16>(lds3, g, S, E); }
        grid.sync();
        if (EN(4)) prep_phase(X, P, l);
        grid.sync();
        if (EN(5)) { pg8::Gemm g{(const bf16_t*)(ws + WS_CQN), (const bf16_t*)(ws + WS_WUQ), M_ALL, 1536, 512}; pg8::StaticOrder S; S.init(M_ALL, 1536, X.nwg, X.wg);
          pg8::EpiBf16 E{(bf16_t*)(ws + WS_QUP), 1536, nullptr, 0};
          pg8::gemm_phase<pg8::EpiBf16>(lds3, g, S, E); }
        if (EN(5)) { pg8::Gemm g{(const bf16_t*)(ws + WS_CKVN), (const bf16_t*)(ws + WS_WUKV), M_ALL, 2048, 256}; pg8::StaticOrder S; S.init(M_ALL, 2048, X.nwg, X.wg);
          pg8::EpiBf16 E{(bf16_t*)(ws + WS_KVUP), 2048, nullptr, 0};
          pg8::gemm_phase<pg8::EpiBf16>(lds3, g, S, E); }
        __syncthreads();
        if (EN(6)) mlstm_a_phase(X, P, l);
        grid.sync();
        if (EN(7)) mla_prep_phase(X, P, l);
        if (EN(8)) mlstm_scan_phase(X, P);
        grid.sync();
        if (EN(9)) mixer_phase(X, P, l);
        grid.sync();
        if (EN(10)) { pg8::Gemm g{AB, (const bf16_t*)(ws + WS_WOUT), Mfin, DM, DM}; pg8::StaticOrder S; S.init(Mfin, DM, X.nwg, X.wg);
          pg8::EpiRes E{xin_lat, xin_ctx, R_lat, R_ctx, modl + 2 * DM};
          pg8::gemm_phase<pg8::EpiRes>(lds3, g, S, E); }
        grid.sync();
        if (EN(2)) modulate_phase(X, R_lat, R_ctx, P.in[I_N2G] + l * DM, modl, 3 * DM, 4 * DM, AB, Mfin);
        grid.sync();
        if (EN(11)) { pg8::Gemm g{AB, (const bf16_t*)(ws + WS_WGU), Mfin, 2 * FF, DM}; pg8::StaticOrder S; S.init(Mfin, 2 * FF, X.nwg, X.wg);
          pg8::EpiSwiGLU E{(bf16_t*)(ws + WS_HID), FF};
          pg8::gemm_phase<pg8::EpiSwiGLU>(lds3, g, S, E); }
        grid.sync();
        if (EN(12)) { pg8::Gemm g{(const bf16_t*)(ws + WS_HID), (const bf16_t*)(ws + WS_WDN), Mfin, DM, FF}; pg8::StaticOrder S; S.init(Mfin, DM, X.nwg, X.wg);
          pg8::EpiRes E{R_lat, R_ctx, R_lat, R_ctx, modl + 5 * DM};
          pg8::gemm_phase<pg8::EpiRes>(lds3, g, S, E); }
        if (l + 1 < DEPTH) grid.sync();
    }
}

extern "C" void kernel_launch(void* const* d_in, const int* in_sizes, int n_in, void* d_out, int out_size, void* d_ws, size_t ws_size, hipStream_t stream) {
    static int grid = 0;
    if (grid == 0) {
        if (n_in != 24 || ws_size < WS_END) { fprintf(stderr, "kernel_launch: unexpected inputs (n_in %d, ws %zu)\n", n_in, ws_size); grid = -1; return; }
        int dev = 0, cus = 0, per_cu = 0;
        (void)hipGetDevice(&dev); (void)hipDeviceGetAttribute(&cus, hipDeviceAttributeMultiprocessorCount, dev);
        if (hipFuncSetAttribute((const void*)fwd_megakernel, hipFuncAttributeMaxDynamicSharedMemorySize, LDS_BYTES) != hipSuccess) { fprintf(stderr, "kernel_launch: hipFuncSetAttribute failed\n"); grid = -1; return; }
        (void)hipOccupancyMaxActiveBlocksPerMultiprocessor(&per_cu, (const void*)fwd_megakernel, 512, LDS_BYTES);
        (void)hipGetLastError();
        if (per_cu < 1) { fprintf(stderr, "kernel_launch: occupancy query says %d\n", per_cu); per_cu = 1; }
        grid = cus;
    }
    if (grid < 0) return;
    Params p{};
    for (int i = 0; i < 24; ++i) p.in[i] = (const float*)d_in[i];
    p.out = (float*)d_out; p.ws = (unsigned char*)d_ws;
    void* args[] = {&p};
    hipError_t e = hipLaunchCooperativeKernel((const void*)fwd_megakernel, dim3(grid), dim3(512), args, LDS_BYTES, stream);
    if (e != hipSuccess) fprintf(stderr, "cooperative launch failed: %s (grid %d)\n", hipGetErrorString(e), grid);
}
```

```cpp
#include <hip/hip_runtime.h>
#include <hip/hip_cooperative_groups.h>
#include <cstdio>
#include <cstdint>
namespace cg = cooperative_groups;

#define LAS __attribute__((address_space(3)))
typedef unsigned short bf16_t;
typedef short bf16x8 __attribute__((ext_vector_type(8)));
typedef float f32x4 __attribute__((ext_vector_type(4)));
typedef float f32x16 __attribute__((ext_vector_type(16)));
typedef unsigned u32x4 __attribute__((ext_vector_type(4)));
typedef unsigned u32x2 __attribute__((ext_vector_type(2)));

constexpr int DM = 2048, BATCH = 4, SEQ = 4096, CTXL = 256, DEPTH = 2;
constexpr int M_LAT = BATCH * SEQ, M_CTX = BATCH * CTXL, M_ALL = M_LAT + M_CTX;
constexpr int TK = CTXL + SEQ;
constexpr int NCH = TK / 64;
constexpr int IN_W = 4432, NPROJ = 4608, FF = 5632;
constexpr int C_DAQ = 0, C_DAK = 512, C_DAV = 1024, C_MLQ = 1536, C_MLK = 2048, C_MLV = 2560, C_MLO = 3072, C_GATE = 3584, C_CQ = 3600, C_CKV = 4112, C_KPE = 4368;
constexpr float EPS = 1e-6f;
constexpr float LOG2E = 1.4426950408889634f;

constexpr size_t MiB = 1u << 20;
constexpr size_t WS_WIN = 0, WS_WOUT = 18 * MiB, WS_WGU = 26 * MiB, WS_WDN = 70 * MiB, WS_WUQ = 92 * MiB, WS_WUKV = 94 * MiB, WS_MOD = 95 * MiB, WS_RCTX = 96 * MiB;
constexpr size_t WS_AB = 104 * MiB;
constexpr size_t WS_PROJ = 172 * MiB;
constexpr size_t WS_QUP = 172 * MiB, WS_KVUP = 223 * MiB, WS_HID = 172 * MiB;
constexpr size_t WS_GATES = 325 * MiB, WS_CQN = 327 * MiB, WS_CKVN = 344 * MiB, WS_KPE = 353 * MiB, WS_OCOPY = 356 * MiB;
constexpr size_t WS_QDA = 373 * MiB, WS_KDA = 390 * MiB, WS_VTDA = 407 * MiB, WS_QML = 424 * MiB, WS_KML = 441 * MiB, WS_KTML = 458 * MiB, WS_VTML = 475 * MiB;
constexpr size_t WS_QM = 492 * MiB, WS_KM = 543 * MiB, WS_VTM = 594 * MiB, WS_CSNAP = 628 * MiB, WS_NSNAP = 696 * MiB, WS_NU = 698 * MiB, WS_CSTAT = 700 * MiB, WS_BAR = 701 * MiB, WS_END = 702 * MiB;
static_assert((size_t)NPROJ * DM * 2 <= 18 * MiB && (size_t)2 * FF * DM * 2 <= 44 * MiB && (size_t)M_ALL * NPROJ * 2 <= 153 * MiB, "ws map");
static_assert(WS_HID + (size_t)M_ALL * FF * 2 <= WS_QDA, "hid overlay");
static_assert(WS_END <= 768 * MiB, "ws fits the guaranteed minimum");

constexpr int LDS_BYTES = 140 * 1024;
#ifndef PH_EN
#define PH_EN 0xFFFF
#endif
#define EN(k) ((PH_EN >> (k)) & 1)
#ifdef PROBE_CAT
#define STAMP(cat) do { xcd_barrier(P.ws); if (blockIdx.x == 0 && threadIdx.x == 0) { volatile unsigned long long* tp_ = (volatile unsigned long long*)(P.ws + WS_END); const unsigned long long t1_ = __builtin_amdgcn_s_memrealtime(); if ((1 << (cat)) & PROBE_CAT) tp_[1] += t1_ - tp_[0]; if ((1 << (cat)) & PROBE_CAT2) tp_[2] += t1_ - tp_[0]; tp_[0] = t1_; } } while (0)
#else
#define STAMP(cat) xcd_barrier(P.ws)
#endif

__device__ __forceinline__ unsigned f2bf(float f) { unsigned u = __builtin_bit_cast(unsigned, f); return (u + 0x7fffu + ((u >> 16) & 1u)) >> 16; }
typedef float f32x2_t __attribute__((ext_vector_type(2))); typedef __bf16 bf16x2_t __attribute__((ext_vector_type(2)));
__device__ __forceinline__ unsigned pk2(float lo, float hi) { f32x2_t v = {lo, hi}; bf16x2_t b = __builtin_convertvector(v, bf16x2_t); return __builtin_bit_cast(unsigned, b); }
__device__ __forceinline__ float bflo(unsigned w) { return __builtin_bit_cast(float, w << 16); }
__device__ __forceinline__ float bfhi(unsigned w) { return __builtin_bit_cast(float, w & 0xffff0000u); }
__device__ __forceinline__ float bf1(bf16_t h) { return __builtin_bit_cast(float, (unsigned)h << 16); }
__device__ __forceinline__ void unpack8(const u32x4 w, float* v) { v[0] = bflo(w.x); v[1] = bfhi(w.x); v[2] = bflo(w.y); v[3] = bfhi(w.y); v[4] = bflo(w.z); v[5] = bfhi(w.z); v[6] = bflo(w.w); v[7] = bfhi(w.w); }
__device__ __forceinline__ u32x4 pack8(const float* v) { u32x4 w; w.x = pk2(v[0], v[1]); w.y = pk2(v[2], v[3]); w.z = pk2(v[4], v[5]); w.w = pk2(v[6], v[7]); return w; }
__device__ __forceinline__ float wave_sum(float v) {
#pragma unroll
    for (int o = 1; o < 64; o <<= 1) v += __shfl_xor(v, o);
    return v;
}
__device__ __forceinline__ float wave_max(float v) {
#pragma unroll
    for (int o = 1; o < 64; o <<= 1) v = fmaxf(v, __shfl_xor(v, o));
    return v;
}
__device__ __forceinline__ float siluf(float x) { return x / (1.f + __expf(-x)); }
__device__ __forceinline__ float sigmf(float x) { return 1.f / (1.f + __expf(-x)); }
__device__ __forceinline__ int crow(int r, int hi) { return (r & 3) + 8 * (r >> 2) + 4 * hi; }
__device__ __forceinline__ int perm_off(int p) { const int h = p >> 3, j = p & 7; return 8 * (j >> 2) + 4 * h + (j & 3); }
__device__ __forceinline__ int mod_batch(int row) { return row < M_LAT ? (row >> 12) : 4; }

namespace pg8 {
constexpr int BM = 256, BK = 64, HALF = 128, HTB = HALF * BK * 2, STAGE_BYTES = 8 * HTB, NXCD = 8, WGM = 8;
__host__ __device__ __forceinline__ int lds_byte(int r, int c) { const int st = (r >> 4) * 2 + (c >> 5), rr = r & 15, cc = c & 31, ob = rr * 64 + cc * 2; return st * 1024 + (ob ^ (((ob >> 9) & 1) << 5)); }
__host__ __device__ __forceinline__ void stage_rc(int b, int& R, int& C) { const int st = b / 1024, sb = b % 1024, swz = sb ^ (((sb >> 9) & 1) << 5); R = (st >> 1) * 16 + swz / 64; C = (st & 1) * 32 + (swz % 64) / 2; }
__host__ __device__ __forceinline__ int perm32(int rho) { const int n = rho >> 4, i = rho & 15; return 8 * (i >> 2) + 4 * n + (i & 3); }

struct Unit { int pm, pn; };
struct Gemm { const bf16_t* A; const bf16_t* Bt; int M, N, K; };

struct StaticOrder {
    int nM, nN, nwg, G, c;
    __device__ void init(int M, int N, int G_, int c_) { nM = M / BM; nN = N / BM; nwg = nM * nN; G = G_; c = c_; }
    __device__ bool next(int i, Unit& u) const {
        const long L = (long)i * G + c; if (L >= nwg) return false;
        int wgid = (int)L; { const int q = nwg / NXCD, r = nwg % NXCD, xcd = wgid % NXCD, off = wgid / NXCD; wgid = (xcd < r ? xcd * (q + 1) : r * (q + 1) + (xcd - r) * q) + off; }
        const int nig = WGM * nN, gid = wgid / nig, fm = gid * WGM, gsz = (nM - fm) < WGM ? (nM - fm) : WGM;
        u.pm = fm + ((wgid % nig) % gsz); u.pn = (wgid % nig) / gsz; return true;
    }
};

struct EpiBf16 {
    static constexpr bool PERM = true;
    bf16_t* O; int ldc; float* gates; int gate_pn;
    __device__ __forceinline__ void operator()(const f32x4 (&acc)[2][2][4][2], const Unit& u, int wr, int wc, int fr, int fq) const {
        const int row0 = u.pm * BM + wr * 64 + fr; const int col0 = u.pn * BM + wc * 32 + 8 * fq;
        const bool g = gates != nullptr && u.pn == gate_pn && wc == 0 && fq < 2;
#pragma unroll
        for (int ai = 0; ai < 2; ++ai)
#pragma unroll
            for (int m = 0; m < 4; ++m) { const int row = row0 + ai * HALF + m * 16; bf16_t* rowp = O + (size_t)row * ldc + col0;
#pragma unroll
                for (int bj = 0; bj < 2; ++bj) { const f32x4 v0 = acc[ai][bj][m][0], v1 = acc[ai][bj][m][1];
                    u32x4 w; w.x = pk2(v0[0], v0[1]); w.y = pk2(v0[2], v0[3]); w.z = pk2(v1[0], v1[1]); w.w = pk2(v1[2], v1[3]);
                    *(u32x4*)(rowp + bj * HALF) = w;
                    if (bj == 0 && g) { *(f32x4*)(gates + (size_t)row * 16 + 8 * fq) = v0; *(f32x4*)(gates + (size_t)row * 16 + 8 * fq + 4) = v1; } } }
    }
};
struct EpiSwiGLU {
    static constexpr bool PERM = true;
    bf16_t* O; int ldc;
    __device__ __forceinline__ void operator()(const f32x4 (&acc)[2][2][4][2], const Unit& u, int wr, int wc, int fr, int fq) const {
        const int row0 = u.pm * BM + wr * 64 + fr; const int col0 = u.pn * HALF + wc * 32 + 8 * fq;
#pragma unroll
        for (int ai = 0; ai < 2; ++ai)
#pragma unroll
            for (int m = 0; m < 4; ++m) { const int row = row0 + ai * HALF + m * 16;
                float o[8];
#pragma unroll
                for (int n = 0; n < 2; ++n)
#pragma unroll
                    for (int i = 0; i < 4; ++i) { const float gt = acc[ai][0][m][n][i], up = acc[ai][1][m][n][i]; o[4 * n + i] = siluf(gt) * up; }
                *(u32x4*)(O + (size_t)row * ldc + col0) = pack8(o); }
    }
};
struct EpiRes {
    static constexpr bool PERM = false;
    const float* res_lat; const float* res_ctx; float* out_lat; float* out_ctx; const float* gate;
    __device__ __forceinline__ void operator()(const f32x4 (&acc)[2][2][4][2], const Unit& u, int wr, int wc, int fr, int fq) const {
        const int row0 = u.pm * BM + wr * 64 + fr; const int col0 = u.pn * BM + wc * 32 + 4 * fq;
#pragma unroll
        for (int ai = 0; ai < 2; ++ai)
#pragma unroll
            for (int m = 0; m < 4; ++m) { const int row = row0 + ai * HALF + m * 16;
                const float* rp = row < M_LAT ? res_lat + (size_t)row * DM : res_ctx + (size_t)(row - M_LAT) * DM;
                float* op = row < M_LAT ? out_lat + (size_t)row * DM : out_ctx + (size_t)(row - M_LAT) * DM;
                const float* gp = gate + (size_t)mod_batch(row) * 6 * DM;
#pragma unroll
                for (int bj = 0; bj < 2; ++bj)
#pragma unroll
                    for (int n = 0; n < 2; ++n) { const int c = col0 + bj * HALF + n * 16;
                        const f32x4 r = *(const f32x4*)(rp + c), g = *(const f32x4*)(gp + c);
                        *(f32x4*)(op + c) = r + g * acc[ai][bj][m][n]; } }
    }
};

template <class Epi, bool ALIGN_EPI = true>
__device__ __forceinline__ void gemm_phase(LAS unsigned char* lds, const Gemm g, const StaticOrder& S, const Epi& E) {
    int tid = threadIdx.x; asm volatile("" : "+v"(tid)); const int wid = __builtin_amdgcn_readfirstlane(tid >> 6), lane = tid & 63, wr = wid >> 2, wc = wid & 3, fr = lane & 15, fq = lane >> 4;
    int K = g.K; asm volatile("" : "+s"(K)); const int nt = K / BK;
    unsigned voffA[2], voffB[2];
#pragma unroll
    for (int i = 0; i < 2; ++i) { int R, C; stage_rc(tid * 16 + i * 8192, R, C); const int Rb = Epi::PERM ? ((R & ~31) + perm32(R & 31)) : R;
        voffA[i] = (unsigned)(R * K + C) * 2u; voffB[i] = (unsigned)(Rb * K + C) * 2u; }
    const size_t kstep = (size_t)(BK * 2);
    const size_t hstep = (size_t)HALF * K * 2;
    const size_t tstep = 2 * hstep;
    const unsigned ldsw = (unsigned)wid * 1024u;
    const int aoff = lds_byte(wr * 64 + fr, fq * 8), boff = lds_byte(wc * 32 + fr, fq * 8);
#define PG8_SA(b, h) (((b) * 2 + (h)) * HTB)
#define PG8_SB(b, h) ((4 + (b) * 2 + (h)) * HTB)
#define PG8_STAGE(bufoff, gbase, voff) do { _Pragma("unroll") for (int _i = 0; _i < 2; ++_i) \
        __builtin_amdgcn_global_load_lds((const unsigned*)((const char*)(gbase) + (voff)[_i]), (LAS unsigned*)(lds + (bufoff) + ldsw + _i * 8192), 16, 0, 0); } while (0)
#define PG8_LDA(dst, b, h) do { _Pragma("unroll") for (int m = 0; m < 4; ++m) _Pragma("unroll") for (int k = 0; k < 2; ++k) dst[m][k] = *(const LAS bf16x8*)(lds + PG8_SA(b, h) + aoff + m * 2048 + k * 1024); } while (0)
#define PG8_LDB(dst, b, h) do { _Pragma("unroll") for (int n = 0; n < 2; ++n) _Pragma("unroll") for (int k = 0; k < 2; ++k) dst[n][k] = *(const LAS bf16x8*)(lds + PG8_SB(b, h) + boff + n * 2048 + k * 1024); } while (0)
#define PG8_MMA(ai, bj, At, Bt) do { __builtin_amdgcn_s_setprio(1); _Pragma("unroll") for (int m = 0; m < 4; ++m) _Pragma("unroll") for (int n = 0; n < 2; ++n) _Pragma("unroll") for (int k = 0; k < 2; ++k) \
        acc[ai][bj][m][n] = __builtin_amdgcn_mfma_f32_16x16x32_bf16(Bt[n][k], At[m][k], acc[ai][bj][m][n], 0, 0, 0); __builtin_amdgcn_s_setprio(0); } while (0)
#define PG8_WAIT_V(n) asm volatile("s_waitcnt vmcnt(" #n ")" ::: "memory")
#define PG8_WAIT_L(n) asm volatile("s_waitcnt lgkmcnt(" #n ")" ::: "memory")
#define PG8_BAR __builtin_amdgcn_s_barrier()
#define PG8_SCHED __builtin_amdgcn_sched_barrier(0)
    Unit cur, nxt; int ui = 0;
    if (!S.next(0, cur)) return;
    f32x4 acc[2][2][4][2];
#pragma unroll
    for (int a = 0; a < 2; ++a)
#pragma unroll
        for (int b = 0; b < 2; ++b)
#pragma unroll
            for (int m = 0; m < 4; ++m)
#pragma unroll
                for (int n = 0; n < 2; ++n) acc[a][b][m][n] = (f32x4){0.f, 0.f, 0.f, 0.f};
    bf16x8 At[4][2], B0[2][2], B1[2][2];
    const char* cA = (const char*)g.A + (size_t)cur.pm * tstep; const char* cB = (const char*)g.Bt + (size_t)cur.pn * tstep;
    PG8_STAGE(PG8_SB(0, 0), cB, voffB); PG8_STAGE(PG8_SB(0, 1), cB + hstep, voffB); PG8_STAGE(PG8_SA(0, 0), cA, voffA); PG8_STAGE(PG8_SA(0, 1), cA + hstep, voffA);
    if (wr == 1) PG8_BAR;
    PG8_WAIT_V(2); PG8_BAR;
    PG8_STAGE(PG8_SB(1, 0), cB + kstep, voffB); PG8_STAGE(PG8_SA(1, 0), cA + kstep, voffA); PG8_STAGE(PG8_SB(1, 1), cB + hstep + kstep, voffB);
    PG8_WAIT_V(6); PG8_BAR;
    for (;;) {
        const bool has_next = S.next(ui + 1, nxt);
        const char* nA = has_next ? (const char*)g.A + (size_t)nxt.pm * tstep : cA; const char* nB = has_next ? (const char*)g.Bt + (size_t)nxt.pn * tstep : cB;
        for (int t = 0; t < nt; t += 2) {
            const bool last = (t == nt - 2);
            const char* a1 = cA + (size_t)(t + 1) * kstep;
            const char* a2 = last ? nA : cA + (size_t)(t + 2) * kstep; const char* b2 = last ? nB : cB + (size_t)(t + 2) * kstep;
            const char* a3 = a2 + kstep; const char* b3 = b2 + kstep;
            PG8_LDB(B0, 0, 0); PG8_LDB(B1, 0, 1); PG8_SCHED; PG8_LDA(At, 0, 0); PG8_STAGE(PG8_SA(1, 1), a1 + hstep, voffA);
            PG8_WAIT_V(8); PG8_WAIT_L(0); PG8_BAR; PG8_MMA(0, 0, At, B0); PG8_MMA(0, 1, At, B1); PG8_BAR; PG8_SCHED;
            PG8_LDA(At, 0, 1); PG8_STAGE(PG8_SB(0, 0), b2, voffB); PG8_STAGE(PG8_SB(0, 1), b2 + hstep, voffB); PG8_STAGE(PG8_SA(0, 0), a2, voffA);
            PG8_WAIT_V(8); PG8_WAIT_L(0); PG8_BAR; PG8_MMA(1, 0, At, B0); PG8_MMA(1, 1, At, B1); PG8_BAR; PG8_SCHED;
            PG8_LDB(B0, 1, 0); PG8_LDB(B1, 1, 1); PG8_SCHED; PG8_LDA(At, 1, 0); PG8_STAGE(PG8_SA(0, 1), a2 + hstep, voffA);
            PG8_WAIT_V(8); PG8_WAIT_L(0); PG8_BAR; PG8_MMA(0, 0, At, B0); PG8_MMA(0, 1, At, B1); PG8_BAR; PG8_SCHED;
            PG8_LDA(At, 1, 1); PG8_STAGE(PG8_SB(1, 0), b3, voffB); PG8_STAGE(PG8_SB(1, 1), b3 + hstep, voffB); PG8_STAGE(PG8_SA(1, 0), a3, voffA);
            PG8_WAIT_V(8); PG8_WAIT_L(0); PG8_BAR; PG8_MMA(1, 0, At, B0); PG8_MMA(1, 1, At, B1); PG8_BAR; PG8_SCHED;
        }
        if constexpr (ALIGN_EPI) { if (wr == 0) PG8_BAR; }
        E(acc, cur, wr, wc, fr, fq);
        if (!has_next) break;
#pragma unroll
        for (int a = 0; a < 2; ++a)
#pragma unroll
            for (int b = 0; b < 2; ++b)
#pragma unroll
                for (int m = 0; m < 4; ++m)
#pragma unroll
                    for (int n = 0; n < 2; ++n) acc[a][b][m][n] = (f32x4){0.f, 0.f, 0.f, 0.f};
        cur = nxt; cA = nA; cB = nB; ++ui;
        if constexpr (ALIGN_EPI) { if (wr == 1) PG8_BAR; }
    }
    PG8_WAIT_V(0);
    if constexpr (!ALIGN_EPI) { if (wr == 0) PG8_BAR; }
    PG8_BAR;
#undef PG8_SA
#undef PG8_SB
#undef PG8_STAGE
#undef PG8_LDA
#undef PG8_LDB
#undef PG8_MMA
#undef PG8_WAIT_V
#undef PG8_WAIT_L
#undef PG8_BAR
#undef PG8_SCHED
}
}


#define XB_TMO      128
#define XB_XCNT(j)  (256  + 64 * (j))
#define XB_XSUB(j)  (1280 + 64 * (j))
#define XB_XGEN(j)  (2304 + 64 * (j))
#define XB_TOP      3328
#define XB_TOPGEN   3392
#define XCD_BAR_WORDS 3456
#define XB_SPIN_CAP (1u << 22)
__device__ __forceinline__ unsigned xb_ld(unsigned* p)              { return __hip_atomic_load(p, __ATOMIC_RELAXED, __HIP_MEMORY_SCOPE_AGENT); }
__device__ __forceinline__ unsigned xb_add(unsigned* p, unsigned v) { return __hip_atomic_fetch_add(p, v, __ATOMIC_RELAXED, __HIP_MEMORY_SCOPE_AGENT); }
__device__ __forceinline__ unsigned xb_xcc_id() { return (unsigned)__builtin_amdgcn_s_getreg((3 << 11) | 20) & 0xFu; }
#define XB_SPIN(cond, bar) do { unsigned _sp = 0; while (cond) { __builtin_amdgcn_s_sleep(1); \
    if ((++_sp & 255u) == 0u) { if (xb_ld(&(bar)[XB_TMO])) break; if (_sp > XB_SPIN_CAP) { atomicAdd(&(bar)[XB_TMO], 1u); break; } } } } while (0)
struct XcdBarrier { unsigned* bar; unsigned x; volatile LAS unsigned* st; };
__device__ __forceinline__ XcdBarrier xcd_barrier_post(unsigned* bar, volatile LAS unsigned* st) {
    XcdBarrier b; b.bar = bar; b.x = xb_xcc_id(); b.st = st;
    if (threadIdx.x == 0) (void)xb_add(&bar[XB_XCNT(b.x)], 1u);
    return b;
}
__device__ __forceinline__ void xcd_barrier_complete(unsigned* bar, unsigned x, unsigned& nloc, unsigned& nx) {
    const unsigned G = gridDim.x * gridDim.y * gridDim.z;
    unsigned sum, cnt, mine, sp = 0u;
    for (;;) {
        sum = 0u; cnt = 0u; mine = 0u;
#pragma unroll
        for (unsigned j = 0; j < 16; ++j) { const unsigned c = xb_ld(&bar[XB_XCNT(j)]); sum += c; cnt += (c > 0u) ? 1u : 0u; mine = (j == x) ? c : mine; }
        if (sum == G) break;
        __builtin_amdgcn_s_sleep(1);
        if ((++sp & 255u) == 0u) { if (xb_ld(&bar[XB_TMO])) break; if (sp > XB_SPIN_CAP) { atomicAdd(&bar[XB_TMO], 1u); break; } }
    }
    nloc = mine > 0u ? mine : 1u; nx = cnt > 0u ? cnt : 1u;
}
__device__ __forceinline__ void xcd_barrier(unsigned char* wsb) {
    XcdBarrier b; b.bar = (unsigned*)(wsb + WS_BAR); b.x = 0; b.st = (volatile LAS unsigned*)(131072 + 64);
    asm volatile("s_waitcnt vmcnt(0)" ::: "memory");
    __syncthreads();
    if (threadIdx.x == 0) {
        unsigned* bar = b.bar; b.x = xb_xcc_id();
        __builtin_amdgcn_s_waitcnt(0);
        unsigned nloc = b.st[0], nx = b.st[1];
        if (nloc == 0u) { xcd_barrier_complete(bar, b.x, nloc, nx); b.st[0] = nloc; b.st[1] = nx; }
        const unsigned old = xb_add(&bar[XB_XSUB(b.x)], 1u);
        const unsigned gen = old / nloc;
        if (old + 1u == (gen + 1u) * nloc) {
            __builtin_amdgcn_fence(__ATOMIC_RELEASE, "agent");
            asm volatile("s_waitcnt vmcnt(0)" ::: "memory");
            const unsigned og = xb_add(&bar[XB_TOP], 1u);
            const unsigned tg = og / nx;
            if (og + 1u == (tg + 1u) * nx) xb_add(&bar[XB_TOPGEN], 1u);
            else XB_SPIN(xb_ld(&bar[XB_TOPGEN]) == tg, bar);
            __builtin_amdgcn_fence(__ATOMIC_ACQUIRE, "agent");
            xb_add(&bar[XB_XGEN(b.x)], 1u);
            asm volatile("s_waitcnt vmcnt(0)" ::: "memory");
        } else {
            XB_SPIN(xb_ld(&bar[XB_XGEN(b.x)]) == gen, bar);
            __builtin_amdgcn_fence(__ATOMIC_ACQUIRE, "agent");
            asm volatile("s_waitcnt vmcnt(0)" ::: "memory");
        }
    }
    __syncthreads();
}

struct Params { const float* in[24]; float* out; unsigned char* ws; };
enum { I_X = 0, I_C, I_CTX, I_CCTX, I_MODW, I_MODB, I_N1G, I_N2G, I_WIN, I_DAQKG, I_DALAM, I_DAOUTG, I_CONVW, I_CONVB, I_GATEB, I_MLOUTG, I_QNG, I_KVNG, I_WUQ, I_WUKV, I_MLAQKG, I_WOUT, I_WGU, I_WDN };

struct Ctx {
    unsigned char* lds;
    int tid, lane, wave, gw, ngw, nwg, wg;
};

__device__ __forceinline__ Ctx fresh(const Ctx& X) {
    Ctx Y = X; int t = X.tid; asm volatile("" : "+v"(t)); Y.tid = t; Y.lane = t & 63; Y.wave = __builtin_amdgcn_readfirstlane(t >> 6); return Y;
}
template <int MODE>
__device__ __forceinline__ void transpose_item(const float* W, int K, int N, bf16_t* WT, float* scr, int item, int nblk, int lane) {
    const int kb = item / nblk, nb = item % nblk, k0 = 64 * kb, n0 = 32 * nb;
    const int ncol = n0 + (lane & 31); const bool ok = ncol < N;
#pragma unroll 8
    for (int i = 0; i < 32; ++i) { const int kk = 2 * i + (lane >> 5); scr[kk * 33 + (lane & 31)] = ok ? W[(size_t)(k0 + kk) * N + ncol] : 0.f; }
    asm volatile("s_waitcnt lgkmcnt(0)" ::: "memory");
    const int c = lane & 7;
#pragma unroll
    for (int j = 0; j < 4; ++j) { const int n = (lane >> 3) + 8 * j; const float* s = scr + (8 * c) * 33 + n;
        u32x4 o; o.x = pk2(s[0 * 33], s[1 * 33]); o.y = pk2(s[2 * 33], s[3 * 33]); o.z = pk2(s[4 * 33], s[5 * 33]); o.w = pk2(s[6 * 33], s[7 * 33]);
        int nn = n0 + n;
        if (MODE == 1) { const int up = nn >= FF ? 1 : 0; const int hcol = nn - up * FF; nn = (hcol >> 7) * 256 + up * 128 + (hcol & 127); }
        *(u32x4*)(WT + (size_t)nn * K + k0 + 8 * c) = o; }
    asm volatile("s_waitcnt lgkmcnt(0)" ::: "memory");
}
__device__ __forceinline__ void convert_weights(const Ctx& X0, const Params& P, int l) {
    const Ctx X = fresh(X0);
    float* scr = (float*)(X.lds + X.wave * 16384);
    unsigned char* ws = P.ws;
    constexpr int I_IN = (DM / 64) * (NPROJ / 32), I_OUT = (DM / 64) * (DM / 32), I_GU = (DM / 64) * (2 * FF / 32), I_DN = (FF / 64) * (DM / 32), I_UQ = (512 / 64) * (1536 / 32), I_UKV = (256 / 64) * (2048 / 32);
    constexpr int NITEMS = I_IN + I_OUT + I_GU + I_DN + I_UQ + I_UKV;
    for (int it = X.gw; it < NITEMS; it += X.ngw) {
        int r = it;
        if (r < I_IN) { transpose_item<0>(P.in[I_WIN] + (size_t)l * DM * IN_W, DM, IN_W, (bf16_t*)(ws + WS_WIN), scr, r, NPROJ / 32, X.lane); continue; } r -= I_IN;
        if (r < I_OUT) { transpose_item<0>(P.in[I_WOUT] + (size_t)l * DM * DM, DM, DM, (bf16_t*)(ws + WS_WOUT), scr, r, DM / 32, X.lane); continue; } r -= I_OUT;
        if (r < I_GU) { transpose_item<1>(P.in[I_WGU] + (size_t)l * DM * 2 * FF, DM, 2 * FF, (bf16_t*)(ws + WS_WGU), scr, r, 2 * FF / 32, X.lane); continue; } r -= I_GU;
        if (r < I_DN) { transpose_item<0>(P.in[I_WDN] + (size_t)l * FF * DM, FF, DM, (bf16_t*)(ws + WS_WDN), scr, r, DM / 32, X.lane); continue; } r -= I_DN;
        if (r < I_UQ) { transpose_item<0>(P.in[I_WUQ] + (size_t)l * 512 * 1536, 512, 1536, (bf16_t*)(ws + WS_WUQ), scr, r, 1536 / 32, X.lane); continue; } r -= I_UQ;
        transpose_item<0>(P.in[I_WUKV] + (size_t)l * 256 * 2048, 256, 2048, (bf16_t*)(ws + WS_WUKV), scr, r, 2048 / 32, X.lane);
    }
}
__device__ __forceinline__ void mod_gemv(const Ctx& X0, const Params& P) {
    const Ctx X = fresh(X0);
    float* sc = (float*)X.lds;
    float* red = (float*)(X.lds + 40960);
    for (int i = X.tid; i < 5 * DM; i += 512) { const int mb = i / DM, k = i % DM; const float v = mb < 4 ? P.in[I_C][mb * DM + k] : P.in[I_CCTX][k]; sc[i] = siluf(v); }
    __syncthreads();
    float* mod = (float*)(P.ws + WS_MOD);
    const int kq = X.tid >> 4, c4 = X.tid & 15;
    for (int task = X.wg; task < DEPTH * 192; task += X.nwg) {
        const int l = task / 192, n0 = (task % 192) * 64;
        const float* W = P.in[I_MODW] + (size_t)l * DM * 6 * DM + n0 + 4 * c4;
        f32x4 a[5];
#pragma unroll
        for (int mb = 0; mb < 5; ++mb) a[mb] = (f32x4){0.f, 0.f, 0.f, 0.f};
#pragma unroll 8
        for (int i = 0; i < 64; ++i) { const int k = kq + 32 * i; const f32x4 w = *(const f32x4*)(W + (size_t)k * 6 * DM);
#pragma unroll
            for (int mb = 0; mb < 5; ++mb) a[mb] += w * sc[mb * DM + k]; }
#pragma unroll
        for (int mb = 0; mb < 5; ++mb) *(f32x4*)(red + (kq * 5 + mb) * 64 + 4 * c4) = a[mb];
        __syncthreads();
        if (X.tid < 320) { const int mb = X.tid >> 6, cc = X.tid & 63; float s = 0.f;
#pragma unroll 8
            for (int q = 0; q < 32; ++q) s += red[(q * 5 + mb) * 64 + cc];
            mod[((size_t)l * 5 + mb) * 6 * DM + n0 + cc] = s + P.in[I_MODB][(size_t)l * 6 * DM + n0 + cc]; }
        __syncthreads();
    }
}

__device__ __forceinline__ void modulate_phase(const Ctx& X0, const float* src_lat, const float* src_ctx, const float* g, const float* modl, int shift_off, int scale_off, bf16_t* A, int nrows) {
    const Ctx X = fresh(X0);
    for (int row = X.gw; row < nrows; row += X.ngw) {
        const float* src = row < M_LAT ? src_lat + (size_t)row * DM : src_ctx + (size_t)(row - M_LAT) * DM;
        f32x4 v[8]; float ss = 0.f;
#pragma unroll
        for (int j = 0; j < 8; ++j) { v[j] = *(const f32x4*)(src + X.lane * 4 + 256 * j); ss += (v[j][0] * v[j][0] + v[j][1] * v[j][1]) + (v[j][2] * v[j][2] + v[j][3] * v[j][3]); }
        const float rstd = rsqrtf(wave_sum(ss) * (1.f / DM) + EPS);
        const float* mp = modl + (size_t)mod_batch(row) * 6 * DM;
#pragma unroll
        for (int j = 0; j < 8; ++j) { const int col = X.lane * 4 + 256 * j;
            const f32x4 gg = *(const f32x4*)(g + col), sc = *(const f32x4*)(mp + scale_off + col), sh = *(const f32x4*)(mp + shift_off + col);
            const f32x4 y = (v[j] * rstd) * gg * (sc + 1.0f) + sh;
            u32x2 w; w.x = pk2(y[0], y[1]); w.y = pk2(y[2], y[3]);
            *(u32x2*)(A + (size_t)row * DM + col) = w; }
    }
}

struct ChunkId { int b, j, row0, tok0, is_lat, seglen; };
__device__ __forceinline__ ChunkId chunk_of_unit(int u) {
    ChunkId c;
    if (u < 256) { c.b = u >> 6; c.j = u & 63; c.row0 = c.b * SEQ + 64 * c.j; c.tok0 = CTXL + 64 * c.j; c.is_lat = 1; c.seglen = SEQ; }
    else { const int uu = u - 256; c.b = uu >> 2; c.j = uu & 3; c.row0 = M_LAT + c.b * CTXL + 64 * c.j; c.tok0 = 64 * c.j; c.is_lat = 0; c.seglen = CTXL; }
    return c;
}
__device__ __forceinline__ int row_of_tokchunk(int b, int jt) { return jt < 4 ? M_LAT + b * CTXL + 64 * jt : b * SEQ + 64 * (jt - 4); }

constexpr int TSTR = 520;
__device__ __forceinline__ void write_vt(const Ctx& X, const bf16_t* tile, bf16_t* img, size_t img_row0, int tok0) {
#pragma unroll 2
    for (int it = 0; it < 8; ++it) { const int task = it * 512 + X.tid; const int k = task & 7, c = task >> 3;
        float v[8];
#pragma unroll
        for (int jj = 0; jj < 8; ++jj) { const int i = 16 * (k >> 1) + 8 * (jj >> 2) + 4 * (k & 1) + (jj & 3); v[jj] = bf1(tile[i * TSTR + c]); }
        *(u32x4*)(img + (img_row0 + c) * TK + tok0 + 8 * k) = pack8(v); }
}
template <class F>
__device__ __forceinline__ void load_tile(const Ctx& X, bf16_t* tile, const bf16_t* src, size_t rstride, F colmap) {
#pragma unroll 4
    for (int it = 0; it < 8; ++it) { const int ch = it * 512 + X.tid; const int i = ch >> 6, cc = ch & 63;
        const u32x4 w = *(const u32x4*)(src + (size_t)i * rstride + colmap(cc));
        *(u32x4*)(tile + i * TSTR + 8 * cc) = w; }
}

__device__ __forceinline__ void rope_cs(int sub, int prow, int pcol, float* cs, float* sn) {
    const float pos = (float)((sub < 4) ? prow : pcol);
#pragma unroll
    for (int e = 0; e < 8; ++e) { const int fi = (sub & 1) * 8 + e; const float inv = exp2f(-(float)fi * (13.287712379549449f / 16.0f)); const float a = pos * inv; cs[e] = __cosf(a); sn[e] = __sinf(a); }
}
__device__ __forceinline__ void rope_apply(int sub, float* y, const float* cs, const float* sn) {
#pragma unroll
    for (int e = 0; e < 8; ++e) { const float p = __shfl_xor(y[e], 2); y[e] = (sub & 2) ? (y[e] * cs[e] + p * sn[e]) : (y[e] * cs[e] - p * sn[e]); }
}

__device__ __forceinline__ void prep_phase(const Ctx& X0, const Params& P, int l) {
    const Ctx X = fresh(X0);
    unsigned char* ws = P.ws;
    const bf16_t* proj = (const bf16_t*)(ws + WS_PROJ);
    bf16_t* tile = (bf16_t*)X.lds;
    const float* qkg = P.in[I_DAQKG] + l * 128;
    const float* convw = P.in[I_CONVW] + (size_t)l * 3 * 1024; const float* convb = P.in[I_CONVB] + l * 1024;
    const float* qng = P.in[I_QNG] + l * 512; const float* kvng = P.in[I_KVNG] + l * 256;
    const int lane = X.lane, sub = lane & 7;
    const float qscale = 0.125f * LOG2E;
    for (int u = X.wg; u < 272; u += X.nwg) {
        const ChunkId c = chunk_of_unit(u);
        for (int i = X.wave; i < 64; i += 8) {
            const int row = c.row0 + i, tseg = 64 * c.j + i, tok = c.tok0 + i;
            const bf16_t* pr = proj + (size_t)row * NPROJ;
            float cs[8], sn[8];
            if (c.is_lat) rope_cs(sub, c.j, i, cs, sn);
#pragma unroll
            for (int qk = 0; qk < 2; ++qk) {
                float y[8]; unpack8(*(const u32x4*)(pr + (qk ? C_DAK : C_DAQ) + 8 * lane), y);
                float ss = 0.f;
#pragma unroll
                for (int e = 0; e < 8; ++e) ss += y[e] * y[e];
                ss += __shfl_xor(ss, 1); ss += __shfl_xor(ss, 2); ss += __shfl_xor(ss, 4);
                const float rstd = rsqrtf(ss * (1.f / 64.f) + EPS);
#pragma unroll
                for (int e = 0; e < 8; ++e) y[e] = y[e] * rstd * qkg[qk * 64 + 8 * sub + e];
                if (c.is_lat) rope_apply(sub, y, cs, sn);
                const int head = lane >> 4, comp = (lane >> 3) & 1;
                if (qk == 0) {
#pragma unroll
                    for (int e = 0; e < 8; ++e) y[e] *= qscale;
                    *(u32x4*)((bf16_t*)(ws + WS_QDA) + ((size_t)head * M_ALL + row) * 128 + comp * 64 + 8 * sub) = pack8(y);
                } else {
                    *(u32x4*)((bf16_t*)(ws + WS_KDA) + ((size_t)(c.b * 4 + head) * TK + tok) * 128 + comp * 64 + 8 * sub) = pack8(y);
                }
            }
            {
                float y[8]; unpack8(*(const u32x4*)(pr + C_CQ + 8 * lane), y);
                float ss = 0.f;
#pragma unroll
                for (int e = 0; e < 8; ++e) ss += y[e] * y[e];
                const float rstd = rsqrtf(wave_sum(ss) * (1.f / 512.f) + EPS);
#pragma unroll
                for (int e = 0; e < 8; ++e) y[e] = y[e] * rstd * qng[8 * lane + e];
                *(u32x4*)((bf16_t*)(ws + WS_CQN) + (size_t)row * 512 + 8 * lane) = pack8(y);
            }
            {
                float y[8];
                if (lane < 32) unpack8(*(const u32x4*)(pr + C_CKV + 8 * lane), y);
                else {
#pragma unroll
                    for (int e = 0; e < 8; ++e) y[e] = 0.f;
                }
                float ss = 0.f;
#pragma unroll
                for (int e = 0; e < 8; ++e) ss += y[e] * y[e];
                const float rstd = rsqrtf(wave_sum(ss) * (1.f / 256.f) + EPS);
                if (lane < 32) {
#pragma unroll
                    for (int e = 0; e < 8; ++e) y[e] = y[e] * rstd * kvng[8 * lane + e];
                    *(u32x4*)((bf16_t*)(ws + WS_CKVN) + (size_t)row * 256 + 8 * lane) = pack8(y);
                }
            }
            if (lane < 8) *(u32x4*)((bf16_t*)(ws + WS_KPE) + (size_t)row * 64 + 8 * lane) = *(const u32x4*)(pr + C_KPE + 8 * lane);
            *(u32x4*)((bf16_t*)(ws + WS_OCOPY) + (size_t)row * 512 + 8 * lane) = *(const u32x4*)(pr + C_MLO + 8 * lane);
#pragma unroll
            for (int qk = 0; qk < 2; ++qk) {
                const int ch0 = qk * 512 + 8 * lane;
                float xm[8], x0[8], xp[8];
                unpack8(*(const u32x4*)(pr + C_MLQ + ch0), x0);
                if (tseg > 0) unpack8(*(const u32x4*)(pr - NPROJ + C_MLQ + ch0), xm);
                else {
#pragma unroll
                    for (int e = 0; e < 8; ++e) xm[e] = 0.f;
                }
                if (tseg < c.seglen - 1) unpack8(*(const u32x4*)(pr + NPROJ + C_MLQ + ch0), xp);
                else {
#pragma unroll
                    for (int e = 0; e < 8; ++e) xp[e] = 0.f;
                }
                float y[8];
#pragma unroll
                for (int e = 0; e < 8; ++e) { const float v = convb[ch0 + e] + convw[ch0 + e] * xm[e] + convw[1024 + ch0 + e] * x0[e] + convw[2048 + ch0 + e] * xp[e]; y[e] = siluf(v) * (qk ? 0.08838834764831845f : 1.0f); }
                const int head = lane >> 4, d = 8 * (lane & 15);
                const u32x4 w = pack8(y);
                *(u32x4*)((bf16_t*)(ws + (qk ? WS_KML : WS_QML)) + ((size_t)(c.b * 4 + head) * TK + tok) * 128 + d) = w;
                if (qk) *(u32x4*)(tile + i * TSTR + 8 * lane) = w;
            }
        }
        __syncthreads();
        write_vt(X, tile, (bf16_t*)(ws + WS_KTML), (size_t)c.b * 512, c.tok0);
        __syncthreads();
        load_tile(X, tile, proj + (size_t)c.row0 * NPROJ, NPROJ, [](int cc) { return C_DAV + 8 * cc; });
        __syncthreads();
        write_vt(X, tile, (bf16_t*)(ws + WS_VTDA), (size_t)c.b * 512, c.tok0);
        __syncthreads();
        load_tile(X, tile, proj + (size_t)c.row0 * NPROJ, NPROJ, [](int cc) { return C_MLV + 8 * cc; });
        __syncthreads();
        write_vt(X, tile, (bf16_t*)(ws + WS_VTML), (size_t)c.b * 512, c.tok0);
        __syncthreads();
    }
}

__device__ __forceinline__ void mla_prep_phase(const Ctx& X0, const Params& P, int l) {
    const Ctx X = fresh(X0);
    unsigned char* ws = P.ws;
    const bf16_t* qup = (const bf16_t*)(ws + WS_QUP); const bf16_t* kvup = (const bf16_t*)(ws + WS_KVUP); const bf16_t* kpe = (const bf16_t*)(ws + WS_KPE);
    bf16_t* tile = (bf16_t*)X.lds;
    const float* g = P.in[I_MLAQKG] + l * 2 * 192;
    const int lane = X.lane, sub = lane & 7, head = lane >> 3;
    const float qscale = 0.07216878364870322f * LOG2E;
    for (int u = X.wg; u < 272; u += X.nwg) {
        const ChunkId c = chunk_of_unit(u);
        for (int i = X.wave; i < 64; i += 8) {
            const int row = c.row0 + i, tok = c.tok0 + i;
            float cs[8], sn[8];
            if (c.is_lat) rope_cs(sub, c.j, i, cs, sn);
#pragma unroll
            for (int qk = 0; qk < 2; ++qk) {
                float y[3][8];
                if (qk == 0) {
#pragma unroll
                    for (int cc = 0; cc < 3; ++cc) unpack8(*(const u32x4*)(qup + (size_t)row * 1536 + head * 192 + 64 * cc + 8 * sub), y[cc]);
                } else {
#pragma unroll
                    for (int cc = 0; cc < 2; ++cc) unpack8(*(const u32x4*)(kvup + (size_t)row * 2048 + head * 256 + 64 * cc + 8 * sub), y[cc]);
                    unpack8(*(const u32x4*)(kpe + (size_t)row * 64 + 8 * sub), y[2]);
                }
                float ss = 0.f;
#pragma unroll
                for (int cc = 0; cc < 3; ++cc)
#pragma unroll
                    for (int e = 0; e < 8; ++e) ss += y[cc][e] * y[cc][e];
                ss += __shfl_xor(ss, 1); ss += __shfl_xor(ss, 2); ss += __shfl_xor(ss, 4);
                const float rstd = rsqrtf(ss * (1.f / 192.f) + EPS);
#pragma unroll
                for (int cc = 0; cc < 3; ++cc)
#pragma unroll
                    for (int e = 0; e < 8; ++e) y[cc][e] = y[cc][e] * rstd * g[qk * 192 + 64 * cc + 8 * sub + e];
                if (c.is_lat) rope_apply(sub, y[2], cs, sn);
                bf16_t* dst;
                if (qk == 0) {
#pragma unroll
                    for (int cc = 0; cc < 3; ++cc)
#pragma unroll
                        for (int e = 0; e < 8; ++e) y[cc][e] *= qscale;
                    dst = (bf16_t*)(ws + WS_QM) + ((size_t)head * M_ALL + row) * 192;
                } else dst = (bf16_t*)(ws + WS_KM) + ((size_t)(c.b * 8 + head) * TK + tok) * 192;
#pragma unroll
                for (int cc = 0; cc < 3; ++cc) *(u32x4*)(dst + 64 * cc + 8 * sub) = pack8(y[cc]);
            }
        }
        for (int p = 0; p < 2; ++p) {
            __syncthreads();
            load_tile(X, tile, kvup + (size_t)c.row0 * 2048, 2048, [p](int cc) { return (4 * p + (cc >> 4)) * 256 + 128 + 8 * (cc & 15); });
            __syncthreads();
            write_vt(X, tile, (bf16_t*)(ws + WS_VTM), (size_t)(c.b * 8 + 4 * p) * 128, c.tok0);
        }
        __syncthreads();
    }
}

__device__ __forceinline__ void ml_gates(const float* gates, const float* gb, int b, int jt, int dir, int h, int lane, float& ig, float& lf, float& pre, float& total) {
    const int row = row_of_tokchunk(b, jt) + lane;
    ig = gates[(size_t)row * 16 + dir * 8 + h] + gb[dir * 8 + h];
    const float fg = gates[(size_t)row * 16 + dir * 8 + 4 + h] + gb[dir * 8 + 4 + h];
    lf = fminf(fg, 0.f) - log1pf(__expf(-fabsf(fg)));
    float s = lf;
#pragma unroll
    for (int o = 1; o < 64; o <<= 1) { const float t = __shfl_up(s, o); if (lane >= o) s += t; }
    pre = s; total = __shfl(s, 63);
}
constexpr int KSTR = 72;
constexpr int QSTR = 136;
__device__ __forceinline__ void mlstm_a_phase(const Ctx& X0, const Params& P, int l) {
    const Ctx X = fresh(X0);
    unsigned char* ws = P.ws;
    const float* gates = (const float*)(ws + WS_GATES); const float* gb = P.in[I_GATEB] + l * 16;
    bf16_t* Kt = (bf16_t*)X.lds;
    bf16_t* Vw = (bf16_t*)(X.lds + 128 * KSTR * 2);
    float* wtab = (float*)(X.lds + 3 * 128 * KSTR * 2);
    const int lane = X.lane, r32 = lane & 31, hi = lane >> 5;
    for (int u = X.wg; u < 16 * NCH; u += X.nwg) {
        const int bh = u / NCH, jt = u % NCH, b = bh >> 2, h = bh & 3, tok0 = 64 * jt;
        if (X.wave < 2) {
            const int dir = X.wave; float ig, lf, pre, total; ml_gates(gates, gb, b, jt, dir, h, lane, ig, lf, pre, total);
            const float cum = dir == 0 ? pre : total - pre + lf;
            const float wlog = total - cum + ig; const float mloc = wave_max(wlog);
            wtab[dir * 64 + lane] = __expf(wlog - mloc);
            if (lane == 0) { float* cs = (float*)(ws + WS_CSTAT) + ((size_t)(bh * 2 + dir) * NCH + jt) * 4; cs[0] = total; cs[1] = mloc; }
        }
        u32x4 vr[2];
#pragma unroll
        for (int it = 0; it < 2; ++it) { const int ch = it * 512 + X.tid; const int rr = ch >> 3, k = ch & 7;
            *(u32x4*)(Kt + rr * KSTR + 8 * k) = *(const u32x4*)((const bf16_t*)(ws + WS_KTML) + ((size_t)bh * 128 + rr) * TK + tok0 + 8 * k);
            vr[it] = *(const u32x4*)((const bf16_t*)(ws + WS_VTML) + ((size_t)bh * 128 + rr) * TK + tok0 + 8 * k); }
        __syncthreads();
#pragma unroll
        for (int it = 0; it < 2; ++it) { const int ch = it * 512 + X.tid; const int rr = ch >> 3, k = ch & 7;
            float v[8]; unpack8(vr[it], v);
#pragma unroll
            for (int dir = 0; dir < 2; ++dir) { float o[8];
#pragma unroll
                for (int jj = 0; jj < 8; ++jj) { const int i = 16 * (k >> 1) + 8 * (jj >> 2) + 4 * (k & 1) + (jj & 3); o[jj] = v[jj] * wtab[dir * 64 + i]; }
                *(u32x4*)(Vw + (dir * 128 + rr) * KSTR + 8 * k) = pack8(o); } }
        __syncthreads();
        {
            const int dir = X.wave >> 2, dvb = X.wave & 3;
            bf16_t* U = (bf16_t*)(ws + WS_AB) + ((size_t)(bh * 2 + dir) * NCH + jt) * 16384;
            bf16x8 a[4];
#pragma unroll
            for (int ks = 0; ks < 4; ++ks) a[ks] = *(const bf16x8*)(Vw + (dir * 128 + 32 * dvb + r32) * KSTR + 16 * ks + 8 * hi);
            for (int dkb = 0; dkb < 4; ++dkb) {
                f32x16 acc;
#pragma unroll
                for (int r = 0; r < 16; ++r) acc[r] = 0.f;
#pragma unroll
                for (int ks = 0; ks < 4; ++ks) { const bf16x8 bb = *(const bf16x8*)(Kt + (32 * dkb + r32) * KSTR + 16 * ks + 8 * hi); acc = __builtin_amdgcn_mfma_f32_32x32x16_bf16(a[ks], bb, acc, 0, 0, 0); }
#pragma unroll
                for (int r = 0; r < 16; ++r) U[(32 * dvb + crow(r, hi)) * 128 + 32 * dkb + r32] = (bf16_t)(pk2(acc[r], 0.f) & 0xffffu);
            }
        }
        if (X.tid < 256) { const int dir = X.tid >> 7, dk = X.tid & 127; float s = 0.f;
#pragma unroll 8
            for (int p = 0; p < 64; ++p) { const int i = (p & ~15) + perm_off(p & 15); s += wtab[dir * 64 + i] * bf1(Kt[dk * KSTR + p]); }
            ((float*)(ws + WS_NU))[((size_t)(bh * 2 + dir) * NCH + jt) * 128 + dk] = s; }
        __syncthreads();
    }
}
__device__ __forceinline__ int ml_jmap(int dir, int c) { return dir == 0 ? c : (c < 4 ? 3 - c : 71 - c); }
__device__ __forceinline__ void mlstm_scan_phase(const Ctx& X0, const Params& P) {
    const Ctx X = fresh(X0);
    unsigned char* ws = P.ws;
    float* cstat = (float*)(ws + WS_CSTAT);
    const int gtid = X.wg * 512 + X.tid, nthr = X.nwg * 512;
    for (int task = gtid; task < 32 * 4128; task += nthr) {
        const int seq = task / 4128, e = task % 4128, dir = seq & 1;
        float m = 0.f; f32x4 C = (f32x4){0.f, 0.f, 0.f, 0.f};
        if (e < 4096) {
            const bf16_t* U = (const bf16_t*)(ws + WS_AB); bf16_t* S = (bf16_t*)(ws + WS_CSNAP);
#pragma unroll 4
            for (int c = 0; c < NCH; ++c) { const size_t base = (size_t)seq * NCH + ml_jmap(dir, c);
                u32x2 w; w.x = pk2(C[0], C[1]); w.y = pk2(C[2], C[3]); *(u32x2*)(S + base * 16384 + 4 * e) = w;
                const float total = cstat[base * 4], mloc = cstat[base * 4 + 1];
                if (e == 0) cstat[base * 4 + 2] = m;
                const float mn = fmaxf(total + m, mloc); const float dec = __expf(total + m - mn), sc = __expf(mloc - mn);
                const u32x2 uu = *(const u32x2*)(U + base * 16384 + 4 * e);
                C = C * dec + (f32x4){bflo(uu.x), bfhi(uu.x), bflo(uu.y), bfhi(uu.y)} * sc; m = mn; }
        } else {
            const int e4 = e - 4096; const float* NU = (const float*)(ws + WS_NU); float* NS = (float*)(ws + WS_NSNAP);
#pragma unroll 4
            for (int c = 0; c < NCH; ++c) { const size_t base = (size_t)seq * NCH + ml_jmap(dir, c);
                *(f32x4*)(NS + base * 128 + 4 * e4) = C;
                const float total = cstat[base * 4], mloc = cstat[base * 4 + 1];
                const float mn = fmaxf(total + m, mloc); const float dec = __expf(total + m - mn), sc = __expf(mloc - mn);
                C = C * dec + *(const f32x4*)(NU + base * 128 + 4 * e4) * sc; m = mn; }
        }
    }
}
__device__ __forceinline__ void mlstm_c_unit(const Ctx& X0, const Params& P, int l, int u) {
    const Ctx X = fresh(X0);
    unsigned char* ws = P.ws;
    const float* gates = (const float*)(ws + WS_GATES); const float* gb = P.in[I_GATEB] + l * 16;
    const float* cstat = (const float*)(ws + WS_CSTAT);
    bf16_t* Qt = (bf16_t*)X.lds;
    bf16_t* Kn = (bf16_t*)(X.lds + 64 * QSTR * 2);
    bf16_t* Vt = (bf16_t*)(X.lds + 2 * 64 * QSTR * 2);
    float* tab = (float*)(X.lds + 2 * 64 * QSTR * 2 + 128 * KSTR * 2);
    float* t_a = tab, *t_c1 = tab + 128, *t_wp = tab + 256, *t_em = tab + 384, *t_n = tab + 512, *t_red = tab + 768;
    const int lane = X.lane, r32 = lane & 31, hi = lane >> 5;
    const int bh = u / NCH, jt = u % NCH, b = bh >> 2, h = bh & 3, tok0 = 64 * jt;
    if (X.wave < 2) {
        const int dir = X.wave; float ig, lf, pre, total; ml_gates(gates, gb, b, jt, dir, h, lane, ig, lf, pre, total);
        const float cum = dir == 0 ? pre : total - pre + lf;
        const float a = ig - cum; float pm = a;
#pragma unroll
        for (int o = 1; o < 64; o <<= 1) { const float t = dir == 0 ? __shfl_up(pm, o) : __shfl_down(pm, o); const bool ok = dir == 0 ? (lane >= o) : (lane + o < 64); if (ok) pm = fmaxf(pm, t); }
        const float mc = cstat[((size_t)(bh * 2 + dir) * NCH + jt) * 4 + 2];
        const float mt = cum + fmaxf(mc, pm);
        t_a[dir * 64 + lane] = a; t_c1[dir * 64 + lane] = cum - mt; t_wp[dir * 64 + lane] = __expf(cum + mc - mt); t_em[dir * 64 + lane] = __expf(-mt);
    }
#pragma unroll
    for (int it = 0; it < 2; ++it) { const int ch = it * 512 + X.tid;
        { const int i = ch >> 4, k = ch & 15;
          *(u32x4*)(Qt + i * QSTR + 8 * k) = *(const u32x4*)((const bf16_t*)(ws + WS_QML) + ((size_t)bh * TK + tok0 + i) * 128 + 8 * k);
          *(u32x4*)(Kn + i * QSTR + 8 * k) = *(const u32x4*)((const bf16_t*)(ws + WS_KML) + ((size_t)bh * TK + tok0 + i) * 128 + 8 * k); }
        { const int rr = ch >> 3, k = ch & 7;
          *(u32x4*)(Vt + rr * KSTR + 8 * k) = *(const u32x4*)((const bf16_t*)(ws + WS_VTML) + ((size_t)bh * 128 + rr) * TK + tok0 + 8 * k); } }
    if (X.tid < 256) t_n[X.tid] = ((const float*)(ws + WS_NSNAP))[((size_t)(bh * 2 + (X.tid >> 7)) * NCH + jt) * 128 + (X.tid & 127)];
    __syncthreads();
    const int tb = X.wave & 1, db = X.wave >> 1, t = 32 * tb + r32;
    bf16x8 qf[8];
#pragma unroll
    for (int ks = 0; ks < 8; ++ks) qf[ks] = *(const bf16x8*)(Qt + t * QSTR + 16 * ks + 8 * hi);
    f32x16 st[2];
#pragma unroll
    for (int sb = 0; sb < 2; ++sb) {
#pragma unroll
        for (int r = 0; r < 16; ++r) st[sb][r] = 0.f;
#pragma unroll
        for (int ks = 0; ks < 8; ++ks) { const bf16x8 kf = *(const bf16x8*)(Kn + (32 * sb + r32) * QSTR + 16 * ks + 8 * hi); st[sb] = __builtin_amdgcn_mfma_f32_32x32x16_bf16(kf, qf[ks], st[sb], 0, 0, 0); }
    }
    f32x16 hsum;
#pragma unroll
    for (int r = 0; r < 16; ++r) hsum[r] = 0.f;
#pragma unroll
    for (int dir = 0; dir < 2; ++dir) {
        const float c1 = t_c1[dir * 64 + t], wp = t_wp[dir * 64 + t], em = t_em[dir * 64 + t];
        float rs = 0.f; u32x4 pw[2][2];
#pragma unroll
        for (int sb = 0; sb < 2; ++sb) { float p[16];
#pragma unroll
            for (int r = 0; r < 16; ++r) { const int s = 32 * sb + crow(r, hi); const bool ok = dir == 0 ? (s <= t) : (s >= t);
                const float dm = ok ? __expf(t_a[dir * 64 + s] + c1) : 0.f; p[r] = st[sb][r] * dm; rs += p[r]; }
            pw[sb][0] = pack8(p); pw[sb][1] = pack8(p + 8); }
        rs += __shfl_xor(rs, 32);
        float qn = 0.f;
#pragma unroll
        for (int ks = 0; ks < 8; ++ks) { float q8[8]; unpack8(__builtin_bit_cast(u32x4, qf[ks]), q8);
#pragma unroll
            for (int e = 0; e < 8; ++e) qn += q8[e] * t_n[dir * 128 + 16 * ks + 8 * hi + e]; }
        qn += __shfl_xor(qn, 32);
        const float den = rs + wp * qn; const float rden = 1.f / fmaxf(fabsf(den), em);
        f32x16 acc;
#pragma unroll
        for (int r = 0; r < 16; ++r) acc[r] = 0.f;
        const bf16_t* Cs = (const bf16_t*)(ws + WS_CSNAP) + ((size_t)(bh * 2 + dir) * NCH + jt) * 16384 + (size_t)(32 * db + r32) * 128;
#pragma unroll
        for (int ks = 0; ks < 8; ++ks) { const bf16x8 cf = *(const bf16x8*)(Cs + 16 * ks + 8 * hi); acc = __builtin_amdgcn_mfma_f32_32x32x16_bf16(cf, qf[ks], acc, 0, 0, 0); }
#pragma unroll
        for (int r = 0; r < 16; ++r) acc[r] *= wp;
#pragma unroll
        for (int sb = 0; sb < 2; ++sb)
#pragma unroll
            for (int s2 = 0; s2 < 2; ++s2) { const bf16x8 vf = *(const bf16x8*)(Vt + (32 * db + r32) * KSTR + 32 * sb + 16 * s2 + 8 * hi);
                acc = __builtin_amdgcn_mfma_f32_32x32x16_bf16(vf, __builtin_bit_cast(bf16x8, pw[sb][s2]), acc, 0, 0, 0); }
#pragma unroll
        for (int r = 0; r < 16; ++r) hsum[r] += acc[r] * rden;
    }
    float ss = 0.f;
#pragma unroll
    for (int r = 0; r < 16; ++r) ss += hsum[r] * hsum[r];
    ss += __shfl_xor(ss, 32);
    if (hi == 0) t_red[(tb * 4 + db) * 32 + r32] = ss;
    __syncthreads();
    const float tot = t_red[(tb * 4 + 0) * 32 + r32] + t_red[(tb * 4 + 1) * 32 + r32] + t_red[(tb * 4 + 2) * 32 + r32] + t_red[(tb * 4 + 3) * 32 + r32];
    const float rstd = rsqrtf(tot * (1.f / 128.f) + EPS);
    const int row = row_of_tokchunk(b, jt) + t;
    const float* og = P.in[I_MLOUTG] + l * 512 + h * 128;
    const bf16_t* oc = (const bf16_t*)(ws + WS_OCOPY) + (size_t)row * 512 + h * 128;
    bf16_t* mix = (bf16_t*)(ws + WS_AB) + (size_t)row * DM + 512 + h * 128;
#pragma unroll
    for (int q = 0; q < 4; ++q) { const int dv = 32 * db + 8 * q + 4 * hi;
        const u32x2 ow = *(const u32x2*)(oc + dv); const f32x4 gg = *(const f32x4*)(og + dv);
        const float o0 = hsum[4 * q + 0] * rstd * gg[0] * sigmf(bflo(ow.x)), o1 = hsum[4 * q + 1] * rstd * gg[1] * sigmf(bfhi(ow.x));
        const float o2 = hsum[4 * q + 2] * rstd * gg[2] * sigmf(bflo(ow.y)), o3 = hsum[4 * q + 3] * rstd * gg[3] * sigmf(bfhi(ow.y));
        u32x2 w; w.x = pk2(o0, o1); w.y = pk2(o2, o3); *(u32x2*)(mix + dv) = w; }
    __syncthreads();
}

template <int DQK, int KROW>
struct AttnCore {
    static constexpr int KS = KROW + 8, KT_B = 64 * KS * 2, VT_B = 128 * KSTR * 2, BUF_B = KT_B + VT_B, NKC = KROW / 8, NKR = (64 * NKC) / 512;
    static __device__ __forceinline__ void run(const Ctx& X, const bf16_t* Qrow  , int kcol  ,
                                               const bf16_t* K, const bf16_t* Vt, int nt, f32x16 (&o)[4]) {
        const int lane = X.lane, r32 = lane & 31, hi = lane >> 5;
        bf16x8 qf[DQK / 16];
#pragma unroll
        for (int ks = 0; ks < DQK / 16; ++ks) qf[ks] = *(const bf16x8*)(Qrow + 16 * ks + 8 * hi);
#pragma unroll
        for (int d = 0; d < 4; ++d)
#pragma unroll
            for (int r = 0; r < 16; ++r) o[d][r] = 0.f;
        float mrun = -1e30f, lrun = 0.f;
        u32x4 kr[NKR], vr[2];
        auto gload = [&](int t) {
#pragma unroll
            for (int it = 0; it < NKR; ++it) { const int ch = it * 512 + X.tid; const int i = ch / NKC, k = ch % NKC; kr[it] = *(const u32x4*)(K + (size_t)(64 * t + i) * KROW + 8 * k); }
#pragma unroll
            for (int it = 0; it < 2; ++it) { const int ch = it * 512 + X.tid; const int rr = ch >> 3, k = ch & 7; vr[it] = *(const u32x4*)(Vt + (size_t)rr * TK + 64 * t + 8 * k); }
        };
        auto lstore = [&](int buf) {
            bf16_t* kt = (bf16_t*)(X.lds + buf * BUF_B); bf16_t* vt = (bf16_t*)(X.lds + buf * BUF_B + KT_B);
#pragma unroll
            for (int it = 0; it < NKR; ++it) { const int ch = it * 512 + X.tid; const int i = ch / NKC, k = ch % NKC; *(u32x4*)(kt + i * KS + 8 * k) = kr[it]; }
#pragma unroll
            for (int it = 0; it < 2; ++it) { const int ch = it * 512 + X.tid; const int rr = ch >> 3, k = ch & 7; *(u32x4*)(vt + rr * KSTR + 8 * k) = vr[it]; }
        };
        gload(0); lstore(0); __syncthreads();
        for (int t = 0; t < nt; ++t) {
            if (t + 1 < nt) gload(t + 1);
            const bf16_t* kt = (const bf16_t*)(X.lds + (t & 1) * BUF_B); const bf16_t* vt = (const bf16_t*)(X.lds + (t & 1) * BUF_B + KT_B);
            f32x16 s0, s1;
#pragma unroll
            for (int r = 0; r < 16; ++r) { s0[r] = 0.f; s1[r] = 0.f; }
#pragma unroll
            for (int ks = 0; ks < DQK / 16; ++ks) {
                const bf16x8 a0 = *(const bf16x8*)(kt + r32 * KS + kcol + 16 * ks + 8 * hi);
                const bf16x8 a1 = *(const bf16x8*)(kt + (32 + r32) * KS + kcol + 16 * ks + 8 * hi);
                s0 = __builtin_amdgcn_mfma_f32_32x32x16_bf16(a0, qf[ks], s0, 0, 0, 0);
                s1 = __builtin_amdgcn_mfma_f32_32x32x16_bf16(a1, qf[ks], s1, 0, 0, 0);
            }
            float mx = fmaxf(s0[0], s1[0]);
#pragma unroll
            for (int r = 1; r < 16; ++r) mx = fmaxf(mx, fmaxf(s0[r], s1[r]));
            mx = fmaxf(mx, __shfl_xor(mx, 32));
            const float mnew = fmaxf(mrun, mx); const float alpha = __builtin_amdgcn_exp2f(mrun - mnew); mrun = mnew;
            float rs = 0.f;
#pragma unroll
            for (int r = 0; r < 16; ++r) { s0[r] = __builtin_amdgcn_exp2f(s0[r] - mnew); s1[r] = __builtin_amdgcn_exp2f(s1[r] - mnew); rs += s0[r] + s1[r]; }
            lrun = lrun * alpha + rs;
            if (__any(alpha != 1.f)) {
#pragma unroll
                for (int d = 0; d < 4; ++d)
#pragma unroll
                    for (int r = 0; r < 16; ++r) o[d][r] *= alpha;
            }
            bf16x8 pf[2][2];
            { float p[16];
#pragma unroll
              for (int r = 0; r < 16; ++r) p[r] = s0[r];
              pf[0][0] = __builtin_bit_cast(bf16x8, pack8(p)); pf[0][1] = __builtin_bit_cast(bf16x8, pack8(p + 8));
#pragma unroll
              for (int r = 0; r < 16; ++r) p[r] = s1[r];
              pf[1][0] = __builtin_bit_cast(bf16x8, pack8(p)); pf[1][1] = __builtin_bit_cast(bf16x8, pack8(p + 8)); }
#pragma unroll
            for (int d = 0; d < 4; ++d)
#pragma unroll
                for (int kb = 0; kb < 2; ++kb)
#pragma unroll
                    for (int s2 = 0; s2 < 2; ++s2) { const bf16x8 vf = *(const bf16x8*)(vt + (32 * d + r32) * KSTR + 32 * kb + 16 * s2 + 8 * hi);
                        o[d] = __builtin_amdgcn_mfma_f32_32x32x16_bf16(vf, pf[kb][s2], o[d], 0, 0, 0); }
            if (t + 1 < nt) lstore((t + 1) & 1);
            __syncthreads();
        }
        lrun += __shfl_xor(lrun, 32);
        const float rl = 1.f / lrun;
#pragma unroll
        for (int d = 0; d < 4; ++d)
#pragma unroll
            for (int r = 0; r < 16; ++r) o[d][r] *= rl;
    }
};

__device__ __forceinline__ void mla_attn_unit(const Ctx& X0, const Params& P, int b, int h, int q0, int is_ctx) {
    const Ctx X = fresh(X0);
    unsigned char* ws = P.ws;
    const int lane = X.lane, r32 = lane & 31, hi = lane >> 5;
    const int row = (is_ctx ? M_LAT + b * CTXL : b * SEQ) + q0 + 32 * X.wave + r32;
    const bf16_t* Q = (const bf16_t*)(ws + WS_QM) + ((size_t)h * M_ALL + row) * 192;
    const bf16_t* K = (const bf16_t*)(ws + WS_KM) + (size_t)(b * 8 + h) * TK * 192;
    const bf16_t* Vt = (const bf16_t*)(ws + WS_VTM) + (size_t)(b * 8 + h) * 128 * TK;
    f32x16 o[4];
    AttnCore<192, 192>::run(X, Q, 0, K, Vt, is_ctx ? 4 : NCH, o);
    bf16_t* mix = (bf16_t*)(ws + WS_AB) + (size_t)row * DM + 1024 + h * 128;
#pragma unroll
    for (int d = 0; d < 4; ++d)
#pragma unroll
        for (int q = 0; q < 4; ++q) { u32x2 w; w.x = pk2(o[d][4 * q], o[d][4 * q + 1]); w.y = pk2(o[d][4 * q + 2], o[d][4 * q + 3]); *(u32x2*)(mix + 32 * d + 8 * q + 4 * hi) = w; }
}
__device__ __forceinline__ void da_attn_unit(const Ctx& X0, const Params& P, int l, int b, int h, int q0, int is_ctx, float lam, float lam_init) {
    const Ctx X = fresh(X0);
    unsigned char* ws = P.ws;
    const int lane = X.lane, r32 = lane & 31, hi = lane >> 5;
    const int comp = X.wave >> 2, qs = X.wave & 3;
    const int row = (is_ctx ? M_LAT + b * CTXL : b * SEQ) + q0 + 32 * qs + r32;
    const bf16_t* Q = (const bf16_t*)(ws + WS_QDA) + ((size_t)h * M_ALL + row) * 128 + comp * 64;
    const bf16_t* K = (const bf16_t*)(ws + WS_KDA) + (size_t)(b * 4 + h) * TK * 128;
    const bf16_t* Vt = (const bf16_t*)(ws + WS_VTDA) + (size_t)(b * 4 + h) * 128 * TK;
    f32x16 o[4];
    AttnCore<64, 128>::run(X, Q, comp * 64, K, Vt, is_ctx ? 4 : NCH, o);
    float* xch = (float*)X.lds;
    if (comp == 1) {
#pragma unroll
        for (int d = 0; d < 4; ++d)
#pragma unroll
            for (int r = 0; r < 16; ++r) xch[(qs * 64 + d * 16 + r) * 64 + lane] = o[d][r];
    }
    __syncthreads();
    if (comp == 0) {
        float ss = 0.f;
#pragma unroll
        for (int d = 0; d < 4; ++d)
#pragma unroll
            for (int r = 0; r < 16; ++r) { o[d][r] -= lam * xch[(qs * 64 + d * 16 + r) * 64 + lane]; ss += o[d][r] * o[d][r]; }
        ss += __shfl_xor(ss, 32);
        const float rstd = rsqrtf(ss * (1.f / 128.f) + EPS) * (1.f - lam_init);
        const float* og = P.in[I_DAOUTG] + l * 128;
        bf16_t* mix = (bf16_t*)(ws + WS_AB) + (size_t)row * DM + h * 128;
#pragma unroll
        for (int d = 0; d < 4; ++d)
#pragma unroll
            for (int q = 0; q < 4; ++q) { const int dv = 32 * d + 8 * q + 4 * hi; const f32x4 gg = *(const f32x4*)(og + dv);
                u32x2 w; w.x = pk2(o[d][4 * q] * rstd * gg[0], o[d][4 * q + 1] * rstd * gg[1]); w.y = pk2(o[d][4 * q + 2] * rstd * gg[2], o[d][4 * q + 3] * rstd * gg[3]);
                *(u32x2*)(mix + dv) = w; }
    }
    __syncthreads();
}

__device__ __forceinline__ void mixer_phase(const Ctx& X, const Params& P, int l) {
    const float* lp = P.in[I_DALAM] + l * 256;
    float s1 = 0.f, s2 = 0.f;
    for (int i = 0; i < 64; ++i) { s1 += lp[i] * lp[64 + i]; s2 += lp[128 + i] * lp[192 + i]; }
    const float lam_init = 0.8f - 0.6f * expf(-0.3f * (float)l);
    const float lam = expf(s1) - expf(s2) + lam_init;
    const bool need_ctx = l < DEPTH - 1;
    if (EN(13)) for (int u = X.wg; u < 512; u += X.nwg) mla_attn_unit(X, P, u >> 7, (u >> 4) & 7, (u & 15) * 256, 0);
    if (EN(14)) for (int v = X.wg; v < 512; v += X.nwg) da_attn_unit(X, P, l, v >> 7, (v >> 5) & 3, (v & 31) * 128, 0, lam, lam_init);
    if (EN(15)) for (int u = X.wg; u < 16 * NCH; u += X.nwg) mlstm_c_unit(X, P, l, u);
    if (need_ctx) {
        if (EN(13)) for (int v = X.wg; v < 32; v += X.nwg) mla_attn_unit(X, P, v >> 3, v & 7, 0, 1);
        if (EN(14)) for (int v = X.nwg - 1 - X.wg; v < 32; v += X.nwg) da_attn_unit(X, P, l, v >> 3, (v >> 1) & 3, (v & 1) * 128, 1, lam, lam_init);
    }
}

__global__ void __launch_bounds__(512, 2) fwd_megakernel(Params P) {
    extern __shared__ __attribute__((aligned(16))) unsigned char lds[];
    cg::grid_group grid = cg::this_grid();
    Ctx X; X.lds = lds; X.tid = threadIdx.x; X.lane = X.tid & 63; X.wave = __builtin_amdgcn_readfirstlane(X.tid >> 6);
    X.nwg = gridDim.x; X.wg = blockIdx.x; X.gw = X.wg * 8 + X.wave; X.ngw = X.nwg * 8;
    LAS unsigned char* lds3 = (LAS unsigned char*)lds;
    unsigned char* ws = P.ws;
    if (threadIdx.x < 16) ((LAS unsigned*)(lds3 + 131072 + 64))[threadIdx.x] = 0u;
    __syncthreads();
    (void)xcd_barrier_post((unsigned*)(ws + WS_BAR), (volatile LAS unsigned*)(lds3 + 131072 + 64));
    float* R_lat = P.out; float* R_ctx = (float*)(ws + WS_RCTX);
    bf16_t* AB = (bf16_t*)(ws + WS_AB);

#ifdef PROBE_CAT
    if (blockIdx.x == 0 && threadIdx.x == 0) { volatile unsigned long long* tp_ = (volatile unsigned long long*)(P.ws + WS_END); tp_[0] = __builtin_amdgcn_s_memrealtime(); tp_[1] = 0; tp_[2] = 0; }
#endif
    if (EN(0)) mod_gemv(X, P);
    if (EN(1)) convert_weights(X, P, 0);
    grid.sync();
#ifdef PROBE_CAT
    STAMP(0);
#endif
    for (int l = 0; l < DEPTH; ++l) {
        const float* modl = (const float*)(ws + WS_MOD) + (size_t)l * 5 * 6 * DM;
        const float* xin_lat = l == 0 ? P.in[I_X] : R_lat; const float* xin_ctx = l == 0 ? P.in[I_CTX] : R_ctx;
        const int Mfin = l < DEPTH - 1 ? M_ALL : M_LAT;
        if (EN(2)) modulate_phase(X, xin_lat, xin_ctx, P.in[I_N1G] + l * DM, modl, 0 * DM, 1 * DM, AB, M_ALL);
        if (EN(1)) if (l > 0) convert_weights(X, P, l);
        STAMP(1);
        if (EN(3)) { pg8::Gemm g{AB, (const bf16_t*)(ws + WS_WIN), M_ALL, NPROJ, DM}; pg8::StaticOrder S; S.init(M_ALL, NPROJ, X.nwg, X.wg);
          pg8::EpiBf16 E{(bf16_t*)(ws + WS_PROJ), NPROJ, (float*)(ws + WS_GATES), C_GATE / 256};
          pg8::gemm_phase<pg8::EpiBf16>(lds3, g, S, E); }
        STAMP(2);
        if (EN(4)) prep_phase(X, P, l);
        STAMP(3);
        if (EN(5)) { pg8::Gemm g{(const bf16_t*)(ws + WS_CQN), (const bf16_t*)(ws + WS_WUQ), M_ALL, 1536, 512}; pg8::StaticOrder S; S.init(M_ALL, 1536, X.nwg, X.wg);
          pg8::EpiBf16 E{(bf16_t*)(ws + WS_QUP), 1536, nullptr, 0};
          pg8::gemm_phase<pg8::EpiBf16>(lds3, g, S, E); }
        if (EN(5)) { pg8::Gemm g{(const bf16_t*)(ws + WS_CKVN), (const bf16_t*)(ws + WS_WUKV), M_ALL, 2048, 256}; pg8::StaticOrder S; S.init(M_ALL, 2048, X.nwg, X.wg);
          pg8::EpiBf16 E{(bf16_t*)(ws + WS_KVUP), 2048, nullptr, 0};
          pg8::gemm_phase<pg8::EpiBf16>(lds3, g, S, E); }
        __syncthreads();
        if (EN(6)) mlstm_a_phase(X, P, l);
        STAMP(4);
        if (EN(7)) mla_prep_phase(X, P, l);
        if (EN(8)) mlstm_scan_phase(X, P);
        STAMP(5);
        if (EN(9)) mixer_phase(X, P, l);
        STAMP(6);
        if (EN(10)) { pg8::Gemm g{AB, (const bf16_t*)(ws + WS_WOUT), Mfin, DM, DM}; pg8::StaticOrder S; S.init(Mfin, DM, X.nwg, X.wg);
          pg8::EpiRes E{xin_lat, xin_ctx, R_lat, R_ctx, modl + 2 * DM};
          pg8::gemm_phase<pg8::EpiRes>(lds3, g, S, E); }
        STAMP(7);
        if (EN(2)) modulate_phase(X, R_lat, R_ctx, P.in[I_N2G] + l * DM, modl, 3 * DM, 4 * DM, AB, Mfin);
        STAMP(1);
        if (EN(11)) { pg8::Gemm g{AB, (const bf16_t*)(ws + WS_WGU), Mfin, 2 * FF, DM}; pg8::StaticOrder S; S.init(Mfin, 2 * FF, X.nwg, X.wg);
          pg8::EpiSwiGLU E{(bf16_t*)(ws + WS_HID), FF};
          pg8::gemm_phase<pg8::EpiSwiGLU>(lds3, g, S, E); }
        STAMP(9);
        if (EN(12)) { pg8::Gemm g{(const bf16_t*)(ws + WS_HID), (const bf16_t*)(ws + WS_WDN), Mfin, DM, FF}; pg8::StaticOrder S; S.init(Mfin, DM, X.nwg, X.wg);
          pg8::EpiRes E{R_lat, R_ctx, R_lat, R_ctx, modl + 5 * DM};
          pg8::gemm_phase<pg8::EpiRes>(lds3, g, S, E); }
#ifdef PROBE_CAT
        STAMP(10);
#else
        if (l + 1 < DEPTH) xcd_barrier(P.ws);
#endif
    }
#ifdef PROBE_CAT
    if (blockIdx.x == 0 && threadIdx.x == 0) P.out[1] += 250.0f * floorf((float)(((volatile unsigned long long*)(P.ws + WS_END))[2]) * 0.01f * (1.0f / 250.0f));
    if (blockIdx.x == 0 && threadIdx.x == 0) P.out[0] += 250.0f * floorf((float)(((volatile unsigned long long*)(P.ws + WS_END))[1]) * 0.01f * (1.0f / 250.0f));
#endif
}

extern "C" void kernel_launch(void* const* d_in, const int* in_sizes, int n_in, void* d_out, int out_size, void* d_ws, size_t ws_size, hipStream_t stream) {
    static int grid = 0;
    if (grid == 0) {
        if (n_in != 24 || ws_size < WS_END) { fprintf(stderr, "kernel_launch: unexpected inputs (n_in %d, ws %zu)\n", n_in, ws_size); grid = -1; return; }
        int dev = 0, cus = 0, per_cu = 0;
        (void)hipGetDevice(&dev); (void)hipDeviceGetAttribute(&cus, hipDeviceAttributeMultiprocessorCount, dev);
        if (hipFuncSetAttribute((const void*)fwd_megakernel, hipFuncAttributeMaxDynamicSharedMemorySize, LDS_BYTES) != hipSuccess) { fprintf(stderr, "kernel_launch: hipFuncSetAttribute failed\n"); grid = -1; return; }
        (void)hipOccupancyMaxActiveBlocksPerMultiprocessor(&per_cu, (const void*)fwd_megakernel, 512, LDS_BYTES);
        (void)hipGetLastError();
        if (per_cu < 1) { fprintf(stderr, "kernel_launch: occupancy query says %d\n", per_cu); per_cu = 1; }
        grid = cus;
    }
    if (grid < 0) return;
    if (hipMemsetAsync((char*)d_ws + WS_BAR, 0, XCD_BAR_WORDS * 4, stream) != hipSuccess) { fprintf(stderr, "kernel_launch: memset failed\n"); return; }
    Params p{};
    for (int i = 0; i < 24; ++i) p.in[i] = (const float*)d_in[i];
    p.out = (float*)d_out; p.ws = (unsigned char*)d_ws;
    void* args[] = {&p};
    hipError_t e = hipLaunchCooperativeKernel((const void*)fwd_megakernel, dim3(grid), dim3(512), args, LDS_BYTES, stream);
    if (e != hipSuccess) fprintf(stderr, "cooperative launch failed: %s (grid %d)\n", hipGetErrorString(e), grid);
}
```

```cpp
#include <hip/hip_runtime.h>
#include <hip/hip_cooperative_groups.h>
#include <cstdio>
#include <cstdint>
namespace cg = cooperative_groups;

#define LAS __attribute__((address_space(3)))
typedef unsigned short bf16_t;
typedef short bf16x8 __attribute__((ext_vector_type(8)));
typedef float f32x4 __attribute__((ext_vector_type(4)));
typedef float f32x16 __attribute__((ext_vector_type(16)));
typedef unsigned u32x4 __attribute__((ext_vector_type(4)));
typedef unsigned u32x2 __attribute__((ext_vector_type(2)));

constexpr int DM = 2048, BATCH = 4, SEQ = 4096, CTXL = 256, DEPTH = 2;
constexpr int M_LAT = BATCH * SEQ, M_CTX = BATCH * CTXL, M_ALL = M_LAT + M_CTX;
constexpr int TK = CTXL + SEQ;
constexpr int NCH = TK / 64;
constexpr int IN_W = 4432, NPROJ = 4608, FF = 5632;
constexpr int C_DAQ = 0, C_DAK = 512, C_DAV = 1024, C_MLQ = 1536, C_MLK = 2048, C_MLV = 2560, C_MLO = 3072, C_GATE = 3584, C_CQ = 3600, C_CKV = 4112, C_KPE = 4368;
constexpr float EPS = 1e-6f;
constexpr float LOG2E = 1.4426950408889634f;

constexpr size_t MiB = 1u << 20;
constexpr size_t WS_WIN = 0, WS_WOUT = 18 * MiB, WS_WGU = 26 * MiB, WS_WDN = 70 * MiB, WS_WUQ = 92 * MiB, WS_WUKV = 94 * MiB, WS_MOD = 95 * MiB, WS_RCTX = 96 * MiB;
constexpr size_t WS_AB = 104 * MiB;
constexpr size_t WS_PROJ = 172 * MiB;
constexpr size_t WS_QUP = 172 * MiB, WS_KVUP = 223 * MiB, WS_HID = 172 * MiB;
constexpr size_t WS_GATES = 325 * MiB, WS_CQN = 327 * MiB, WS_CKVN = 344 * MiB, WS_KPE = 353 * MiB, WS_OCOPY = 356 * MiB;
constexpr size_t WS_QDA = 373 * MiB, WS_KDA = 390 * MiB, WS_VTDA = 407 * MiB, WS_QML = 424 * MiB, WS_KML = 441 * MiB, WS_KTML = 458 * MiB, WS_VTML = 475 * MiB;
constexpr size_t WS_QM = 492 * MiB, WS_KM = 543 * MiB, WS_VTM = 594 * MiB, WS_CSNAP = 628 * MiB, WS_NSNAP = 696 * MiB, WS_NU = 698 * MiB, WS_CSTAT = 700 * MiB, WS_BAR = 701 * MiB, WS_END = 702 * MiB;
static_assert((size_t)NPROJ * DM * 2 <= 18 * MiB && (size_t)2 * FF * DM * 2 <= 44 * MiB && (size_t)M_ALL * NPROJ * 2 <= 153 * MiB, "ws map");
static_assert(WS_HID + (size_t)M_ALL * FF * 2 <= WS_QDA, "hid overlay");
static_assert(WS_END <= 768 * MiB, "ws fits the guaranteed minimum");

constexpr int LDS_BYTES = 140 * 1024;
#ifndef PH_EN
#define PH_EN 0xFFFF
#endif
#define EN(k) ((PH_EN >> (k)) & 1)
#ifdef PROBE_CAT
#define STAMP(cat) do { xcd_barrier(P.ws()); if (blockIdx.x == 0 && threadIdx.x == 0) { volatile unsigned long long* tp_ = (volatile unsigned long long*)(P.ws() + WS_END); const unsigned long long t1_ = __builtin_amdgcn_s_memrealtime(); if ((1 << (cat)) & PROBE_CAT) tp_[1] += t1_ - tp_[0]; if ((1 << (cat)) & PROBE_CAT2) tp_[2] += t1_ - tp_[0]; tp_[0] = t1_; } } while (0)
#define STAMPN(cat) do { __syncthreads(); if (blockIdx.x == 0 && threadIdx.x == 0) { volatile unsigned long long* tp_ = (volatile unsigned long long*)(P.ws() + WS_END); const unsigned long long t1_ = __builtin_amdgcn_s_memrealtime(); if ((1 << (cat)) & PROBE_CAT) tp_[1] += t1_ - tp_[0]; tp_[0] = t1_; } } while (0)
#else
#define STAMPN(cat) do {} while (0)
#define STAMP(cat) xcd_barrier(P.ws())
#endif

__device__ __forceinline__ unsigned f2bf(float f) { unsigned u = __builtin_bit_cast(unsigned, f); return (u + 0x7fffu + ((u >> 16) & 1u)) >> 16; }
typedef float f32x2_t __attribute__((ext_vector_type(2))); typedef __bf16 bf16x2_t __attribute__((ext_vector_type(2)));
__device__ __forceinline__ unsigned pk2(float lo, float hi) { f32x2_t v = {lo, hi}; bf16x2_t b = __builtin_convertvector(v, bf16x2_t); return __builtin_bit_cast(unsigned, b); }
__device__ __forceinline__ float bflo(unsigned w) { return __builtin_bit_cast(float, w << 16); }
__device__ __forceinline__ float bfhi(unsigned w) { return __builtin_bit_cast(float, w & 0xffff0000u); }
__device__ __forceinline__ float bf1(bf16_t h) { return __builtin_bit_cast(float, (unsigned)h << 16); }
__device__ __forceinline__ void unpack8(const u32x4 w, float* v) { v[0] = bflo(w.x); v[1] = bfhi(w.x); v[2] = bflo(w.y); v[3] = bfhi(w.y); v[4] = bflo(w.z); v[5] = bfhi(w.z); v[6] = bflo(w.w); v[7] = bfhi(w.w); }
__device__ __forceinline__ u32x4 pack8(const float* v) { u32x4 w; w.x = pk2(v[0], v[1]); w.y = pk2(v[2], v[3]); w.z = pk2(v[4], v[5]); w.w = pk2(v[6], v[7]); return w; }
__device__ __forceinline__ float wave_sum(float v) {
#pragma unroll
    for (int o = 1; o < 64; o <<= 1) v += __shfl_xor(v, o);
    return v;
}
__device__ __forceinline__ float wave_max(float v) {
#pragma unroll
    for (int o = 1; o < 64; o <<= 1) v = fmaxf(v, __shfl_xor(v, o));
    return v;
}
__device__ __forceinline__ float siluf(float x) { return x / (1.f + __expf(-x)); }
__device__ __forceinline__ float sigmf(float x) { return 1.f / (1.f + __expf(-x)); }
__device__ __forceinline__ int crow(int r, int hi) { return (r & 3) + 8 * (r >> 2) + 4 * hi; }
__device__ __forceinline__ int perm_off(int p) { const int h = p >> 3, j = p & 7; return 8 * (j >> 2) + 4 * h + (j & 3); }
__device__ __forceinline__ int mod_batch(int row) { return row < M_LAT ? (row >> 12) : 4; }

namespace pg8 {
constexpr int BM = 256, BK = 64, HALF = 128, HTB = HALF * BK * 2, STAGE_BYTES = 8 * HTB, NXCD = 8, WGM = 8;
__host__ __device__ __forceinline__ int lds_byte(int r, int c) { const int st = (r >> 4) * 2 + (c >> 5), rr = r & 15, cc = c & 31, ob = rr * 64 + cc * 2; return st * 1024 + (ob ^ (((ob >> 9) & 1) << 5)); }
__host__ __device__ __forceinline__ void stage_rc(int b, int& R, int& C) { const int st = b / 1024, sb = b % 1024, swz = sb ^ (((sb >> 9) & 1) << 5); R = (st >> 1) * 16 + swz / 64; C = (st & 1) * 32 + (swz % 64) / 2; }
__host__ __device__ __forceinline__ int perm32(int rho) { const int n = rho >> 4, i = rho & 15; return 8 * (i >> 2) + 4 * n + (i & 3); }

struct Unit { int pm, pn; };
struct Gemm { const bf16_t* A; const bf16_t* Bt; int M, N, K; };

struct StaticOrder {
    int nM, nN, nwg, G, c;
    __device__ void init(int M, int N, int G_, int c_) { nM = M / BM; nN = N / BM; nwg = nM * nN; G = G_; c = c_; }
    __device__ bool next(int i, Unit& u) const {
        const long L = (long)i * G + c; if (L >= nwg) return false;
        int wgid = (int)L; { const int q = nwg / NXCD, r = nwg % NXCD, xcd = wgid % NXCD, off = wgid / NXCD; wgid = (xcd < r ? xcd * (q + 1) : r * (q + 1) + (xcd - r) * q) + off; }
        const int nig = WGM * nN, gid = wgid / nig, fm = gid * WGM, gsz = (nM - fm) < WGM ? (nM - fm) : WGM;
        u.pm = fm + ((wgid % nig) % gsz); u.pn = (wgid % nig) / gsz; return true;
    }
};

struct EpiBf16 {
    static constexpr bool PERM = true;
    bf16_t* O; int ldc; float* gates; int gate_pn;
    __device__ __forceinline__ void operator()(const f32x4 (&acc)[2][2][4][2], const Unit& u, int wr, int wc, int fr, int fq) const {
        const int row0 = u.pm * BM + wr * 64 + fr; const int col0 = u.pn * BM + wc * 32 + 8 * fq;
        const bool g = gates != nullptr && u.pn == gate_pn && wc == 0 && fq < 2;
#pragma unroll
        for (int ai = 0; ai < 2; ++ai)
#pragma unroll
            for (int m = 0; m < 4; ++m) { const int row = row0 + ai * HALF + m * 16; bf16_t* rowp = O + (size_t)row * ldc + col0;
#pragma unroll
                for (int bj = 0; bj < 2; ++bj) { const f32x4 v0 = acc[ai][bj][m][0], v1 = acc[ai][bj][m][1];
                    u32x4 w; w.x = pk2(v0[0], v0[1]); w.y = pk2(v0[2], v0[3]); w.z = pk2(v1[0], v1[1]); w.w = pk2(v1[2], v1[3]);
                    *(u32x4*)(rowp + bj * HALF) = w;
                    if (bj == 0 && g) { *(f32x4*)(gates + (size_t)row * 16 + 8 * fq) = v0; *(f32x4*)(gates + (size_t)row * 16 + 8 * fq + 4) = v1; } } }
    }
};
struct EpiSwiGLU {
    static constexpr bool PERM = true;
    bf16_t* O; int ldc;
    __device__ __forceinline__ void operator()(const f32x4 (&acc)[2][2][4][2], const Unit& u, int wr, int wc, int fr, int fq) const {
        const int row0 = u.pm * BM + wr * 64 + fr; const int col0 = u.pn * HALF + wc * 32 + 8 * fq;
#pragma unroll
        for (int ai = 0; ai < 2; ++ai)
#pragma unroll
            for (int m = 0; m < 4; ++m) { const int row = row0 + ai * HALF + m * 16;
                float o[8];
#pragma unroll
                for (int n = 0; n < 2; ++n)
#pragma unroll
                    for (int i = 0; i < 4; ++i) { const float gt = acc[ai][0][m][n][i], up = acc[ai][1][m][n][i]; o[4 * n + i] = siluf(gt) * up; }
                *(u32x4*)(O + (size_t)row * ldc + col0) = pack8(o); }
    }
};
struct EpiRes {
    static constexpr bool PERM = false;
    const float* res_lat; const float* res_ctx; float* out_lat; float* out_ctx; const float* gate;
    __device__ __forceinline__ void operator()(const f32x4 (&acc)[2][2][4][2], const Unit& u, int wr, int wc, int fr, int fq) const {
        const int row0 = u.pm * BM + wr * 64 + fr; const int col0 = u.pn * BM + wc * 32 + 4 * fq;
#pragma unroll
        for (int ai = 0; ai < 2; ++ai)
#pragma unroll
            for (int m = 0; m < 4; ++m) { const int row = row0 + ai * HALF + m * 16;
                const float* rp = row < M_LAT ? res_lat + (size_t)row * DM : res_ctx + (size_t)(row - M_LAT) * DM;
                float* op = row < M_LAT ? out_lat + (size_t)row * DM : out_ctx + (size_t)(row - M_LAT) * DM;
                const float* gp = gate + (size_t)mod_batch(row) * 6 * DM;
#pragma unroll
                for (int bj = 0; bj < 2; ++bj)
#pragma unroll
                    for (int n = 0; n < 2; ++n) { const int c = col0 + bj * HALF + n * 16;
                        const f32x4 r = *(const f32x4*)(rp + c), g = *(const f32x4*)(gp + c);
                        *(f32x4*)(op + c) = r + g * acc[ai][bj][m][n]; } }
    }
};

template <class Epi, bool ALIGN_EPI = true>
__device__ __forceinline__ void gemm_phase(LAS unsigned char* lds, const Gemm g, const StaticOrder& S, const Epi& E) {
    int tid = threadIdx.x; asm volatile("" : "+v"(tid)); const int wid = __builtin_amdgcn_readfirstlane(tid >> 6), lane = tid & 63, wr = wid >> 2, wc = wid & 3, fr = lane & 15, fq = lane >> 4;
    int K = g.K; asm volatile("" : "+s"(K)); const int nt = K / BK;
    unsigned voffA[2], voffB[2];
#pragma unroll
    for (int i = 0; i < 2; ++i) { int R, C; stage_rc(tid * 16 + i * 8192, R, C); const int Rb = Epi::PERM ? ((R & ~31) + perm32(R & 31)) : R;
        voffA[i] = (unsigned)(R * K + C) * 2u; voffB[i] = (unsigned)(Rb * K + C) * 2u; }
    const size_t kstep = (size_t)(BK * 2);
    const size_t hstep = (size_t)HALF * K * 2;
    const size_t tstep = 2 * hstep;
    const unsigned ldsw = (unsigned)wid * 1024u;
    const int aoff = lds_byte(wr * 64 + fr, fq * 8), boff = lds_byte(wc * 32 + fr, fq * 8);
#define PG8_SA(b, h) (((b) * 2 + (h)) * HTB)
#define PG8_SB(b, h) ((4 + (b) * 2 + (h)) * HTB)
#define PG8_STAGE(bufoff, gbase, voff) do { _Pragma("unroll") for (int _i = 0; _i < 2; ++_i) \
        __builtin_amdgcn_global_load_lds((const unsigned*)((const char*)(gbase) + (voff)[_i]), (LAS unsigned*)(lds + (bufoff) + ldsw + _i * 8192), 16, 0, 0); } while (0)
#define PG8_LDA(dst, b, h) do { _Pragma("unroll") for (int m = 0; m < 4; ++m) _Pragma("unroll") for (int k = 0; k < 2; ++k) dst[m][k] = *(const LAS bf16x8*)(lds + PG8_SA(b, h) + aoff + m * 2048 + k * 1024); } while (0)
#define PG8_LDB(dst, b, h) do { _Pragma("unroll") for (int n = 0; n < 2; ++n) _Pragma("unroll") for (int k = 0; k < 2; ++k) dst[n][k] = *(const LAS bf16x8*)(lds + PG8_SB(b, h) + boff + n * 2048 + k * 1024); } while (0)
#define PG8_MMA(ai, bj, At, Bt) do { __builtin_amdgcn_s_setprio(1); _Pragma("unroll") for (int m = 0; m < 4; ++m) _Pragma("unroll") for (int n = 0; n < 2; ++n) _Pragma("unroll") for (int k = 0; k < 2; ++k) \
        acc[ai][bj][m][n] = __builtin_amdgcn_mfma_f32_16x16x32_bf16(Bt[n][k], At[m][k], acc[ai][bj][m][n], 0, 0, 0); __builtin_amdgcn_s_setprio(0); } while (0)
#define PG8_WAIT_V(n) asm volatile("s_waitcnt vmcnt(" #n ")" ::: "memory")
#define PG8_WAIT_L(n) asm volatile("s_waitcnt lgkmcnt(" #n ")" ::: "memory")
#define PG8_BAR __builtin_amdgcn_s_barrier()
#define PG8_SCHED __builtin_amdgcn_sched_barrier(0)
    Unit cur, nxt; int ui = 0;
    if (!S.next(0, cur)) return;
    f32x4 acc[2][2][4][2];
#pragma unroll
    for (int a = 0; a < 2; ++a)
#pragma unroll
        for (int b = 0; b < 2; ++b)
#pragma unroll
            for (int m = 0; m < 4; ++m)
#pragma unroll
                for (int n = 0; n < 2; ++n) acc[a][b][m][n] = (f32x4){0.f, 0.f, 0.f, 0.f};
    bf16x8 At[4][2], B0[2][2], B1[2][2];
    const char* cA = (const char*)g.A + (size_t)cur.pm * tstep; const char* cB = (const char*)g.Bt + (size_t)cur.pn * tstep;
    PG8_STAGE(PG8_SB(0, 0), cB, voffB); PG8_STAGE(PG8_SB(0, 1), cB + hstep, voffB); PG8_STAGE(PG8_SA(0, 0), cA, voffA); PG8_STAGE(PG8_SA(0, 1), cA + hstep, voffA);
    if (wr == 1) PG8_BAR;
    PG8_WAIT_V(2); PG8_BAR;
    PG8_STAGE(PG8_SB(1, 0), cB + kstep, voffB); PG8_STAGE(PG8_SA(1, 0), cA + kstep, voffA); PG8_STAGE(PG8_SB(1, 1), cB + hstep + kstep, voffB);
    PG8_WAIT_V(6); PG8_BAR;
    for (;;) {
        const bool has_next = S.next(ui + 1, nxt);
        const char* nA = has_next ? (const char*)g.A + (size_t)nxt.pm * tstep : cA; const char* nB = has_next ? (const char*)g.Bt + (size_t)nxt.pn * tstep : cB;
        for (int t = 0; t < nt; t += 2) {
            const bool last = (t == nt - 2);
            const char* a1 = cA + (size_t)(t + 1) * kstep;
            const char* a2 = last ? nA : cA + (size_t)(t + 2) * kstep; const char* b2 = last ? nB : cB + (size_t)(t + 2) * kstep;
            const char* a3 = a2 + kstep; const char* b3 = b2 + kstep;
            PG8_LDB(B0, 0, 0); PG8_LDB(B1, 0, 1); PG8_SCHED; PG8_LDA(At, 0, 0); PG8_STAGE(PG8_SA(1, 1), a1 + hstep, voffA);
            PG8_WAIT_V(8); PG8_WAIT_L(0); PG8_BAR; PG8_MMA(0, 0, At, B0); PG8_MMA(0, 1, At, B1); PG8_BAR; PG8_SCHED;
            PG8_LDA(At, 0, 1); PG8_STAGE(PG8_SB(0, 0), b2, voffB); PG8_STAGE(PG8_SB(0, 1), b2 + hstep, voffB); PG8_STAGE(PG8_SA(0, 0), a2, voffA);
            PG8_WAIT_V(8); PG8_WAIT_L(0); PG8_BAR; PG8_MMA(1, 0, At, B0); PG8_MMA(1, 1, At, B1); PG8_BAR; PG8_SCHED;
            PG8_LDB(B0, 1, 0); PG8_LDB(B1, 1, 1); PG8_SCHED; PG8_LDA(At, 1, 0); PG8_STAGE(PG8_SA(0, 1), a2 + hstep, voffA);
            PG8_WAIT_V(8); PG8_WAIT_L(0); PG8_BAR; PG8_MMA(0, 0, At, B0); PG8_MMA(0, 1, At, B1); PG8_BAR; PG8_SCHED;
            PG8_LDA(At, 1, 1); PG8_STAGE(PG8_SB(1, 0), b3, voffB); PG8_STAGE(PG8_SB(1, 1), b3 + hstep, voffB); PG8_STAGE(PG8_SA(1, 0), a3, voffA);
            PG8_WAIT_V(8); PG8_WAIT_L(0); PG8_BAR; PG8_MMA(1, 0, At, B0); PG8_MMA(1, 1, At, B1); PG8_BAR; PG8_SCHED;
        }
        if constexpr (ALIGN_EPI) { if (wr == 0) PG8_BAR; }
        E(acc, cur, wr, wc, fr, fq);
        if (!has_next) break;
#pragma unroll
        for (int a = 0; a < 2; ++a)
#pragma unroll
            for (int b = 0; b < 2; ++b)
#pragma unroll
                for (int m = 0; m < 4; ++m)
#pragma unroll
                    for (int n = 0; n < 2; ++n) acc[a][b][m][n] = (f32x4){0.f, 0.f, 0.f, 0.f};
        cur = nxt; cA = nA; cB = nB; ++ui;
        if constexpr (ALIGN_EPI) { if (wr == 1) PG8_BAR; }
    }
    PG8_WAIT_V(0);
    if constexpr (!ALIGN_EPI) { if (wr == 0) PG8_BAR; }
    PG8_BAR;
#undef PG8_SA
#undef PG8_SB
#undef PG8_STAGE
#undef PG8_LDA
#undef PG8_LDB
#undef PG8_MMA
#undef PG8_WAIT_V
#undef PG8_WAIT_L
#undef PG8_BAR
#undef PG8_SCHED
}
}


#define XB_TMO      128
#define XB_XCNT(j)  (256  + 64 * (j))
#define XB_XSUB(j)  (1280 + 64 * (j))
#define XB_XGEN(j)  (2304 + 64 * (j))
#define XB_TOP      3328
#define XB_TOPGEN   3392
#define XCD_BAR_WORDS 3456
#define XB_SPIN_CAP (1u << 22)
__device__ __forceinline__ unsigned xb_ld(unsigned* p)              { return __hip_atomic_load(p, __ATOMIC_RELAXED, __HIP_MEMORY_SCOPE_AGENT); }
__device__ __forceinline__ unsigned xb_add(unsigned* p, unsigned v) { return __hip_atomic_fetch_add(p, v, __ATOMIC_RELAXED, __HIP_MEMORY_SCOPE_AGENT); }
__device__ __forceinline__ unsigned xb_xcc_id() { return (unsigned)__builtin_amdgcn_s_getreg((3 << 11) | 20) & 0xFu; }
#define XB_SPIN(cond, bar) do { unsigned _sp = 0; while (cond) { __builtin_amdgcn_s_sleep(1); \
    if ((++_sp & 255u) == 0u) { if (xb_ld(&(bar)[XB_TMO])) break; if (_sp > XB_SPIN_CAP) { atomicAdd(&(bar)[XB_TMO], 1u); break; } } } } while (0)
struct XcdBarrier { unsigned* bar; unsigned x; volatile LAS unsigned* st; };
__device__ __forceinline__ XcdBarrier xcd_barrier_post(unsigned* bar, volatile LAS unsigned* st) {
    XcdBarrier b; b.bar = bar; b.x = xb_xcc_id(); b.st = st;
    if (threadIdx.x == 0) (void)xb_add(&bar[XB_XCNT(b.x)], 1u);
    return b;
}
__device__ __forceinline__ void xcd_barrier_complete(unsigned* bar, unsigned x, unsigned& nloc, unsigned& nx) {
    const unsigned G = gridDim.x * gridDim.y * gridDim.z;
    unsigned sum, cnt, mine, sp = 0u;
    for (;;) {
        sum = 0u; cnt = 0u; mine = 0u;
#pragma unroll
        for (unsigned j = 0; j < 16; ++j) { const unsigned c = xb_ld(&bar[XB_XCNT(j)]); sum += c; cnt += (c > 0u) ? 1u : 0u; mine = (j == x) ? c : mine; }
        if (sum == G) break;
        __builtin_amdgcn_s_sleep(1);
        if ((++sp & 255u) == 0u) { if (xb_ld(&bar[XB_TMO])) break; if (sp > XB_SPIN_CAP) { atomicAdd(&bar[XB_TMO], 1u); break; } }
    }
    nloc = mine > 0u ? mine : 1u; nx = cnt > 0u ? cnt : 1u;
}
__device__ __forceinline__ void xcd_barrier(unsigned char* wsb) {
    XcdBarrier b; b.bar = (unsigned*)(wsb + WS_BAR); b.x = 0; b.st = (volatile LAS unsigned*)(135168 + 64);
    asm volatile("s_waitcnt vmcnt(0)" ::: "memory");
    __syncthreads();
    if (threadIdx.x == 0) {
        unsigned* bar = b.bar; b.x = xb_xcc_id();
        __builtin_amdgcn_s_waitcnt(0);
        unsigned nloc = b.st[0], nx = b.st[1];
        if (nloc == 0u) { xcd_barrier_complete(bar, b.x, nloc, nx); b.st[0] = nloc; b.st[1] = nx; }
        const unsigned old = xb_add(&bar[XB_XSUB(b.x)], 1u);
        const unsigned gen = old / nloc;
        if (old + 1u == (gen + 1u) * nloc) {
            __builtin_amdgcn_fence(__ATOMIC_RELEASE, "agent");
            asm volatile("s_waitcnt vmcnt(0)" ::: "memory");
            const unsigned og = xb_add(&bar[XB_TOP], 1u);
            const unsigned tg = og / nx;
            if (og + 1u == (tg + 1u) * nx) xb_add(&bar[XB_TOPGEN], 1u);
            else XB_SPIN(xb_ld(&bar[XB_TOPGEN]) == tg, bar);
            __builtin_amdgcn_fence(__ATOMIC_ACQUIRE, "agent");
            xb_add(&bar[XB_XGEN(b.x)], 1u);
            asm volatile("s_waitcnt vmcnt(0)" ::: "memory");
        } else {
            XB_SPIN(xb_ld(&bar[XB_XGEN(b.x)]) == gen, bar);
            __builtin_amdgcn_fence(__ATOMIC_ACQUIRE, "agent");
            asm volatile("s_waitcnt vmcnt(0)" ::: "memory");
        }
    }
    __syncthreads();
}

struct Params { const float* in[24]; float* out; unsigned char* ws; };
struct PRef {
    typedef const __attribute__((address_space(4))) char* kptr_t;
    __device__ __forceinline__ kptr_t base() const { kptr_t ka = (kptr_t)__builtin_amdgcn_kernarg_segment_ptr(); asm volatile("" : "+s"(ka)); return ka; }
    __device__ __forceinline__ const float* in(int i) const { return *(const float* const __attribute__((address_space(4)))*)(base() + 8 * i); }
    __device__ __forceinline__ float* out() const { return *(float* const __attribute__((address_space(4)))*)(base() + 8 * 24); }
    __device__ __forceinline__ unsigned char* ws() const { return *(unsigned char* const __attribute__((address_space(4)))*)(base() + 8 * 25); }
};
enum { I_X = 0, I_C, I_CTX, I_CCTX, I_MODW, I_MODB, I_N1G, I_N2G, I_WIN, I_DAQKG, I_DALAM, I_DAOUTG, I_CONVW, I_CONVB, I_GATEB, I_MLOUTG, I_QNG, I_KVNG, I_WUQ, I_WUKV, I_MLAQKG, I_WOUT, I_WGU, I_WDN };

struct Ctx {
    unsigned char* lds;
    int tid, lane, wave, gw, ngw, nwg, wg; unsigned l3off;
};

__device__ __forceinline__ Ctx fresh(const Ctx& X) {
    Ctx Y = X; int t = X.tid; asm volatile("" : "+v"(t)); Y.tid = t; Y.lane = t & 63; Y.wave = __builtin_amdgcn_readfirstlane(t >> 6); return Y;
}
template <int MODE>
__device__ __forceinline__ void transpose_item(const float* W, int K, int N, bf16_t* WT, float* scr, int item, int nblk, int lane) {
    const int kb = item / nblk, nb = item % nblk, k0 = 64 * kb, n0 = 32 * nb;
    const int ncol = n0 + (lane & 31); const bool ok = ncol < N;
#pragma unroll 8
    for (int i = 0; i < 32; ++i) { const int kk = 2 * i + (lane >> 5); scr[kk * 33 + (lane & 31)] = ok ? W[(size_t)(k0 + kk) * N + ncol] : 0.f; }
    asm volatile("s_waitcnt lgkmcnt(0)" ::: "memory");
    const int c = lane & 7;
#pragma unroll
    for (int j = 0; j < 4; ++j) { const int n = (lane >> 3) + 8 * j; const float* s = scr + (8 * c) * 33 + n;
        u32x4 o; o.x = pk2(s[0 * 33], s[1 * 33]); o.y = pk2(s[2 * 33], s[3 * 33]); o.z = pk2(s[4 * 33], s[5 * 33]); o.w = pk2(s[6 * 33], s[7 * 33]);
        int nn = n0 + n;
        if (MODE == 1) { const int up = nn >= FF ? 1 : 0; const int hcol = nn - up * FF; nn = (hcol >> 7) * 256 + up * 128 + (hcol & 127); }
        *(u32x4*)(WT + (size_t)nn * K + k0 + 8 * c) = o; }
    asm volatile("s_waitcnt lgkmcnt(0)" ::: "memory");
}
__device__ __forceinline__ void convert_weights(const Ctx& X0, const PRef& P, int l) {
    const Ctx X = fresh(X0);
    float* scr = (float*)(X.lds + X.wave * 16384);
    unsigned char* ws = P.ws();
    constexpr int I_IN = (DM / 64) * (NPROJ / 32), I_OUT = (DM / 64) * (DM / 32), I_GU = (DM / 64) * (2 * FF / 32), I_DN = (FF / 64) * (DM / 32), I_UQ = (512 / 64) * (1536 / 32), I_UKV = (256 / 64) * (2048 / 32);
    constexpr int NITEMS = I_IN + I_OUT + I_GU + I_DN + I_UQ + I_UKV;
    for (int it = X.gw; it < NITEMS; it += X.ngw) {
        int r = it;
        if (r < I_IN) { transpose_item<0>(P.in(I_WIN) + (size_t)l * DM * IN_W, DM, IN_W, (bf16_t*)(ws + WS_WIN), scr, r, NPROJ / 32, X.lane); continue; } r -= I_IN;
        if (r < I_OUT) { transpose_item<0>(P.in(I_WOUT) + (size_t)l * DM * DM, DM, DM, (bf16_t*)(ws + WS_WOUT), scr, r, DM / 32, X.lane); continue; } r -= I_OUT;
        if (r < I_GU) { transpose_item<1>(P.in(I_WGU) + (size_t)l * DM * 2 * FF, DM, 2 * FF, (bf16_t*)(ws + WS_WGU), scr, r, 2 * FF / 32, X.lane); continue; } r -= I_GU;
        if (r < I_DN) { transpose_item<0>(P.in(I_WDN) + (size_t)l * FF * DM, FF, DM, (bf16_t*)(ws + WS_WDN), scr, r, DM / 32, X.lane); continue; } r -= I_DN;
        if (r < I_UQ) { transpose_item<0>(P.in(I_WUQ) + (size_t)l * 512 * 1536, 512, 1536, (bf16_t*)(ws + WS_WUQ), scr, r, 1536 / 32, X.lane); continue; } r -= I_UQ;
        transpose_item<0>(P.in(I_WUKV) + (size_t)l * 256 * 2048, 256, 2048, (bf16_t*)(ws + WS_WUKV), scr, r, 2048 / 32, X.lane);
    }
}
__device__ __forceinline__ void mod_gemv(const Ctx& X0, const PRef& P) {
    const Ctx X = fresh(X0);
    float* sc = (float*)X.lds;
    float* red = (float*)(X.lds + 40960);
    for (int i = X.tid; i < 5 * DM; i += 512) { const int mb = i / DM, k = i % DM; const float v = mb < 4 ? P.in(I_C)[mb * DM + k] : P.in(I_CCTX)[k]; sc[i] = siluf(v); }
    __syncthreads();
    float* mod = (float*)(P.ws() + WS_MOD);
    const int kq = X.tid >> 4, c4 = X.tid & 15;
    for (int task = X.wg; task < DEPTH * 192; task += X.nwg) {
        const int l = task / 192, n0 = (task % 192) * 64;
        const float* W = P.in(I_MODW) + (size_t)l * DM * 6 * DM + n0 + 4 * c4;
        f32x4 a[5];
#pragma unroll
        for (int mb = 0; mb < 5; ++mb) a[mb] = (f32x4){0.f, 0.f, 0.f, 0.f};
#pragma unroll 8
        for (int i = 0; i < 64; ++i) { const int k = kq + 32 * i; const f32x4 w = *(const f32x4*)(W + (size_t)k * 6 * DM);
#pragma unroll
            for (int mb = 0; mb < 5; ++mb) a[mb] += w * sc[mb * DM + k]; }
#pragma unroll
        for (int mb = 0; mb < 5; ++mb) *(f32x4*)(red + (kq * 5 + mb) * 64 + 4 * c4) = a[mb];
        __syncthreads();
        if (X.tid < 320) { const int mb = X.tid >> 6, cc = X.tid & 63; float s = 0.f;
#pragma unroll 8
            for (int q = 0; q < 32; ++q) s += red[(q * 5 + mb) * 64 + cc];
            mod[((size_t)l * 5 + mb) * 6 * DM + n0 + cc] = s + P.in(I_MODB)[(size_t)l * 6 * DM + n0 + cc]; }
        __syncthreads();
    }
}

__device__ __forceinline__ void modulate_phase(const Ctx& X0, const float* src_lat, const float* src_ctx, const float* g, const float* modl, int shift_off, int scale_off, bf16_t* A, int nrows) {
    const Ctx X = fresh(X0);
    f32x4 v[8], nx[8];
    int row = X.gw;
    if (row < nrows) { const float* src = row < M_LAT ? src_lat + (size_t)row * DM : src_ctx + (size_t)(row - M_LAT) * DM;
#pragma unroll
        for (int j = 0; j < 8; ++j) v[j] = *(const f32x4*)(src + X.lane * 4 + 256 * j); }
    for (; row < nrows; row += X.ngw) {
        const int nrow = row + X.ngw;
        if (nrow < nrows) { const float* src = nrow < M_LAT ? src_lat + (size_t)nrow * DM : src_ctx + (size_t)(nrow - M_LAT) * DM;
#pragma unroll
            for (int j = 0; j < 8; ++j) nx[j] = *(const f32x4*)(src + X.lane * 4 + 256 * j); }
        float ss = 0.f;
#pragma unroll
        for (int j = 0; j < 8; ++j) ss += (v[j][0] * v[j][0] + v[j][1] * v[j][1]) + (v[j][2] * v[j][2] + v[j][3] * v[j][3]);
        const float rstd = rsqrtf(wave_sum(ss) * (1.f / DM) + EPS);
        const float* mp = modl + (size_t)mod_batch(row) * 6 * DM;
#pragma unroll
        for (int j = 0; j < 8; ++j) { const int col = X.lane * 4 + 256 * j;
            const f32x4 gg = *(const f32x4*)(g + col), sc = *(const f32x4*)(mp + scale_off + col), sh = *(const f32x4*)(mp + shift_off + col);
            const f32x4 y = (v[j] * rstd) * gg * (sc + 1.0f) + sh;
            u32x2 w; w.x = pk2(y[0], y[1]); w.y = pk2(y[2], y[3]);
            *(u32x2*)(A + (size_t)row * DM + col) = w; }
#pragma unroll
        for (int j = 0; j < 8; ++j) v[j] = nx[j];
    }
}

struct ChunkId { int b, j, row0, tok0, is_lat, seglen; };
__device__ __forceinline__ ChunkId chunk_of_unit(int u) {
    ChunkId c;
    if (u < 256) { c.b = u >> 6; c.j = u & 63; c.row0 = c.b * SEQ + 64 * c.j; c.tok0 = CTXL + 64 * c.j; c.is_lat = 1; c.seglen = SEQ; }
    else { const int uu = u - 256; c.b = uu >> 2; c.j = uu & 3; c.row0 = M_LAT + c.b * CTXL + 64 * c.j; c.tok0 = 64 * c.j; c.is_lat = 0; c.seglen = CTXL; }
    return c;
}
__device__ __forceinline__ int row_of_tokchunk(int b, int jt) { return jt < 4 ? M_LAT + b * CTXL + 64 * jt : b * SEQ + 64 * (jt - 4); }

constexpr int TSTR = 520;
__device__ __forceinline__ void write_vt(const Ctx& X, const bf16_t* tile, bf16_t* img, size_t img_row0, int tok0) {
#pragma unroll 2
    for (int it = 0; it < 8; ++it) { const int task = it * 512 + X.tid; const int k = task & 7, c = task >> 3;
        float v[8];
#pragma unroll
        for (int jj = 0; jj < 8; ++jj) { const int i = 16 * (k >> 1) + 8 * (jj >> 2) + 4 * (k & 1) + (jj & 3); v[jj] = bf1(tile[i * TSTR + c]); }
        *(u32x4*)(img + (img_row0 + c) * TK + tok0 + 8 * k) = pack8(v); }
}
template <class F>
__device__ __forceinline__ void load_tile(const Ctx& X, bf16_t* tile, const bf16_t* src, size_t rstride, F colmap) {
#pragma unroll 4
    for (int it = 0; it < 8; ++it) { const int ch = it * 512 + X.tid; const int i = ch >> 6, cc = ch & 63;
        const u32x4 w = *(const u32x4*)(src + (size_t)i * rstride + colmap(cc));
        *(u32x4*)(tile + i * TSTR + 8 * cc) = w; }
}

__device__ __forceinline__ void rope_cs(int sub, int prow, int pcol, float* cs, float* sn) {
    const float pos = (float)((sub < 4) ? prow : pcol);
#pragma unroll
    for (int e = 0; e < 8; ++e) { const int fi = (sub & 1) * 8 + e; const float inv = exp2f(-(float)fi * (13.287712379549449f / 16.0f)); const float a = pos * inv; cs[e] = __cosf(a); sn[e] = __sinf(a); }
}
__device__ __forceinline__ void rope_apply(int sub, float* y, const float* cs, const float* sn) {
#pragma unroll
    for (int e = 0; e < 8; ++e) { const float p = __shfl_xor(y[e], 2); y[e] = (sub & 2) ? (y[e] * cs[e] + p * sn[e]) : (y[e] * cs[e] - p * sn[e]); }
}

__device__ __forceinline__ void prep_phase(const Ctx& X0, const PRef& P, int l) {
    const Ctx X = fresh(X0);
    unsigned char* ws = P.ws();
    const bf16_t* proj = (const bf16_t*)(ws + WS_PROJ);
    bf16_t* tile = (bf16_t*)X.lds;
    const float* qkg = P.in(I_DAQKG) + l * 128;
    const float* convw = P.in(I_CONVW) + (size_t)l * 3 * 1024; const float* convb = P.in(I_CONVB) + l * 1024;
    const float* qng = P.in(I_QNG) + l * 512; const float* kvng = P.in(I_KVNG) + l * 256;
    const int lane = X.lane, sub = lane & 7;
    const float qscale = 0.125f * LOG2E;
    for (int u = X.wg; u < 272; u += X.nwg) {
        const ChunkId c = chunk_of_unit(u);
        for (int i = X.wave; i < 64; i += 8) {
            const int row = c.row0 + i, tseg = 64 * c.j + i, tok = c.tok0 + i;
            const bf16_t* pr = proj + (size_t)row * NPROJ;
            float cs[8], sn[8];
            if (c.is_lat) rope_cs(sub, c.j, i, cs, sn);
#pragma unroll
            for (int qk = 0; qk < 2; ++qk) {
                float y[8]; unpack8(*(const u32x4*)(pr + (qk ? C_DAK : C_DAQ) + 8 * lane), y);
                float ss = 0.f;
#pragma unroll
                for (int e = 0; e < 8; ++e) ss += y[e] * y[e];
                ss += __shfl_xor(ss, 1); ss += __shfl_xor(ss, 2); ss += __shfl_xor(ss, 4);
                const float rstd = rsqrtf(ss * (1.f / 64.f) + EPS);
#pragma unroll
                for (int e = 0; e < 8; ++e) y[e] = y[e] * rstd * qkg[qk * 64 + 8 * sub + e];
                if (c.is_lat) rope_apply(sub, y, cs, sn);
                const int head = lane >> 4, comp = (lane >> 3) & 1;
                if (qk == 0) {
#pragma unroll
                    for (int e = 0; e < 8; ++e) y[e] *= qscale;
                    *(u32x4*)((bf16_t*)(ws + WS_QDA) + ((size_t)head * M_ALL + row) * 128 + comp * 64 + 8 * sub) = pack8(y);
                } else {
                    *(u32x4*)((bf16_t*)(ws + WS_KDA) + ((size_t)(c.b * 4 + head) * TK + tok) * 128 + comp * 64 + 8 * sub) = pack8(y);
                }
            }
            {
                float y[8]; unpack8(*(const u32x4*)(pr + C_CQ + 8 * lane), y);
                float ss = 0.f;
#pragma unroll
                for (int e = 0; e < 8; ++e) ss += y[e] * y[e];
                const float rstd = rsqrtf(wave_sum(ss) * (1.f / 512.f) + EPS);
#pragma unroll
                for (int e = 0; e < 8; ++e) y[e] = y[e] * rstd * qng[8 * lane + e];
                *(u32x4*)((bf16_t*)(ws + WS_CQN) + (size_t)row * 512 + 8 * lane) = pack8(y);
            }
            {
                float y[8];
                if (lane < 32) unpack8(*(const u32x4*)(pr + C_CKV + 8 * lane), y);
                else {
#pragma unroll
                    for (int e = 0; e < 8; ++e) y[e] = 0.f;
                }
                float ss = 0.f;
#pragma unroll
                for (int e = 0; e < 8; ++e) ss += y[e] * y[e];
                const float rstd = rsqrtf(wave_sum(ss) * (1.f / 256.f) + EPS);
                if (lane < 32) {
#pragma unroll
                    for (int e = 0; e < 8; ++e) y[e] = y[e] * rstd * kvng[8 * lane + e];
                    *(u32x4*)((bf16_t*)(ws + WS_CKVN) + (size_t)row * 256 + 8 * lane) = pack8(y);
                }
            }
            if (lane < 8) *(u32x4*)((bf16_t*)(ws + WS_KPE) + (size_t)row * 64 + 8 * lane) = *(const u32x4*)(pr + C_KPE + 8 * lane);
            *(u32x4*)((bf16_t*)(ws + WS_OCOPY) + (size_t)row * 512 + 8 * lane) = *(const u32x4*)(pr + C_MLO + 8 * lane);
#pragma unroll
            for (int qk = 0; qk < 2; ++qk) {
                const int ch0 = qk * 512 + 8 * lane;
                float xm[8], x0[8], xp[8];
                unpack8(*(const u32x4*)(pr + C_MLQ + ch0), x0);
                if (tseg > 0) unpack8(*(const u32x4*)(pr - NPROJ + C_MLQ + ch0), xm);
                else {
#pragma unroll
                    for (int e = 0; e < 8; ++e) xm[e] = 0.f;
                }
                if (tseg < c.seglen - 1) unpack8(*(const u32x4*)(pr + NPROJ + C_MLQ + ch0), xp);
                else {
#pragma unroll
                    for (int e = 0; e < 8; ++e) xp[e] = 0.f;
                }
                float y[8];
#pragma unroll
                for (int e = 0; e < 8; ++e) { const float v = convb[ch0 + e] + convw[ch0 + e] * xm[e] + convw[1024 + ch0 + e] * x0[e] + convw[2048 + ch0 + e] * xp[e]; y[e] = siluf(v) * (qk ? 0.08838834764831845f : 1.0f); }
                const int head = lane >> 4, d = 8 * (lane & 15);
                const u32x4 w = pack8(y);
                *(u32x4*)((bf16_t*)(ws + (qk ? WS_KML : WS_QML)) + ((size_t)(c.b * 4 + head) * TK + tok) * 128 + d) = w;
                if (qk) *(u32x4*)(tile + i * TSTR + 8 * lane) = w;
            }
        }
        __syncthreads();
        write_vt(X, tile, (bf16_t*)(ws + WS_KTML), (size_t)c.b * 512, c.tok0);
        __syncthreads();
        load_tile(X, tile, proj + (size_t)c.row0 * NPROJ, NPROJ, [](int cc) { return C_DAV + 8 * cc; });
        __syncthreads();
        write_vt(X, tile, (bf16_t*)(ws + WS_VTDA), (size_t)c.b * 512, c.tok0);
        __syncthreads();
        load_tile(X, tile, proj + (size_t)c.row0 * NPROJ, NPROJ, [](int cc) { return C_MLV + 8 * cc; });
        __syncthreads();
        write_vt(X, tile, (bf16_t*)(ws + WS_VTML), (size_t)c.b * 512, c.tok0);
        __syncthreads();
    }
}

__device__ __forceinline__ void mla_prep_phase(const Ctx& X0, const PRef& P, int l) {
    const Ctx X = fresh(X0);
    unsigned char* ws = P.ws();
    const bf16_t* qup = (const bf16_t*)(ws + WS_QUP); const bf16_t* kvup = (const bf16_t*)(ws + WS_KVUP); const bf16_t* kpe = (const bf16_t*)(ws + WS_KPE);
    bf16_t* tile = (bf16_t*)X.lds;
    const float* g = P.in(I_MLAQKG) + l * 2 * 192;
    const int lane = X.lane, sub = lane & 7, head = lane >> 3;
    const float qscale = 0.07216878364870322f * LOG2E;
    for (int u = X.wg; u < 272; u += X.nwg) {
        const ChunkId c = chunk_of_unit(u);
        for (int i = X.wave; i < 64; i += 8) {
            const int row = c.row0 + i, tok = c.tok0 + i;
            float cs[8], sn[8];
            if (c.is_lat) rope_cs(sub, c.j, i, cs, sn);
#pragma unroll
            for (int qk = 0; qk < 2; ++qk) {
                float y[3][8];
                if (qk == 0) {
#pragma unroll
                    for (int cc = 0; cc < 3; ++cc) unpack8(*(const u32x4*)(qup + (size_t)row * 1536 + head * 192 + 64 * cc + 8 * sub), y[cc]);
                } else {
#pragma unroll
                    for (int cc = 0; cc < 2; ++cc) unpack8(*(const u32x4*)(kvup + (size_t)row * 2048 + head * 256 + 64 * cc + 8 * sub), y[cc]);
                    unpack8(*(const u32x4*)(kpe + (size_t)row * 64 + 8 * sub), y[2]);
                }
                float ss = 0.f;
#pragma unroll
                for (int cc = 0; cc < 3; ++cc)
#pragma unroll
                    for (int e = 0; e < 8; ++e) ss += y[cc][e] * y[cc][e];
                ss += __shfl_xor(ss, 1); ss += __shfl_xor(ss, 2); ss += __shfl_xor(ss, 4);
                const float rstd = rsqrtf(ss * (1.f / 192.f) + EPS);
#pragma unroll
                for (int cc = 0; cc < 3; ++cc)
#pragma unroll
                    for (int e = 0; e < 8; ++e) y[cc][e] = y[cc][e] * rstd * g[qk * 192 + 64 * cc + 8 * sub + e];
                if (c.is_lat) rope_apply(sub, y[2], cs, sn);
                bf16_t* dst;
                if (qk == 0) {
#pragma unroll
                    for (int cc = 0; cc < 3; ++cc)
#pragma unroll
                        for (int e = 0; e < 8; ++e) y[cc][e] *= qscale;
                    dst = (bf16_t*)(ws + WS_QM) + ((size_t)head * M_ALL + row) * 192;
                } else dst = (bf16_t*)(ws + WS_KM) + ((size_t)(c.b * 8 + head) * TK + tok) * 192;
#pragma unroll
                for (int cc = 0; cc < 3; ++cc) *(u32x4*)(dst + 64 * cc + 8 * sub) = pack8(y[cc]);
            }
        }
        for (int p = 0; p < 2; ++p) {
            __syncthreads();
            load_tile(X, tile, kvup + (size_t)c.row0 * 2048, 2048, [p](int cc) { return (4 * p + (cc >> 4)) * 256 + 128 + 8 * (cc & 15); });
            __syncthreads();
            write_vt(X, tile, (bf16_t*)(ws + WS_VTM), (size_t)(c.b * 8 + 4 * p) * 128, c.tok0);
        }
        __syncthreads();
    }
}

__device__ __forceinline__ void ml_gates(const float* gates, const float* gb, int b, int jt, int dir, int h, int lane, float& ig, float& lf, float& pre, float& total) {
    const int row = row_of_tokchunk(b, jt) + lane;
    ig = gates[(size_t)row * 16 + dir * 8 + h] + gb[dir * 8 + h];
    const float fg = gates[(size_t)row * 16 + dir * 8 + 4 + h] + gb[dir * 8 + 4 + h];
    lf = fminf(fg, 0.f) - log1pf(__expf(-fabsf(fg)));
    float s = lf;
#pragma unroll
    for (int o = 1; o < 64; o <<= 1) { const float t = __shfl_up(s, o); if (lane >= o) s += t; }
    pre = s; total = __shfl(s, 63);
}
constexpr int KSTR = 72;
constexpr int QSTR = 136;
__device__ __forceinline__ void mlstm_a_phase(const Ctx& X0, const PRef& P, int l) {
    const Ctx X = fresh(X0);
    unsigned char* ws = P.ws();
    const float* gates = (const float*)(ws + WS_GATES); const float* gb = P.in(I_GATEB) + l * 16;
    bf16_t* Kt = (bf16_t*)X.lds;
    bf16_t* Vw = (bf16_t*)(X.lds + 128 * KSTR * 2);
    float* wtab = (float*)(X.lds + 3 * 128 * KSTR * 2);
    const int lane = X.lane, r32 = lane & 31, hi = lane >> 5;
    for (int u = X.wg; u < 16 * NCH; u += X.nwg) {
        const int bh = u / NCH, jt = u % NCH, b = bh >> 2, h = bh & 3, tok0 = 64 * jt;
        if (X.wave < 2) {
            const int dir = X.wave; float ig, lf, pre, total; ml_gates(gates, gb, b, jt, dir, h, lane, ig, lf, pre, total);
            const float cum = dir == 0 ? pre : total - pre + lf;
            const float wlog = total - cum + ig; const float mloc = wave_max(wlog);
            wtab[dir * 64 + lane] = __expf(wlog - mloc);
            if (lane == 0) { float* cs = (float*)(ws + WS_CSTAT) + ((size_t)(bh * 2 + dir) * NCH + jt) * 4; cs[0] = total; cs[1] = mloc; }
        }
        u32x4 vr[2];
#pragma unroll
        for (int it = 0; it < 2; ++it) { const int ch = it * 512 + X.tid; const int rr = ch >> 3, k = ch & 7;
            *(u32x4*)(Kt + rr * KSTR + 8 * k) = *(const u32x4*)((const bf16_t*)(ws + WS_KTML) + ((size_t)bh * 128 + rr) * TK + tok0 + 8 * k);
            vr[it] = *(const u32x4*)((const bf16_t*)(ws + WS_VTML) + ((size_t)bh * 128 + rr) * TK + tok0 + 8 * k); }
        __syncthreads();
#pragma unroll
        for (int it = 0; it < 2; ++it) { const int ch = it * 512 + X.tid; const int rr = ch >> 3, k = ch & 7;
            float v[8]; unpack8(vr[it], v);
#pragma unroll
            for (int dir = 0; dir < 2; ++dir) { float o[8];
#pragma unroll
                for (int jj = 0; jj < 8; ++jj) { const int i = 16 * (k >> 1) + 8 * (jj >> 2) + 4 * (k & 1) + (jj & 3); o[jj] = v[jj] * wtab[dir * 64 + i]; }
                *(u32x4*)(Vw + (dir * 128 + rr) * KSTR + 8 * k) = pack8(o); } }
        __syncthreads();
        {
            const int dir = X.wave >> 2, dvb = X.wave & 3;
            bf16_t* U = (bf16_t*)(ws + WS_AB) + ((size_t)(bh * 2 + dir) * NCH + jt) * 16384;
            bf16x8 a[4];
#pragma unroll
            for (int ks = 0; ks < 4; ++ks) a[ks] = *(const bf16x8*)(Vw + (dir * 128 + 32 * dvb + r32) * KSTR + 16 * ks + 8 * hi);
            for (int dkb = 0; dkb < 4; ++dkb) {
                f32x16 acc;
#pragma unroll
                for (int r = 0; r < 16; ++r) acc[r] = 0.f;
#pragma unroll
                for (int ks = 0; ks < 4; ++ks) { const bf16x8 bb = *(const bf16x8*)(Kt + (32 * dkb + r32) * KSTR + 16 * ks + 8 * hi); acc = __builtin_amdgcn_mfma_f32_32x32x16_bf16(a[ks], bb, acc, 0, 0, 0); }
#pragma unroll
                for (int r = 0; r < 16; ++r) U[(32 * dvb + crow(r, hi)) * 128 + 32 * dkb + r32] = (bf16_t)(pk2(acc[r], 0.f) & 0xffffu);
            }
        }
        if (X.tid < 256) { const int dir = X.tid >> 7, dk = X.tid & 127; float s = 0.f;
#pragma unroll 8
            for (int p = 0; p < 64; ++p) { const int i = (p & ~15) + perm_off(p & 15); s += wtab[dir * 64 + i] * bf1(Kt[dk * KSTR + p]); }
            ((float*)(ws + WS_NU))[((size_t)(bh * 2 + dir) * NCH + jt) * 128 + dk] = s; }
        __syncthreads();
    }
}
__device__ __forceinline__ int ml_jmap(int dir, int c) { return dir == 0 ? c : (c < 4 ? 3 - c : 71 - c); }
__device__ __forceinline__ void mlstm_scan_phase(const Ctx& X0, const PRef& P) {
    const Ctx X = fresh(X0);
    unsigned char* ws = P.ws();
    float* cstat = (float*)(ws + WS_CSTAT);
    const int gtid = X.wg * 512 + X.tid, nthr = X.nwg * 512;
    for (int task = gtid; task < 65536 + 1024; task += nthr) {
        float m = 0.f;
        if (task < 65536) {
            const int seq = task >> 11, e = task & 2047, dir = seq & 1;
            const bf16_t* __restrict__ U = (const bf16_t*)(ws + WS_AB); bf16_t* __restrict__ S = (bf16_t*)(ws + WS_CSNAP);
            float C[8];
#pragma unroll
            for (int i = 0; i < 8; ++i) C[i] = 0.f;
            for (int cb = 0; cb < 4; ++cb) {
                u32x4 uu[17]; float tot[17], mlc[17];
#pragma unroll
                for (int i = 0; i < 17; ++i) { const size_t base = (size_t)seq * NCH + ml_jmap(dir, cb * 17 + i);
                    uu[i] = *(const u32x4*)(U + base * 16384 + 8 * e); tot[i] = cstat[base * 4]; mlc[i] = cstat[base * 4 + 1]; }
#pragma unroll
                for (int i = 0; i < 17; ++i) { const size_t base = (size_t)seq * NCH + ml_jmap(dir, cb * 17 + i);
                    *(u32x4*)(S + base * 16384 + 8 * e) = pack8(C);
                    if (e == 0) cstat[base * 4 + 2] = m;
                    const float mn = fmaxf(tot[i] + m, mlc[i]); const float dec = __expf(tot[i] + m - mn), sc = __expf(mlc[i] - mn);
                    float u8[8]; unpack8(uu[i], u8);
#pragma unroll
                    for (int q = 0; q < 8; ++q) C[q] = C[q] * dec + u8[q] * sc;
                    m = mn; }
            }
        } else {
            const int t2 = task - 65536, seq = t2 >> 5, e4 = t2 & 31, dir = seq & 1;
            const float* __restrict__ NU = (const float*)(ws + WS_NU); float* __restrict__ NS = (float*)(ws + WS_NSNAP);
            f32x4 C = (f32x4){0.f, 0.f, 0.f, 0.f};
            for (int cb = 0; cb < 4; ++cb) {
                f32x4 uu[17]; float tot[17], mlc[17];
#pragma unroll
                for (int i = 0; i < 17; ++i) { const size_t base = (size_t)seq * NCH + ml_jmap(dir, cb * 17 + i);
                    uu[i] = *(const f32x4*)(NU + base * 128 + 4 * e4); tot[i] = cstat[base * 4]; mlc[i] = cstat[base * 4 + 1]; }
#pragma unroll
                for (int i = 0; i < 17; ++i) { const size_t base = (size_t)seq * NCH + ml_jmap(dir, cb * 17 + i);
                    *(f32x4*)(NS + base * 128 + 4 * e4) = C;
                    const float mn = fmaxf(tot[i] + m, mlc[i]); const float dec = __expf(tot[i] + m - mn), sc = __expf(mlc[i] - mn);
                    C = C * dec + uu[i] * sc; m = mn; }
            }
        }
    }
}
__device__ __forceinline__ void mlstm_c_unit(const Ctx& X0, const PRef& P, int l, int u) {
    const Ctx X = fresh(X0);
    unsigned char* ws = P.ws();
    const float* gates = (const float*)(ws + WS_GATES); const float* gb = P.in(I_GATEB) + l * 16;
    const float* cstat = (const float*)(ws + WS_CSTAT);
    bf16_t* Qt = (bf16_t*)X.lds;
    bf16_t* Kn = (bf16_t*)(X.lds + 64 * QSTR * 2);
    bf16_t* Vt = (bf16_t*)(X.lds + 2 * 64 * QSTR * 2);
    float* tab = (float*)(X.lds + 2 * 64 * QSTR * 2 + 128 * KSTR * 2);
    float* t_a = tab, *t_c1 = tab + 128, *t_wp = tab + 256, *t_em = tab + 384, *t_n = tab + 512, *t_red = tab + 768;
    const int lane = X.lane, r32 = lane & 31, hi = lane >> 5;
    const int bh = u / NCH, jt = u % NCH, b = bh >> 2, h = bh & 3, tok0 = 64 * jt;
    if (X.wave < 2) {
        const int dir = X.wave; float ig, lf, pre, total; ml_gates(gates, gb, b, jt, dir, h, lane, ig, lf, pre, total);
        const float cum = dir == 0 ? pre : total - pre + lf;
        const float a = ig - cum; float pm = a;
#pragma unroll
        for (int o = 1; o < 64; o <<= 1) { const float t = dir == 0 ? __shfl_up(pm, o) : __shfl_down(pm, o); const bool ok = dir == 0 ? (lane >= o) : (lane + o < 64); if (ok) pm = fmaxf(pm, t); }
        const float mc = cstat[((size_t)(bh * 2 + dir) * NCH + jt) * 4 + 2];
        const float mt = cum + fmaxf(mc, pm);
        t_a[dir * 64 + lane] = a; t_c1[dir * 64 + lane] = cum - mt; t_wp[dir * 64 + lane] = __expf(cum + mc - mt); t_em[dir * 64 + lane] = __expf(-mt);
    }
#pragma unroll
    for (int it = 0; it < 2; ++it) { const int ch = it * 512 + X.tid;
        { const int i = ch >> 4, k = ch & 15;
          *(u32x4*)(Qt + i * QSTR + 8 * k) = *(const u32x4*)((const bf16_t*)(ws + WS_QML) + ((size_t)bh * TK + tok0 + i) * 128 + 8 * k);
          *(u32x4*)(Kn + i * QSTR + 8 * k) = *(const u32x4*)((const bf16_t*)(ws + WS_KML) + ((size_t)bh * TK + tok0 + i) * 128 + 8 * k); }
        { const int rr = ch >> 3, k = ch & 7;
          *(u32x4*)(Vt + rr * KSTR + 8 * k) = *(const u32x4*)((const bf16_t*)(ws + WS_VTML) + ((size_t)bh * 128 + rr) * TK + tok0 + 8 * k); } }
    if (X.tid < 256) t_n[X.tid] = ((const float*)(ws + WS_NSNAP))[((size_t)(bh * 2 + (X.tid >> 7)) * NCH + jt) * 128 + (X.tid & 127)];
    __syncthreads();
    const int tb = X.wave & 1, db = X.wave >> 1, t = 32 * tb + r32;
    bf16x8 qf[8];
#pragma unroll
    for (int ks = 0; ks < 8; ++ks) qf[ks] = *(const bf16x8*)(Qt + t * QSTR + 16 * ks + 8 * hi);
    f32x16 st[2];
#pragma unroll
    for (int sb = 0; sb < 2; ++sb) {
#pragma unroll
        for (int r = 0; r < 16; ++r) st[sb][r] = 0.f;
#pragma unroll
        for (int ks = 0; ks < 8; ++ks) { const bf16x8 kf = *(const bf16x8*)(Kn + (32 * sb + r32) * QSTR + 16 * ks + 8 * hi); st[sb] = __builtin_amdgcn_mfma_f32_32x32x16_bf16(kf, qf[ks], st[sb], 0, 0, 0); }
    }
    f32x16 hsum;
#pragma unroll
    for (int r = 0; r < 16; ++r) hsum[r] = 0.f;
#pragma unroll
    for (int dir = 0; dir < 2; ++dir) {
        const float c1 = t_c1[dir * 64 + t], wp = t_wp[dir * 64 + t], em = t_em[dir * 64 + t];
        float rs = 0.f; u32x4 pw[2][2];
#pragma unroll
        for (int sb = 0; sb < 2; ++sb) { float p[16];
#pragma unroll
            for (int r = 0; r < 16; ++r) { const int s = 32 * sb + crow(r, hi); const bool ok = dir == 0 ? (s <= t) : (s >= t);
                const float dm = ok ? __expf(t_a[dir * 64 + s] + c1) : 0.f; p[r] = st[sb][r] * dm; rs += p[r]; }
            pw[sb][0] = pack8(p); pw[sb][1] = pack8(p + 8); }
        rs += __shfl_xor(rs, 32);
        float qn = 0.f;
#pragma unroll
        for (int ks = 0; ks < 8; ++ks) { float q8[8]; unpack8(__builtin_bit_cast(u32x4, qf[ks]), q8);
#pragma unroll
            for (int e = 0; e < 8; ++e) qn += q8[e] * t_n[dir * 128 + 16 * ks + 8 * hi + e]; }
        qn += __shfl_xor(qn, 32);
        const float den = rs + wp * qn; const float rden = 1.f / fmaxf(fabsf(den), em);
        f32x16 acc;
#pragma unroll
        for (int r = 0; r < 16; ++r) acc[r] = 0.f;
        const bf16_t* Cs = (const bf16_t*)(ws + WS_CSNAP) + ((size_t)(bh * 2 + dir) * NCH + jt) * 16384 + (size_t)(32 * db + r32) * 128;
#pragma unroll
        for (int ks = 0; ks < 8; ++ks) { const bf16x8 cf = *(const bf16x8*)(Cs + 16 * ks + 8 * hi); acc = __builtin_amdgcn_mfma_f32_32x32x16_bf16(cf, qf[ks], acc, 0, 0, 0); }
#pragma unroll
        for (int r = 0; r < 16; ++r) acc[r] *= wp;
#pragma unroll
        for (int sb = 0; sb < 2; ++sb)
#pragma unroll
            for (int s2 = 0; s2 < 2; ++s2) { const bf16x8 vf = *(const bf16x8*)(Vt + (32 * db + r32) * KSTR + 32 * sb + 16 * s2 + 8 * hi);
                acc = __builtin_amdgcn_mfma_f32_32x32x16_bf16(vf, __builtin_bit_cast(bf16x8, pw[sb][s2]), acc, 0, 0, 0); }
#pragma unroll
        for (int r = 0; r < 16; ++r) hsum[r] += acc[r] * rden;
    }
    float ss = 0.f;
#pragma unroll
    for (int r = 0; r < 16; ++r) ss += hsum[r] * hsum[r];
    ss += __shfl_xor(ss, 32);
    if (hi == 0) t_red[(tb * 4 + db) * 32 + r32] = ss;
    __syncthreads();
    const float tot = t_red[(tb * 4 + 0) * 32 + r32] + t_red[(tb * 4 + 1) * 32 + r32] + t_red[(tb * 4 + 2) * 32 + r32] + t_red[(tb * 4 + 3) * 32 + r32];
    const float rstd = rsqrtf(tot * (1.f / 128.f) + EPS);
    const int row = row_of_tokchunk(b, jt) + t;
    const float* og = P.in(I_MLOUTG) + l * 512 + h * 128;
    const bf16_t* oc = (const bf16_t*)(ws + WS_OCOPY) + (size_t)row * 512 + h * 128;
    bf16_t* mix = (bf16_t*)(ws + WS_AB) + (size_t)row * DM + 512 + h * 128;
#pragma unroll
    for (int q = 0; q < 4; ++q) { const int dv = 32 * db + 8 * q + 4 * hi;
        const u32x2 ow = *(const u32x2*)(oc + dv); const f32x4 gg = *(const f32x4*)(og + dv);
        const float o0 = hsum[4 * q + 0] * rstd * gg[0] * sigmf(bflo(ow.x)), o1 = hsum[4 * q + 1] * rstd * gg[1] * sigmf(bfhi(ow.x));
        const float o2 = hsum[4 * q + 2] * rstd * gg[2] * sigmf(bflo(ow.y)), o3 = hsum[4 * q + 3] * rstd * gg[3] * sigmf(bfhi(ow.y));
        u32x2 w; w.x = pk2(o0, o1); w.y = pk2(o2, o3); *(u32x2*)(mix + dv) = w; }
    __syncthreads();
}

template <int DQK, int KROW>
struct AttnCore {
    static constexpr int NKS = DQK / 16, NKC1 = KROW / 8 + 1, KS = NKC1 * 8, KT_B = 64 * NKC1 * 16, VT_B = 128 * 9 * 16, SLOT_B = KT_B + VT_B;
    static constexpr int NBK = KT_B / 1024, NBV = VT_B / 1024, NB = NBK + NBV, NI = (NB + 7) / 8;
    static_assert(KT_B % 1024 == 0 && VT_B % 1024 == 0 && 8 * NI - NB <= 8 && 3 * SLOT_B <= 135168, "attention LDS geometry");
    static __device__ __forceinline__ void run(const Ctx& X, const bf16_t* Qrow, int kcol, const bf16_t* K, const bf16_t* Vt, int nt, f32x16 (&o)[4]) {
        const int lane = X.lane, r32 = lane & 31, hi = lane >> 5;
        LAS unsigned char* l3 = (LAS unsigned char*)0 + X.l3off;
        bf16x8 qf[NKS];
#pragma unroll
        for (int ks = 0; ks < NKS; ++ks) qf[ks] = *(const bf16x8*)(Qrow + 16 * ks + 8 * hi);
        unsigned goff[NI]; int bsel[NI];
#pragma unroll
        for (int i = 0; i < NI; ++i) {
            int bidx = X.wave + 8 * i; if (bidx >= NB) bidx -= NB;
            bsel[i] = bidx;
            if (bidx < NBK) { const int c = bidx * 64 + lane; const int row = c / NKC1; int col = c % NKC1; if (col > NKC1 - 2) col = NKC1 - 2; goff[i] = (unsigned)(row * KROW + 8 * col) * 2u; }
            else { const int c = (bidx - NBK) * 64 + lane; const int row = c / 9; int col = c % 9; if (col > 7) col = 7; goff[i] = (unsigned)(row * TK + 8 * col) * 2u; }
        }
        asm volatile("s_waitcnt vmcnt(0)" ::: "memory");
#pragma unroll
        for (int ks = 0; ks < NKS; ++ks) asm volatile("" : "+v"(qf[ks]));
        auto issue = [&](int t, int slotoff) {
#pragma unroll
            for (int i = 0; i < NI; ++i) {
                const char* base = bsel[i] < NBK ? (const char*)K + (size_t)t * (64 * KROW * 2) : (const char*)Vt + (size_t)t * 128;
                __builtin_amdgcn_global_load_lds((const unsigned*)(base + goff[i]), (LAS unsigned*)(l3 + slotoff + bsel[i] * 1024), 16, 0, 0);
            }
        };
#pragma unroll
        for (int d = 0; d < 4; ++d)
#pragma unroll
            for (int r = 0; r < 16; ++r) o[d][r] = 0.f;
        float mrun = -1e30f, lrun = 0.f;
        issue(0, 0); issue(1, SLOT_B);
        asm volatile("s_waitcnt vmcnt(%0)" :: "i"(NI) : "memory");
        __builtin_amdgcn_s_barrier(); asm volatile("" ::: "memory");
        int s_cur = 0, s_nn = 2 * SLOT_B;
        for (int t = 0; t < nt; ++t) {
            if (t + 2 < nt) issue(t + 2, s_nn);
            const LAS bf16_t* kt = (const LAS bf16_t*)(l3 + s_cur) + r32 * KS + kcol + 8 * hi; const LAS bf16_t* vt = (const LAS bf16_t*)(l3 + s_cur + KT_B) + r32 * KSTR + 8 * hi;
            f32x16 s0, s1;
#pragma unroll
            for (int r = 0; r < 16; ++r) { s0[r] = 0.f; s1[r] = 0.f; }
            {
                bf16x8 a0 = *(const LAS bf16x8*)(kt), a1 = *(const LAS bf16x8*)(kt + 32 * KS);
                __builtin_amdgcn_sched_group_barrier(0x100, 2, 0);
#pragma unroll
                for (int ks = 0; ks < NKS; ++ks) {
                    bf16x8 b0 = a0, b1 = a1;
                    if (ks + 1 < NKS) { b0 = *(const LAS bf16x8*)(kt + 16 * (ks + 1)); b1 = *(const LAS bf16x8*)(kt + 32 * KS + 16 * (ks + 1)); }
                    s0 = __builtin_amdgcn_mfma_f32_32x32x16_bf16(a0, qf[ks], s0, 0, 0, 0);
                    s1 = __builtin_amdgcn_mfma_f32_32x32x16_bf16(a1, qf[ks], s1, 0, 0, 0);
                    if (ks + 1 < NKS) __builtin_amdgcn_sched_group_barrier(0x100, 2, 0);
                    __builtin_amdgcn_sched_group_barrier(0x008, 2, 0);
                    a0 = b0; a1 = b1;
                }
            }
            bf16x8 vf[4];
#pragma unroll
            for (int d = 0; d < 4; ++d) vf[d] = *(const LAS bf16x8*)(vt + 32 * d * KSTR);
            float mx = fmaxf(s0[0], s1[0]);
#pragma unroll
            for (int r = 1; r < 16; ++r) mx = fmaxf(fmaxf(mx, s0[r]), s1[r]);
            mx = fmaxf(mx, __shfl_xor(mx, 32));
            const float mnew = fmaxf(mrun, mx); const float alpha = __builtin_amdgcn_exp2f(mrun - mnew); mrun = mnew;
            s0 = s0 - mnew; s1 = s1 - mnew;
#pragma unroll
            for (int r = 0; r < 16; ++r) { s0[r] = __builtin_amdgcn_exp2f(s0[r]); s1[r] = __builtin_amdgcn_exp2f(s1[r]); }
            { const f32x16 sm = s0 + s1;
              const float rs = ((sm[0] + sm[1]) + (sm[2] + sm[3])) + ((sm[4] + sm[5]) + (sm[6] + sm[7])) + (((sm[8] + sm[9]) + (sm[10] + sm[11])) + ((sm[12] + sm[13]) + (sm[14] + sm[15])));
              lrun = lrun * alpha + rs; }
            if (__any(alpha != 1.f)) {
#pragma unroll
                for (int d = 0; d < 4; ++d) o[d] = o[d] * alpha;
            }
            bf16x8 pf[4];
            { float p[16];
#pragma unroll
              for (int r = 0; r < 16; ++r) p[r] = s0[r];
              pf[0] = __builtin_bit_cast(bf16x8, pack8(p)); pf[1] = __builtin_bit_cast(bf16x8, pack8(p + 8));
#pragma unroll
              for (int r = 0; r < 16; ++r) p[r] = s1[r];
              pf[2] = __builtin_bit_cast(bf16x8, pack8(p)); pf[3] = __builtin_bit_cast(bf16x8, pack8(p + 8)); }
#pragma unroll
            for (int g = 0; g < 4; ++g) {
                bf16x8 vn[4];
                if (g + 1 < 4) {
#pragma unroll
                    for (int d = 0; d < 4; ++d) vn[d] = *(const LAS bf16x8*)(vt + 32 * d * KSTR + 16 * (g + 1));
                }
#pragma unroll
                for (int d = 0; d < 4; ++d) o[d] = __builtin_amdgcn_mfma_f32_32x32x16_bf16(vf[d], pf[g], o[d], 0, 0, 0);
                if (g + 1 < 4) {
                    __builtin_amdgcn_sched_group_barrier(0x100, 4, 0);
#pragma unroll
                    for (int d = 0; d < 4; ++d) vf[d] = vn[d];
                }
                __builtin_amdgcn_sched_group_barrier(0x008, 4, 0);
            }
            if (t + 2 < nt) asm volatile("s_waitcnt vmcnt(%0)" :: "i"(NI) : "memory");
            else asm volatile("s_waitcnt vmcnt(0)" ::: "memory");
            asm volatile("s_waitcnt lgkmcnt(0)" ::: "memory");
            __builtin_amdgcn_s_barrier(); asm volatile("" ::: "memory");
            s_cur = (s_cur == 2 * SLOT_B) ? 0 : s_cur + SLOT_B; s_nn = (s_nn == 2 * SLOT_B) ? 0 : s_nn + SLOT_B;
        }
        lrun += __shfl_xor(lrun, 32);
        const float rl = 1.f / lrun;
#pragma unroll
        for (int d = 0; d < 4; ++d) o[d] = o[d] * rl;
    }
};

__device__ __forceinline__ void mla_attn_unit(const Ctx& X0, const PRef& P, int b, int h, int q0, int is_ctx) {
    const Ctx X = fresh(X0);
    unsigned char* ws = P.ws();
    const int lane = X.lane, r32 = lane & 31, hi = lane >> 5;
    const int row = (is_ctx ? M_LAT + b * CTXL : b * SEQ) + q0 + 32 * X.wave + r32;
    const bf16_t* Q = (const bf16_t*)(ws + WS_QM) + ((size_t)h * M_ALL + row) * 192;
    const bf16_t* K = (const bf16_t*)(ws + WS_KM) + (size_t)(b * 8 + h) * TK * 192;
    const bf16_t* Vt = (const bf16_t*)(ws + WS_VTM) + (size_t)(b * 8 + h) * 128 * TK;
    f32x16 o[4];
    AttnCore<192, 192>::run(X, Q, 0, K, Vt, is_ctx ? 4 : NCH, o);
    bf16_t* mix = (bf16_t*)(ws + WS_AB) + (size_t)row * DM + 1024 + h * 128;
#pragma unroll
    for (int d = 0; d < 4; ++d)
#pragma unroll
        for (int q = 0; q < 4; ++q) { u32x2 w; w.x = pk2(o[d][4 * q], o[d][4 * q + 1]); w.y = pk2(o[d][4 * q + 2], o[d][4 * q + 3]); *(u32x2*)(mix + 32 * d + 8 * q + 4 * hi) = w; }
}
__device__ __forceinline__ void da_attn_unit(const Ctx& X0, const PRef& P, int l, int b, int h, int q0, int is_ctx, float lam, float lam_init) {
    const Ctx X = fresh(X0);
    unsigned char* ws = P.ws();
    const int lane = X.lane, r32 = lane & 31, hi = lane >> 5;
    const int comp = X.wave >> 2, qs = X.wave & 3;
    const int row = (is_ctx ? M_LAT + b * CTXL : b * SEQ) + q0 + 32 * qs + r32;
    const bf16_t* Q = (const bf16_t*)(ws + WS_QDA) + ((size_t)h * M_ALL + row) * 128 + comp * 64;
    const bf16_t* K = (const bf16_t*)(ws + WS_KDA) + (size_t)(b * 4 + h) * TK * 128;
    const bf16_t* Vt = (const bf16_t*)(ws + WS_VTDA) + (size_t)(b * 4 + h) * 128 * TK;
    f32x16 o[4];
    AttnCore<64, 128>::run(X, Q, comp * 64, K, Vt, is_ctx ? 4 : NCH, o);
    float* xch = (float*)X.lds;
    if (comp == 1) {
#pragma unroll
        for (int d = 0; d < 4; ++d)
#pragma unroll
            for (int r = 0; r < 16; ++r) xch[(qs * 64 + d * 16 + r) * 64 + lane] = o[d][r];
    }
    __syncthreads();
    if (comp == 0) {
        float ss = 0.f;
#pragma unroll
        for (int d = 0; d < 4; ++d)
#pragma unroll
            for (int r = 0; r < 16; ++r) { o[d][r] -= lam * xch[(qs * 64 + d * 16 + r) * 64 + lane]; ss += o[d][r] * o[d][r]; }
        ss += __shfl_xor(ss, 32);
        const float rstd = rsqrtf(ss * (1.f / 128.f) + EPS) * (1.f - lam_init);
        const float* og = P.in(I_DAOUTG) + l * 128;
        bf16_t* mix = (bf16_t*)(ws + WS_AB) + (size_t)row * DM + h * 128;
#pragma unroll
        for (int d = 0; d < 4; ++d)
#pragma unroll
            for (int q = 0; q < 4; ++q) { const int dv = 32 * d + 8 * q + 4 * hi; const f32x4 gg = *(const f32x4*)(og + dv);
                u32x2 w; w.x = pk2(o[d][4 * q] * rstd * gg[0], o[d][4 * q + 1] * rstd * gg[1]); w.y = pk2(o[d][4 * q + 2] * rstd * gg[2], o[d][4 * q + 3] * rstd * gg[3]);
                *(u32x2*)(mix + dv) = w; }
    }
    __syncthreads();
}

__device__ __forceinline__ void mixer_phase(const Ctx& X, const PRef& P, int l) {
    const bool need_ctx = l < DEPTH - 1;
    STAMPN(20);
    const int vcu = (X.nwg % 8 == 0) ? (X.wg % 8) * (X.nwg / 8) + X.wg / 8 : X.wg;
    if (EN(13)) for (int u = vcu; u < 512; u += X.nwg) mla_attn_unit(X, P, u >> 7, (u >> 4) & 7, (u & 15) * 256, 0);
    STAMPN(11);
    float lam, lam_init;
    { const float* lp = P.in(I_DALAM) + l * 256;
      float s1 = 0.f, s2 = 0.f;
      for (int i = 0; i < 64; ++i) { s1 += lp[i] * lp[64 + i]; s2 += lp[128 + i] * lp[192 + i]; }
      const float li = 0.8f - 0.6f * expf(-0.3f * (float)l);
      const float la = expf(s1) - expf(s2) + li;
      lam = __builtin_bit_cast(float, __builtin_amdgcn_readfirstlane(__builtin_bit_cast(int, la)));
      lam_init = __builtin_bit_cast(float, __builtin_amdgcn_readfirstlane(__builtin_bit_cast(int, li))); }
    if (EN(14)) for (int v = vcu; v < 512; v += X.nwg) da_attn_unit(X, P, l, v >> 7, (v >> 5) & 3, (v & 31) * 128, 0, lam, lam_init);
    STAMPN(12);
    if (EN(15)) for (int u = X.wg; u < 16 * NCH; u += X.nwg) mlstm_c_unit(X, P, l, u);
    STAMPN(13);
    if (need_ctx) {
        if (EN(13)) for (int v = X.wg; v < 32; v += X.nwg) mla_attn_unit(X, P, v >> 3, v & 7, 0, 1);
        if (EN(14)) for (int v = X.nwg - 1 - X.wg; v < 32; v += X.nwg) da_attn_unit(X, P, l, v >> 3, (v >> 1) & 3, (v & 1) * 128, 1, lam, lam_init);
    }
}

__global__ void __launch_bounds__(512, 2) fwd_megakernel(Params Pk) {
    const PRef P;
    extern __shared__ __attribute__((aligned(16))) unsigned char lds[];
    cg::grid_group grid = cg::this_grid();
    Ctx X; X.lds = lds; X.tid = threadIdx.x; X.lane = X.tid & 63; X.wave = __builtin_amdgcn_readfirstlane(X.tid >> 6);
    X.nwg = gridDim.x; X.wg = blockIdx.x; X.gw = X.wg * 8 + X.wave; X.ngw = X.nwg * 8;
    LAS unsigned char* lds3 = (LAS unsigned char*)lds; X.l3off = (unsigned)(uintptr_t)lds3;
    unsigned char* ws = P.ws();
    if (threadIdx.x < 16) ((LAS unsigned*)(lds3 + 135168 + 64))[threadIdx.x] = 0u;
    __syncthreads();
    (void)xcd_barrier_post((unsigned*)(ws + WS_BAR), (volatile LAS unsigned*)(lds3 + 135168 + 64));
    float* R_lat = P.out(); float* R_ctx = (float*)(ws + WS_RCTX);
    bf16_t* AB = (bf16_t*)(ws + WS_AB);

#ifdef PROBE_CAT
    if (blockIdx.x == 0 && threadIdx.x == 0) { volatile unsigned long long* tp_ = (volatile unsigned long long*)(P.ws() + WS_END); tp_[0] = __builtin_amdgcn_s_memrealtime(); tp_[1] = 0; tp_[2] = 0; }
#endif
    if (EN(0)) mod_gemv(X, P);
    if (EN(1)) convert_weights(X, P, 0);
    grid.sync();
#ifdef PROBE_CAT
    STAMP(0);
#endif
    for (int l = 0; l < DEPTH; ++l) {
        const float* modl = (const float*)(ws + WS_MOD) + (size_t)l * 5 * 6 * DM;
        const float* xin_lat = l == 0 ? P.in(I_X) : R_lat; const float* xin_ctx = l == 0 ? P.in(I_CTX) : R_ctx;
        const int Mfin = l < DEPTH - 1 ? M_ALL : M_LAT;
        if (EN(2)) modulate_phase(X, xin_lat, xin_ctx, P.in(I_N1G) + l * DM, modl, 0 * DM, 1 * DM, AB, M_ALL);
        if (EN(1)) if (l > 0) convert_weights(X, P, l);
        STAMP(1);
        if (EN(3)) { pg8::Gemm g{AB, (const bf16_t*)(ws + WS_WIN), M_ALL, NPROJ, DM}; pg8::StaticOrder S; S.init(M_ALL, NPROJ, X.nwg, X.wg);
          pg8::EpiBf16 E{(bf16_t*)(ws + WS_PROJ), NPROJ, (float*)(ws + WS_GATES), C_GATE / 256};
          pg8::gemm_phase<pg8::EpiBf16>(lds3, g, S, E); }
        STAMP(2);
        if (EN(4)) prep_phase(X, P, l);
        STAMP(3);
        if (EN(5)) { pg8::Gemm g{(const bf16_t*)(ws + WS_CQN), (const bf16_t*)(ws + WS_WUQ), M_ALL, 1536, 512}; pg8::StaticOrder S; S.init(M_ALL, 1536, X.nwg, X.wg);
          pg8::EpiBf16 E{(bf16_t*)(ws + WS_QUP), 1536, nullptr, 0};
          pg8::gemm_phase<pg8::EpiBf16>(lds3, g, S, E); }
        if (EN(5)) { pg8::Gemm g{(const bf16_t*)(ws + WS_CKVN), (const bf16_t*)(ws + WS_WUKV), M_ALL, 2048, 256}; pg8::StaticOrder S; S.init(M_ALL, 2048, X.nwg, X.wg);
          pg8::EpiBf16 E{(bf16_t*)(ws + WS_KVUP), 2048, nullptr, 0};
          pg8::gemm_phase<pg8::EpiBf16>(lds3, g, S, E); }
        __syncthreads();
        if (EN(6)) mlstm_a_phase(X, P, l);
        STAMP(4);
        if (EN(7)) mla_prep_phase(X, P, l);
        if (EN(8)) mlstm_scan_phase(X, P);
        STAMP(5);
        if (EN(9)) mixer_phase(X, P, l);
        STAMP(6);
        if (EN(10)) { pg8::Gemm g{AB, (const bf16_t*)(ws + WS_WOUT), Mfin, DM, DM}; pg8::StaticOrder S; S.init(Mfin, DM, X.nwg, X.wg);
          pg8::EpiRes E{xin_lat, xin_ctx, R_lat, R_ctx, modl + 2 * DM};
          pg8::gemm_phase<pg8::EpiRes>(lds3, g, S, E); }
        STAMP(7);
        if (EN(2)) modulate_phase(X, R_lat, R_ctx, P.in(I_N2G) + l * DM, modl, 3 * DM, 4 * DM, AB, Mfin);
        STAMP(1);
        if (EN(11)) { pg8::Gemm g{AB, (const bf16_t*)(ws + WS_WGU), Mfin, 2 * FF, DM}; pg8::StaticOrder S; S.init(Mfin, 2 * FF, X.nwg, X.wg);
          pg8::EpiSwiGLU E{(bf16_t*)(ws + WS_HID), FF};
          pg8::gemm_phase<pg8::EpiSwiGLU>(lds3, g, S, E); }
        STAMP(9);
        if (EN(12)) { pg8::Gemm g{(const bf16_t*)(ws + WS_HID), (const bf16_t*)(ws + WS_WDN), Mfin, DM, FF}; pg8::StaticOrder S; S.init(Mfin, DM, X.nwg, X.wg);
          pg8::EpiRes E{R_lat, R_ctx, R_lat, R_ctx, modl + 5 * DM};
          pg8::gemm_phase<pg8::EpiRes>(lds3, g, S, E); }
#ifdef PROBE_CAT
        STAMP(10);
#else
        if (l + 1 < DEPTH) xcd_barrier(P.ws());
#endif
    }
#ifdef PROBE_CAT
    if (blockIdx.x == 0 && threadIdx.x == 0) P.out()[0] += (float)(((volatile unsigned long long*)(P.ws() + WS_END))[1]) * (0.01f / PROBE_SCALE);
#endif
}

extern "C" void kernel_launch(void* const* d_in, const int* in_sizes, int n_in, void* d_out, int out_size, void* d_ws, size_t ws_size, hipStream_t stream) {
    static int grid = 0;
    if (grid == 0) {
        if (n_in != 24 || ws_size < WS_END) { fprintf(stderr, "kernel_launch: unexpected inputs (n_in %d, ws %zu)\n", n_in, ws_size); grid = -1; return; }
        int dev = 0, cus = 0, per_cu = 0;
        (void)hipGetDevice(&dev); (void)hipDeviceGetAttribute(&cus, hipDeviceAttributeMultiprocessorCount, dev);
        if (hipFuncSetAttribute((const void*)fwd_megakernel, hipFuncAttributeMaxDynamicSharedMemorySize, LDS_BYTES) != hipSuccess) { fprintf(stderr, "kernel_launch: hipFuncSetAttribute failed\n"); grid = -1; return; }
        (void)hipOccupancyMaxActiveBlocksPerMultiprocessor(&per_cu, (const void*)fwd_megakernel, 512, LDS_BYTES);
        (void)hipGetLastError();
        if (per_cu < 1) { fprintf(stderr, "kernel_launch: occupancy query says %d\n", per_cu); per_cu = 1; }
        grid = cus;
    }
    if (grid < 0) return;
    if (hipMemsetAsync((char*)d_ws + WS_BAR, 0, XCD_BAR_WORDS * 4, stream) != hipSuccess) { fprintf(stderr, "kernel_launch: memset failed\n"); return; }
    Params p{};
    for (int i = 0; i < 24; ++i) p.in[i] = (const float*)d_in[i];
    p.out = (float*)d_out; p.ws = (unsigned char*)d_ws;
    void* args[] = {&p};
    hipError_t e = hipLaunchCooperativeKernel((const void*)fwd_megakernel, dim3(grid), dim3(512), args, LDS_BYTES, stream);
    if (e != hipSuccess) fprintf(stderr, "cooperative launch failed: %s (grid %d)\n", hipGetErrorString(e), grid);
}
```

```cpp
#include <hip/hip_runtime.h>
#include <hip/hip_cooperative_groups.h>
#include <cstdio>
#include <cstdint>
namespace cg = cooperative_groups;

#define LAS __attribute__((address_space(3)))
typedef unsigned short bf16_t;
typedef short bf16x8 __attribute__((ext_vector_type(8)));
typedef float f32x4 __attribute__((ext_vector_type(4)));
typedef float f32x16 __attribute__((ext_vector_type(16)));
typedef unsigned u32x4 __attribute__((ext_vector_type(4)));
typedef unsigned u32x2 __attribute__((ext_vector_type(2)));

constexpr int DM = 2048, BATCH = 4, SEQ = 4096, CTXL = 256, DEPTH = 2;
constexpr int M_LAT = BATCH * SEQ, M_CTX = BATCH * CTXL, M_ALL = M_LAT + M_CTX;
constexpr int TK = CTXL + SEQ;
constexpr int NCH = TK / 64;
constexpr int IN_W = 4432, NPROJ = 4608, FF = 5632;
constexpr int C_DAQ = 0, C_DAK = 512, C_DAV = 1024, C_MLQ = 1536, C_MLK = 2048, C_MLV = 2560, C_MLO = 3072, C_GATE = 3584, C_CQ = 3600, C_CKV = 4112, C_KPE = 4368;
constexpr float EPS = 1e-6f;
constexpr float LOG2E = 1.4426950408889634f;

constexpr size_t MiB = 1u << 20;
constexpr size_t WS_WIN = 0, WS_WOUT = 18 * MiB, WS_WGU = 26 * MiB, WS_WDN = 70 * MiB, WS_WUQ = 92 * MiB, WS_WUKV = 94 * MiB, WS_MOD = 95 * MiB, WS_RCTX = 96 * MiB;
constexpr size_t WS_AB = 104 * MiB;
constexpr size_t WS_PROJ = 172 * MiB;
constexpr size_t WS_QUP = 172 * MiB, WS_KVUP = 223 * MiB, WS_HID = 172 * MiB;
constexpr size_t WS_GATES = 325 * MiB, WS_CQN = 327 * MiB, WS_CKVN = 344 * MiB, WS_KPE = 353 * MiB, WS_OCOPY = 356 * MiB;
constexpr size_t WS_QDA = 373 * MiB, WS_KDA = 390 * MiB, WS_VTDA = 407 * MiB, WS_QML = 424 * MiB, WS_KML = 441 * MiB, WS_KTML = 458 * MiB, WS_VTML = 475 * MiB;
constexpr size_t WS_QM = 492 * MiB, WS_KM = 543 * MiB, WS_VTM = 594 * MiB, WS_CSNAP = 628 * MiB, WS_NSNAP = 696 * MiB, WS_NU = 698 * MiB, WS_CSTAT = 700 * MiB, WS_BAR = 701 * MiB, WS_END = 702 * MiB;
static_assert((size_t)NPROJ * DM * 2 <= 18 * MiB && (size_t)2 * FF * DM * 2 <= 44 * MiB && (size_t)M_ALL * NPROJ * 2 <= 153 * MiB, "ws map");
static_assert(WS_HID + (size_t)M_ALL * FF * 2 <= WS_QDA, "hid overlay");
static_assert(WS_END <= 768 * MiB, "ws fits the guaranteed minimum");

constexpr int LDS_BYTES = 140 * 1024;
#ifndef PH_EN
#define PH_EN 0xFFFF
#endif
#define EN(k) ((PH_EN >> (k)) & 1)
#ifdef PROBE_CAT
#define STAMP(cat) do { xcd_barrier(P.ws()); if (blockIdx.x == 0 && threadIdx.x == 0) { volatile unsigned long long* tp_ = (volatile unsigned long long*)(P.ws() + WS_END); const unsigned long long t1_ = __builtin_amdgcn_s_memrealtime(); if ((1 << (cat)) & PROBE_CAT) tp_[1] += t1_ - tp_[0]; if ((1 << (cat)) & PROBE_CAT2) tp_[2] += t1_ - tp_[0]; tp_[0] = t1_; } } while (0)
#define STAMPN(cat) do { __syncthreads(); if (blockIdx.x == 0 && threadIdx.x == 0) { volatile unsigned long long* tp_ = (volatile unsigned long long*)(P.ws() + WS_END); const unsigned long long t1_ = __builtin_amdgcn_s_memrealtime(); if ((1 << (cat)) & PROBE_CAT) tp_[1] += t1_ - tp_[0]; tp_[0] = t1_; } } while (0)
#else
#define STAMPN(cat) do {} while (0)
#define STAMP(cat) xcd_barrier(P.ws())
#endif

__device__ __forceinline__ unsigned f2bf(float f) { unsigned u = __builtin_bit_cast(unsigned, f); return (u + 0x7fffu + ((u >> 16) & 1u)) >> 16; }
typedef float f32x2_t __attribute__((ext_vector_type(2))); typedef __bf16 bf16x2_t __attribute__((ext_vector_type(2)));
__device__ __forceinline__ unsigned pk2(float lo, float hi) { f32x2_t v = {lo, hi}; bf16x2_t b = __builtin_convertvector(v, bf16x2_t); return __builtin_bit_cast(unsigned, b); }
__device__ __forceinline__ float bflo(unsigned w) { return __builtin_bit_cast(float, w << 16); }
__device__ __forceinline__ float bfhi(unsigned w) { return __builtin_bit_cast(float, w & 0xffff0000u); }
__device__ __forceinline__ float bf1(bf16_t h) { return __builtin_bit_cast(float, (unsigned)h << 16); }
__device__ __forceinline__ void unpack8(const u32x4 w, float* v) { v[0] = bflo(w.x); v[1] = bfhi(w.x); v[2] = bflo(w.y); v[3] = bfhi(w.y); v[4] = bflo(w.z); v[5] = bfhi(w.z); v[6] = bflo(w.w); v[7] = bfhi(w.w); }
__device__ __forceinline__ u32x4 pack8(const float* v) { u32x4 w; w.x = pk2(v[0], v[1]); w.y = pk2(v[2], v[3]); w.z = pk2(v[4], v[5]); w.w = pk2(v[6], v[7]); return w; }
__device__ __forceinline__ float wave_sum(float v) {
#pragma unroll
    for (int o = 1; o < 64; o <<= 1) v += __shfl_xor(v, o);
    return v;
}
__device__ __forceinline__ float wave_max(float v) {
#pragma unroll
    for (int o = 1; o < 64; o <<= 1) v = fmaxf(v, __shfl_xor(v, o));
    return v;
}
__device__ __forceinline__ float siluf(float x) { return x / (1.f + __expf(-x)); }
__device__ __forceinline__ float sigmf(float x) { return 1.f / (1.f + __expf(-x)); }
__device__ __forceinline__ int crow(int r, int hi) { return (r & 3) + 8 * (r >> 2) + 4 * hi; }
__device__ __forceinline__ int perm_off(int p) { const int h = p >> 3, j = p & 7; return 8 * (j >> 2) + 4 * h + (j & 3); }
__device__ __forceinline__ int mod_batch(int row) { return row < M_LAT ? (row >> 12) : 4; }

namespace pg8 {
constexpr int BM = 256, BK = 64, HALF = 128, HTB = HALF * BK * 2, STAGE_BYTES = 8 * HTB, NXCD = 8, WGM = 8;
__host__ __device__ __forceinline__ int lds_byte(int r, int c) { const int st = (r >> 4) * 2 + (c >> 5), rr = r & 15, cc = c & 31, ob = rr * 64 + cc * 2; return st * 1024 + (ob ^ (((ob >> 9) & 1) << 5)); }
__host__ __device__ __forceinline__ void stage_rc(int b, int& R, int& C) { const int st = b / 1024, sb = b % 1024, swz = sb ^ (((sb >> 9) & 1) << 5); R = (st >> 1) * 16 + swz / 64; C = (st & 1) * 32 + (swz % 64) / 2; }
__host__ __device__ __forceinline__ int perm32(int rho) { const int n = rho >> 4, i = rho & 15; return 8 * (i >> 2) + 4 * n + (i & 3); }

struct Unit { int pm, pn; };
struct Gemm { const bf16_t* A; const bf16_t* Bt; int M, N, K; };

struct StaticOrder {
    int nM, nN, nwg, G, c;
    __device__ void init(int M, int N, int G_, int c_) { nM = M / BM; nN = N / BM; nwg = nM * nN; G = G_; c = c_; }
    __device__ bool next(int i, Unit& u) const {
        const long L = (long)i * G + c; if (L >= nwg) return false;
        int wgid = (int)L; { const int q = nwg / NXCD, r = nwg % NXCD, xcd = wgid % NXCD, off = wgid / NXCD; wgid = (xcd < r ? xcd * (q + 1) : r * (q + 1) + (xcd - r) * q) + off; }
        const int nig = WGM * nN, gid = wgid / nig, fm = gid * WGM, gsz = (nM - fm) < WGM ? (nM - fm) : WGM;
        u.pm = fm + ((wgid % nig) % gsz); u.pn = (wgid % nig) / gsz; return true;
    }
};

struct EpiBf16 {
    static constexpr bool PERM = true;
    bf16_t* O; int ldc; float* gates; int gate_pn;
    __device__ __forceinline__ void operator()(const f32x4 (&acc)[2][2][4][2], const Unit& u, int wr, int wc, int fr, int fq) const {
        const int row0 = u.pm * BM + wr * 64 + fr; const int col0 = u.pn * BM + wc * 32 + 8 * fq;
        const bool g = gates != nullptr && u.pn == gate_pn && wc == 0 && fq < 2;
#pragma unroll
        for (int ai = 0; ai < 2; ++ai)
#pragma unroll
            for (int m = 0; m < 4; ++m) { const int row = row0 + ai * HALF + m * 16; bf16_t* rowp = O + (size_t)row * ldc + col0;
#pragma unroll
                for (int bj = 0; bj < 2; ++bj) { const f32x4 v0 = acc[ai][bj][m][0], v1 = acc[ai][bj][m][1];
                    u32x4 w; w.x = pk2(v0[0], v0[1]); w.y = pk2(v0[2], v0[3]); w.z = pk2(v1[0], v1[1]); w.w = pk2(v1[2], v1[3]);
                    *(u32x4*)(rowp + bj * HALF) = w;
                    if (bj == 0 && g) { *(f32x4*)(gates + (size_t)row * 16 + 8 * fq) = v0; *(f32x4*)(gates + (size_t)row * 16 + 8 * fq + 4) = v1; } } }
    }
};
struct EpiSwiGLU {
    static constexpr bool PERM = true;
    bf16_t* O; int ldc;
    __device__ __forceinline__ void operator()(const f32x4 (&acc)[2][2][4][2], const Unit& u, int wr, int wc, int fr, int fq) const {
        const int row0 = u.pm * BM + wr * 64 + fr; const int col0 = u.pn * HALF + wc * 32 + 8 * fq;
#pragma unroll
        for (int ai = 0; ai < 2; ++ai)
#pragma unroll
            for (int m = 0; m < 4; ++m) { const int row = row0 + ai * HALF + m * 16;
                float o[8];
#pragma unroll
                for (int n = 0; n < 2; ++n)
#pragma unroll
                    for (int i = 0; i < 4; ++i) { const float gt = acc[ai][0][m][n][i], up = acc[ai][1][m][n][i]; o[4 * n + i] = siluf(gt) * up; }
                *(u32x4*)(O + (size_t)row * ldc + col0) = pack8(o); }
    }
};
struct EpiRes {
    static constexpr bool PERM = false;
    const float* res_lat; const float* res_ctx; float* out_lat; float* out_ctx; const float* gate;
    __device__ __forceinline__ void operator()(const f32x4 (&acc)[2][2][4][2], const Unit& u, int wr, int wc, int fr, int fq) const {
        const int row0 = u.pm * BM + wr * 64 + fr; const int col0 = u.pn * BM + wc * 32 + 4 * fq;
#pragma unroll
        for (int ai = 0; ai < 2; ++ai)
#pragma unroll
            for (int m = 0; m < 4; ++m) { const int row = row0 + ai * HALF + m * 16;
                const float* rp = row < M_LAT ? res_lat + (size_t)row * DM : res_ctx + (size_t)(row - M_LAT) * DM;
                float* op = row < M_LAT ? out_lat + (size_t)row * DM : out_ctx + (size_t)(row - M_LAT) * DM;
                const float* gp = gate + (size_t)mod_batch(row) * 6 * DM;
#pragma unroll
                for (int bj = 0; bj < 2; ++bj)
#pragma unroll
                    for (int n = 0; n < 2; ++n) { const int c = col0 + bj * HALF + n * 16;
                        const f32x4 r = *(const f32x4*)(rp + c), g = *(const f32x4*)(gp + c);
                        *(f32x4*)(op + c) = r + g * acc[ai][bj][m][n]; } }
    }
};

template <class Epi, bool ALIGN_EPI = true>
__device__ __forceinline__ void gemm_phase(LAS unsigned char* lds, const Gemm g, const StaticOrder& S, const Epi& E) {
    int tid = threadIdx.x; asm volatile("" : "+v"(tid)); const int wid = __builtin_amdgcn_readfirstlane(tid >> 6), lane = tid & 63, wr = wid >> 2, wc = wid & 3, fr = lane & 15, fq = lane >> 4;
    int K = g.K; asm volatile("" : "+s"(K)); const int nt = K / BK;
    unsigned voffA[2], voffB[2];
#pragma unroll
    for (int i = 0; i < 2; ++i) { int R, C; stage_rc(tid * 16 + i * 8192, R, C); const int Rb = Epi::PERM ? ((R & ~31) + perm32(R & 31)) : R;
        voffA[i] = (unsigned)(R * K + C) * 2u; voffB[i] = (unsigned)(Rb * K + C) * 2u; }
    const size_t kstep = (size_t)(BK * 2);
    const size_t hstep = (size_t)HALF * K * 2;
    const size_t tstep = 2 * hstep;
    const unsigned ldsw = (unsigned)wid * 1024u;
    const int aoff = lds_byte(wr * 64 + fr, fq * 8), boff = lds_byte(wc * 32 + fr, fq * 8);
#define PG8_SA(b, h) (((b) * 2 + (h)) * HTB)
#define PG8_SB(b, h) ((4 + (b) * 2 + (h)) * HTB)
#define PG8_STAGE(bufoff, gbase, voff) do { _Pragma("unroll") for (int _i = 0; _i < 2; ++_i) \
        __builtin_amdgcn_global_load_lds((const unsigned*)((const char*)(gbase) + (voff)[_i]), (LAS unsigned*)(lds + (bufoff) + ldsw + _i * 8192), 16, 0, 0); } while (0)
#define PG8_LDA(dst, b, h) do { _Pragma("unroll") for (int m = 0; m < 4; ++m) _Pragma("unroll") for (int k = 0; k < 2; ++k) dst[m][k] = *(const LAS bf16x8*)(lds + PG8_SA(b, h) + aoff + m * 2048 + k * 1024); } while (0)
#define PG8_LDB(dst, b, h) do { _Pragma("unroll") for (int n = 0; n < 2; ++n) _Pragma("unroll") for (int k = 0; k < 2; ++k) dst[n][k] = *(const LAS bf16x8*)(lds + PG8_SB(b, h) + boff + n * 2048 + k * 1024); } while (0)
#define PG8_MMA(ai, bj, At, Bt) do { __builtin_amdgcn_s_setprio(1); _Pragma("unroll") for (int m = 0; m < 4; ++m) _Pragma("unroll") for (int n = 0; n < 2; ++n) _Pragma("unroll") for (int k = 0; k < 2; ++k) \
        acc[ai][bj][m][n] = __builtin_amdgcn_mfma_f32_16x16x32_bf16(Bt[n][k], At[m][k], acc[ai][bj][m][n], 0, 0, 0); __builtin_amdgcn_s_setprio(0); } while (0)
#define PG8_WAIT_V(n) asm volatile("s_waitcnt vmcnt(" #n ")" ::: "memory")
#define PG8_WAIT_L(n) asm volatile("s_waitcnt lgkmcnt(" #n ")" ::: "memory")
#define PG8_BAR __builtin_amdgcn_s_barrier()
#define PG8_SCHED __builtin_amdgcn_sched_barrier(0)
    Unit cur, nxt; int ui = 0;
    if (!S.next(0, cur)) return;
    f32x4 acc[2][2][4][2];
#pragma unroll
    for (int a = 0; a < 2; ++a)
#pragma unroll
        for (int b = 0; b < 2; ++b)
#pragma unroll
            for (int m = 0; m < 4; ++m)
#pragma unroll
                for (int n = 0; n < 2; ++n) acc[a][b][m][n] = (f32x4){0.f, 0.f, 0.f, 0.f};
    bf16x8 At[4][2], B0[2][2], B1[2][2];
    const char* cA = (const char*)g.A + (size_t)cur.pm * tstep; const char* cB = (const char*)g.Bt + (size_t)cur.pn * tstep;
    PG8_STAGE(PG8_SB(0, 0), cB, voffB); PG8_STAGE(PG8_SB(0, 1), cB + hstep, voffB); PG8_STAGE(PG8_SA(0, 0), cA, voffA); PG8_STAGE(PG8_SA(0, 1), cA + hstep, voffA);
    if (wr == 1) PG8_BAR;
    PG8_WAIT_V(2); PG8_BAR;
    PG8_STAGE(PG8_SB(1, 0), cB + kstep, voffB); PG8_STAGE(PG8_SA(1, 0), cA + kstep, voffA); PG8_STAGE(PG8_SB(1, 1), cB + hstep + kstep, voffB);
    PG8_WAIT_V(6); PG8_BAR;
    for (;;) {
        const bool has_next = S.next(ui + 1, nxt);
        const char* nA = has_next ? (const char*)g.A + (size_t)nxt.pm * tstep : cA; const char* nB = has_next ? (const char*)g.Bt + (size_t)nxt.pn * tstep : cB;
        for (int t = 0; t < nt; t += 2) {
            const bool last = (t == nt - 2);
            const char* a1 = cA + (size_t)(t + 1) * kstep;
            const char* a2 = last ? nA : cA + (size_t)(t + 2) * kstep; const char* b2 = last ? nB : cB + (size_t)(t + 2) * kstep;
            const char* a3 = a2 + kstep; const char* b3 = b2 + kstep;
            PG8_LDB(B0, 0, 0); PG8_LDB(B1, 0, 1); PG8_SCHED; PG8_LDA(At, 0, 0); PG8_STAGE(PG8_SA(1, 1), a1 + hstep, voffA);
            PG8_WAIT_V(8); PG8_WAIT_L(0); PG8_BAR; PG8_MMA(0, 0, At, B0); PG8_MMA(0, 1, At, B1); PG8_BAR; PG8_SCHED;
            PG8_LDA(At, 0, 1); PG8_STAGE(PG8_SB(0, 0), b2, voffB); PG8_STAGE(PG8_SB(0, 1), b2 + hstep, voffB); PG8_STAGE(PG8_SA(0, 0), a2, voffA);
            PG8_WAIT_V(8); PG8_WAIT_L(0); PG8_BAR; PG8_MMA(1, 0, At, B0); PG8_MMA(1, 1, At, B1); PG8_BAR; PG8_SCHED;
            PG8_LDB(B0, 1, 0); PG8_LDB(B1, 1, 1); PG8_SCHED; PG8_LDA(At, 1, 0); PG8_STAGE(PG8_SA(0, 1), a2 + hstep, voffA);
            PG8_WAIT_V(8); PG8_WAIT_L(0); PG8_BAR; PG8_MMA(0, 0, At, B0); PG8_MMA(0, 1, At, B1); PG8_BAR; PG8_SCHED;
            PG8_LDA(At, 1, 1); PG8_STAGE(PG8_SB(1, 0), b3, voffB); PG8_STAGE(PG8_SB(1, 1), b3 + hstep, voffB); PG8_STAGE(PG8_SA(1, 0), a3, voffA);
            PG8_WAIT_V(8); PG8_WAIT_L(0); PG8_BAR; PG8_MMA(1, 0, At, B0); PG8_MMA(1, 1, At, B1); PG8_BAR; PG8_SCHED;
        }
        if constexpr (ALIGN_EPI) { if (wr == 0) PG8_BAR; }
        E(acc, cur, wr, wc, fr, fq);
        if (!has_next) break;
#pragma unroll
        for (int a = 0; a < 2; ++a)
#pragma unroll
            for (int b = 0; b < 2; ++b)
#pragma unroll
                for (int m = 0; m < 4; ++m)
#pragma unroll
                    for (int n = 0; n < 2; ++n) acc[a][b][m][n] = (f32x4){0.f, 0.f, 0.f, 0.f};
        cur = nxt; cA = nA; cB = nB; ++ui;
        if constexpr (ALIGN_EPI) { if (wr == 1) PG8_BAR; }
    }
    PG8_WAIT_V(0);
    if constexpr (!ALIGN_EPI) { if (wr == 0) PG8_BAR; }
    PG8_BAR;
#undef PG8_SA
#undef PG8_SB
#undef PG8_STAGE
#undef PG8_LDA
#undef PG8_LDB
#undef PG8_MMA
#undef PG8_WAIT_V
#undef PG8_WAIT_L
#undef PG8_BAR
#undef PG8_SCHED
}
}


#define XB_TMO      128
#define XB_XCNT(j)  (256  + 64 * (j))
#define XB_XSUB(j)  (1280 + 64 * (j))
#define XB_XGEN(j)  (2304 + 64 * (j))
#define XB_TOP      3328
#define XB_TOPGEN   3392
#define XCD_BAR_WORDS 3456
#define XB_SPIN_CAP (1u << 22)
__device__ __forceinline__ unsigned xb_ld(unsigned* p)              { return __hip_atomic_load(p, __ATOMIC_RELAXED, __HIP_MEMORY_SCOPE_AGENT); }
__device__ __forceinline__ unsigned xb_add(unsigned* p, unsigned v) { return __hip_atomic_fetch_add(p, v, __ATOMIC_RELAXED, __HIP_MEMORY_SCOPE_AGENT); }
__device__ __forceinline__ unsigned xb_xcc_id() { return (unsigned)__builtin_amdgcn_s_getreg((3 << 11) | 20) & 0xFu; }
#define XB_SPIN(cond, bar) do { unsigned _sp = 0; while (cond) { __builtin_amdgcn_s_sleep(1); \
    if ((++_sp & 255u) == 0u) { if (xb_ld(&(bar)[XB_TMO])) break; if (_sp > XB_SPIN_CAP) { atomicAdd(&(bar)[XB_TMO], 1u); break; } } } } while (0)
struct XcdBarrier { unsigned* bar; unsigned x; volatile LAS unsigned* st; };
__device__ __forceinline__ XcdBarrier xcd_barrier_post(unsigned* bar, volatile LAS unsigned* st) {
    XcdBarrier b; b.bar = bar; b.x = xb_xcc_id(); b.st = st;
    if (threadIdx.x == 0) (void)xb_add(&bar[XB_XCNT(b.x)], 1u);
    return b;
}
__device__ __forceinline__ void xcd_barrier_complete(unsigned* bar, unsigned x, unsigned& nloc, unsigned& nx) {
    const unsigned G = gridDim.x * gridDim.y * gridDim.z;
    unsigned sum, cnt, mine, sp = 0u;
    for (;;) {
        sum = 0u; cnt = 0u; mine = 0u;
#pragma unroll
        for (unsigned j = 0; j < 16; ++j) { const unsigned c = xb_ld(&bar[XB_XCNT(j)]); sum += c; cnt += (c > 0u) ? 1u : 0u; mine = (j == x) ? c : mine; }
        if (sum == G) break;
        __builtin_amdgcn_s_sleep(1);
        if ((++sp & 255u) == 0u) { if (xb_ld(&bar[XB_TMO])) break; if (sp > XB_SPIN_CAP) { atomicAdd(&bar[XB_TMO], 1u); break; } }
    }
    nloc = mine > 0u ? mine : 1u; nx = cnt > 0u ? cnt : 1u;
}
__device__ __forceinline__ void xcd_barrier(unsigned char* wsb) {
    XcdBarrier b; b.bar = (unsigned*)(wsb + WS_BAR); b.x = 0; b.st = (volatile LAS unsigned*)(135168 + 64);
    asm volatile("s_waitcnt vmcnt(0)" ::: "memory");
    __syncthreads();
    if (threadIdx.x == 0) {
        unsigned* bar = b.bar; b.x = xb_xcc_id();
        __builtin_amdgcn_s_waitcnt(0);
        unsigned nloc = b.st[0], nx = b.st[1];
        if (nloc == 0u) { xcd_barrier_complete(bar, b.x, nloc, nx); b.st[0] = nloc; b.st[1] = nx; }
        const unsigned old = xb_add(&bar[XB_XSUB(b.x)], 1u);
        const unsigned gen = old / nloc;
        if (old + 1u == (gen + 1u) * nloc) {
            __builtin_amdgcn_fence(__ATOMIC_RELEASE, "agent");
            asm volatile("s_waitcnt vmcnt(0)" ::: "memory");
            const unsigned og = xb_add(&bar[XB_TOP], 1u);
            const unsigned tg = og / nx;
            if (og + 1u == (tg + 1u) * nx) xb_add(&bar[XB_TOPGEN], 1u);
            else XB_SPIN(xb_ld(&bar[XB_TOPGEN]) == tg, bar);
            __builtin_amdgcn_fence(__ATOMIC_ACQUIRE, "agent");
            xb_add(&bar[XB_XGEN(b.x)], 1u);
            asm volatile("s_waitcnt vmcnt(0)" ::: "memory");
        } else {
            XB_SPIN(xb_ld(&bar[XB_XGEN(b.x)]) == gen, bar);
            __builtin_amdgcn_fence(__ATOMIC_ACQUIRE, "agent");
            asm volatile("s_waitcnt vmcnt(0)" ::: "memory");
        }
    }
    __syncthreads();
}

struct Params { const float* in[24]; float* out; unsigned char* ws; };
struct PRef {
    typedef const __attribute__((address_space(4))) char* kptr_t;
    __device__ __forceinline__ kptr_t base() const { kptr_t ka = (kptr_t)__builtin_amdgcn_kernarg_segment_ptr(); asm volatile("" : "+s"(ka)); return ka; }
    __device__ __forceinline__ const float* in(int i) const { return *(const float* const __attribute__((address_space(4)))*)(base() + 8 * i); }
    __device__ __forceinline__ float* out() const { return *(float* const __attribute__((address_space(4)))*)(base() + 8 * 24); }
    __device__ __forceinline__ unsigned char* ws() const { return *(unsigned char* const __attribute__((address_space(4)))*)(base() + 8 * 25); }
};
enum { I_X = 0, I_C, I_CTX, I_CCTX, I_MODW, I_MODB, I_N1G, I_N2G, I_WIN, I_DAQKG, I_DALAM, I_DAOUTG, I_CONVW, I_CONVB, I_GATEB, I_MLOUTG, I_QNG, I_KVNG, I_WUQ, I_WUKV, I_MLAQKG, I_WOUT, I_WGU, I_WDN };

struct Ctx {
    unsigned char* lds;
    int tid, lane, wave, gw, ngw, nwg, wg; unsigned l3off;
};

__device__ __forceinline__ Ctx fresh(const Ctx& X) {
    Ctx Y = X; int t = X.tid; asm volatile("" : "+v"(t)); Y.tid = t; Y.lane = t & 63; Y.wave = __builtin_amdgcn_readfirstlane(t >> 6); return Y;
}
template <int MODE>
__device__ __forceinline__ void transpose_item(const float* W, int K, int N, bf16_t* WT, float* scr, int item, int nblk, int lane) {
    const int kb = item / nblk, nb = item % nblk, k0 = 64 * kb, n0 = 32 * nb;
    const int ncol = n0 + (lane & 31); const bool ok = ncol < N;
#pragma unroll 8
    for (int i = 0; i < 32; ++i) { const int kk = 2 * i + (lane >> 5); scr[kk * 33 + (lane & 31)] = ok ? W[(size_t)(k0 + kk) * N + ncol] : 0.f; }
    asm volatile("s_waitcnt lgkmcnt(0)" ::: "memory");
    const int c = lane & 7;
#pragma unroll
    for (int j = 0; j < 4; ++j) { const int n = (lane >> 3) + 8 * j; const float* s = scr + (8 * c) * 33 + n;
        u32x4 o; o.x = pk2(s[0 * 33], s[1 * 33]); o.y = pk2(s[2 * 33], s[3 * 33]); o.z = pk2(s[4 * 33], s[5 * 33]); o.w = pk2(s[6 * 33], s[7 * 33]);
        int nn = n0 + n;
        if (MODE == 1) { const int up = nn >= FF ? 1 : 0; const int hcol = nn - up * FF; nn = (hcol >> 7) * 256 + up * 128 + (hcol & 127); }
        *(u32x4*)(WT + (size_t)nn * K + k0 + 8 * c) = o; }
    asm volatile("s_waitcnt lgkmcnt(0)" ::: "memory");
}
__device__ __forceinline__ void convert_weights(const Ctx& X0, const PRef& P, int l) {
    const Ctx X = fresh(X0);
    float* scr = (float*)(X.lds + X.wave * 16384);
    unsigned char* ws = P.ws();
    constexpr int I_IN = (DM / 64) * (NPROJ / 32), I_OUT = (DM / 64) * (DM / 32), I_GU = (DM / 64) * (2 * FF / 32), I_DN = (FF / 64) * (DM / 32), I_UQ = (512 / 64) * (1536 / 32), I_UKV = (256 / 64) * (2048 / 32);
    constexpr int NITEMS = I_IN + I_OUT + I_GU + I_DN + I_UQ + I_UKV;
    for (int it = X.gw; it < NITEMS; it += X.ngw) {
        int r = it;
        if (r < I_IN) { transpose_item<0>(P.in(I_WIN) + (size_t)l * DM * IN_W, DM, IN_W, (bf16_t*)(ws + WS_WIN), scr, r, NPROJ / 32, X.lane); continue; } r -= I_IN;
        if (r < I_OUT) { transpose_item<0>(P.in(I_WOUT) + (size_t)l * DM * DM, DM, DM, (bf16_t*)(ws + WS_WOUT), scr, r, DM / 32, X.lane); continue; } r -= I_OUT;
        if (r < I_GU) { transpose_item<1>(P.in(I_WGU) + (size_t)l * DM * 2 * FF, DM, 2 * FF, (bf16_t*)(ws + WS_WGU), scr, r, 2 * FF / 32, X.lane); continue; } r -= I_GU;
        if (r < I_DN) { transpose_item<0>(P.in(I_WDN) + (size_t)l * FF * DM, FF, DM, (bf16_t*)(ws + WS_WDN), scr, r, DM / 32, X.lane); continue; } r -= I_DN;
        if (r < I_UQ) { transpose_item<0>(P.in(I_WUQ) + (size_t)l * 512 * 1536, 512, 1536, (bf16_t*)(ws + WS_WUQ), scr, r, 1536 / 32, X.lane); continue; } r -= I_UQ;
        transpose_item<0>(P.in(I_WUKV) + (size_t)l * 256 * 2048, 256, 2048, (bf16_t*)(ws + WS_WUKV), scr, r, 2048 / 32, X.lane);
    }
}
__device__ __forceinline__ void mod_gemv(const Ctx& X0, const PRef& P) {
    const Ctx X = fresh(X0);
    float* sc = (float*)X.lds;
    float* red = (float*)(X.lds + 40960);
    for (int i = X.tid; i < 5 * DM; i += 512) { const int mb = i / DM, k = i % DM; const float v = mb < 4 ? P.in(I_C)[mb * DM + k] : P.in(I_CCTX)[k]; sc[i] = siluf(v); }
    __syncthreads();
    float* mod = (float*)(P.ws() + WS_MOD);
    const int kq = X.tid >> 4, c4 = X.tid & 15;
    for (int task = X.wg; task < DEPTH * 192; task += X.nwg) {
        const int l = task / 192, n0 = (task % 192) * 64;
        const float* W = P.in(I_MODW) + (size_t)l * DM * 6 * DM + n0 + 4 * c4;
        f32x4 a[5];
#pragma unroll
        for (int mb = 0; mb < 5; ++mb) a[mb] = (f32x4){0.f, 0.f, 0.f, 0.f};
#pragma unroll 8
        for (int i = 0; i < 64; ++i) { const int k = kq + 32 * i; const f32x4 w = *(const f32x4*)(W + (size_t)k * 6 * DM);
#pragma unroll
            for (int mb = 0; mb < 5; ++mb) a[mb] += w * sc[mb * DM + k]; }
#pragma unroll
        for (int mb = 0; mb < 5; ++mb) *(f32x4*)(red + (kq * 5 + mb) * 64 + 4 * c4) = a[mb];
        __syncthreads();
        if (X.tid < 320) { const int mb = X.tid >> 6, cc = X.tid & 63; float s = 0.f;
#pragma unroll 8
            for (int q = 0; q < 32; ++q) s += red[(q * 5 + mb) * 64 + cc];
            mod[((size_t)l * 5 + mb) * 6 * DM + n0 + cc] = s + P.in(I_MODB)[(size_t)l * 6 * DM + n0 + cc]; }
        __syncthreads();
    }
}

__device__ __forceinline__ void modulate_phase(const Ctx& X0, const float* src_lat, const float* src_ctx, const float* g, const float* modl, int shift_off, int scale_off, bf16_t* A, int nrows) {
    const Ctx X = fresh(X0);
    const int rpw = (nrows + X.ngw - 1) / X.ngw;
    int row = X.gw * rpw; const int rend = min(row + rpw, nrows);
    f32x4 v[8], nx[8], gm[8], sh[8];
    int cur_mb = -1;
    if (row < rend) { const float* src = row < M_LAT ? src_lat + (size_t)row * DM : src_ctx + (size_t)(row - M_LAT) * DM;
#pragma unroll
        for (int j = 0; j < 8; ++j) v[j] = *(const f32x4*)(src + X.lane * 4 + 256 * j); }
    for (; row < rend; ++row) {
        const int nrow = row + 1;
        if (nrow < rend) { const float* src = nrow < M_LAT ? src_lat + (size_t)nrow * DM : src_ctx + (size_t)(nrow - M_LAT) * DM;
#pragma unroll
            for (int j = 0; j < 8; ++j) nx[j] = *(const f32x4*)(src + X.lane * 4 + 256 * j); }
        const int mb = mod_batch(row);
        if (mb != cur_mb) { cur_mb = mb; const float* mp = modl + (size_t)mb * 6 * DM;
#pragma unroll
            for (int j = 0; j < 8; ++j) { const int col = X.lane * 4 + 256 * j; gm[j] = *(const f32x4*)(g + col) * (*(const f32x4*)(mp + scale_off + col) + 1.0f); sh[j] = *(const f32x4*)(mp + shift_off + col); } }
        float ss = 0.f;
#pragma unroll
        for (int j = 0; j < 8; ++j) ss += (v[j][0] * v[j][0] + v[j][1] * v[j][1]) + (v[j][2] * v[j][2] + v[j][3] * v[j][3]);
        const float rstd = rsqrtf(wave_sum(ss) * (1.f / DM) + EPS);
#pragma unroll
        for (int j = 0; j < 8; ++j) { const int col = X.lane * 4 + 256 * j;
            const f32x4 y = (v[j] * rstd) * gm[j] + sh[j];
            u32x2 w; w.x = pk2(y[0], y[1]); w.y = pk2(y[2], y[3]);
            *(u32x2*)(A + (size_t)row * DM + col) = w; }
#pragma unroll
        for (int j = 0; j < 8; ++j) v[j] = nx[j];
    }
}

struct ChunkId { int b, j, row0, tok0, is_lat, seglen; };
__device__ __forceinline__ ChunkId chunk_of_unit(int u) {
    ChunkId c;
    if (u < 256) { c.b = u >> 6; c.j = u & 63; c.row0 = c.b * SEQ + 64 * c.j; c.tok0 = CTXL + 64 * c.j; c.is_lat = 1; c.seglen = SEQ; }
    else { const int uu = u - 256; c.b = uu >> 2; c.j = uu & 3; c.row0 = M_LAT + c.b * CTXL + 64 * c.j; c.tok0 = 64 * c.j; c.is_lat = 0; c.seglen = CTXL; }
    return c;
}
__device__ __forceinline__ int row_of_tokchunk(int b, int jt) { return jt < 4 ? M_LAT + b * CTXL + 64 * jt : b * SEQ + 64 * (jt - 4); }

constexpr int TSTR = 520;
__device__ __forceinline__ void write_vt(const Ctx& X, const bf16_t* tile, bf16_t* img, size_t img_row0, int tok0) {
#pragma unroll 2
    for (int it = 0; it < 8; ++it) { const int task = it * 512 + X.tid; const int k = task & 7, c = task >> 3;
        float v[8];
#pragma unroll
        for (int jj = 0; jj < 8; ++jj) { const int i = 16 * (k >> 1) + 8 * (jj >> 2) + 4 * (k & 1) + (jj & 3); v[jj] = bf1(tile[i * TSTR + c]); }
        *(u32x4*)(img + (img_row0 + c) * TK + tok0 + 8 * k) = pack8(v); }
}
template <class F>
__device__ __forceinline__ void load_tile(const Ctx& X, bf16_t* tile, const bf16_t* src, size_t rstride, F colmap) {
#pragma unroll 4
    for (int it = 0; it < 8; ++it) { const int ch = it * 512 + X.tid; const int i = ch >> 6, cc = ch & 63;
        const u32x4 w = *(const u32x4*)(src + (size_t)i * rstride + colmap(cc));
        *(u32x4*)(tile + i * TSTR + 8 * cc) = w; }
}

__device__ __forceinline__ void rope_cs(int sub, int prow, int pcol, float* cs, float* sn) {
    const float pos = (float)((sub < 4) ? prow : pcol);
#pragma unroll
    for (int e = 0; e < 8; ++e) { const int fi = (sub & 1) * 8 + e; const float inv = exp2f(-(float)fi * (13.287712379549449f / 16.0f)); const float a = pos * inv; cs[e] = __cosf(a); sn[e] = __sinf(a); }
}
__device__ __forceinline__ void rope_apply(int sub, float* y, const float* cs, const float* sn) {
#pragma unroll
    for (int e = 0; e < 8; ++e) { const float p = __shfl_xor(y[e], 2); y[e] = (sub & 2) ? (y[e] * cs[e] + p * sn[e]) : (y[e] * cs[e] - p * sn[e]); }
}

__device__ __forceinline__ void prep_phase(const Ctx& X0, const PRef& P, int l) {
    const Ctx X = fresh(X0);
    unsigned char* ws = P.ws();
    const bf16_t* proj = (const bf16_t*)(ws + WS_PROJ);
    bf16_t* tile = (bf16_t*)X.lds;
    const float* qkg = P.in(I_DAQKG) + l * 128;
    const float* convw = P.in(I_CONVW) + (size_t)l * 3 * 1024; const float* convb = P.in(I_CONVB) + l * 1024;
    const float* qng = P.in(I_QNG) + l * 512; const float* kvng = P.in(I_KVNG) + l * 256;
    const int lane = X.lane, sub = lane & 7;
    const float qscale = 0.125f * LOG2E;
    for (int uu = X.wg; uu < 4 * 272; uu += X.nwg) {
        const int part = uu / 272, u = uu % 272;
        const ChunkId c = chunk_of_unit(u);
        if (part == 0) {
        for (int i = X.wave; i < 64; i += 8) {
            const int row = c.row0 + i, tok = c.tok0 + i;
            const bf16_t* pr = proj + (size_t)row * NPROJ;
            float cs[8], sn[8];
            if (c.is_lat) rope_cs(sub, c.j, i, cs, sn);
#pragma unroll
            for (int qk = 0; qk < 2; ++qk) {
                float y[8]; unpack8(*(const u32x4*)(pr + (qk ? C_DAK : C_DAQ) + 8 * lane), y);
                float ss = 0.f;
#pragma unroll
                for (int e = 0; e < 8; ++e) ss += y[e] * y[e];
                ss += __shfl_xor(ss, 1); ss += __shfl_xor(ss, 2); ss += __shfl_xor(ss, 4);
                const float rstd = rsqrtf(ss * (1.f / 64.f) + EPS);
#pragma unroll
                for (int e = 0; e < 8; ++e) y[e] = y[e] * rstd * qkg[qk * 64 + 8 * sub + e];
                if (c.is_lat) rope_apply(sub, y, cs, sn);
                const int head = lane >> 4, comp = (lane >> 3) & 1;
                if (qk == 0) {
#pragma unroll
                    for (int e = 0; e < 8; ++e) y[e] *= qscale;
                    *(u32x4*)((bf16_t*)(ws + WS_QDA) + ((size_t)head * M_ALL + row) * 128 + comp * 64 + 8 * sub) = pack8(y);
                } else {
                    *(u32x4*)((bf16_t*)(ws + WS_KDA) + ((size_t)(c.b * 4 + head) * TK + tok) * 128 + comp * 64 + 8 * sub) = pack8(y);
                }
            }
            {
                float y[8]; unpack8(*(const u32x4*)(pr + C_CQ + 8 * lane), y);
                float ss = 0.f;
#pragma unroll
                for (int e = 0; e < 8; ++e) ss += y[e] * y[e];
                const float rstd = rsqrtf(wave_sum(ss) * (1.f / 512.f) + EPS);
#pragma unroll
                for (int e = 0; e < 8; ++e) y[e] = y[e] * rstd * qng[8 * lane + e];
                *(u32x4*)((bf16_t*)(ws + WS_CQN) + (size_t)row * 512 + 8 * lane) = pack8(y);
            }
            {
                float y[8];
                if (lane < 32) unpack8(*(const u32x4*)(pr + C_CKV + 8 * lane), y);
                else {
#pragma unroll
                    for (int e = 0; e < 8; ++e) y[e] = 0.f;
                }
                float ss = 0.f;
#pragma unroll
                for (int e = 0; e < 8; ++e) ss += y[e] * y[e];
                const float rstd = rsqrtf(wave_sum(ss) * (1.f / 256.f) + EPS);
                if (lane < 32) {
#pragma unroll
                    for (int e = 0; e < 8; ++e) y[e] = y[e] * rstd * kvng[8 * lane + e];
                    *(u32x4*)((bf16_t*)(ws + WS_CKVN) + (size_t)row * 256 + 8 * lane) = pack8(y);
                }
            }
            if (lane < 8) *(u32x4*)((bf16_t*)(ws + WS_KPE) + (size_t)row * 64 + 8 * lane) = *(const u32x4*)(pr + C_KPE + 8 * lane);
            *(u32x4*)((bf16_t*)(ws + WS_OCOPY) + (size_t)row * 512 + 8 * lane) = *(const u32x4*)(pr + C_MLO + 8 * lane);
        }
        } else if (part == 1) {
        for (int i = X.wave; i < 64; i += 8) {
            const int row = c.row0 + i, tseg = 64 * c.j + i, tok = c.tok0 + i;
            const bf16_t* pr = proj + (size_t)row * NPROJ;
#pragma unroll
            for (int qk = 0; qk < 2; ++qk) {
                const int ch0 = qk * 512 + 8 * lane;
                float xm[8], x0[8], xp[8];
                unpack8(*(const u32x4*)(pr + C_MLQ + ch0), x0);
                if (tseg > 0) unpack8(*(const u32x4*)(pr - NPROJ + C_MLQ + ch0), xm);
                else {
#pragma unroll
                    for (int e = 0; e < 8; ++e) xm[e] = 0.f;
                }
                if (tseg < c.seglen - 1) unpack8(*(const u32x4*)(pr + NPROJ + C_MLQ + ch0), xp);
                else {
#pragma unroll
                    for (int e = 0; e < 8; ++e) xp[e] = 0.f;
                }
                float y[8];
#pragma unroll
                for (int e = 0; e < 8; ++e) { const float v = convb[ch0 + e] + convw[ch0 + e] * xm[e] + convw[1024 + ch0 + e] * x0[e] + convw[2048 + ch0 + e] * xp[e]; y[e] = siluf(v) * (qk ? 0.08838834764831845f : 1.0f); }
                const int head = lane >> 4, d = 8 * (lane & 15);
                const u32x4 w = pack8(y);
                *(u32x4*)((bf16_t*)(ws + (qk ? WS_KML : WS_QML)) + ((size_t)(c.b * 4 + head) * TK + tok) * 128 + d) = w;
                if (qk) *(u32x4*)(tile + i * TSTR + 8 * lane) = w;
            }
        }
        __syncthreads();
        write_vt(X, tile, (bf16_t*)(ws + WS_KTML), (size_t)c.b * 512, c.tok0);
        __syncthreads();
        } else if (part == 2) {
        load_tile(X, tile, proj + (size_t)c.row0 * NPROJ, NPROJ, [](int cc) { return C_DAV + 8 * cc; });
        __syncthreads();
        write_vt(X, tile, (bf16_t*)(ws + WS_VTDA), (size_t)c.b * 512, c.tok0);
        __syncthreads();
        } else {
        load_tile(X, tile, proj + (size_t)c.row0 * NPROJ, NPROJ, [](int cc) { return C_MLV + 8 * cc; });
        __syncthreads();
        write_vt(X, tile, (bf16_t*)(ws + WS_VTML), (size_t)c.b * 512, c.tok0);
        __syncthreads();
        }
    }
}

__device__ __forceinline__ void mla_prep_phase(const Ctx& X0, const PRef& P, int l) {
    const Ctx X = fresh(X0);
    unsigned char* ws = P.ws();
    const bf16_t* qup = (const bf16_t*)(ws + WS_QUP); const bf16_t* kvup = (const bf16_t*)(ws + WS_KVUP); const bf16_t* kpe = (const bf16_t*)(ws + WS_KPE);
    bf16_t* tile = (bf16_t*)X.lds;
    const float* g = P.in(I_MLAQKG) + l * 2 * 192;
    const int lane = X.lane, sub = lane & 7, head = lane >> 3;
    const float qscale = 0.07216878364870322f * LOG2E;
    for (int uu = X.wg; uu < 3 * 272; uu += X.nwg) {
        const int part = uu / 272, u = uu % 272;
        const ChunkId c = chunk_of_unit(u);
        if (part == 0) {
        for (int i = X.wave; i < 64; i += 8) {
            const int row = c.row0 + i, tok = c.tok0 + i;
            float cs[8], sn[8];
            if (c.is_lat) rope_cs(sub, c.j, i, cs, sn);
#pragma unroll
            for (int qk = 0; qk < 2; ++qk) {
                float y[3][8];
                if (qk == 0) {
#pragma unroll
                    for (int cc = 0; cc < 3; ++cc) unpack8(*(const u32x4*)(qup + (size_t)row * 1536 + head * 192 + 64 * cc + 8 * sub), y[cc]);
                } else {
#pragma unroll
                    for (int cc = 0; cc < 2; ++cc) unpack8(*(const u32x4*)(kvup + (size_t)row * 2048 + head * 256 + 64 * cc + 8 * sub), y[cc]);
                    unpack8(*(const u32x4*)(kpe + (size_t)row * 64 + 8 * sub), y[2]);
                }
                float ss = 0.f;
#pragma unroll
                for (int cc = 0; cc < 3; ++cc)
#pragma unroll
                    for (int e = 0; e < 8; ++e) ss += y[cc][e] * y[cc][e];
                ss += __shfl_xor(ss, 1); ss += __shfl_xor(ss, 2); ss += __shfl_xor(ss, 4);
                const float rstd = rsqrtf(ss * (1.f / 192.f) + EPS);
#pragma unroll
                for (int cc = 0; cc < 3; ++cc)
#pragma unroll
                    for (int e = 0; e < 8; ++e) y[cc][e] = y[cc][e] * rstd * g[qk * 192 + 64 * cc + 8 * sub + e];
                if (c.is_lat) rope_apply(sub, y[2], cs, sn);
                bf16_t* dst;
                if (qk == 0) {
#pragma unroll
                    for (int cc = 0; cc < 3; ++cc)
#pragma unroll
                        for (int e = 0; e < 8; ++e) y[cc][e] *= qscale;
                    dst = (bf16_t*)(ws + WS_QM) + ((size_t)head * M_ALL + row) * 192;
                } else dst = (bf16_t*)(ws + WS_KM) + ((size_t)(c.b * 8 + head) * TK + tok) * 192;
#pragma unroll
                for (int cc = 0; cc < 3; ++cc) *(u32x4*)(dst + 64 * cc + 8 * sub) = pack8(y[cc]);
            }
        }
        } else {
            const int p = part - 1;
            load_tile(X, tile, kvup + (size_t)c.row0 * 2048, 2048, [p](int cc) { return (4 * p + (cc >> 4)) * 256 + 128 + 8 * (cc & 15); });
            __syncthreads();
            write_vt(X, tile, (bf16_t*)(ws + WS_VTM), (size_t)(c.b * 8 + 4 * p) * 128, c.tok0);
            __syncthreads();
        }
    }
}

__device__ __forceinline__ void ml_gates(const float* gates, const float* gb, int b, int jt, int dir, int h, int lane, float& ig, float& lf, float& pre, float& total) {
    const int row = row_of_tokchunk(b, jt) + lane;
    ig = gates[(size_t)row * 16 + dir * 8 + h] + gb[dir * 8 + h];
    const float fg = gates[(size_t)row * 16 + dir * 8 + 4 + h] + gb[dir * 8 + 4 + h];
    lf = fminf(fg, 0.f) - log1pf(__expf(-fabsf(fg)));
    float s = lf;
#pragma unroll
    for (int o = 1; o < 64; o <<= 1) { const float t = __shfl_up(s, o); if (lane >= o) s += t; }
    pre = s; total = __shfl(s, 63);
}
constexpr int KSTR = 72;
constexpr int QSTR = 136;
__device__ __forceinline__ void mlstm_a_phase(const Ctx& X0, const PRef& P, int l) {
    const Ctx X = fresh(X0);
    unsigned char* ws = P.ws();
    const float* gates = (const float*)(ws + WS_GATES); const float* gb = P.in(I_GATEB) + l * 16;
    bf16_t* Kt = (bf16_t*)X.lds;
    bf16_t* Vw = (bf16_t*)(X.lds + 128 * KSTR * 2);
    float* wtab = (float*)(X.lds + 3 * 128 * KSTR * 2);
    const int lane = X.lane, r32 = lane & 31, hi = lane >> 5;
    for (int u = X.wg; u < 16 * NCH; u += X.nwg) {
        const int bh = u / NCH, jt = u % NCH, b = bh >> 2, h = bh & 3, tok0 = 64 * jt;
        if (X.wave < 2) {
            const int dir = X.wave; float ig, lf, pre, total; ml_gates(gates, gb, b, jt, dir, h, lane, ig, lf, pre, total);
            const float cum = dir == 0 ? pre : total - pre + lf;
            const float wlog = total - cum + ig; const float mloc = wave_max(wlog);
            wtab[dir * 64 + lane] = __expf(wlog - mloc);
            if (lane == 0) { float* cs = (float*)(ws + WS_CSTAT) + ((size_t)(bh * 2 + dir) * NCH + jt) * 4; cs[0] = total; cs[1] = mloc; }
        }
        u32x4 vr[2];
#pragma unroll
        for (int it = 0; it < 2; ++it) { const int ch = it * 512 + X.tid; const int rr = ch >> 3, k = ch & 7;
            *(u32x4*)(Kt + rr * KSTR + 8 * k) = *(const u32x4*)((const bf16_t*)(ws + WS_KTML) + ((size_t)bh * 128 + rr) * TK + tok0 + 8 * k);
            vr[it] = *(const u32x4*)((const bf16_t*)(ws + WS_VTML) + ((size_t)bh * 128 + rr) * TK + tok0 + 8 * k); }
        __syncthreads();
#pragma unroll
        for (int it = 0; it < 2; ++it) { const int ch = it * 512 + X.tid; const int rr = ch >> 3, k = ch & 7;
            float v[8]; unpack8(vr[it], v);
#pragma unroll
            for (int dir = 0; dir < 2; ++dir) { float o[8];
#pragma unroll
                for (int jj = 0; jj < 8; ++jj) { const int i = 16 * (k >> 1) + 8 * (jj >> 2) + 4 * (k & 1) + (jj & 3); o[jj] = v[jj] * wtab[dir * 64 + i]; }
                *(u32x4*)(Vw + (dir * 128 + rr) * KSTR + 8 * k) = pack8(o); } }
        __syncthreads();
        {
            const int dir = X.wave >> 2, dvb = X.wave & 3;
            bf16_t* U = (bf16_t*)(ws + WS_AB) + ((size_t)(bh * 2 + dir) * NCH + jt) * 16384;
            bf16x8 a[4];
#pragma unroll
            for (int ks = 0; ks < 4; ++ks) a[ks] = *(const bf16x8*)(Vw + (dir * 128 + 32 * dvb + r32) * KSTR + 16 * ks + 8 * hi);
            for (int dkb = 0; dkb < 4; ++dkb) {
                f32x16 acc;
#pragma unroll
                for (int r = 0; r < 16; ++r) acc[r] = 0.f;
#pragma unroll
                for (int ks = 0; ks < 4; ++ks) { const bf16x8 bb = *(const bf16x8*)(Kt + (32 * dkb + r32) * KSTR + 16 * ks + 8 * hi); acc = __builtin_amdgcn_mfma_f32_32x32x16_bf16(a[ks], bb, acc, 0, 0, 0); }
#pragma unroll
                for (int r = 0; r < 16; ++r) U[(32 * dvb + crow(r, hi)) * 128 + 32 * dkb + r32] = (bf16_t)(pk2(acc[r], 0.f) & 0xffffu);
            }
        }
        if (X.tid < 256) { const int dir = X.tid >> 7, dk = X.tid & 127; float s = 0.f;
#pragma unroll 8
            for (int p = 0; p < 64; ++p) { const int i = (p & ~15) + perm_off(p & 15); s += wtab[dir * 64 + i] * bf1(Kt[dk * KSTR + p]); }
            ((float*)(ws + WS_NU))[((size_t)(bh * 2 + dir) * NCH + jt) * 128 + dk] = s; }
        __syncthreads();
    }
}
__device__ __forceinline__ int ml_jmap(int dir, int c) { return dir == 0 ? c : (c < 4 ? 3 - c : 71 - c); }
__device__ __forceinline__ void mlstm_scan_phase(const Ctx& X0, const PRef& P) {
    const Ctx X = fresh(X0);
    unsigned char* ws = P.ws();
    float* cstat = (float*)(ws + WS_CSTAT);
    const int gtid = X.wg * 512 + X.tid, nthr = X.nwg * 512;
    for (int task = gtid; task < 65536 + 1024; task += nthr) {
        float m = 0.f;
        if (task < 65536) {
            const int seq = task >> 11, e = task & 2047, dir = seq & 1;
            const bf16_t* __restrict__ U = (const bf16_t*)(ws + WS_AB); bf16_t* __restrict__ S = (bf16_t*)(ws + WS_CSNAP);
            float C[8];
#pragma unroll
            for (int i = 0; i < 8; ++i) C[i] = 0.f;
            for (int cb = 0; cb < 4; ++cb) {
                u32x4 uu[17]; float tot[17], mlc[17];
#pragma unroll
                for (int i = 0; i < 17; ++i) { const size_t base = (size_t)seq * NCH + ml_jmap(dir, cb * 17 + i);
                    uu[i] = *(const u32x4*)(U + base * 16384 + 8 * e); tot[i] = cstat[base * 4]; mlc[i] = cstat[base * 4 + 1]; }
#pragma unroll
                for (int i = 0; i < 17; ++i) { const size_t base = (size_t)seq * NCH + ml_jmap(dir, cb * 17 + i);
                    *(u32x4*)(S + base * 16384 + 8 * e) = pack8(C);
                    if (e == 0) cstat[base * 4 + 2] = m;
                    const float mn = fmaxf(tot[i] + m, mlc[i]); const float dec = __expf(tot[i] + m - mn), sc = __expf(mlc[i] - mn);
                    float u8[8]; unpack8(uu[i], u8);
#pragma unroll
                    for (int q = 0; q < 8; ++q) C[q] = C[q] * dec + u8[q] * sc;
                    m = mn; }
            }
        } else {
            const int t2 = task - 65536, seq = t2 >> 5, e4 = t2 & 31, dir = seq & 1;
            const float* __restrict__ NU = (const float*)(ws + WS_NU); float* __restrict__ NS = (float*)(ws + WS_NSNAP);
            f32x4 C = (f32x4){0.f, 0.f, 0.f, 0.f};
            for (int cb = 0; cb < 4; ++cb) {
                f32x4 uu[17]; float tot[17], mlc[17];
#pragma unroll
                for (int i = 0; i < 17; ++i) { const size_t base = (size_t)seq * NCH + ml_jmap(dir, cb * 17 + i);
                    uu[i] = *(const f32x4*)(NU + base * 128 + 4 * e4); tot[i] = cstat[base * 4]; mlc[i] = cstat[base * 4 + 1]; }
#pragma unroll
                for (int i = 0; i < 17; ++i) { const size_t base = (size_t)seq * NCH + ml_jmap(dir, cb * 17 + i);
                    *(f32x4*)(NS + base * 128 + 4 * e4) = C;
                    const float mn = fmaxf(tot[i] + m, mlc[i]); const float dec = __expf(tot[i] + m - mn), sc = __expf(mlc[i] - mn);
                    C = C * dec + uu[i] * sc; m = mn; }
            }
        }
    }
}
__device__ __forceinline__ void mlstm_c_unit(const Ctx& X0, const PRef& P, int l, int u) {
    const Ctx X = fresh(X0);
    unsigned char* ws = P.ws();
    const float* gates = (const float*)(ws + WS_GATES); const float* gb = P.in(I_GATEB) + l * 16;
    const float* cstat = (const float*)(ws + WS_CSTAT);
    bf16_t* Qt = (bf16_t*)X.lds;
    bf16_t* Kn = (bf16_t*)(X.lds + 64 * QSTR * 2);
    bf16_t* Vt = (bf16_t*)(X.lds + 2 * 64 * QSTR * 2);
    float* tab = (float*)(X.lds + 2 * 64 * QSTR * 2 + 128 * KSTR * 2);
    float* t_a = tab, *t_c1 = tab + 128, *t_wp = tab + 256, *t_em = tab + 384, *t_n = tab + 512, *t_red = tab + 768;
    const int lane = X.lane, r32 = lane & 31, hi = lane >> 5;
    const int bh = u / NCH, jt = u % NCH, b = bh >> 2, h = bh & 3, tok0 = 64 * jt;
    if (X.wave < 2) {
        const int dir = X.wave; float ig, lf, pre, total; ml_gates(gates, gb, b, jt, dir, h, lane, ig, lf, pre, total);
        const float cum = dir == 0 ? pre : total - pre + lf;
        const float a = ig - cum; float pm = a;
#pragma unroll
        for (int o = 1; o < 64; o <<= 1) { const float t = dir == 0 ? __shfl_up(pm, o) : __shfl_down(pm, o); const bool ok = dir == 0 ? (lane >= o) : (lane + o < 64); if (ok) pm = fmaxf(pm, t); }
        const float mc = cstat[((size_t)(bh * 2 + dir) * NCH + jt) * 4 + 2];
        const float mt = cum + fmaxf(mc, pm);
        t_a[dir * 64 + lane] = a; t_c1[dir * 64 + lane] = cum - mt; t_wp[dir * 64 + lane] = __expf(cum + mc - mt); t_em[dir * 64 + lane] = __expf(-mt);
    }
#pragma unroll
    for (int it = 0; it < 2; ++it) { const int ch = it * 512 + X.tid;
        { const int i = ch >> 4, k = ch & 15;
          *(u32x4*)(Qt + i * QSTR + 8 * k) = *(const u32x4*)((const bf16_t*)(ws + WS_QML) + ((size_t)bh * TK + tok0 + i) * 128 + 8 * k);
          *(u32x4*)(Kn + i * QSTR + 8 * k) = *(const u32x4*)((const bf16_t*)(ws + WS_KML) + ((size_t)bh * TK + tok0 + i) * 128 + 8 * k); }
        { const int rr = ch >> 3, k = ch & 7;
          *(u32x4*)(Vt + rr * KSTR + 8 * k) = *(const u32x4*)((const bf16_t*)(ws + WS_VTML) + ((size_t)bh * 128 + rr) * TK + tok0 + 8 * k); } }
    if (X.tid < 256) t_n[X.tid] = ((const float*)(ws + WS_NSNAP))[((size_t)(bh * 2 + (X.tid >> 7)) * NCH + jt) * 128 + (X.tid & 127)];
    __syncthreads();
    const int tb = X.wave & 1, db = X.wave >> 1, t = 32 * tb + r32;
    bf16x8 qf[8];
#pragma unroll
    for (int ks = 0; ks < 8; ++ks) qf[ks] = *(const bf16x8*)(Qt + t * QSTR + 16 * ks + 8 * hi);
    f32x16 st[2];
#pragma unroll
    for (int sb = 0; sb < 2; ++sb) {
#pragma unroll
        for (int r = 0; r < 16; ++r) st[sb][r] = 0.f;
#pragma unroll
        for (int ks = 0; ks < 8; ++ks) { const bf16x8 kf = *(const bf16x8*)(Kn + (32 * sb + r32) * QSTR + 16 * ks + 8 * hi); st[sb] = __builtin_amdgcn_mfma_f32_32x32x16_bf16(kf, qf[ks], st[sb], 0, 0, 0); }
    }
    f32x16 hsum;
#pragma unroll
    for (int r = 0; r < 16; ++r) hsum[r] = 0.f;
#pragma unroll
    for (int dir = 0; dir < 2; ++dir) {
        const float c1 = t_c1[dir * 64 + t], wp = t_wp[dir * 64 + t], em = t_em[dir * 64 + t];
        float rs = 0.f; u32x4 pw[2][2];
#pragma unroll
        for (int sb = 0; sb < 2; ++sb) { float p[16];
#pragma unroll
            for (int r = 0; r < 16; ++r) { const int s = 32 * sb + crow(r, hi); const bool ok = dir == 0 ? (s <= t) : (s >= t);
                const float dm = ok ? __expf(t_a[dir * 64 + s] + c1) : 0.f; p[r] = st[sb][r] * dm; rs += p[r]; }
            pw[sb][0] = pack8(p); pw[sb][1] = pack8(p + 8); }
        rs += __shfl_xor(rs, 32);
        float qn = 0.f;
#pragma unroll
        for (int ks = 0; ks < 8; ++ks) { float q8[8]; unpack8(__builtin_bit_cast(u32x4, qf[ks]), q8);
#pragma unroll
            for (int e = 0; e < 8; ++e) qn += q8[e] * t_n[dir * 128 + 16 * ks + 8 * hi + e]; }
        qn += __shfl_xor(qn, 32);
        const float den = rs + wp * qn; const float rden = 1.f / fmaxf(fabsf(den), em);
        f32x16 acc;
#pragma unroll
        for (int r = 0; r < 16; ++r) acc[r] = 0.f;
        const bf16_t* Cs = (const bf16_t*)(ws + WS_CSNAP) + ((size_t)(bh * 2 + dir) * NCH + jt) * 16384 + (size_t)(32 * db + r32) * 128;
#pragma unroll
        for (int ks = 0; ks < 8; ++ks) { const bf16x8 cf = *(const bf16x8*)(Cs + 16 * ks + 8 * hi); acc = __builtin_amdgcn_mfma_f32_32x32x16_bf16(cf, qf[ks], acc, 0, 0, 0); }
#pragma unroll
        for (int r = 0; r < 16; ++r) acc[r] *= wp;
#pragma unroll
        for (int sb = 0; sb < 2; ++sb)
#pragma unroll
            for (int s2 = 0; s2 < 2; ++s2) { const bf16x8 vf = *(const bf16x8*)(Vt + (32 * db + r32) * KSTR + 32 * sb + 16 * s2 + 8 * hi);
                acc = __builtin_amdgcn_mfma_f32_32x32x16_bf16(vf, __builtin_bit_cast(bf16x8, pw[sb][s2]), acc, 0, 0, 0); }
#pragma unroll
        for (int r = 0; r < 16; ++r) hsum[r] += acc[r] * rden;
    }
    float ss = 0.f;
#pragma unroll
    for (int r = 0; r < 16; ++r) ss += hsum[r] * hsum[r];
    ss += __shfl_xor(ss, 32);
    if (hi == 0) t_red[(tb * 4 + db) * 32 + r32] = ss;
    __syncthreads();
    const float tot = t_red[(tb * 4 + 0) * 32 + r32] + t_red[(tb * 4 + 1) * 32 + r32] + t_red[(tb * 4 + 2) * 32 + r32] + t_red[(tb * 4 + 3) * 32 + r32];
    const float rstd = rsqrtf(tot * (1.f / 128.f) + EPS);
    const int row = row_of_tokchunk(b, jt) + t;
    const float* og = P.in(I_MLOUTG) + l * 512 + h * 128;
    const bf16_t* oc = (const bf16_t*)(ws + WS_OCOPY) + (size_t)row * 512 + h * 128;
    bf16_t* mix = (bf16_t*)(ws + WS_AB) + (size_t)row * DM + 512 + h * 128;
#pragma unroll
    for (int q = 0; q < 4; ++q) { const int dv = 32 * db + 8 * q + 4 * hi;
        const u32x2 ow = *(const u32x2*)(oc + dv); const f32x4 gg = *(const f32x4*)(og + dv);
        const float o0 = hsum[4 * q + 0] * rstd * gg[0] * sigmf(bflo(ow.x)), o1 = hsum[4 * q + 1] * rstd * gg[1] * sigmf(bfhi(ow.x));
        const float o2 = hsum[4 * q + 2] * rstd * gg[2] * sigmf(bflo(ow.y)), o3 = hsum[4 * q + 3] * rstd * gg[3] * sigmf(bfhi(ow.y));
        u32x2 w; w.x = pk2(o0, o1); w.y = pk2(o2, o3); *(u32x2*)(mix + dv) = w; }
    __syncthreads();
}

template <int DQK, int KROW>
struct AttnCore {
    static constexpr int NKS = DQK / 16, NKC1 = KROW / 8 + 1, KS = NKC1 * 8, KT_B = 64 * NKC1 * 16, VT_B = 128 * 9 * 16, SLOT_B = KT_B + VT_B;
    static constexpr int NBK = KT_B / 1024, NBV = VT_B / 1024, NB = NBK + NBV, NI = (NB + 7) / 8;
    static_assert(KT_B % 1024 == 0 && VT_B % 1024 == 0 && 8 * NI - NB <= 8 && 3 * SLOT_B <= 135168, "attention LDS geometry");
    static __device__ __forceinline__ void run(const Ctx& X, const bf16_t* Qrow, int kcol, const bf16_t* K, const bf16_t* Vt, int nt, f32x16 (&o)[4]) {
        const int lane = X.lane, r32 = lane & 31, hi = lane >> 5;
        LAS unsigned char* l3 = (LAS unsigned char*)0 + X.l3off;
        bf16x8 qf[NKS];
#pragma unroll
        for (int ks = 0; ks < NKS; ++ks) qf[ks] = *(const bf16x8*)(Qrow + 16 * ks + 8 * hi);
        unsigned goff[NI]; int bsel[NI];
#pragma unroll
        for (int i = 0; i < NI; ++i) {
            int bidx = X.wave + 8 * i; if (bidx >= NB) bidx -= NB;
            bsel[i] = bidx;
            if (bidx < NBK) { const int c = bidx * 64 + lane; const int row = c / NKC1; int col = c % NKC1; if (col > NKC1 - 2) col = NKC1 - 2; goff[i] = (unsigned)(row * KROW + 8 * col) * 2u; }
            else { const int c = (bidx - NBK) * 64 + lane; const int row = c / 9; int col = c % 9; if (col > 7) col = 7; goff[i] = (unsigned)(row * TK + 8 * col) * 2u; }
        }
        asm volatile("s_waitcnt vmcnt(0)" ::: "memory");
#pragma unroll
        for (int ks = 0; ks < NKS; ++ks) asm volatile("" : "+v"(qf[ks]));
        auto issue = [&](int t, int slotoff) {
#pragma unroll
            for (int i = 0; i < NI; ++i) {
                const char* base = bsel[i] < NBK ? (const char*)K + (size_t)t * (64 * KROW * 2) : (const char*)Vt + (size_t)t * 128;
                __builtin_amdgcn_global_load_lds((const unsigned*)(base + goff[i]), (LAS unsigned*)(l3 + slotoff + bsel[i] * 1024), 16, 0, 0);
            }
        };
#pragma unroll
        for (int d = 0; d < 4; ++d)
#pragma unroll
            for (int r = 0; r < 16; ++r) o[d][r] = 0.f;
        float mrun = -1e30f, lrun = 0.f;
        issue(0, 0); issue(1, SLOT_B);
        asm volatile("s_waitcnt vmcnt(%0)" :: "i"(NI) : "memory");
        __builtin_amdgcn_s_barrier(); asm volatile("" ::: "memory");
        int s_cur = 0, s_nn = 2 * SLOT_B;
        for (int t = 0; t < nt; ++t) {
            if (t + 2 < nt) issue(t + 2, s_nn);
            const LAS bf16_t* kt = (const LAS bf16_t*)(l3 + s_cur) + r32 * KS + kcol + 8 * hi; const LAS bf16_t* vt = (const LAS bf16_t*)(l3 + s_cur + KT_B) + r32 * KSTR + 8 * hi;
            f32x16 s0, s1;
#pragma unroll
            for (int r = 0; r < 16; ++r) { s0[r] = 0.f; s1[r] = 0.f; }
            {
                bf16x8 a0 = *(const LAS bf16x8*)(kt), a1 = *(const LAS bf16x8*)(kt + 32 * KS);
                __builtin_amdgcn_sched_group_barrier(0x100, 2, 0);
#pragma unroll
                for (int ks = 0; ks < NKS; ++ks) {
                    bf16x8 b0 = a0, b1 = a1;
                    if (ks + 1 < NKS) { b0 = *(const LAS bf16x8*)(kt + 16 * (ks + 1)); b1 = *(const LAS bf16x8*)(kt + 32 * KS + 16 * (ks + 1)); }
                    s0 = __builtin_amdgcn_mfma_f32_32x32x16_bf16(a0, qf[ks], s0, 0, 0, 0);
                    s1 = __builtin_amdgcn_mfma_f32_32x32x16_bf16(a1, qf[ks], s1, 0, 0, 0);
                    if (ks + 1 < NKS) __builtin_amdgcn_sched_group_barrier(0x100, 2, 0);
                    __builtin_amdgcn_sched_group_barrier(0x008, 2, 0);
                    a0 = b0; a1 = b1;
                }
            }
            bf16x8 vf[4];
#pragma unroll
            for (int d = 0; d < 4; ++d) vf[d] = *(const LAS bf16x8*)(vt + 32 * d * KSTR);
            float mx = fmaxf(s0[0], s1[0]);
#pragma unroll
            for (int r = 1; r < 16; ++r) mx = fmaxf(fmaxf(mx, s0[r]), s1[r]);
            mx = fmaxf(mx, __shfl_xor(mx, 32));
            const float mnew = fmaxf(mrun, mx); const float alpha = __builtin_amdgcn_exp2f(mrun - mnew); mrun = mnew;
            s0 = s0 - mnew; s1 = s1 - mnew;
#pragma unroll
            for (int r = 0; r < 16; ++r) { s0[r] = __builtin_amdgcn_exp2f(s0[r]); s1[r] = __builtin_amdgcn_exp2f(s1[r]); }
            { const f32x16 sm = s0 + s1;
              const float rs = ((sm[0] + sm[1]) + (sm[2] + sm[3])) + ((sm[4] + sm[5]) + (sm[6] + sm[7])) + (((sm[8] + sm[9]) + (sm[10] + sm[11])) + ((sm[12] + sm[13]) + (sm[14] + sm[15])));
              lrun = lrun * alpha + rs; }
            if (__any(alpha != 1.f)) {
#pragma unroll
                for (int d = 0; d < 4; ++d) o[d] = o[d] * alpha;
            }
            bf16x8 pf[4];
            { float p[16];
#pragma unroll
              for (int r = 0; r < 16; ++r) p[r] = s0[r];
              pf[0] = __builtin_bit_cast(bf16x8, pack8(p)); pf[1] = __builtin_bit_cast(bf16x8, pack8(p + 8));
#pragma unroll
              for (int r = 0; r < 16; ++r) p[r] = s1[r];
              pf[2] = __builtin_bit_cast(bf16x8, pack8(p)); pf[3] = __builtin_bit_cast(bf16x8, pack8(p + 8)); }
#pragma unroll
            for (int g = 0; g < 4; ++g) {
                bf16x8 vn[4];
                if (g + 1 < 4) {
#pragma unroll
                    for (int d = 0; d < 4; ++d) vn[d] = *(const LAS bf16x8*)(vt + 32 * d * KSTR + 16 * (g + 1));
                }
#pragma unroll
                for (int d = 0; d < 4; ++d) o[d] = __builtin_amdgcn_mfma_f32_32x32x16_bf16(vf[d], pf[g], o[d], 0, 0, 0);
                if (g + 1 < 4) {
                    __builtin_amdgcn_sched_group_barrier(0x100, 4, 0);
#pragma unroll
                    for (int d = 0; d < 4; ++d) vf[d] = vn[d];
                }
                __builtin_amdgcn_sched_group_barrier(0x008, 4, 0);
            }
            if (t + 2 < nt) asm volatile("s_waitcnt vmcnt(%0)" :: "i"(NI) : "memory");
            else asm volatile("s_waitcnt vmcnt(0)" ::: "memory");
            asm volatile("s_waitcnt lgkmcnt(0)" ::: "memory");
            __builtin_amdgcn_s_barrier(); asm volatile("" ::: "memory");
            s_cur = (s_cur == 2 * SLOT_B) ? 0 : s_cur + SLOT_B; s_nn = (s_nn == 2 * SLOT_B) ? 0 : s_nn + SLOT_B;
        }
        lrun += __shfl_xor(lrun, 32);
        const float rl = 1.f / lrun;
#pragma unroll
        for (int d = 0; d < 4; ++d) o[d] = o[d] * rl;
    }
};

template <int DQK, int KROW>
struct AttnCoreP {
    static constexpr int NKS = DQK / 16, NKC1 = KROW / 8 + 1, KS = NKC1 * 8, KT_B = 64 * NKC1 * 16, VT_B = 128 * 9 * 16, SLOT_B = KT_B + VT_B;
    static constexpr int NBK = KT_B / 1024, NBV = VT_B / 1024, NB = NBK + NBV, NI = (NB + 7) / 8;
    static_assert(KT_B % 1024 == 0 && VT_B % 1024 == 0 && 8 * NI - NB <= 8 && 3 * SLOT_B <= 135168, "attention LDS geometry");
    static __device__ __forceinline__ void run(const Ctx& X, const bf16_t* Qrow, int kcol, const bf16_t* K, const bf16_t* Vt, int nt, f32x16 (&o)[4]) {
        const int lane = X.lane, r32 = lane & 31, hi = lane >> 5, role = X.wave >> 2;
        LAS unsigned char* l3 = (LAS unsigned char*)0 + X.l3off;
        bf16x8 qf[NKS];
#pragma unroll
        for (int ks = 0; ks < NKS; ++ks) qf[ks] = *(const bf16x8*)(Qrow + 16 * ks + 8 * hi);
        unsigned goff[NI]; int bsel[NI];
#pragma unroll
        for (int i = 0; i < NI; ++i) {
            int bidx = X.wave + 8 * i; if (bidx >= NB) bidx -= NB;
            bsel[i] = bidx;
            if (bidx < NBK) { const int c = bidx * 64 + lane; const int row = c / NKC1; int col = c % NKC1; if (col > NKC1 - 2) col = NKC1 - 2; goff[i] = (unsigned)(row * KROW + 8 * col) * 2u; }
            else { const int c = (bidx - NBK) * 64 + lane; const int row = c / 9; int col = c % 9; if (col > 7) col = 7; goff[i] = (unsigned)(row * TK + 8 * col) * 2u; }
        }
        asm volatile("s_waitcnt vmcnt(0)" ::: "memory");
#pragma unroll
        for (int ks = 0; ks < NKS; ++ks) asm volatile("" : "+v"(qf[ks]));
        auto issue = [&](int tk, int ks_off, bool doK, int tv, int vs_off, bool doV) {
#pragma unroll
            for (int i = 0; i < NI; ++i) {
                const bool isK = bsel[i] < NBK;
                if (isK ? doK : doV) {
                    const char* base = isK ? (const char*)K + (size_t)tk * (64 * KROW * 2) : (const char*)Vt + (size_t)tv * 128;
                    __builtin_amdgcn_global_load_lds((const unsigned*)(base + goff[i]), (LAS unsigned*)(l3 + (isK ? ks_off : vs_off) + bsel[i] * 1024), 16, 0, 0);
                }
            }
        };
#pragma unroll
        for (int d = 0; d < 4; ++d)
#pragma unroll
            for (int r = 0; r < 16; ++r) o[d][r] = 0.f;
        float mrun = -1e30f, lrun = 0.f;
        issue(0, 0, true, 0, 0, true); issue(1, SLOT_B, true, 1, SLOT_B, true); issue(2, 2 * SLOT_B, nt > 2, 0, 0, false);
        asm volatile("s_waitcnt vmcnt(0)" ::: "memory");
        __builtin_amdgcn_s_barrier(); asm volatile("" ::: "memory");
        f32x16 sc0, sc1;
        {
            const LAS bf16_t* kt = (const LAS bf16_t*)(l3) + r32 * KS + kcol + 8 * hi;
#pragma unroll
            for (int r = 0; r < 16; ++r) { sc0[r] = 0.f; sc1[r] = 0.f; }
#pragma unroll
            for (int ks = 0; ks < NKS; ++ks) {
                const bf16x8 a0 = *(const LAS bf16x8*)(kt + 16 * ks), a1 = *(const LAS bf16x8*)(kt + 32 * KS + 16 * ks);
                sc0 = __builtin_amdgcn_mfma_f32_32x32x16_bf16(a0, qf[ks], sc0, 0, 0, 0);
                sc1 = __builtin_amdgcn_mfma_f32_32x32x16_bf16(a1, qf[ks], sc1, 0, 0, 0);
            }
        }
        int s0off = 0, s1off = SLOT_B, s2off = 2 * SLOT_B;
        for (int t = 0; t < nt; ++t) {
            issue(t + 3, s0off, t + 3 < nt, t + 2, s2off, t + 2 < nt);
            const bool hasN = t + 1 < nt;
            const LAS bf16_t* kt = (const LAS bf16_t*)(l3 + s1off) + r32 * KS + kcol + 8 * hi;
            const LAS bf16_t* vt = (const LAS bf16_t*)(l3 + s0off + KT_B) + r32 * KSTR + 8 * hi;
            f32x16 sn0, sn1;
            auto qk_next = [&]() {
#pragma unroll
                for (int r = 0; r < 16; ++r) { sn0[r] = 0.f; sn1[r] = 0.f; }
                bf16x8 a0 = *(const LAS bf16x8*)(kt), a1 = *(const LAS bf16x8*)(kt + 32 * KS);
                __builtin_amdgcn_sched_group_barrier(0x100, 2, 0);
#pragma unroll
                for (int ks = 0; ks < NKS; ++ks) {
                    bf16x8 b0 = a0, b1 = a1;
                    if (ks + 1 < NKS) { b0 = *(const LAS bf16x8*)(kt + 16 * (ks + 1)); b1 = *(const LAS bf16x8*)(kt + 32 * KS + 16 * (ks + 1)); }
                    sn0 = __builtin_amdgcn_mfma_f32_32x32x16_bf16(a0, qf[ks], sn0, 0, 0, 0);
                    sn1 = __builtin_amdgcn_mfma_f32_32x32x16_bf16(a1, qf[ks], sn1, 0, 0, 0);
                    if (ks + 1 < NKS) __builtin_amdgcn_sched_group_barrier(0x100, 2, 0);
                    __builtin_amdgcn_sched_group_barrier(0x008, 2, 0);
                    a0 = b0; a1 = b1;
                }
            };
            if (role == 0 && hasN) qk_next();
            float mx = fmaxf(sc0[0], sc1[0]);
#pragma unroll
            for (int r = 1; r < 16; ++r) mx = fmaxf(fmaxf(mx, sc0[r]), sc1[r]);
            mx = fmaxf(mx, __shfl_xor(mx, 32));
            const float mnew = fmaxf(mrun, mx); const float alpha = __builtin_amdgcn_exp2f(mrun - mnew); mrun = mnew;
            sc0 = sc0 - mnew; sc1 = sc1 - mnew;
#pragma unroll
            for (int r = 0; r < 16; ++r) { sc0[r] = __builtin_amdgcn_exp2f(sc0[r]); sc1[r] = __builtin_amdgcn_exp2f(sc1[r]); }
            { const f32x16 sm = sc0 + sc1;
              const float rs = ((sm[0] + sm[1]) + (sm[2] + sm[3])) + ((sm[4] + sm[5]) + (sm[6] + sm[7])) + (((sm[8] + sm[9]) + (sm[10] + sm[11])) + ((sm[12] + sm[13]) + (sm[14] + sm[15])));
              lrun = lrun * alpha + rs; }
            if (__any(alpha != 1.f)) {
#pragma unroll
                for (int d = 0; d < 4; ++d) o[d] = o[d] * alpha;
            }
            bf16x8 pf[4];
            { float p[16];
#pragma unroll
              for (int r = 0; r < 16; ++r) p[r] = sc0[r];
              pf[0] = __builtin_bit_cast(bf16x8, pack8(p)); pf[1] = __builtin_bit_cast(bf16x8, pack8(p + 8));
#pragma unroll
              for (int r = 0; r < 16; ++r) p[r] = sc1[r];
              pf[2] = __builtin_bit_cast(bf16x8, pack8(p)); pf[3] = __builtin_bit_cast(bf16x8, pack8(p + 8)); }
            bf16x8 vf[4];
#pragma unroll
            for (int d = 0; d < 4; ++d) vf[d] = *(const LAS bf16x8*)(vt + 32 * d * KSTR);
#pragma unroll
            for (int g = 0; g < 4; ++g) {
                bf16x8 vn[4];
                if (g + 1 < 4) {
#pragma unroll
                    for (int d = 0; d < 4; ++d) vn[d] = *(const LAS bf16x8*)(vt + 32 * d * KSTR + 16 * (g + 1));
                }
#pragma unroll
                for (int d = 0; d < 4; ++d) o[d] = __builtin_amdgcn_mfma_f32_32x32x16_bf16(vf[d], pf[g], o[d], 0, 0, 0);
                if (g + 1 < 4) {
#pragma unroll
                    for (int d = 0; d < 4; ++d) vf[d] = vn[d];
                }
            }
            if (role != 0 && hasN) qk_next();
            if (t + 3 < nt) asm volatile("s_waitcnt vmcnt(%0)" :: "i"(NI) : "memory");
            else asm volatile("s_waitcnt vmcnt(0)" ::: "memory");
            asm volatile("s_waitcnt lgkmcnt(0)" ::: "memory");
            __builtin_amdgcn_s_barrier(); asm volatile("" ::: "memory");
            sc0 = sn0; sc1 = sn1;
            const int tmp = s0off; s0off = s1off; s1off = s2off; s2off = tmp;
        }
        lrun += __shfl_xor(lrun, 32);
        const float rl = 1.f / lrun;
#pragma unroll
        for (int d = 0; d < 4; ++d) o[d] = o[d] * rl;
    }
};

__device__ __forceinline__ void mla_attn_unit(const Ctx& X0, const PRef& P, int b, int h, int q0, int is_ctx) {
    const Ctx X = fresh(X0);
    unsigned char* ws = P.ws();
    const int lane = X.lane, r32 = lane & 31, hi = lane >> 5;
    const int row = (is_ctx ? M_LAT + b * CTXL : b * SEQ) + q0 + 32 * X.wave + r32;
    const bf16_t* Q = (const bf16_t*)(ws + WS_QM) + ((size_t)h * M_ALL + row) * 192;
    const bf16_t* K = (const bf16_t*)(ws + WS_KM) + (size_t)(b * 8 + h) * TK * 192;
    const bf16_t* Vt = (const bf16_t*)(ws + WS_VTM) + (size_t)(b * 8 + h) * 128 * TK;
    f32x16 o[4];
    AttnCore<192, 192>::run(X, Q, 0, K, Vt, is_ctx ? 4 : NCH, o);
    bf16_t* mix = (bf16_t*)(ws + WS_AB) + (size_t)row * DM + 1024 + h * 128;
#pragma unroll
    for (int d = 0; d < 4; ++d)
#pragma unroll
        for (int q = 0; q < 4; ++q) { u32x2 w; w.x = pk2(o[d][4 * q], o[d][4 * q + 1]); w.y = pk2(o[d][4 * q + 2], o[d][4 * q + 3]); *(u32x2*)(mix + 32 * d + 8 * q + 4 * hi) = w; }
}
__device__ __forceinline__ void da_attn_unit(const Ctx& X0, const PRef& P, int l, int b, int h, int q0, int is_ctx, float lam, float lam_init) {
    const Ctx X = fresh(X0);
    unsigned char* ws = P.ws();
    const int lane = X.lane, r32 = lane & 31, hi = lane >> 5;
    const int comp = X.wave >> 2, qs = X.wave & 3;
    const int row = (is_ctx ? M_LAT + b * CTXL : b * SEQ) + q0 + 32 * qs + r32;
    const bf16_t* Q = (const bf16_t*)(ws + WS_QDA) + ((size_t)h * M_ALL + row) * 128 + comp * 64;
    const bf16_t* K = (const bf16_t*)(ws + WS_KDA) + (size_t)(b * 4 + h) * TK * 128;
    const bf16_t* Vt = (const bf16_t*)(ws + WS_VTDA) + (size_t)(b * 4 + h) * 128 * TK;
    f32x16 o[4];
    AttnCoreP<64, 128>::run(X, Q, comp * 64, K, Vt, is_ctx ? 4 : NCH, o);
    float* xch = (float*)X.lds;
    if (comp == 1) {
#pragma unroll
        for (int d = 0; d < 4; ++d)
#pragma unroll
            for (int r = 0; r < 16; ++r) xch[(qs * 64 + d * 16 + r) * 64 + lane] = o[d][r];
    }
    __syncthreads();
    if (comp == 0) {
        float ss = 0.f;
#pragma unroll
        for (int d = 0; d < 4; ++d)
#pragma unroll
            for (int r = 0; r < 16; ++r) { o[d][r] -= lam * xch[(qs * 64 + d * 16 + r) * 64 + lane]; ss += o[d][r] * o[d][r]; }
        ss += __shfl_xor(ss, 32);
        float li_ = lam_init; asm volatile("" : "+s"(li_));
        const float rstd = rsqrtf(ss * (1.f / 128.f) + EPS) * (1.f - li_);
        const float* og = P.in(I_DAOUTG) + l * 128;
        bf16_t* mix = (bf16_t*)(ws + WS_AB) + (size_t)row * DM + h * 128;
#pragma unroll
        for (int d = 0; d < 4; ++d)
#pragma unroll
            for (int q = 0; q < 4; ++q) { const int dv = 32 * d + 8 * q + 4 * hi; const f32x4 gg = *(const f32x4*)(og + dv);
                u32x2 w; w.x = pk2(o[d][4 * q] * rstd * gg[0], o[d][4 * q + 1] * rstd * gg[1]); w.y = pk2(o[d][4 * q + 2] * rstd * gg[2], o[d][4 * q + 3] * rstd * gg[3]);
                *(u32x2*)(mix + dv) = w; }
    }
    __syncthreads();
}

__device__ __forceinline__ void mixer_phase(const Ctx& X, const PRef& P, int l) {
    const bool need_ctx = l < DEPTH - 1;
    STAMPN(20);
    const int vcu = (X.nwg % 8 == 0) ? (X.wg % 8) * (X.nwg / 8) + X.wg / 8 : X.wg;
    if (EN(13)) for (int u = vcu; u < 512; u += X.nwg) mla_attn_unit(X, P, u >> 7, (u >> 4) & 7, (u & 15) * 256, 0);
    STAMPN(11);
    float lam, lam_init;
    { const float* lp = P.in(I_DALAM) + l * 256;
      float s1 = 0.f, s2 = 0.f;
      for (int i = 0; i < 64; ++i) { s1 += lp[i] * lp[64 + i]; s2 += lp[128 + i] * lp[192 + i]; }
      const float li = 0.8f - 0.6f * expf(-0.3f * (float)l);
      const float la = expf(s1) - expf(s2) + li;
      lam = __builtin_bit_cast(float, __builtin_amdgcn_readfirstlane(__builtin_bit_cast(int, la)));
      lam_init = __builtin_bit_cast(float, __builtin_amdgcn_readfirstlane(__builtin_bit_cast(int, li))); }
    if (EN(14)) for (int v = vcu; v < 512; v += X.nwg) da_attn_unit(X, P, l, v >> 7, (v >> 5) & 3, (v & 31) * 128, 0, lam, lam_init);
    STAMPN(12);
    if (EN(15)) for (int u = X.wg; u < 16 * NCH; u += X.nwg) mlstm_c_unit(X, P, l, u);
    STAMPN(13);
    if (need_ctx) {
        if (EN(13)) for (int v = X.wg; v < 32; v += X.nwg) mla_attn_unit(X, P, v >> 3, v & 7, 0, 1);
        if (EN(14)) for (int v = X.nwg - 1 - X.wg; v < 32; v += X.nwg) da_attn_unit(X, P, l, v >> 3, (v >> 1) & 3, (v & 1) * 128, 1, lam, lam_init);
    }
}

__global__ void __launch_bounds__(512, 2) fwd_megakernel(Params Pk) {
    const PRef P;
    extern __shared__ __attribute__((aligned(16))) unsigned char lds[];
    cg::grid_group grid = cg::this_grid();
    Ctx X; X.lds = lds; X.tid = threadIdx.x; X.lane = X.tid & 63; X.wave = __builtin_amdgcn_readfirstlane(X.tid >> 6);
    X.nwg = gridDim.x; X.wg = blockIdx.x; X.gw = X.wg * 8 + X.wave; X.ngw = X.nwg * 8;
    LAS unsigned char* lds3 = (LAS unsigned char*)lds; X.l3off = (unsigned)(uintptr_t)lds3;
    unsigned char* ws = P.ws();
    if (threadIdx.x < 16) ((LAS unsigned*)(lds3 + 135168 + 64))[threadIdx.x] = 0u;
    __syncthreads();
    (void)xcd_barrier_post((unsigned*)(ws + WS_BAR), (volatile LAS unsigned*)(lds3 + 135168 + 64));
    float* R_lat = P.out(); float* R_ctx = (float*)(ws + WS_RCTX);
    bf16_t* AB = (bf16_t*)(ws + WS_AB);

#ifdef PROBE_CAT
    if (blockIdx.x == 0 && threadIdx.x == 0) { volatile unsigned long long* tp_ = (volatile unsigned long long*)(P.ws() + WS_END); tp_[0] = __builtin_amdgcn_s_memrealtime(); tp_[1] = 0; tp_[2] = 0; }
#endif
    if (EN(0)) mod_gemv(X, P);
    if (EN(1)) convert_weights(X, P, 0);
    grid.sync();
#ifdef PROBE_CAT
    STAMP(0);
#endif
    for (int l = 0; l < DEPTH; ++l) {
        const float* modl = (const float*)(ws + WS_MOD) + (size_t)l * 5 * 6 * DM;
        const float* xin_lat = l == 0 ? P.in(I_X) : R_lat; const float* xin_ctx = l == 0 ? P.in(I_CTX) : R_ctx;
        const int Mfin = l < DEPTH - 1 ? M_ALL : M_LAT;
        if (EN(2)) modulate_phase(X, xin_lat, xin_ctx, P.in(I_N1G) + l * DM, modl, 0 * DM, 1 * DM, AB, M_ALL);
        if (EN(1)) if (l > 0) convert_weights(X, P, l);
        STAMP(1);
        if (EN(3)) { pg8::Gemm g{AB, (const bf16_t*)(ws + WS_WIN), M_ALL, NPROJ, DM}; pg8::StaticOrder S; S.init(M_ALL, NPROJ, X.nwg, X.wg);
          pg8::EpiBf16 E{(bf16_t*)(ws + WS_PROJ), NPROJ, (float*)(ws + WS_GATES), C_GATE / 256};
          pg8::gemm_phase<pg8::EpiBf16>(lds3, g, S, E); }
        STAMP(2);
        if (EN(4)) prep_phase(X, P, l);
        STAMP(3);
        if (EN(5)) { pg8::Gemm g{(const bf16_t*)(ws + WS_CQN), (const bf16_t*)(ws + WS_WUQ), M_ALL, 1536, 512}; pg8::StaticOrder S; S.init(M_ALL, 1536, X.nwg, X.wg);
          pg8::EpiBf16 E{(bf16_t*)(ws + WS_QUP), 1536, nullptr, 0};
          pg8::gemm_phase<pg8::EpiBf16>(lds3, g, S, E); }
        if (EN(5)) { pg8::Gemm g{(const bf16_t*)(ws + WS_CKVN), (const bf16_t*)(ws + WS_WUKV), M_ALL, 2048, 256}; pg8::StaticOrder S; S.init(M_ALL, 2048, X.nwg, X.wg);
          pg8::EpiBf16 E{(bf16_t*)(ws + WS_KVUP), 2048, nullptr, 0};
          pg8::gemm_phase<pg8::EpiBf16>(lds3, g, S, E); }
        __syncthreads();
        if (EN(6)) mlstm_a_phase(X, P, l);
        STAMP(4);
        if (EN(7)) mla_prep_phase(X, P, l);
        if (EN(8)) mlstm_scan_phase(X, P);
        STAMP(5);
        if (EN(9)) mixer_phase(X, P, l);
        STAMP(6);
        if (EN(10)) { pg8::Gemm g{AB, (const bf16_t*)(ws + WS_WOUT), Mfin, DM, DM}; pg8::StaticOrder S; S.init(Mfin, DM, X.nwg, X.wg);
          pg8::EpiRes E{xin_lat, xin_ctx, R_lat, R_ctx, modl + 2 * DM};
          pg8::gemm_phase<pg8::EpiRes>(lds3, g, S, E); }
        STAMP(7);
        if (EN(2)) modulate_phase(X, R_lat, R_ctx, P.in(I_N2G) + l * DM, modl, 3 * DM, 4 * DM, AB, Mfin);
        STAMP(1);
        if (EN(11)) { pg8::Gemm g{AB, (const bf16_t*)(ws + WS_WGU), Mfin, 2 * FF, DM}; pg8::StaticOrder S; S.init(Mfin, 2 * FF, X.nwg, X.wg);
          pg8::EpiSwiGLU E{(bf16_t*)(ws + WS_HID), FF};
          pg8::gemm_phase<pg8::EpiSwiGLU>(lds3, g, S, E); }
        STAMP(9);
        if (EN(12)) { pg8::Gemm g{(const bf16_t*)(ws + WS_HID), (const bf16_t*)(ws + WS_WDN), Mfin, DM, FF}; pg8::StaticOrder S; S.init(Mfin, DM, X.nwg, X.wg);
          pg8::EpiRes E{R_lat, R_ctx, R_lat, R_ctx, modl + 5 * DM};
          pg8::gemm_phase<pg8::EpiRes>(lds3, g, S, E); }
#ifdef PROBE_CAT
        STAMP(10);
#else
        if (l + 1 < DEPTH) xcd_barrier(P.ws());
#endif
    }
#ifdef PROBE_CAT
    if (blockIdx.x == 0 && threadIdx.x == 0) P.out()[0] += (float)(((volatile unsigned long long*)(P.ws() + WS_END))[1]) * (0.01f / PROBE_SCALE);
#endif
}

extern "C" void kernel_launch(void* const* d_in, const int* in_sizes, int n_in, void* d_out, int out_size, void* d_ws, size_t ws_size, hipStream_t stream) {
    static int grid = 0;
    if (grid == 0) {
        if (n_in != 24 || ws_size < WS_END) { fprintf(stderr, "kernel_launch: unexpected inputs (n_in %d, ws %zu)\n", n_in, ws_size); grid = -1; return; }
        int dev = 0, cus = 0, per_cu = 0;
        (void)hipGetDevice(&dev); (void)hipDeviceGetAttribute(&cus, hipDeviceAttributeMultiprocessorCount, dev);
        if (hipFuncSetAttribute((const void*)fwd_megakernel, hipFuncAttributeMaxDynamicSharedMemorySize, LDS_BYTES) != hipSuccess) { fprintf(stderr, "kernel_launch: hipFuncSetAttribute failed\n"); grid = -1; return; }
        (void)hipOccupancyMaxActiveBlocksPerMultiprocessor(&per_cu, (const void*)fwd_megakernel, 512, LDS_BYTES);
        (void)hipGetLastError();
        if (per_cu < 1) { fprintf(stderr, "kernel_launch: occupancy query says %d\n", per_cu); per_cu = 1; }
        grid = cus;
    }
    if (grid < 0) return;
    if (hipMemsetAsync((char*)d_ws + WS_BAR, 0, XCD_BAR_WORDS * 4, stream) != hipSuccess) { fprintf(stderr, "kernel_launch: memset failed\n"); return; }
    Params p{};
    for (int i = 0; i < 24; ++i) p.in[i] = (const float*)d_in[i];
    p.out = (float*)d_out; p.ws = (unsigned char*)d_ws;
    void* args[] = {&p};
    hipError_t e = hipLaunchCooperativeKernel((const void*)fwd_megakernel, dim3(grid), dim3(512), args, LDS_BYTES, stream);
    if (e != hipSuccess) fprintf(stderr, "cooperative launch failed: %s (grid %d)\n", hipGetErrorString(e), grid);
}
```

```cpp
#include <hip/hip_runtime.h>
#include <hip/hip_cooperative_groups.h>
#include <cstdio>
#include <cstdint>
namespace cg = cooperative_groups;

#define LAS __attribute__((address_space(3)))
typedef unsigned short bf16_t;
typedef short bf16x8 __attribute__((ext_vector_type(8)));
typedef float f32x4 __attribute__((ext_vector_type(4)));
typedef float f32x16 __attribute__((ext_vector_type(16)));
typedef unsigned u32x4 __attribute__((ext_vector_type(4)));
typedef unsigned u32x2 __attribute__((ext_vector_type(2)));

constexpr int DM = 2048, BATCH = 4, SEQ = 4096, CTXL = 256, DEPTH = 2;
constexpr int M_LAT = BATCH * SEQ, M_CTX = BATCH * CTXL, M_ALL = M_LAT + M_CTX;
constexpr int TK = CTXL + SEQ;
constexpr int NCH = TK / 64;
constexpr int IN_W = 4432, NPROJ = 4608, FF = 5632;
constexpr int C_DAQ = 0, C_DAK = 512, C_DAV = 1024, C_MLQ = 1536, C_MLK = 2048, C_MLV = 2560, C_MLO = 3072, C_GATE = 3584, C_CQ = 3600, C_CKV = 4112, C_KPE = 4368;
constexpr float EPS = 1e-6f;
constexpr float LOG2E = 1.4426950408889634f;
constexpr float RESC_THR = 8.0f;

constexpr size_t MiB = 1u << 20;
constexpr size_t WS_WIN = 0, WS_WOUT = 18 * MiB, WS_WGU = 26 * MiB, WS_WDN = 70 * MiB, WS_WUQ = 92 * MiB, WS_WUKV = 94 * MiB, WS_MOD = 95 * MiB, WS_RCTX = 96 * MiB;
constexpr size_t WS_AB = 104 * MiB;
constexpr size_t WS_PROJ = 172 * MiB;
constexpr size_t WS_QUP = 172 * MiB, WS_KVUP = 223 * MiB, WS_HID = 172 * MiB;
constexpr size_t WS_GATES = 325 * MiB, WS_CQN = 327 * MiB, WS_CKVN = 344 * MiB, WS_KPE = 353 * MiB, WS_OCOPY = 356 * MiB;
constexpr size_t WS_QDA = 373 * MiB, WS_KDA = 390 * MiB, WS_VTDA = 407 * MiB, WS_QML = 424 * MiB, WS_KML = 441 * MiB, WS_KTML = 458 * MiB, WS_VTML = 475 * MiB;
constexpr size_t WS_QM = 492 * MiB, WS_KM = 543 * MiB, WS_VTM = 594 * MiB, WS_CSNAP = 628 * MiB, WS_NSNAP = 696 * MiB, WS_NU = 698 * MiB, WS_CSTAT = 700 * MiB, WS_BAR = 701 * MiB, WS_END = 702 * MiB;
static_assert((size_t)NPROJ * DM * 2 <= 18 * MiB && (size_t)2 * FF * DM * 2 <= 44 * MiB && (size_t)M_ALL * NPROJ * 2 <= 153 * MiB, "ws map");
static_assert(WS_HID + (size_t)M_ALL * FF * 2 <= WS_QDA, "hid overlay");
static_assert(WS_END <= 768 * MiB, "ws fits the guaranteed minimum");

constexpr int LDS_BYTES = 140 * 1024;
#ifndef PH_EN
#define PH_EN 0xFFFF
#endif
#define EN(k) ((PH_EN >> (k)) & 1)
#ifdef PROBE_CAT
#define STAMP(cat) do { xcd_barrier(P.ws()); if (blockIdx.x == 0 && threadIdx.x == 0) { volatile unsigned long long* tp_ = (volatile unsigned long long*)(P.ws() + WS_END); const unsigned long long t1_ = __builtin_amdgcn_s_memrealtime(); if ((1 << (cat)) & PROBE_CAT) tp_[1] += t1_ - tp_[0]; if ((1 << (cat)) & PROBE_CAT2) tp_[2] += t1_ - tp_[0]; tp_[0] = t1_; } } while (0)
#define STAMPN(cat) do { __syncthreads(); if (blockIdx.x == 0 && threadIdx.x == 0) { volatile unsigned long long* tp_ = (volatile unsigned long long*)(P.ws() + WS_END); const unsigned long long t1_ = __builtin_amdgcn_s_memrealtime(); if ((1 << (cat)) & PROBE_CAT) tp_[1] += t1_ - tp_[0]; tp_[0] = t1_; } } while (0)
#else
#define STAMPN(cat) do {} while (0)
#define STAMP(cat) xcd_barrier(P.ws())
#endif

__device__ __forceinline__ unsigned f2bf(float f) { unsigned u = __builtin_bit_cast(unsigned, f); return (u + 0x7fffu + ((u >> 16) & 1u)) >> 16; }
typedef float f32x2_t __attribute__((ext_vector_type(2))); typedef __bf16 bf16x2_t __attribute__((ext_vector_type(2)));
__device__ __forceinline__ unsigned pk2(float lo, float hi) { f32x2_t v = {lo, hi}; bf16x2_t b = __builtin_convertvector(v, bf16x2_t); return __builtin_bit_cast(unsigned, b); }
__device__ __forceinline__ float bflo(unsigned w) { return __builtin_bit_cast(float, w << 16); }
__device__ __forceinline__ float bfhi(unsigned w) { return __builtin_bit_cast(float, w & 0xffff0000u); }
__device__ __forceinline__ float bf1(bf16_t h) { return __builtin_bit_cast(float, (unsigned)h << 16); }
__device__ __forceinline__ void unpack8(const u32x4 w, float* v) { v[0] = bflo(w.x); v[1] = bfhi(w.x); v[2] = bflo(w.y); v[3] = bfhi(w.y); v[4] = bflo(w.z); v[5] = bfhi(w.z); v[6] = bflo(w.w); v[7] = bfhi(w.w); }
__device__ __forceinline__ u32x4 pack8(const float* v) { u32x4 w; w.x = pk2(v[0], v[1]); w.y = pk2(v[2], v[3]); w.z = pk2(v[4], v[5]); w.w = pk2(v[6], v[7]); return w; }
__device__ __forceinline__ float wave_sum(float v) {
#pragma unroll
    for (int o = 1; o < 64; o <<= 1) v += __shfl_xor(v, o);
    return v;
}
__device__ __forceinline__ float wave_max(float v) {
#pragma unroll
    for (int o = 1; o < 64; o <<= 1) v = fmaxf(v, __shfl_xor(v, o));
    return v;
}
__device__ __forceinline__ float siluf(float x) { return x / (1.f + __expf(-x)); }
__device__ __forceinline__ float sigmf(float x) { return 1.f / (1.f + __expf(-x)); }
__device__ __forceinline__ int crow(int r, int hi) { return (r & 3) + 8 * (r >> 2) + 4 * hi; }
__device__ __forceinline__ int perm_off(int p) { const int h = p >> 3, j = p & 7; return 8 * (j >> 2) + 4 * h + (j & 3); }
__device__ __forceinline__ int mod_batch(int row) { return row < M_LAT ? (row >> 12) : 4; }

namespace pg8 {
constexpr int BM = 256, BK = 64, HALF = 128, HTB = HALF * BK * 2, STAGE_BYTES = 8 * HTB, NXCD = 8, WGM = 8;
__host__ __device__ __forceinline__ int lds_byte(int r, int c) { const int st = (r >> 4) * 2 + (c >> 5), rr = r & 15, cc = c & 31, ob = rr * 64 + cc * 2; return st * 1024 + (ob ^ (((ob >> 9) & 1) << 5)); }
__host__ __device__ __forceinline__ void stage_rc(int b, int& R, int& C) { const int st = b / 1024, sb = b % 1024, swz = sb ^ (((sb >> 9) & 1) << 5); R = (st >> 1) * 16 + swz / 64; C = (st & 1) * 32 + (swz % 64) / 2; }
__host__ __device__ __forceinline__ int perm32(int rho) { const int n = rho >> 4, i = rho & 15; return 8 * (i >> 2) + 4 * n + (i & 3); }

struct Unit { int pm, pn; };
struct Gemm { const bf16_t* A; const bf16_t* Bt; int M, N, K; };

struct StaticOrder {
    int nM, nN, nwg, G, c;
    __device__ void init(int M, int N, int G_, int c_) { nM = M / BM; nN = N / BM; nwg = nM * nN; G = G_; c = c_; }
    __device__ bool next(int i, Unit& u) const {
        const long L = (long)i * G + c; if (L >= nwg) return false;
        int wgid = (int)L; { const int q = nwg / NXCD, r = nwg % NXCD, xcd = wgid % NXCD, off = wgid / NXCD; wgid = (xcd < r ? xcd * (q + 1) : r * (q + 1) + (xcd - r) * q) + off; }
        const int nig = WGM * nN, gid = wgid / nig, fm = gid * WGM, gsz = (nM - fm) < WGM ? (nM - fm) : WGM;
        u.pm = fm + ((wgid % nig) % gsz); u.pn = (wgid % nig) / gsz; return true;
    }
};

struct EpiBf16 {
    static constexpr bool PERM = true;
    bf16_t* O; int ldc; float* gates; int gate_pn;
    __device__ __forceinline__ void operator()(const f32x4 (&acc)[2][2][4][2], const Unit& u, int wr, int wc, int fr, int fq) const {
        const int row0 = u.pm * BM + wr * 64 + fr; const int col0 = u.pn * BM + wc * 32 + 8 * fq;
        const bool g = gates != nullptr && u.pn == gate_pn && wc == 0 && fq < 2;
#pragma unroll
        for (int ai = 0; ai < 2; ++ai)
#pragma unroll
            for (int m = 0; m < 4; ++m) { const int row = row0 + ai * HALF + m * 16; bf16_t* rowp = O + (size_t)row * ldc + col0;
#pragma unroll
                for (int bj = 0; bj < 2; ++bj) { const f32x4 v0 = acc[ai][bj][m][0], v1 = acc[ai][bj][m][1];
                    u32x4 w; w.x = pk2(v0[0], v0[1]); w.y = pk2(v0[2], v0[3]); w.z = pk2(v1[0], v1[1]); w.w = pk2(v1[2], v1[3]);
                    *(u32x4*)(rowp + bj * HALF) = w;
                    if (bj == 0 && g) { *(f32x4*)(gates + (size_t)row * 16 + 8 * fq) = v0; *(f32x4*)(gates + (size_t)row * 16 + 8 * fq + 4) = v1; } } }
    }
};
struct EpiSwiGLU {
    static constexpr bool PERM = true;
    bf16_t* O; int ldc;
    __device__ __forceinline__ void operator()(const f32x4 (&acc)[2][2][4][2], const Unit& u, int wr, int wc, int fr, int fq) const {
        const int row0 = u.pm * BM + wr * 64 + fr; const int col0 = u.pn * HALF + wc * 32 + 8 * fq;
#pragma unroll
        for (int ai = 0; ai < 2; ++ai)
#pragma unroll
            for (int m = 0; m < 4; ++m) { const int row = row0 + ai * HALF + m * 16;
                float o[8];
#pragma unroll
                for (int n = 0; n < 2; ++n)
#pragma unroll
                    for (int i = 0; i < 4; ++i) { const float gt = acc[ai][0][m][n][i], up = acc[ai][1][m][n][i]; o[4 * n + i] = siluf(gt) * up; }
                *(u32x4*)(O + (size_t)row * ldc + col0) = pack8(o); }
    }
};
struct EpiRes {
    static constexpr bool PERM = false;
    const float* res_lat; const float* res_ctx; float* out_lat; float* out_ctx; const float* gate;
    __device__ __forceinline__ void operator()(const f32x4 (&acc)[2][2][4][2], const Unit& u, int wr, int wc, int fr, int fq) const {
        const int row0 = u.pm * BM + wr * 64 + fr; const int col0 = u.pn * BM + wc * 32 + 4 * fq;
#pragma unroll
        for (int ai = 0; ai < 2; ++ai)
#pragma unroll
            for (int m = 0; m < 4; ++m) { const int row = row0 + ai * HALF + m * 16;
                const float* rp = row < M_LAT ? res_lat + (size_t)row * DM : res_ctx + (size_t)(row - M_LAT) * DM;
                float* op = row < M_LAT ? out_lat + (size_t)row * DM : out_ctx + (size_t)(row - M_LAT) * DM;
                const float* gp = gate + (size_t)mod_batch(row) * 6 * DM;
#pragma unroll
                for (int bj = 0; bj < 2; ++bj)
#pragma unroll
                    for (int n = 0; n < 2; ++n) { const int c = col0 + bj * HALF + n * 16;
                        const f32x4 r = *(const f32x4*)(rp + c), g = *(const f32x4*)(gp + c);
                        *(f32x4*)(op + c) = r + g * acc[ai][bj][m][n]; } }
    }
};

template <class Epi, bool ALIGN_EPI = true>
__device__ __forceinline__ void gemm_phase(LAS unsigned char* lds, const Gemm g, const StaticOrder& S, const Epi& E) {
    int tid = threadIdx.x; asm volatile("" : "+v"(tid)); const int wid = __builtin_amdgcn_readfirstlane(tid >> 6), lane = tid & 63, wr = wid >> 2, wc = wid & 3, fr = lane & 15, fq = lane >> 4;
    int K = g.K; asm volatile("" : "+s"(K)); const int nt = K / BK;
    unsigned voffA[2], voffB[2];
#pragma unroll
    for (int i = 0; i < 2; ++i) { int R, C; stage_rc(tid * 16 + i * 8192, R, C); const int Rb = Epi::PERM ? ((R & ~31) + perm32(R & 31)) : R;
        voffA[i] = (unsigned)(R * K + C) * 2u; voffB[i] = (unsigned)(Rb * K + C) * 2u; }
    const size_t kstep = (size_t)(BK * 2);
    const size_t hstep = (size_t)HALF * K * 2;
    const size_t tstep = 2 * hstep;
    const unsigned ldsw = (unsigned)wid * 1024u;
    const int aoff = lds_byte(wr * 64 + fr, fq * 8), boff = lds_byte(wc * 32 + fr, fq * 8);
#define PG8_SA(b, h) (((b) * 2 + (h)) * HTB)
#define PG8_SB(b, h) ((4 + (b) * 2 + (h)) * HTB)
#define PG8_STAGE(bufoff, gbase, voff) do { _Pragma("unroll") for (int _i = 0; _i < 2; ++_i) \
        __builtin_amdgcn_global_load_lds((const unsigned*)((const char*)(gbase) + (voff)[_i]), (LAS unsigned*)(lds + (bufoff) + ldsw + _i * 8192), 16, 0, 0); } while (0)
#define PG8_LDA(dst, b, h) do { _Pragma("unroll") for (int m = 0; m < 4; ++m) _Pragma("unroll") for (int k = 0; k < 2; ++k) dst[m][k] = *(const LAS bf16x8*)(lds + PG8_SA(b, h) + aoff + m * 2048 + k * 1024); } while (0)
#define PG8_LDB(dst, b, h) do { _Pragma("unroll") for (int n = 0; n < 2; ++n) _Pragma("unroll") for (int k = 0; k < 2; ++k) dst[n][k] = *(const LAS bf16x8*)(lds + PG8_SB(b, h) + boff + n * 2048 + k * 1024); } while (0)
#define PG8_MMA(ai, bj, At, Bt) do { __builtin_amdgcn_s_setprio(1); _Pragma("unroll") for (int m = 0; m < 4; ++m) _Pragma("unroll") for (int n = 0; n < 2; ++n) _Pragma("unroll") for (int k = 0; k < 2; ++k) \
        acc[ai][bj][m][n] = __builtin_amdgcn_mfma_f32_16x16x32_bf16(Bt[n][k], At[m][k], acc[ai][bj][m][n], 0, 0, 0); __builtin_amdgcn_s_setprio(0); } while (0)
#define PG8_WAIT_V(n) asm volatile("s_waitcnt vmcnt(" #n ")" ::: "memory")
#define PG8_WAIT_L(n) asm volatile("s_waitcnt lgkmcnt(" #n ")" ::: "memory")
#define PG8_BAR __builtin_amdgcn_s_barrier()
#define PG8_SCHED __builtin_amdgcn_sched_barrier(0)
    Unit cur, nxt; int ui = 0;
    if (!S.next(0, cur)) return;
    f32x4 acc[2][2][4][2];
#pragma unroll
    for (int a = 0; a < 2; ++a)
#pragma unroll
        for (int b = 0; b < 2; ++b)
#pragma unroll
            for (int m = 0; m < 4; ++m)
#pragma unroll
                for (int n = 0; n < 2; ++n) acc[a][b][m][n] = (f32x4){0.f, 0.f, 0.f, 0.f};
    bf16x8 At[4][2], B0[2][2], B1[2][2];
    const char* cA = (const char*)g.A + (size_t)cur.pm * tstep; const char* cB = (const char*)g.Bt + (size_t)cur.pn * tstep;
    PG8_STAGE(PG8_SB(0, 0), cB, voffB); PG8_STAGE(PG8_SB(0, 1), cB + hstep, voffB); PG8_STAGE(PG8_SA(0, 0), cA, voffA); PG8_STAGE(PG8_SA(0, 1), cA + hstep, voffA);
    if (wr == 1) PG8_BAR;
    PG8_WAIT_V(2); PG8_BAR;
    PG8_STAGE(PG8_SB(1, 0), cB + kstep, voffB); PG8_STAGE(PG8_SA(1, 0), cA + kstep, voffA); PG8_STAGE(PG8_SB(1, 1), cB + hstep + kstep, voffB);
    PG8_WAIT_V(6); PG8_BAR;
    for (;;) {
        const bool has_next = S.next(ui + 1, nxt);
        const char* nA = has_next ? (const char*)g.A + (size_t)nxt.pm * tstep : cA; const char* nB = has_next ? (const char*)g.Bt + (size_t)nxt.pn * tstep : cB;
        for (int t = 0; t < nt; t += 2) {
            const bool last = (t == nt - 2);
            const char* a1 = cA + (size_t)(t + 1) * kstep;
            const char* a2 = last ? nA : cA + (size_t)(t + 2) * kstep; const char* b2 = last ? nB : cB + (size_t)(t + 2) * kstep;
            const char* a3 = a2 + kstep; const char* b3 = b2 + kstep;
            PG8_LDB(B0, 0, 0); PG8_LDB(B1, 0, 1); PG8_SCHED; PG8_LDA(At, 0, 0); PG8_STAGE(PG8_SA(1, 1), a1 + hstep, voffA);
            PG8_WAIT_V(8); PG8_WAIT_L(0); PG8_BAR; PG8_MMA(0, 0, At, B0); PG8_MMA(0, 1, At, B1); PG8_BAR; PG8_SCHED;
            PG8_LDA(At, 0, 1); PG8_STAGE(PG8_SB(0, 0), b2, voffB); PG8_STAGE(PG8_SB(0, 1), b2 + hstep, voffB); PG8_STAGE(PG8_SA(0, 0), a2, voffA);
            PG8_WAIT_V(8); PG8_WAIT_L(0); PG8_BAR; PG8_MMA(1, 0, At, B0); PG8_MMA(1, 1, At, B1); PG8_BAR; PG8_SCHED;
            PG8_LDB(B0, 1, 0); PG8_LDB(B1, 1, 1); PG8_SCHED; PG8_LDA(At, 1, 0); PG8_STAGE(PG8_SA(0, 1), a2 + hstep, voffA);
            PG8_WAIT_V(8); PG8_WAIT_L(0); PG8_BAR; PG8_MMA(0, 0, At, B0); PG8_MMA(0, 1, At, B1); PG8_BAR; PG8_SCHED;
            PG8_LDA(At, 1, 1); PG8_STAGE(PG8_SB(1, 0), b3, voffB); PG8_STAGE(PG8_SB(1, 1), b3 + hstep, voffB); PG8_STAGE(PG8_SA(1, 0), a3, voffA);
            PG8_WAIT_V(8); PG8_WAIT_L(0); PG8_BAR; PG8_MMA(1, 0, At, B0); PG8_MMA(1, 1, At, B1); PG8_BAR; PG8_SCHED;
        }
        if constexpr (ALIGN_EPI) { if (wr == 0) PG8_BAR; }
        E(acc, cur, wr, wc, fr, fq);
        if (!has_next) break;
#pragma unroll
        for (int a = 0; a < 2; ++a)
#pragma unroll
            for (int b = 0; b < 2; ++b)
#pragma unroll
                for (int m = 0; m < 4; ++m)
#pragma unroll
                    for (int n = 0; n < 2; ++n) acc[a][b][m][n] = (f32x4){0.f, 0.f, 0.f, 0.f};
        cur = nxt; cA = nA; cB = nB; ++ui;
        if constexpr (ALIGN_EPI) { if (wr == 1) PG8_BAR; }
    }
    PG8_WAIT_V(0);
    if constexpr (!ALIGN_EPI) { if (wr == 0) PG8_BAR; }
    PG8_BAR;
#undef PG8_SA
#undef PG8_SB
#undef PG8_STAGE
#undef PG8_LDA
#undef PG8_LDB
#undef PG8_MMA
#undef PG8_WAIT_V
#undef PG8_WAIT_L
#undef PG8_BAR
#undef PG8_SCHED
}
}


#define XB_TMO      128
#define XB_XCNT(j)  (256  + 64 * (j))
#define XB_XSUB(j)  (1280 + 64 * (j))
#define XB_XGEN(j)  (2304 + 64 * (j))
#define XB_TOP      3328
#define XB_TOPGEN   3392
#define XCD_BAR_WORDS 3456
#define XB_SPIN_CAP (1u << 22)
__device__ __forceinline__ unsigned xb_ld(unsigned* p)              { return __hip_atomic_load(p, __ATOMIC_RELAXED, __HIP_MEMORY_SCOPE_AGENT); }
__device__ __forceinline__ unsigned xb_add(unsigned* p, unsigned v) { return __hip_atomic_fetch_add(p, v, __ATOMIC_RELAXED, __HIP_MEMORY_SCOPE_AGENT); }
__device__ __forceinline__ unsigned xb_xcc_id() { return (unsigned)__builtin_amdgcn_s_getreg((3 << 11) | 20) & 0xFu; }
#define XB_SPIN(cond, bar) do { unsigned _sp = 0; while (cond) { __builtin_amdgcn_s_sleep(1); \
    if ((++_sp & 255u) == 0u) { if (xb_ld(&(bar)[XB_TMO])) break; if (_sp > XB_SPIN_CAP) { atomicAdd(&(bar)[XB_TMO], 1u); break; } } } } while (0)
struct XcdBarrier { unsigned* bar; unsigned x; volatile LAS unsigned* st; };
__device__ __forceinline__ XcdBarrier xcd_barrier_post(unsigned* bar, volatile LAS unsigned* st) {
    XcdBarrier b; b.bar = bar; b.x = xb_xcc_id(); b.st = st;
    if (threadIdx.x == 0) (void)xb_add(&bar[XB_XCNT(b.x)], 1u);
    return b;
}
__device__ __forceinline__ void xcd_barrier_complete(unsigned* bar, unsigned x, unsigned& nloc, unsigned& nx) {
    const unsigned G = gridDim.x * gridDim.y * gridDim.z;
    unsigned sum, cnt, mine, sp = 0u;
    for (;;) {
        sum = 0u; cnt = 0u; mine = 0u;
#pragma unroll
        for (unsigned j = 0; j < 16; ++j) { const unsigned c = xb_ld(&bar[XB_XCNT(j)]); sum += c; cnt += (c > 0u) ? 1u : 0u; mine = (j == x) ? c : mine; }
        if (sum == G) break;
        __builtin_amdgcn_s_sleep(1);
        if ((++sp & 255u) == 0u) { if (xb_ld(&bar[XB_TMO])) break; if (sp > XB_SPIN_CAP) { atomicAdd(&bar[XB_TMO], 1u); break; } }
    }
    nloc = mine > 0u ? mine : 1u; nx = cnt > 0u ? cnt : 1u;
}
__device__ __forceinline__ void xcd_barrier(unsigned char* wsb) {
    XcdBarrier b; b.bar = (unsigned*)(wsb + WS_BAR); b.x = 0; b.st = (volatile LAS unsigned*)(135168 + 64);
    asm volatile("s_waitcnt vmcnt(0)" ::: "memory");
    __syncthreads();
    if (threadIdx.x == 0) {
        unsigned* bar = b.bar; b.x = xb_xcc_id();
        __builtin_amdgcn_s_waitcnt(0);
        unsigned nloc = b.st[0], nx = b.st[1];
        if (nloc == 0u) { xcd_barrier_complete(bar, b.x, nloc, nx); b.st[0] = nloc; b.st[1] = nx; }
        const unsigned old = xb_add(&bar[XB_XSUB(b.x)], 1u);
        const unsigned gen = old / nloc;
        if (old + 1u == (gen + 1u) * nloc) {
            __builtin_amdgcn_fence(__ATOMIC_RELEASE, "agent");
            asm volatile("s_waitcnt vmcnt(0)" ::: "memory");
            const unsigned og = xb_add(&bar[XB_TOP], 1u);
            const unsigned tg = og / nx;
            if (og + 1u == (tg + 1u) * nx) xb_add(&bar[XB_TOPGEN], 1u);
            else XB_SPIN(xb_ld(&bar[XB_TOPGEN]) == tg, bar);
            __builtin_amdgcn_fence(__ATOMIC_ACQUIRE, "agent");
            xb_add(&bar[XB_XGEN(b.x)], 1u);
            asm volatile("s_waitcnt vmcnt(0)" ::: "memory");
        } else {
            XB_SPIN(xb_ld(&bar[XB_XGEN(b.x)]) == gen, bar);
            __builtin_amdgcn_fence(__ATOMIC_ACQUIRE, "agent");
            asm volatile("s_waitcnt vmcnt(0)" ::: "memory");
        }
    }
    __syncthreads();
}

struct Params { const float* in[24]; float* out; unsigned char* ws; };
struct PRef {
    typedef const __attribute__((address_space(4))) char* kptr_t;
    __device__ __forceinline__ kptr_t base() const { kptr_t ka = (kptr_t)__builtin_amdgcn_kernarg_segment_ptr(); asm volatile("" : "+s"(ka)); return ka; }
    __device__ __forceinline__ const float* in(int i) const { return *(const float* const __attribute__((address_space(4)))*)(base() + 8 * i); }
    __device__ __forceinline__ float* out() const { return *(float* const __attribute__((address_space(4)))*)(base() + 8 * 24); }
    __device__ __forceinline__ unsigned char* ws() const { return *(unsigned char* const __attribute__((address_space(4)))*)(base() + 8 * 25); }
};
enum { I_X = 0, I_C, I_CTX, I_CCTX, I_MODW, I_MODB, I_N1G, I_N2G, I_WIN, I_DAQKG, I_DALAM, I_DAOUTG, I_CONVW, I_CONVB, I_GATEB, I_MLOUTG, I_QNG, I_KVNG, I_WUQ, I_WUKV, I_MLAQKG, I_WOUT, I_WGU, I_WDN };

struct Ctx {
    unsigned char* lds;
    int tid, lane, wave, gw, ngw, nwg, wg; unsigned l3off;
};

__device__ __forceinline__ Ctx fresh(const Ctx& X) {
    Ctx Y = X; int t = X.tid; asm volatile("" : "+v"(t)); Y.tid = t; Y.lane = t & 63; Y.wave = __builtin_amdgcn_readfirstlane(t >> 6); return Y;
}
template <int MODE>
__device__ __forceinline__ void transpose_item(const float* W, int K, int N, bf16_t* WT, float* scr, int item, int nblk, int lane) {
    const int kb = item / nblk, nb = item % nblk, k0 = 64 * kb, n0 = 32 * nb;
    const int ncol = n0 + (lane & 31); const bool ok = ncol < N;
#pragma unroll 8
    for (int i = 0; i < 32; ++i) { const int kk = 2 * i + (lane >> 5); scr[kk * 33 + (lane & 31)] = ok ? W[(size_t)(k0 + kk) * N + ncol] : 0.f; }
    asm volatile("s_waitcnt lgkmcnt(0)" ::: "memory");
    const int c = lane & 7;
#pragma unroll
    for (int j = 0; j < 4; ++j) { const int n = (lane >> 3) + 8 * j; const float* s = scr + (8 * c) * 33 + n;
        u32x4 o; o.x = pk2(s[0 * 33], s[1 * 33]); o.y = pk2(s[2 * 33], s[3 * 33]); o.z = pk2(s[4 * 33], s[5 * 33]); o.w = pk2(s[6 * 33], s[7 * 33]);
        int nn = n0 + n;
        if (MODE == 1) { const int up = nn >= FF ? 1 : 0; const int hcol = nn - up * FF; nn = (hcol >> 7) * 256 + up * 128 + (hcol & 127); }
        *(u32x4*)(WT + (size_t)nn * K + k0 + 8 * c) = o; }
    asm volatile("s_waitcnt lgkmcnt(0)" ::: "memory");
}
__device__ __forceinline__ void convert_weights(const Ctx& X0, const PRef& P, int l) {
    const Ctx X = fresh(X0);
    float* scr = (float*)(X.lds + X.wave * 16384);
    unsigned char* ws = P.ws();
    constexpr int I_IN = (DM / 64) * (NPROJ / 32), I_OUT = (DM / 64) * (DM / 32), I_GU = (DM / 64) * (2 * FF / 32), I_DN = (FF / 64) * (DM / 32), I_UQ = (512 / 64) * (1536 / 32), I_UKV = (256 / 64) * (2048 / 32);
    constexpr int NITEMS = I_IN + I_OUT + I_GU + I_DN + I_UQ + I_UKV;
    for (int it = X.gw; it < NITEMS; it += X.ngw) {
        int r = it;
        if (r < I_IN) { transpose_item<0>(P.in(I_WIN) + (size_t)l * DM * IN_W, DM, IN_W, (bf16_t*)(ws + WS_WIN), scr, r, NPROJ / 32, X.lane); continue; } r -= I_IN;
        if (r < I_OUT) { transpose_item<0>(P.in(I_WOUT) + (size_t)l * DM * DM, DM, DM, (bf16_t*)(ws + WS_WOUT), scr, r, DM / 32, X.lane); continue; } r -= I_OUT;
        if (r < I_GU) { transpose_item<1>(P.in(I_WGU) + (size_t)l * DM * 2 * FF, DM, 2 * FF, (bf16_t*)(ws + WS_WGU), scr, r, 2 * FF / 32, X.lane); continue; } r -= I_GU;
        if (r < I_DN) { transpose_item<0>(P.in(I_WDN) + (size_t)l * FF * DM, FF, DM, (bf16_t*)(ws + WS_WDN), scr, r, DM / 32, X.lane); continue; } r -= I_DN;
        if (r < I_UQ) { transpose_item<0>(P.in(I_WUQ) + (size_t)l * 512 * 1536, 512, 1536, (bf16_t*)(ws + WS_WUQ), scr, r, 1536 / 32, X.lane); continue; } r -= I_UQ;
        transpose_item<0>(P.in(I_WUKV) + (size_t)l * 256 * 2048, 256, 2048, (bf16_t*)(ws + WS_WUKV), scr, r, 2048 / 32, X.lane);
    }
}
__device__ __forceinline__ void mod_gemv(const Ctx& X0, const PRef& P) {
    const Ctx X = fresh(X0);
    float* sc = (float*)X.lds;
    float* red = (float*)(X.lds + 40960);
    for (int i = X.tid; i < 5 * DM; i += 512) { const int mb = i / DM, k = i % DM; const float v = mb < 4 ? P.in(I_C)[mb * DM + k] : P.in(I_CCTX)[k]; sc[i] = siluf(v); }
    __syncthreads();
    float* mod = (float*)(P.ws() + WS_MOD);
    const int kq = X.tid >> 4, c4 = X.tid & 15;
    for (int task = X.wg; task < DEPTH * 192; task += X.nwg) {
        const int l = task / 192, n0 = (task % 192) * 64;
        const float* W = P.in(I_MODW) + (size_t)l * DM * 6 * DM + n0 + 4 * c4;
        f32x4 a[5];
#pragma unroll
        for (int mb = 0; mb < 5; ++mb) a[mb] = (f32x4){0.f, 0.f, 0.f, 0.f};
#pragma unroll 8
        for (int i = 0; i < 64; ++i) { const int k = kq + 32 * i; const f32x4 w = *(const f32x4*)(W + (size_t)k * 6 * DM);
#pragma unroll
            for (int mb = 0; mb < 5; ++mb) a[mb] += w * sc[mb * DM + k]; }
#pragma unroll
        for (int mb = 0; mb < 5; ++mb) *(f32x4*)(red + (kq * 5 + mb) * 64 + 4 * c4) = a[mb];
        __syncthreads();
        if (X.tid < 320) { const int mb = X.tid >> 6, cc = X.tid & 63; float s = 0.f;
#pragma unroll 8
            for (int q = 0; q < 32; ++q) s += red[(q * 5 + mb) * 64 + cc];
            mod[((size_t)l * 5 + mb) * 6 * DM + n0 + cc] = s + P.in(I_MODB)[(size_t)l * 6 * DM + n0 + cc]; }
        __syncthreads();
    }
}

__device__ __forceinline__ void modulate_phase(const Ctx& X0, const float* src_lat, const float* src_ctx, const float* g, const float* modl, int shift_off, int scale_off, bf16_t* A, int nrows) {
    const Ctx X = fresh(X0);
    const int rpw = (nrows + X.ngw - 1) / X.ngw;
    int row = X.gw * rpw; const int rend = min(row + rpw, nrows);
    f32x4 v[8], nx[8], gm[8], sh[8];
    int cur_mb = -1;
    if (row < rend) { const float* src = row < M_LAT ? src_lat + (size_t)row * DM : src_ctx + (size_t)(row - M_LAT) * DM;
#pragma unroll
        for (int j = 0; j < 8; ++j) v[j] = *(const f32x4*)(src + X.lane * 4 + 256 * j); }
    for (; row < rend; ++row) {
        const int nrow = row + 1;
        if (nrow < rend) { const float* src = nrow < M_LAT ? src_lat + (size_t)nrow * DM : src_ctx + (size_t)(nrow - M_LAT) * DM;
#pragma unroll
            for (int j = 0; j < 8; ++j) nx[j] = *(const f32x4*)(src + X.lane * 4 + 256 * j); }
        const int mb = mod_batch(row);
        if (mb != cur_mb) { cur_mb = mb; const float* mp = modl + (size_t)mb * 6 * DM;
#pragma unroll
            for (int j = 0; j < 8; ++j) { const int col = X.lane * 4 + 256 * j; gm[j] = *(const f32x4*)(g + col) * (*(const f32x4*)(mp + scale_off + col) + 1.0f); sh[j] = *(const f32x4*)(mp + shift_off + col); } }
        float ss = 0.f;
#pragma unroll
        for (int j = 0; j < 8; ++j) ss += (v[j][0] * v[j][0] + v[j][1] * v[j][1]) + (v[j][2] * v[j][2] + v[j][3] * v[j][3]);
        const float rstd = rsqrtf(wave_sum(ss) * (1.f / DM) + EPS);
#pragma unroll
        for (int j = 0; j < 8; ++j) { const int col = X.lane * 4 + 256 * j;
            const f32x4 y = (v[j] * rstd) * gm[j] + sh[j];
            u32x2 w; w.x = pk2(y[0], y[1]); w.y = pk2(y[2], y[3]);
            *(u32x2*)(A + (size_t)row * DM + col) = w; }
#pragma unroll
        for (int j = 0; j < 8; ++j) v[j] = nx[j];
    }
}

struct ChunkId { int b, j, row0, tok0, is_lat, seglen; };
__device__ __forceinline__ ChunkId chunk_of_unit(int u) {
    ChunkId c;
    if (u < 256) { c.b = u >> 6; c.j = u & 63; c.row0 = c.b * SEQ + 64 * c.j; c.tok0 = CTXL + 64 * c.j; c.is_lat = 1; c.seglen = SEQ; }
    else { const int uu = u - 256; c.b = uu >> 2; c.j = uu & 3; c.row0 = M_LAT + c.b * CTXL + 64 * c.j; c.tok0 = 64 * c.j; c.is_lat = 0; c.seglen = CTXL; }
    return c;
}
__device__ __forceinline__ int row_of_tokchunk(int b, int jt) { return jt < 4 ? M_LAT + b * CTXL + 64 * jt : b * SEQ + 64 * (jt - 4); }

constexpr int TSTR = 520;
__device__ __forceinline__ void write_vt(const Ctx& X, const bf16_t* tile, bf16_t* img, size_t img_row0, int tok0) {
#pragma unroll 2
    for (int it = 0; it < 8; ++it) { const int task = it * 512 + X.tid; const int k = task & 7, c = task >> 3;
        float v[8];
#pragma unroll
        for (int jj = 0; jj < 8; ++jj) { const int i = 16 * (k >> 1) + 8 * (jj >> 2) + 4 * (k & 1) + (jj & 3); v[jj] = bf1(tile[i * TSTR + c]); }
        *(u32x4*)(img + (img_row0 + c) * TK + tok0 + 8 * k) = pack8(v); }
}
template <class F>
__device__ __forceinline__ void load_tile(const Ctx& X, bf16_t* tile, const bf16_t* src, size_t rstride, F colmap) {
#pragma unroll 4
    for (int it = 0; it < 8; ++it) { const int ch = it * 512 + X.tid; const int i = ch >> 6, cc = ch & 63;
        const u32x4 w = *(const u32x4*)(src + (size_t)i * rstride + colmap(cc));
        *(u32x4*)(tile + i * TSTR + 8 * cc) = w; }
}

__device__ __forceinline__ void rope_cs(int sub, int prow, int pcol, float* cs, float* sn) {
    const float pos = (float)((sub < 4) ? prow : pcol);
#pragma unroll
    for (int e = 0; e < 8; ++e) { const int fi = (sub & 1) * 8 + e; const float inv = exp2f(-(float)fi * (13.287712379549449f / 16.0f)); const float a = pos * inv; cs[e] = __cosf(a); sn[e] = __sinf(a); }
}
__device__ __forceinline__ void rope_apply(int sub, float* y, const float* cs, const float* sn) {
#pragma unroll
    for (int e = 0; e < 8; ++e) { const float p = __shfl_xor(y[e], 2); y[e] = (sub & 2) ? (y[e] * cs[e] + p * sn[e]) : (y[e] * cs[e] - p * sn[e]); }
}

__device__ __forceinline__ void prep_phase(const Ctx& X0, const PRef& P, int l) {
    const Ctx X = fresh(X0);
    unsigned char* ws = P.ws();
    const bf16_t* proj = (const bf16_t*)(ws + WS_PROJ);
    bf16_t* tile = (bf16_t*)X.lds;
    const float* qkg = P.in(I_DAQKG) + l * 128;
    const float* convw = P.in(I_CONVW) + (size_t)l * 3 * 1024; const float* convb = P.in(I_CONVB) + l * 1024;
    const float* qng = P.in(I_QNG) + l * 512; const float* kvng = P.in(I_KVNG) + l * 256;
    const int lane = X.lane, sub = lane & 7;
    const float qscale = 0.125f * LOG2E;
    for (int uu = X.wg; uu < 4 * 272; uu += X.nwg) {
        const int part = uu / 272, u = uu % 272;
        const ChunkId c = chunk_of_unit(u);
        if (part == 0) {
        for (int i = X.wave; i < 64; i += 8) {
            const int row = c.row0 + i, tok = c.tok0 + i;
            const bf16_t* pr = proj + (size_t)row * NPROJ;
            float cs[8], sn[8];
            if (c.is_lat) rope_cs(sub, c.j, i, cs, sn);
#pragma unroll
            for (int qk = 0; qk < 2; ++qk) {
                float y[8]; unpack8(*(const u32x4*)(pr + (qk ? C_DAK : C_DAQ) + 8 * lane), y);
                float ss = 0.f;
#pragma unroll
                for (int e = 0; e < 8; ++e) ss += y[e] * y[e];
                ss += __shfl_xor(ss, 1); ss += __shfl_xor(ss, 2); ss += __shfl_xor(ss, 4);
                const float rstd = rsqrtf(ss * (1.f / 64.f) + EPS);
#pragma unroll
                for (int e = 0; e < 8; ++e) y[e] = y[e] * rstd * qkg[qk * 64 + 8 * sub + e];
                if (c.is_lat) rope_apply(sub, y, cs, sn);
                const int head = lane >> 4, comp = (lane >> 3) & 1;
                if (qk == 0) {
#pragma unroll
                    for (int e = 0; e < 8; ++e) y[e] *= qscale;
                    *(u32x4*)((bf16_t*)(ws + WS_QDA) + ((size_t)head * M_ALL + row) * 128 + comp * 64 + 8 * sub) = pack8(y);
                } else {
                    *(u32x4*)((bf16_t*)(ws + WS_KDA) + ((size_t)(c.b * 4 + head) * TK + tok) * 128 + comp * 64 + 8 * sub) = pack8(y);
                }
            }
            {
                float y[8]; unpack8(*(const u32x4*)(pr + C_CQ + 8 * lane), y);
                float ss = 0.f;
#pragma unroll
                for (int e = 0; e < 8; ++e) ss += y[e] * y[e];
                const float rstd = rsqrtf(wave_sum(ss) * (1.f / 512.f) + EPS);
#pragma unroll
                for (int e = 0; e < 8; ++e) y[e] = y[e] * rstd * qng[8 * lane + e];
                *(u32x4*)((bf16_t*)(ws + WS_CQN) + (size_t)row * 512 + 8 * lane) = pack8(y);
            }
            {
                float y[8];
                if (lane < 32) unpack8(*(const u32x4*)(pr + C_CKV + 8 * lane), y);
                else {
#pragma unroll
                    for (int e = 0; e < 8; ++e) y[e] = 0.f;
                }
                float ss = 0.f;
#pragma unroll
                for (int e = 0; e < 8; ++e) ss += y[e] * y[e];
                const float rstd = rsqrtf(wave_sum(ss) * (1.f / 256.f) + EPS);
                if (lane < 32) {
#pragma unroll
                    for (int e = 0; e < 8; ++e) y[e] = y[e] * rstd * kvng[8 * lane + e];
                    *(u32x4*)((bf16_t*)(ws + WS_CKVN) + (size_t)row * 256 + 8 * lane) = pack8(y);
                }
            }
            if (lane < 8) *(u32x4*)((bf16_t*)(ws + WS_KPE) + (size_t)row * 64 + 8 * lane) = *(const u32x4*)(pr + C_KPE + 8 * lane);
            *(u32x4*)((bf16_t*)(ws + WS_OCOPY) + (size_t)row * 512 + 8 * lane) = *(const u32x4*)(pr + C_MLO + 8 * lane);
        }
        } else if (part == 1) {
        for (int i = X.wave; i < 64; i += 8) {
            const int row = c.row0 + i, tseg = 64 * c.j + i, tok = c.tok0 + i;
            const bf16_t* pr = proj + (size_t)row * NPROJ;
#pragma unroll
            for (int qk = 0; qk < 2; ++qk) {
                const int ch0 = qk * 512 + 8 * lane;
                float xm[8], x0[8], xp[8];
                unpack8(*(const u32x4*)(pr + C_MLQ + ch0), x0);
                if (tseg > 0) unpack8(*(const u32x4*)(pr - NPROJ + C_MLQ + ch0), xm);
                else {
#pragma unroll
                    for (int e = 0; e < 8; ++e) xm[e] = 0.f;
                }
                if (tseg < c.seglen - 1) unpack8(*(const u32x4*)(pr + NPROJ + C_MLQ + ch0), xp);
                else {
#pragma unroll
                    for (int e = 0; e < 8; ++e) xp[e] = 0.f;
                }
                float y[8];
#pragma unroll
                for (int e = 0; e < 8; ++e) { const float v = convb[ch0 + e] + convw[ch0 + e] * xm[e] + convw[1024 + ch0 + e] * x0[e] + convw[2048 + ch0 + e] * xp[e]; y[e] = siluf(v) * (qk ? 0.08838834764831845f : 1.0f); }
                const int head = lane >> 4, d = 8 * (lane & 15);
                const u32x4 w = pack8(y);
                *(u32x4*)((bf16_t*)(ws + (qk ? WS_KML : WS_QML)) + ((size_t)(c.b * 4 + head) * TK + tok) * 128 + d) = w;
                if (qk) *(u32x4*)(tile + i * TSTR + 8 * lane) = w;
            }
        }
        __syncthreads();
        write_vt(X, tile, (bf16_t*)(ws + WS_KTML), (size_t)c.b * 512, c.tok0);
        __syncthreads();
        } else if (part == 2) {
        load_tile(X, tile, proj + (size_t)c.row0 * NPROJ, NPROJ, [](int cc) { return C_DAV + 8 * cc; });
        __syncthreads();
        write_vt(X, tile, (bf16_t*)(ws + WS_VTDA), (size_t)c.b * 512, c.tok0);
        __syncthreads();
        } else {
        load_tile(X, tile, proj + (size_t)c.row0 * NPROJ, NPROJ, [](int cc) { return C_MLV + 8 * cc; });
        __syncthreads();
        write_vt(X, tile, (bf16_t*)(ws + WS_VTML), (size_t)c.b * 512, c.tok0);
        __syncthreads();
        }
    }
}

__device__ __forceinline__ void mla_prep_phase(const Ctx& X0, const PRef& P, int l) {
    const Ctx X = fresh(X0);
    unsigned char* ws = P.ws();
    const bf16_t* qup = (const bf16_t*)(ws + WS_QUP); const bf16_t* kvup = (const bf16_t*)(ws + WS_KVUP); const bf16_t* kpe = (const bf16_t*)(ws + WS_KPE);
    bf16_t* tile = (bf16_t*)X.lds;
    const float* g = P.in(I_MLAQKG) + l * 2 * 192;
    const int lane = X.lane, sub = lane & 7, head = lane >> 3;
    const float qscale = 0.07216878364870322f * LOG2E;
    for (int uu = X.wg; uu < 3 * 272; uu += X.nwg) {
        const int part = uu / 272, u = uu % 272;
        const ChunkId c = chunk_of_unit(u);
        if (part == 0) {
        for (int i = X.wave; i < 64; i += 8) {
            const int row = c.row0 + i, tok = c.tok0 + i;
            float cs[8], sn[8];
            if (c.is_lat) rope_cs(sub, c.j, i, cs, sn);
#pragma unroll
            for (int qk = 0; qk < 2; ++qk) {
                float y[3][8];
                if (qk == 0) {
#pragma unroll
                    for (int cc = 0; cc < 3; ++cc) unpack8(*(const u32x4*)(qup + (size_t)row * 1536 + head * 192 + 64 * cc + 8 * sub), y[cc]);
                } else {
#pragma unroll
                    for (int cc = 0; cc < 2; ++cc) unpack8(*(const u32x4*)(kvup + (size_t)row * 2048 + head * 256 + 64 * cc + 8 * sub), y[cc]);
                    unpack8(*(const u32x4*)(kpe + (size_t)row * 64 + 8 * sub), y[2]);
                }
                float ss = 0.f;
#pragma unroll
                for (int cc = 0; cc < 3; ++cc)
#pragma unroll
                    for (int e = 0; e < 8; ++e) ss += y[cc][e] * y[cc][e];
                ss += __shfl_xor(ss, 1); ss += __shfl_xor(ss, 2); ss += __shfl_xor(ss, 4);
                const float rstd = rsqrtf(ss * (1.f / 192.f) + EPS);
#pragma unroll
                for (int cc = 0; cc < 3; ++cc)
#pragma unroll
                    for (int e = 0; e < 8; ++e) y[cc][e] = y[cc][e] * rstd * g[qk * 192 + 64 * cc + 8 * sub + e];
                if (c.is_lat) rope_apply(sub, y[2], cs, sn);
                bf16_t* dst;
                if (qk == 0) {
#pragma unroll
                    for (int cc = 0; cc < 3; ++cc)
#pragma unroll
                        for (int e = 0; e < 8; ++e) y[cc][e] *= qscale;
                    dst = (bf16_t*)(ws + WS_QM) + ((size_t)head * M_ALL + row) * 192;
                } else dst = (bf16_t*)(ws + WS_KM) + ((size_t)(c.b * 8 + head) * TK + tok) * 192;
#pragma unroll
                for (int cc = 0; cc < 3; ++cc) *(u32x4*)(dst + 64 * cc + 8 * sub) = pack8(y[cc]);
            }
        }
        } else {
            const int p = part - 1;
            load_tile(X, tile, kvup + (size_t)c.row0 * 2048, 2048, [p](int cc) { return (4 * p + (cc >> 4)) * 256 + 128 + 8 * (cc & 15); });
            __syncthreads();
            write_vt(X, tile, (bf16_t*)(ws + WS_VTM), (size_t)(c.b * 8 + 4 * p) * 128, c.tok0);
            __syncthreads();
        }
    }
}

__device__ __forceinline__ void ml_gates(const float* gates, const float* gb, int b, int jt, int dir, int h, int lane, float& ig, float& lf, float& pre, float& total) {
    const int row = row_of_tokchunk(b, jt) + lane;
    ig = gates[(size_t)row * 16 + dir * 8 + h] + gb[dir * 8 + h];
    const float fg = gates[(size_t)row * 16 + dir * 8 + 4 + h] + gb[dir * 8 + 4 + h];
    lf = fminf(fg, 0.f) - log1pf(__expf(-fabsf(fg)));
    float s = lf;
#pragma unroll
    for (int o = 1; o < 64; o <<= 1) { const float t = __shfl_up(s, o); if (lane >= o) s += t; }
    pre = s; total = __shfl(s, 63);
}
constexpr int KSTR = 72;
constexpr int QSTR = 136;
__device__ __forceinline__ void mlstm_a_phase(const Ctx& X0, const PRef& P, int l) {
    const Ctx X = fresh(X0);
    unsigned char* ws = P.ws();
    const float* gates = (const float*)(ws + WS_GATES); const float* gb = P.in(I_GATEB) + l * 16;
    bf16_t* Kt = (bf16_t*)X.lds;
    bf16_t* Vw = (bf16_t*)(X.lds + 128 * KSTR * 2);
    float* wtab = (float*)(X.lds + 3 * 128 * KSTR * 2);
    const int lane = X.lane, r32 = lane & 31, hi = lane >> 5;
    for (int u = X.wg; u < 16 * NCH; u += X.nwg) {
        const int bh = u / NCH, jt = u % NCH, b = bh >> 2, h = bh & 3, tok0 = 64 * jt;
        if (X.wave < 2) {
            const int dir = X.wave; float ig, lf, pre, total; ml_gates(gates, gb, b, jt, dir, h, lane, ig, lf, pre, total);
            const float cum = dir == 0 ? pre : total - pre + lf;
            const float wlog = total - cum + ig; const float mloc = wave_max(wlog);
            wtab[dir * 64 + lane] = __expf(wlog - mloc);
            if (lane == 0) { float* cs = (float*)(ws + WS_CSTAT) + ((size_t)(bh * 2 + dir) * NCH + jt) * 4; cs[0] = total; cs[1] = mloc; }
        }
        u32x4 vr[2];
#pragma unroll
        for (int it = 0; it < 2; ++it) { const int ch = it * 512 + X.tid; const int rr = ch >> 3, k = ch & 7;
            *(u32x4*)(Kt + rr * KSTR + 8 * k) = *(const u32x4*)((const bf16_t*)(ws + WS_KTML) + ((size_t)bh * 128 + rr) * TK + tok0 + 8 * k);
            vr[it] = *(const u32x4*)((const bf16_t*)(ws + WS_VTML) + ((size_t)bh * 128 + rr) * TK + tok0 + 8 * k); }
        __syncthreads();
#pragma unroll
        for (int it = 0; it < 2; ++it) { const int ch = it * 512 + X.tid; const int rr = ch >> 3, k = ch & 7;
            float v[8]; unpack8(vr[it], v);
#pragma unroll
            for (int dir = 0; dir < 2; ++dir) { float o[8];
#pragma unroll
                for (int jj = 0; jj < 8; ++jj) { const int i = 16 * (k >> 1) + 8 * (jj >> 2) + 4 * (k & 1) + (jj & 3); o[jj] = v[jj] * wtab[dir * 64 + i]; }
                *(u32x4*)(Vw + (dir * 128 + rr) * KSTR + 8 * k) = pack8(o); } }
        __syncthreads();
        {
            const int dir = X.wave >> 2, dvb = X.wave & 3;
            bf16_t* U = (bf16_t*)(ws + WS_AB) + ((size_t)(bh * 2 + dir) * NCH + jt) * 16384;
            bf16x8 a[4];
#pragma unroll
            for (int ks = 0; ks < 4; ++ks) a[ks] = *(const bf16x8*)(Vw + (dir * 128 + 32 * dvb + r32) * KSTR + 16 * ks + 8 * hi);
            for (int dkb = 0; dkb < 4; ++dkb) {
                f32x16 acc;
#pragma unroll
                for (int r = 0; r < 16; ++r) acc[r] = 0.f;
#pragma unroll
                for (int ks = 0; ks < 4; ++ks) { const bf16x8 bb = *(const bf16x8*)(Kt + (32 * dkb + r32) * KSTR + 16 * ks + 8 * hi); acc = __builtin_amdgcn_mfma_f32_32x32x16_bf16(a[ks], bb, acc, 0, 0, 0); }
#pragma unroll
                for (int r = 0; r < 16; ++r) U[(32 * dvb + crow(r, hi)) * 128 + 32 * dkb + r32] = (bf16_t)(pk2(acc[r], 0.f) & 0xffffu);
            }
        }
        if (X.tid < 256) { const int dir = X.tid >> 7, dk = X.tid & 127; float s = 0.f;
#pragma unroll 8
            for (int p = 0; p < 64; ++p) { const int i = (p & ~15) + perm_off(p & 15); s += wtab[dir * 64 + i] * bf1(Kt[dk * KSTR + p]); }
            ((float*)(ws + WS_NU))[((size_t)(bh * 2 + dir) * NCH + jt) * 128 + dk] = s; }
        __syncthreads();
    }
}
__device__ __forceinline__ int ml_jmap(int dir, int c) { return dir == 0 ? c : (c < 4 ? 3 - c : 71 - c); }
__device__ __forceinline__ void mlstm_scan_phase(const Ctx& X0, const PRef& P) {
    const Ctx X = fresh(X0);
    unsigned char* ws = P.ws();
    float* cstat = (float*)(ws + WS_CSTAT);
    const int gtid = X.wg * 512 + X.tid, nthr = X.nwg * 512;
    for (int task = gtid; task < 65536 + 1024; task += nthr) {
        float m = 0.f;
        if (task < 65536) {
            const int seq = task >> 11, e = task & 2047, dir = seq & 1;
            const bf16_t* __restrict__ U = (const bf16_t*)(ws + WS_AB); bf16_t* __restrict__ S = (bf16_t*)(ws + WS_CSNAP);
            float C[8];
#pragma unroll
            for (int i = 0; i < 8; ++i) C[i] = 0.f;
            for (int cb = 0; cb < 4; ++cb) {
                u32x4 uu[17]; float tot[17], mlc[17];
#pragma unroll
                for (int i = 0; i < 17; ++i) { const size_t base = (size_t)seq * NCH + ml_jmap(dir, cb * 17 + i);
                    uu[i] = *(const u32x4*)(U + base * 16384 + 8 * e); tot[i] = cstat[base * 4]; mlc[i] = cstat[base * 4 + 1]; }
#pragma unroll
                for (int i = 0; i < 17; ++i) { const size_t base = (size_t)seq * NCH + ml_jmap(dir, cb * 17 + i);
                    *(u32x4*)(S + base * 16384 + 8 * e) = pack8(C);
                    if (e == 0) cstat[base * 4 + 2] = m;
                    const float mn = fmaxf(tot[i] + m, mlc[i]); const float dec = __expf(tot[i] + m - mn), sc = __expf(mlc[i] - mn);
                    float u8[8]; unpack8(uu[i], u8);
#pragma unroll
                    for (int q = 0; q < 8; ++q) C[q] = C[q] * dec + u8[q] * sc;
                    m = mn; }
            }
        } else {
            const int t2 = task - 65536, seq = t2 >> 5, e4 = t2 & 31, dir = seq & 1;
            const float* __restrict__ NU = (const float*)(ws + WS_NU); float* __restrict__ NS = (float*)(ws + WS_NSNAP);
            f32x4 C = (f32x4){0.f, 0.f, 0.f, 0.f};
            for (int cb = 0; cb < 4; ++cb) {
                f32x4 uu[17]; float tot[17], mlc[17];
#pragma unroll
                for (int i = 0; i < 17; ++i) { const size_t base = (size_t)seq * NCH + ml_jmap(dir, cb * 17 + i);
                    uu[i] = *(const f32x4*)(NU + base * 128 + 4 * e4); tot[i] = cstat[base * 4]; mlc[i] = cstat[base * 4 + 1]; }
#pragma unroll
                for (int i = 0; i < 17; ++i) { const size_t base = (size_t)seq * NCH + ml_jmap(dir, cb * 17 + i);
                    *(f32x4*)(NS + base * 128 + 4 * e4) = C;
                    const float mn = fmaxf(tot[i] + m, mlc[i]); const float dec = __expf(tot[i] + m - mn), sc = __expf(mlc[i] - mn);
                    C = C * dec + uu[i] * sc; m = mn; }
            }
        }
    }
}
__device__ __forceinline__ void mlstm_c_unit(const Ctx& X0, const PRef& P, int l, int u) {
    const Ctx X = fresh(X0);
    unsigned char* ws = P.ws();
    const float* gates = (const float*)(ws + WS_GATES); const float* gb = P.in(I_GATEB) + l * 16;
    const float* cstat = (const float*)(ws + WS_CSTAT);
    bf16_t* Qt = (bf16_t*)X.lds;
    bf16_t* Kn = (bf16_t*)(X.lds + 64 * QSTR * 2);
    bf16_t* Vt = (bf16_t*)(X.lds + 2 * 64 * QSTR * 2);
    float* tab = (float*)(X.lds + 2 * 64 * QSTR * 2 + 128 * KSTR * 2);
    float* t_a = tab, *t_c1 = tab + 128, *t_wp = tab + 256, *t_em = tab + 384, *t_n = tab + 512, *t_red = tab + 768;
    const int lane = X.lane, r32 = lane & 31, hi = lane >> 5;
    const int bh = u / NCH, jt = u % NCH, b = bh >> 2, h = bh & 3, tok0 = 64 * jt;
    if (X.wave < 2) {
        const int dir = X.wave; float ig, lf, pre, total; ml_gates(gates, gb, b, jt, dir, h, lane, ig, lf, pre, total);
        const float cum = dir == 0 ? pre : total - pre + lf;
        const float a = ig - cum; float pm = a;
#pragma unroll
        for (int o = 1; o < 64; o <<= 1) { const float t = dir == 0 ? __shfl_up(pm, o) : __shfl_down(pm, o); const bool ok = dir == 0 ? (lane >= o) : (lane + o < 64); if (ok) pm = fmaxf(pm, t); }
        const float mc = cstat[((size_t)(bh * 2 + dir) * NCH + jt) * 4 + 2];
        const float mt = cum + fmaxf(mc, pm);
        t_a[dir * 64 + lane] = a; t_c1[dir * 64 + lane] = cum - mt; t_wp[dir * 64 + lane] = __expf(cum + mc - mt); t_em[dir * 64 + lane] = __expf(-mt);
    }
#pragma unroll
    for (int it = 0; it < 2; ++it) { const int ch = it * 512 + X.tid;
        { const int i = ch >> 4, k = ch & 15;
          *(u32x4*)(Qt + i * QSTR + 8 * k) = *(const u32x4*)((const bf16_t*)(ws + WS_QML) + ((size_t)bh * TK + tok0 + i) * 128 + 8 * k);
          *(u32x4*)(Kn + i * QSTR + 8 * k) = *(const u32x4*)((const bf16_t*)(ws + WS_KML) + ((size_t)bh * TK + tok0 + i) * 128 + 8 * k); }
        { const int rr = ch >> 3, k = ch & 7;
          *(u32x4*)(Vt + rr * KSTR + 8 * k) = *(const u32x4*)((const bf16_t*)(ws + WS_VTML) + ((size_t)bh * 128 + rr) * TK + tok0 + 8 * k); } }
    if (X.tid < 256) t_n[X.tid] = ((const float*)(ws + WS_NSNAP))[((size_t)(bh * 2 + (X.tid >> 7)) * NCH + jt) * 128 + (X.tid & 127)];
    __syncthreads();
    const int tb = X.wave & 1, db = X.wave >> 1, t = 32 * tb + r32;
    bf16x8 qf[8];
#pragma unroll
    for (int ks = 0; ks < 8; ++ks) qf[ks] = *(const bf16x8*)(Qt + t * QSTR + 16 * ks + 8 * hi);
    f32x16 st[2];
#pragma unroll
    for (int sb = 0; sb < 2; ++sb) {
#pragma unroll
        for (int r = 0; r < 16; ++r) st[sb][r] = 0.f;
#pragma unroll
        for (int ks = 0; ks < 8; ++ks) { const bf16x8 kf = *(const bf16x8*)(Kn + (32 * sb + r32) * QSTR + 16 * ks + 8 * hi); st[sb] = __builtin_amdgcn_mfma_f32_32x32x16_bf16(kf, qf[ks], st[sb], 0, 0, 0); }
    }
    f32x16 hsum;
#pragma unroll
    for (int r = 0; r < 16; ++r) hsum[r] = 0.f;
#pragma unroll
    for (int dir = 0; dir < 2; ++dir) {
        const float c1 = t_c1[dir * 64 + t], wp = t_wp[dir * 64 + t], em = t_em[dir * 64 + t];
        float rs = 0.f; u32x4 pw[2][2];
#pragma unroll
        for (int sb = 0; sb < 2; ++sb) { float p[16];
#pragma unroll
            for (int r = 0; r < 16; ++r) { const int s = 32 * sb + crow(r, hi); const bool ok = dir == 0 ? (s <= t) : (s >= t);
                const float dm = ok ? __expf(t_a[dir * 64 + s] + c1) : 0.f; p[r] = st[sb][r] * dm; rs += p[r]; }
            pw[sb][0] = pack8(p); pw[sb][1] = pack8(p + 8); }
        rs += __shfl_xor(rs, 32);
        float qn = 0.f;
#pragma unroll
        for (int ks = 0; ks < 8; ++ks) { float q8[8]; unpack8(__builtin_bit_cast(u32x4, qf[ks]), q8);
#pragma unroll
            for (int e = 0; e < 8; ++e) qn += q8[e] * t_n[dir * 128 + 16 * ks + 8 * hi + e]; }
        qn += __shfl_xor(qn, 32);
        const float den = rs + wp * qn; const float rden = 1.f / fmaxf(fabsf(den), em);
        f32x16 acc;
#pragma unroll
        for (int r = 0; r < 16; ++r) acc[r] = 0.f;
        const bf16_t* Cs = (const bf16_t*)(ws + WS_CSNAP) + ((size_t)(bh * 2 + dir) * NCH + jt) * 16384 + (size_t)(32 * db + r32) * 128;
#pragma unroll
        for (int ks = 0; ks < 8; ++ks) { const bf16x8 cf = *(const bf16x8*)(Cs + 16 * ks + 8 * hi); acc = __builtin_amdgcn_mfma_f32_32x32x16_bf16(cf, qf[ks], acc, 0, 0, 0); }
#pragma unroll
        for (int r = 0; r < 16; ++r) acc[r] *= wp;
#pragma unroll
        for (int sb = 0; sb < 2; ++sb)
#pragma unroll
            for (int s2 = 0; s2 < 2; ++s2) { const bf16x8 vf = *(const bf16x8*)(Vt + (32 * db + r32) * KSTR + 32 * sb + 16 * s2 + 8 * hi);
                acc = __builtin_amdgcn_mfma_f32_32x32x16_bf16(vf, __builtin_bit_cast(bf16x8, pw[sb][s2]), acc, 0, 0, 0); }
#pragma unroll
        for (int r = 0; r < 16; ++r) hsum[r] += acc[r] * rden;
    }
    float ss = 0.f;
#pragma unroll
    for (int r = 0; r < 16; ++r) ss += hsum[r] * hsum[r];
    ss += __shfl_xor(ss, 32);
    if (hi == 0) t_red[(tb * 4 + db) * 32 + r32] = ss;
    __syncthreads();
    const float tot = t_red[(tb * 4 + 0) * 32 + r32] + t_red[(tb * 4 + 1) * 32 + r32] + t_red[(tb * 4 + 2) * 32 + r32] + t_red[(tb * 4 + 3) * 32 + r32];
    const float rstd = rsqrtf(tot * (1.f / 128.f) + EPS);
    const int row = row_of_tokchunk(b, jt) + t;
    const float* og = P.in(I_MLOUTG) + l * 512 + h * 128;
    const bf16_t* oc = (const bf16_t*)(ws + WS_OCOPY) + (size_t)row * 512 + h * 128;
    bf16_t* mix = (bf16_t*)(ws + WS_AB) + (size_t)row * DM + 512 + h * 128;
#pragma unroll
    for (int q = 0; q < 4; ++q) { const int dv = 32 * db + 8 * q + 4 * hi;
        const u32x2 ow = *(const u32x2*)(oc + dv); const f32x4 gg = *(const f32x4*)(og + dv);
        const float o0 = hsum[4 * q + 0] * rstd * gg[0] * sigmf(bflo(ow.x)), o1 = hsum[4 * q + 1] * rstd * gg[1] * sigmf(bfhi(ow.x));
        const float o2 = hsum[4 * q + 2] * rstd * gg[2] * sigmf(bflo(ow.y)), o3 = hsum[4 * q + 3] * rstd * gg[3] * sigmf(bfhi(ow.y));
        u32x2 w; w.x = pk2(o0, o1); w.y = pk2(o2, o3); *(u32x2*)(mix + dv) = w; }
    __syncthreads();
}

template <int DQK, int KROW>
struct AttnCore {
    static constexpr int NKS = DQK / 16, NKC1 = KROW / 8 + 1, KS = NKC1 * 8, KT_B = 64 * NKC1 * 16, VT_B = 128 * 9 * 16, SLOT_B = KT_B + VT_B;
    static constexpr int NBK = KT_B / 1024, NBV = VT_B / 1024, NB = NBK + NBV, NI = (NB + 7) / 8;
    static_assert(KT_B % 1024 == 0 && VT_B % 1024 == 0 && 8 * NI - NB <= 8 && 3 * SLOT_B <= 135168, "attention LDS geometry");
    static __device__ __forceinline__ void run(const Ctx& X, const bf16_t* Qrow, int kcol, const bf16_t* K, const bf16_t* Vt, int nt, f32x16 (&o)[4]) {
        const int lane = X.lane, r32 = lane & 31, hi = lane >> 5;
        LAS unsigned char* l3 = (LAS unsigned char*)0 + X.l3off;
        bf16x8 qf[NKS];
#pragma unroll
        for (int ks = 0; ks < NKS; ++ks) qf[ks] = *(const bf16x8*)(Qrow + 16 * ks + 8 * hi);
        unsigned goff[NI]; int bsel[NI];
#pragma unroll
        for (int i = 0; i < NI; ++i) {
            int bidx = X.wave + 8 * i; if (bidx >= NB) bidx -= NB;
            bsel[i] = bidx;
            if (bidx < NBK) { const int c = bidx * 64 + lane; const int row = c / NKC1; int col = c % NKC1; if (col > NKC1 - 2) col = NKC1 - 2; goff[i] = (unsigned)(row * KROW + 8 * col) * 2u; }
            else { const int c = (bidx - NBK) * 64 + lane; const int row = c / 9; int col = c % 9; if (col > 7) col = 7; goff[i] = (unsigned)(row * TK + 8 * col) * 2u; }
        }
        asm volatile("s_waitcnt vmcnt(0)" ::: "memory");
#pragma unroll
        for (int ks = 0; ks < NKS; ++ks) asm volatile("" : "+v"(qf[ks]));
        auto issue = [&](int t, int slotoff) {
#pragma unroll
            for (int i = 0; i < NI; ++i) {
                const char* base = bsel[i] < NBK ? (const char*)K + (size_t)t * (64 * KROW * 2) : (const char*)Vt + (size_t)t * 128;
                __builtin_amdgcn_global_load_lds((const unsigned*)(base + goff[i]), (LAS unsigned*)(l3 + slotoff + bsel[i] * 1024), 16, 0, 0);
            }
        };
#pragma unroll
        for (int d = 0; d < 4; ++d)
#pragma unroll
            for (int r = 0; r < 16; ++r) o[d][r] = 0.f;
        float mrun = -1e30f, lrun = 0.f;
        issue(0, 0); issue(1, SLOT_B);
        asm volatile("s_waitcnt vmcnt(%0)" :: "i"(NI) : "memory");
        __builtin_amdgcn_s_barrier(); asm volatile("" ::: "memory");
        int s_cur = 0, s_nn = 2 * SLOT_B;
        for (int t = 0; t < nt; ++t) {
            if (t + 2 < nt) issue(t + 2, s_nn);
            const LAS bf16_t* kt = (const LAS bf16_t*)(l3 + s_cur) + r32 * KS + kcol + 8 * hi; const LAS bf16_t* vt = (const LAS bf16_t*)(l3 + s_cur + KT_B) + r32 * KSTR + 8 * hi;
            f32x16 s0, s1;
#pragma unroll
            for (int r = 0; r < 16; ++r) { s0[r] = 0.f; s1[r] = 0.f; }
            {
                bf16x8 a0 = *(const LAS bf16x8*)(kt), a1 = *(const LAS bf16x8*)(kt + 32 * KS);
                __builtin_amdgcn_sched_group_barrier(0x100, 2, 0);
#pragma unroll
                for (int ks = 0; ks < NKS; ++ks) {
                    bf16x8 b0 = a0, b1 = a1;
                    if (ks + 1 < NKS) { b0 = *(const LAS bf16x8*)(kt + 16 * (ks + 1)); b1 = *(const LAS bf16x8*)(kt + 32 * KS + 16 * (ks + 1)); }
                    s0 = __builtin_amdgcn_mfma_f32_32x32x16_bf16(a0, qf[ks], s0, 0, 0, 0);
                    s1 = __builtin_amdgcn_mfma_f32_32x32x16_bf16(a1, qf[ks], s1, 0, 0, 0);
                    if (ks + 1 < NKS) __builtin_amdgcn_sched_group_barrier(0x100, 2, 0);
                    __builtin_amdgcn_sched_group_barrier(0x008, 2, 0);
                    a0 = b0; a1 = b1;
                }
            }
            bf16x8 vf[4];
#pragma unroll
            for (int d = 0; d < 4; ++d) vf[d] = *(const LAS bf16x8*)(vt + 32 * d * KSTR);
            float mx = fmaxf(s0[0], s1[0]);
#pragma unroll
            for (int r = 1; r < 16; ++r) mx = fmaxf(fmaxf(mx, s0[r]), s1[r]);
            mx = fmaxf(mx, __shfl_xor(mx, 32));
            if (__any(mx - mrun > RESC_THR)) {
                const float mnew = fmaxf(mrun, mx); const float alpha = __builtin_amdgcn_exp2f(mrun - mnew); mrun = mnew; lrun *= alpha;
#pragma unroll
                for (int d = 0; d < 4; ++d) o[d] = o[d] * alpha;
            }
            s0 = s0 - mrun; s1 = s1 - mrun;
#pragma unroll
            for (int r = 0; r < 16; ++r) { s0[r] = __builtin_amdgcn_exp2f(s0[r]); s1[r] = __builtin_amdgcn_exp2f(s1[r]); }
            { const f32x16 sm = s0 + s1;
              lrun += ((sm[0] + sm[1]) + (sm[2] + sm[3])) + ((sm[4] + sm[5]) + (sm[6] + sm[7])) + (((sm[8] + sm[9]) + (sm[10] + sm[11])) + ((sm[12] + sm[13]) + (sm[14] + sm[15]))); }
            bf16x8 pf[4];
            { float p[16];
#pragma unroll
              for (int r = 0; r < 16; ++r) p[r] = s0[r];
              pf[0] = __builtin_bit_cast(bf16x8, pack8(p)); pf[1] = __builtin_bit_cast(bf16x8, pack8(p + 8));
#pragma unroll
              for (int r = 0; r < 16; ++r) p[r] = s1[r];
              pf[2] = __builtin_bit_cast(bf16x8, pack8(p)); pf[3] = __builtin_bit_cast(bf16x8, pack8(p + 8)); }
#pragma unroll
            for (int g = 0; g < 4; ++g) {
                bf16x8 vn[4];
                if (g + 1 < 4) {
#pragma unroll
                    for (int d = 0; d < 4; ++d) vn[d] = *(const LAS bf16x8*)(vt + 32 * d * KSTR + 16 * (g + 1));
                }
#pragma unroll
                for (int d = 0; d < 4; ++d) o[d] = __builtin_amdgcn_mfma_f32_32x32x16_bf16(vf[d], pf[g], o[d], 0, 0, 0);
                if (g + 1 < 4) {
                    __builtin_amdgcn_sched_group_barrier(0x100, 4, 0);
#pragma unroll
                    for (int d = 0; d < 4; ++d) vf[d] = vn[d];
                }
                __builtin_amdgcn_sched_group_barrier(0x008, 4, 0);
            }
            if (t + 2 < nt) asm volatile("s_waitcnt vmcnt(%0)" :: "i"(NI) : "memory");
            else asm volatile("s_waitcnt vmcnt(0)" ::: "memory");
            asm volatile("s_waitcnt lgkmcnt(0)" ::: "memory");
            __builtin_amdgcn_s_barrier(); asm volatile("" ::: "memory");
            s_cur = (s_cur == 2 * SLOT_B) ? 0 : s_cur + SLOT_B; s_nn = (s_nn == 2 * SLOT_B) ? 0 : s_nn + SLOT_B;
        }
        lrun += __shfl_xor(lrun, 32);
        const float rl = 1.f / lrun;
#pragma unroll
        for (int d = 0; d < 4; ++d) o[d] = o[d] * rl;
    }
};

template <int DQK, int KROW>
struct AttnCoreP {
    static constexpr int NKS = DQK / 16, NKC1 = KROW / 8 + 1, KS = NKC1 * 8, KT_B = 64 * NKC1 * 16, VT_B = 128 * 9 * 16, SLOT_B = KT_B + VT_B;
    static constexpr int NBK = KT_B / 1024, NBV = VT_B / 1024, NB = NBK + NBV, NI = (NB + 7) / 8;
    static_assert(KT_B % 1024 == 0 && VT_B % 1024 == 0 && 8 * NI - NB <= 8 && 3 * SLOT_B <= 135168, "attention LDS geometry");
    static __device__ __forceinline__ void run(const Ctx& X, const bf16_t* Qrow, int kcol, const bf16_t* K, const bf16_t* Vt, int nt, f32x16 (&o)[4]) {
        const int lane = X.lane, r32 = lane & 31, hi = lane >> 5, role = X.wave >> 2;
        LAS unsigned char* l3 = (LAS unsigned char*)0 + X.l3off;
        bf16x8 qf[NKS];
#pragma unroll
        for (int ks = 0; ks < NKS; ++ks) qf[ks] = *(const bf16x8*)(Qrow + 16 * ks + 8 * hi);
        unsigned goff[NI]; int bsel[NI];
#pragma unroll
        for (int i = 0; i < NI; ++i) {
            int bidx = X.wave + 8 * i; if (bidx >= NB) bidx -= NB;
            bsel[i] = bidx;
            if (bidx < NBK) { const int c = bidx * 64 + lane; const int row = c / NKC1; int col = c % NKC1; if (col > NKC1 - 2) col = NKC1 - 2; goff[i] = (unsigned)(row * KROW + 8 * col) * 2u; }
            else { const int c = (bidx - NBK) * 64 + lane; const int row = c / 9; int col = c % 9; if (col > 7) col = 7; goff[i] = (unsigned)(row * TK + 8 * col) * 2u; }
        }
        asm volatile("s_waitcnt vmcnt(0)" ::: "memory");
#pragma unroll
        for (int ks = 0; ks < NKS; ++ks) asm volatile("" : "+v"(qf[ks]));
        auto issue = [&](int tk, int ks_off, bool doK, int tv, int vs_off, bool doV) {
#pragma unroll
            for (int i = 0; i < NI; ++i) {
                const bool isK = bsel[i] < NBK;
                if (isK ? doK : doV) {
                    const char* base = isK ? (const char*)K + (size_t)tk * (64 * KROW * 2) : (const char*)Vt + (size_t)tv * 128;
                    __builtin_amdgcn_global_load_lds((const unsigned*)(base + goff[i]), (LAS unsigned*)(l3 + (isK ? ks_off : vs_off) + bsel[i] * 1024), 16, 0, 0);
                }
            }
        };
#pragma unroll
        for (int d = 0; d < 4; ++d)
#pragma unroll
            for (int r = 0; r < 16; ++r) o[d][r] = 0.f;
        float mrun = -1e30f, lrun = 0.f;
        issue(0, 0, true, 0, 0, true); issue(1, SLOT_B, true, 1, SLOT_B, true); issue(2, 2 * SLOT_B, nt > 2, 0, 0, false);
        asm volatile("s_waitcnt vmcnt(0)" ::: "memory");
        __builtin_amdgcn_s_barrier(); asm volatile("" ::: "memory");
        f32x16 sc0, sc1;
        {
            const LAS bf16_t* kt = (const LAS bf16_t*)(l3) + r32 * KS + kcol + 8 * hi;
#pragma unroll
            for (int r = 0; r < 16; ++r) { sc0[r] = 0.f; sc1[r] = 0.f; }
#pragma unroll
            for (int ks = 0; ks < NKS; ++ks) {
                const bf16x8 a0 = *(const LAS bf16x8*)(kt + 16 * ks), a1 = *(const LAS bf16x8*)(kt + 32 * KS + 16 * ks);
                sc0 = __builtin_amdgcn_mfma_f32_32x32x16_bf16(a0, qf[ks], sc0, 0, 0, 0);
                sc1 = __builtin_amdgcn_mfma_f32_32x32x16_bf16(a1, qf[ks], sc1, 0, 0, 0);
            }
        }
        int s0off = 0, s1off = SLOT_B, s2off = 2 * SLOT_B;
        for (int t = 0; t < nt; ++t) {
            issue(t + 3, s0off, t + 3 < nt, t + 2, s2off, t + 2 < nt);
            const bool hasN = t + 1 < nt;
            const LAS bf16_t* kt = (const LAS bf16_t*)(l3 + s1off) + r32 * KS + kcol + 8 * hi;
            const LAS bf16_t* vt = (const LAS bf16_t*)(l3 + s0off + KT_B) + r32 * KSTR + 8 * hi;
            f32x16 sn0, sn1;
            auto qk_next = [&]() {
#pragma unroll
                for (int r = 0; r < 16; ++r) { sn0[r] = 0.f; sn1[r] = 0.f; }
                bf16x8 a0 = *(const LAS bf16x8*)(kt), a1 = *(const LAS bf16x8*)(kt + 32 * KS);
                __builtin_amdgcn_sched_group_barrier(0x100, 2, 0);
#pragma unroll
                for (int ks = 0; ks < NKS; ++ks) {
                    bf16x8 b0 = a0, b1 = a1;
                    if (ks + 1 < NKS) { b0 = *(const LAS bf16x8*)(kt + 16 * (ks + 1)); b1 = *(const LAS bf16x8*)(kt + 32 * KS + 16 * (ks + 1)); }
                    sn0 = __builtin_amdgcn_mfma_f32_32x32x16_bf16(a0, qf[ks], sn0, 0, 0, 0);
                    sn1 = __builtin_amdgcn_mfma_f32_32x32x16_bf16(a1, qf[ks], sn1, 0, 0, 0);
                    if (ks + 1 < NKS) __builtin_amdgcn_sched_group_barrier(0x100, 2, 0);
                    __builtin_amdgcn_sched_group_barrier(0x008, 2, 0);
                    a0 = b0; a1 = b1;
                }
            };
            if (role == 0 && hasN) qk_next();
            float mx = fmaxf(sc0[0], sc1[0]);
#pragma unroll
            for (int r = 1; r < 16; ++r) mx = fmaxf(fmaxf(mx, sc0[r]), sc1[r]);
            mx = fmaxf(mx, __shfl_xor(mx, 32));
            if (__any(mx - mrun > RESC_THR)) {
                const float mnew = fmaxf(mrun, mx); const float alpha = __builtin_amdgcn_exp2f(mrun - mnew); mrun = mnew; lrun *= alpha;
#pragma unroll
                for (int d = 0; d < 4; ++d) o[d] = o[d] * alpha;
            }
            sc0 = sc0 - mrun; sc1 = sc1 - mrun;
#pragma unroll
            for (int r = 0; r < 16; ++r) { sc0[r] = __builtin_amdgcn_exp2f(sc0[r]); sc1[r] = __builtin_amdgcn_exp2f(sc1[r]); }
            { const f32x16 sm = sc0 + sc1;
              lrun += ((sm[0] + sm[1]) + (sm[2] + sm[3])) + ((sm[4] + sm[5]) + (sm[6] + sm[7])) + (((sm[8] + sm[9]) + (sm[10] + sm[11])) + ((sm[12] + sm[13]) + (sm[14] + sm[15]))); }
            bf16x8 pf[4];
            { float p[16];
#pragma unroll
              for (int r = 0; r < 16; ++r) p[r] = sc0[r];
              pf[0] = __builtin_bit_cast(bf16x8, pack8(p)); pf[1] = __builtin_bit_cast(bf16x8, pack8(p + 8));
#pragma unroll
              for (int r = 0; r < 16; ++r) p[r] = sc1[r];
              pf[2] = __builtin_bit_cast(bf16x8, pack8(p)); pf[3] = __builtin_bit_cast(bf16x8, pack8(p + 8)); }
            bf16x8 vf[4];
#pragma unroll
            for (int d = 0; d < 4; ++d) vf[d] = *(const LAS bf16x8*)(vt + 32 * d * KSTR);
#pragma unroll
            for (int g = 0; g < 4; ++g) {
                bf16x8 vn[4];
                if (g + 1 < 4) {
#pragma unroll
                    for (int d = 0; d < 4; ++d) vn[d] = *(const LAS bf16x8*)(vt + 32 * d * KSTR + 16 * (g + 1));
                }
#pragma unroll
                for (int d = 0; d < 4; ++d) o[d] = __builtin_amdgcn_mfma_f32_32x32x16_bf16(vf[d], pf[g], o[d], 0, 0, 0);
                if (g + 1 < 4) {
#pragma unroll
                    for (int d = 0; d < 4; ++d) vf[d] = vn[d];
                }
            }
            if (role != 0 && hasN) qk_next();
            if (t + 3 < nt) asm volatile("s_waitcnt vmcnt(%0)" :: "i"(NI) : "memory");
            else asm volatile("s_waitcnt vmcnt(0)" ::: "memory");
            asm volatile("s_waitcnt lgkmcnt(0)" ::: "memory");
            __builtin_amdgcn_s_barrier(); asm volatile("" ::: "memory");
            sc0 = sn0; sc1 = sn1;
            const int tmp = s0off; s0off = s1off; s1off = s2off; s2off = tmp;
        }
        lrun += __shfl_xor(lrun, 32);
        const float rl = 1.f / lrun;
#pragma unroll
        for (int d = 0; d < 4; ++d) o[d] = o[d] * rl;
    }
};

__device__ __forceinline__ void mla_attn_unit(const Ctx& X0, const PRef& P, int b, int h, int q0, int is_ctx) {
    const Ctx X = fresh(X0);
    unsigned char* ws = P.ws();
    const int lane = X.lane, r32 = lane & 31, hi = lane >> 5;
    const int row = (is_ctx ? M_LAT + b * CTXL : b * SEQ) + q0 + 32 * X.wave + r32;
    const bf16_t* Q = (const bf16_t*)(ws + WS_QM) + ((size_t)h * M_ALL + row) * 192;
    const bf16_t* K = (const bf16_t*)(ws + WS_KM) + (size_t)(b * 8 + h) * TK * 192;
    const bf16_t* Vt = (const bf16_t*)(ws + WS_VTM) + (size_t)(b * 8 + h) * 128 * TK;
    f32x16 o[4];
    AttnCore<192, 192>::run(X, Q, 0, K, Vt, is_ctx ? 4 : NCH, o);
    bf16_t* mix = (bf16_t*)(ws + WS_AB) + (size_t)row * DM + 1024 + h * 128;
#pragma unroll
    for (int d = 0; d < 4; ++d)
#pragma unroll
        for (int q = 0; q < 4; ++q) { u32x2 w; w.x = pk2(o[d][4 * q], o[d][4 * q + 1]); w.y = pk2(o[d][4 * q + 2], o[d][4 * q + 3]); *(u32x2*)(mix + 32 * d + 8 * q + 4 * hi) = w; }
}
__device__ __forceinline__ void da_attn_unit(const Ctx& X0, const PRef& P, int l, int b, int h, int q0, int is_ctx, float lam, float lam_init) {
    const Ctx X = fresh(X0);
    unsigned char* ws = P.ws();
    const int lane = X.lane, r32 = lane & 31, hi = lane >> 5;
    const int comp = X.wave >> 2, qs = X.wave & 3;
    const int row = (is_ctx ? M_LAT + b * CTXL : b * SEQ) + q0 + 32 * qs + r32;
    const bf16_t* Q = (const bf16_t*)(ws + WS_QDA) + ((size_t)h * M_ALL + row) * 128 + comp * 64;
    const bf16_t* K = (const bf16_t*)(ws + WS_KDA) + (size_t)(b * 4 + h) * TK * 128;
    const bf16_t* Vt = (const bf16_t*)(ws + WS_VTDA) + (size_t)(b * 4 + h) * 128 * TK;
    f32x16 o[4];
    AttnCoreP<64, 128>::run(X, Q, comp * 64, K, Vt, is_ctx ? 4 : NCH, o);
    float* xch = (float*)X.lds;
    if (comp == 1) {
#pragma unroll
        for (int d = 0; d < 4; ++d)
#pragma unroll
            for (int r = 0; r < 16; ++r) xch[(qs * 64 + d * 16 + r) * 64 + lane] = o[d][r];
    }
    __syncthreads();
    if (comp == 0) {
        float ss = 0.f;
#pragma unroll
        for (int d = 0; d < 4; ++d)
#pragma unroll
            for (int r = 0; r < 16; ++r) { o[d][r] -= lam * xch[(qs * 64 + d * 16 + r) * 64 + lane]; ss += o[d][r] * o[d][r]; }
        ss += __shfl_xor(ss, 32);
        float li_ = lam_init; asm volatile("" : "+s"(li_));
        const float rstd = rsqrtf(ss * (1.f / 128.f) + EPS) * (1.f - li_);
        const float* og = P.in(I_DAOUTG) + l * 128;
        bf16_t* mix = (bf16_t*)(ws + WS_AB) + (size_t)row * DM + h * 128;
#pragma unroll
        for (int d = 0; d < 4; ++d)
#pragma unroll
            for (int q = 0; q < 4; ++q) { const int dv = 32 * d + 8 * q + 4 * hi; const f32x4 gg = *(const f32x4*)(og + dv);
                u32x2 w; w.x = pk2(o[d][4 * q] * rstd * gg[0], o[d][4 * q + 1] * rstd * gg[1]); w.y = pk2(o[d][4 * q + 2] * rstd * gg[2], o[d][4 * q + 3] * rstd * gg[3]);
                *(u32x2*)(mix + dv) = w; }
    }
    __syncthreads();
}

__device__ __forceinline__ void mixer_phase(const Ctx& X, const PRef& P, int l) {
    const bool need_ctx = l < DEPTH - 1;
    STAMPN(20);
    const int vcu = (X.nwg % 8 == 0) ? (X.wg % 8) * (X.nwg / 8) + X.wg / 8 : X.wg;
    if (EN(13)) for (int u = vcu; u < 512; u += X.nwg) mla_attn_unit(X, P, u >> 7, (u >> 4) & 7, (u & 15) * 256, 0);
    STAMPN(11);
    float lam, lam_init;
    { const float* lp = P.in(I_DALAM) + l * 256;
      float s1 = 0.f, s2 = 0.f;
      for (int i = 0; i < 64; ++i) { s1 += lp[i] * lp[64 + i]; s2 += lp[128 + i] * lp[192 + i]; }
      const float li = 0.8f - 0.6f * expf(-0.3f * (float)l);
      const float la = expf(s1) - expf(s2) + li;
      lam = __builtin_bit_cast(float, __builtin_amdgcn_readfirstlane(__builtin_bit_cast(int, la)));
      lam_init = __builtin_bit_cast(float, __builtin_amdgcn_readfirstlane(__builtin_bit_cast(int, li))); }
    if (EN(14)) for (int v = vcu; v < 512; v += X.nwg) da_attn_unit(X, P, l, v >> 7, (v >> 5) & 3, (v & 31) * 128, 0, lam, lam_init);
    STAMPN(12);
    if (EN(15)) for (int u = X.wg; u < 16 * NCH; u += X.nwg) mlstm_c_unit(X, P, l, u);
    STAMPN(13);
    if (need_ctx) {
        if (EN(13)) for (int v = X.wg; v < 32; v += X.nwg) mla_attn_unit(X, P, v >> 3, v & 7, 0, 1);
        if (EN(14)) for (int v = X.nwg - 1 - X.wg; v < 32; v += X.nwg) da_attn_unit(X, P, l, v >> 3, (v >> 1) & 3, (v & 1) * 128, 1, lam, lam_init);
    }
}

__global__ void __launch_bounds__(512, 2) fwd_megakernel(Params Pk) {
    const PRef P;
    extern __shared__ __attribute__((aligned(16))) unsigned char lds[];
    cg::grid_group grid = cg::this_grid();
    Ctx X; X.lds = lds; X.tid = threadIdx.x; X.lane = X.tid & 63; X.wave = __builtin_amdgcn_readfirstlane(X.tid >> 6);
    X.nwg = gridDim.x; X.wg = blockIdx.x; X.gw = X.wg * 8 + X.wave; X.ngw = X.nwg * 8;
    LAS unsigned char* lds3 = (LAS unsigned char*)lds; X.l3off = (unsigned)(uintptr_t)lds3;
    unsigned char* ws = P.ws();
    if (threadIdx.x < 16) ((LAS unsigned*)(lds3 + 135168 + 64))[threadIdx.x] = 0u;
    __syncthreads();
    (void)xcd_barrier_post((unsigned*)(ws + WS_BAR), (volatile LAS unsigned*)(lds3 + 135168 + 64));
    float* R_lat = P.out(); float* R_ctx = (float*)(ws + WS_RCTX);
    bf16_t* AB = (bf16_t*)(ws + WS_AB);

#ifdef PROBE_CAT
    if (blockIdx.x == 0 && threadIdx.x == 0) { volatile unsigned long long* tp_ = (volatile unsigned long long*)(P.ws() + WS_END); tp_[0] = __builtin_amdgcn_s_memrealtime(); tp_[1] = 0; tp_[2] = 0; }
#endif
    if (EN(0)) mod_gemv(X, P);
    if (EN(1)) convert_weights(X, P, 0);
    grid.sync();
#ifdef PROBE_CAT
    STAMP(0);
#endif
    for (int l = 0; l < DEPTH; ++l) {
        const float* modl = (const float*)(ws + WS_MOD) + (size_t)l * 5 * 6 * DM;
        const float* xin_lat = l == 0 ? P.in(I_X) : R_lat; const float* xin_ctx = l == 0 ? P.in(I_CTX) : R_ctx;
        const int Mfin = l < DEPTH - 1 ? M_ALL : M_LAT;
        if (EN(2)) modulate_phase(X, xin_lat, xin_ctx, P.in(I_N1G) + l * DM, modl, 0 * DM, 1 * DM, AB, M_ALL);
        if (EN(1)) if (l > 0) convert_weights(X, P, l);
        STAMP(1);
        if (EN(3)) { pg8::Gemm g{AB, (const bf16_t*)(ws + WS_WIN), M_ALL, NPROJ, DM}; pg8::StaticOrder S; S.init(M_ALL, NPROJ, X.nwg, X.wg);
          pg8::EpiBf16 E{(bf16_t*)(ws + WS_PROJ), NPROJ, (float*)(ws + WS_GATES), C_GATE / 256};
          pg8::gemm_phase<pg8::EpiBf16>(lds3, g, S, E); }
        STAMP(2);
        if (EN(4)) prep_phase(X, P, l);
        STAMP(3);
        if (EN(5)) { pg8::Gemm g{(const bf16_t*)(ws + WS_CQN), (const bf16_t*)(ws + WS_WUQ), M_ALL, 1536, 512}; pg8::StaticOrder S; S.init(M_ALL, 1536, X.nwg, X.wg);
          pg8::EpiBf16 E{(bf16_t*)(ws + WS_QUP), 1536, nullptr, 0};
          pg8::gemm_phase<pg8::EpiBf16>(lds3, g, S, E); }
        if (EN(5)) { pg8::Gemm g{(const bf16_t*)(ws + WS_CKVN), (const bf16_t*)(ws + WS_WUKV), M_ALL, 2048, 256}; pg8::StaticOrder S; S.init(M_ALL, 2048, X.nwg, X.wg);
          pg8::EpiBf16 E{(bf16_t*)(ws + WS_KVUP), 2048, nullptr, 0};
          pg8::gemm_phase<pg8::EpiBf16>(lds3, g, S, E); }
        __syncthreads();
        if (EN(6)) mlstm_a_phase(X, P, l);
        STAMP(4);
        if (EN(7)) mla_prep_phase(X, P, l);
        if (EN(8)) mlstm_scan_phase(X, P);
        STAMP(5);
        if (EN(9)) mixer_phase(X, P, l);
        STAMP(6);
        if (EN(10)) { pg8::Gemm g{AB, (const bf16_t*)(ws + WS_WOUT), Mfin, DM, DM}; pg8::StaticOrder S; S.init(Mfin, DM, X.nwg, X.wg);
          pg8::EpiRes E{xin_lat, xin_ctx, R_lat, R_ctx, modl + 2 * DM};
          pg8::gemm_phase<pg8::EpiRes>(lds3, g, S, E); }
        STAMP(7);
        if (EN(2)) modulate_phase(X, R_lat, R_ctx, P.in(I_N2G) + l * DM, modl, 3 * DM, 4 * DM, AB, Mfin);
        STAMP(1);
        if (EN(11)) { pg8::Gemm g{AB, (const bf16_t*)(ws + WS_WGU), Mfin, 2 * FF, DM}; pg8::StaticOrder S; S.init(Mfin, 2 * FF, X.nwg, X.wg);
          pg8::EpiSwiGLU E{(bf16_t*)(ws + WS_HID), FF};
          pg8::gemm_phase<pg8::EpiSwiGLU>(lds3, g, S, E); }
        STAMP(9);
        if (EN(12)) { pg8::Gemm g{(const bf16_t*)(ws + WS_HID), (const bf16_t*)(ws + WS_WDN), Mfin, DM, FF}; pg8::StaticOrder S; S.init(Mfin, DM, X.nwg, X.wg);
          pg8::EpiRes E{R_lat, R_ctx, R_lat, R_ctx, modl + 5 * DM};
          pg8::gemm_phase<pg8::EpiRes>(lds3, g, S, E); }
#ifdef PROBE_CAT
        STAMP(10);
#else
        if (l + 1 < DEPTH) xcd_barrier(P.ws());
#endif
    }
#ifdef PROBE_CAT
    if (blockIdx.x == 0 && threadIdx.x == 0) P.out()[0] += (float)(((volatile unsigned long long*)(P.ws() + WS_END))[1]) * (0.01f / PROBE_SCALE);
#endif
}

extern "C" void kernel_launch(void* const* d_in, const int* in_sizes, int n_in, void* d_out, int out_size, void* d_ws, size_t ws_size, hipStream_t stream) {
    static int grid = 0;
    if (grid == 0) {
        if (n_in != 24 || ws_size < WS_END) { fprintf(stderr, "kernel_launch: unexpected inputs (n_in %d, ws %zu)\n", n_in, ws_size); grid = -1; return; }
        int dev = 0, cus = 0, per_cu = 0;
        (void)hipGetDevice(&dev); (void)hipDeviceGetAttribute(&cus, hipDeviceAttributeMultiprocessorCount, dev);
        if (hipFuncSetAttribute((const void*)fwd_megakernel, hipFuncAttributeMaxDynamicSharedMemorySize, LDS_BYTES) != hipSuccess) { fprintf(stderr, "kernel_launch: hipFuncSetAttribute failed\n"); grid = -1; return; }
        (void)hipOccupancyMaxActiveBlocksPerMultiprocessor(&per_cu, (const void*)fwd_megakernel, 512, LDS_BYTES);
        (void)hipGetLastError();
        if (per_cu < 1) { fprintf(stderr, "kernel_launch: occupancy query says %d\n", per_cu); per_cu = 1; }
        grid = cus;
    }
    if (grid < 0) return;
    if (hipMemsetAsync((char*)d_ws + WS_BAR, 0, XCD_BAR_WORDS * 4, stream) != hipSuccess) { fprintf(stderr, "kernel_launch: memset failed\n"); return; }
    Params p{};
    for (int i = 0; i < 24; ++i) p.in[i] = (const float*)d_in[i];
    p.out = (float*)d_out; p.ws = (unsigned char*)d_ws;
    void* args[] = {&p};
    hipError_t e = hipLaunchCooperativeKernel((const void*)fwd_megakernel, dim3(grid), dim3(512), args, LDS_BYTES, stream);
    if (e != hipSuccess) fprintf(stderr, "cooperative launch failed: %s (grid %d)\n", hipGetErrorString(e), grid);
}
```

```cpp
#include <hip/hip_runtime.h>
#include <hip/hip_cooperative_groups.h>
#include <cstdio>
#include <cstdint>
namespace cg = cooperative_groups;

#define LAS __attribute__((address_space(3)))
typedef unsigned short bf16_t;
typedef short bf16x8 __attribute__((ext_vector_type(8)));
typedef float f32x4 __attribute__((ext_vector_type(4)));
typedef float f32x16 __attribute__((ext_vector_type(16)));
typedef unsigned u32x4 __attribute__((ext_vector_type(4)));
typedef unsigned u32x2 __attribute__((ext_vector_type(2)));

constexpr int DM = 2048, BATCH = 4, SEQ = 4096, CTXL = 256, DEPTH = 2;
constexpr int M_LAT = BATCH * SEQ, M_CTX = BATCH * CTXL, M_ALL = M_LAT + M_CTX;
constexpr int TK = CTXL + SEQ;
constexpr int NCH = TK / 64;
constexpr int IN_W = 4432, NPROJ = 4608, FF = 5632;
constexpr int C_DAQ = 0, C_DAK = 512, C_DAV = 1024, C_MLQ = 1536, C_MLK = 2048, C_MLV = 2560, C_MLO = 3072, C_GATE = 3584, C_CQ = 3600, C_CKV = 4112, C_KPE = 4368;
constexpr float EPS = 1e-6f;
constexpr float LOG2E = 1.4426950408889634f;
constexpr float RESC_THR = 8.0f;

constexpr size_t MiB = 1u << 20;
constexpr size_t WS_WIN = 0, WS_WOUT = 18 * MiB, WS_WGU = 26 * MiB, WS_WDN = 70 * MiB, WS_WUQ = 92 * MiB, WS_WUKV = 94 * MiB, WS_MOD = 95 * MiB, WS_RCTX = 96 * MiB;
constexpr size_t WS_AB = 104 * MiB;
constexpr size_t WS_PROJ = 172 * MiB;
constexpr size_t WS_QUP = 172 * MiB, WS_KVUP = 223 * MiB, WS_HID = 172 * MiB;
constexpr size_t WS_GATES = 325 * MiB, WS_CQN = 327 * MiB, WS_CKVN = 344 * MiB, WS_KPE = 353 * MiB, WS_OCOPY = 356 * MiB;
constexpr size_t WS_QDA = 373 * MiB, WS_KDA = 390 * MiB, WS_VTDA = 407 * MiB, WS_QML = 424 * MiB, WS_KML = 441 * MiB, WS_KTML = 458 * MiB, WS_VTML = 475 * MiB;
constexpr size_t WS_QM = 492 * MiB, WS_KM = 543 * MiB, WS_VTM = 594 * MiB, WS_CSNAP = 628 * MiB, WS_NSNAP = 696 * MiB, WS_NU = 698 * MiB, WS_CSTAT = 700 * MiB, WS_BAR = 701 * MiB, WS_END = 702 * MiB;
static_assert((size_t)NPROJ * DM * 2 <= 18 * MiB && (size_t)2 * FF * DM * 2 <= 44 * MiB && (size_t)M_ALL * NPROJ * 2 <= 153 * MiB, "ws map");
static_assert(WS_HID + (size_t)M_ALL * FF * 2 <= WS_QDA, "hid overlay");
static_assert(WS_END <= 768 * MiB, "ws fits the guaranteed minimum");

constexpr int LDS_BYTES = 140 * 1024;
#ifndef PH_EN
#define PH_EN 0xFFFF
#endif
#define EN(k) ((PH_EN >> (k)) & 1)
#ifdef PROBE_CAT
#define STAMP(cat) do { xcd_barrier(P.ws()); if (blockIdx.x == 0 && threadIdx.x == 0) { volatile unsigned long long* tp_ = (volatile unsigned long long*)(P.ws() + WS_END); const unsigned long long t1_ = __builtin_amdgcn_s_memrealtime(); if ((1 << (cat)) & PROBE_CAT) tp_[1] += t1_ - tp_[0]; if ((1 << (cat)) & PROBE_CAT2) tp_[2] += t1_ - tp_[0]; tp_[0] = t1_; } } while (0)
#define STAMPN(cat) do { __syncthreads(); if (blockIdx.x == 0 && threadIdx.x == 0) { volatile unsigned long long* tp_ = (volatile unsigned long long*)(P.ws() + WS_END); const unsigned long long t1_ = __builtin_amdgcn_s_memrealtime(); if ((1 << (cat)) & PROBE_CAT) tp_[1] += t1_ - tp_[0]; tp_[0] = t1_; } } while (0)
#else
#define STAMPN(cat) do {} while (0)
#define STAMP(cat) xcd_barrier(P.ws())
#endif

#define LOG2E_ 1.4426950408889634f
__device__ __forceinline__ unsigned f2bf(float f) { unsigned u = __builtin_bit_cast(unsigned, f); return (u + 0x7fffu + ((u >> 16) & 1u)) >> 16; }
typedef float f32x2_t __attribute__((ext_vector_type(2))); typedef __bf16 bf16x2_t __attribute__((ext_vector_type(2)));
__device__ __forceinline__ unsigned pk2(float lo, float hi) { f32x2_t v = {lo, hi}; bf16x2_t b = __builtin_convertvector(v, bf16x2_t); return __builtin_bit_cast(unsigned, b); }
__device__ __forceinline__ float bflo(unsigned w) { return __builtin_bit_cast(float, w << 16); }
__device__ __forceinline__ float bfhi(unsigned w) { return __builtin_bit_cast(float, w & 0xffff0000u); }
__device__ __forceinline__ float bf1(bf16_t h) { return __builtin_bit_cast(float, (unsigned)h << 16); }
__device__ __forceinline__ void unpack8(const u32x4 w, float* v) { v[0] = bflo(w.x); v[1] = bfhi(w.x); v[2] = bflo(w.y); v[3] = bfhi(w.y); v[4] = bflo(w.z); v[5] = bfhi(w.z); v[6] = bflo(w.w); v[7] = bfhi(w.w); }
__device__ __forceinline__ u32x4 pack8(const float* v) { u32x4 w; w.x = pk2(v[0], v[1]); w.y = pk2(v[2], v[3]); w.z = pk2(v[4], v[5]); w.w = pk2(v[6], v[7]); return w; }
__device__ __forceinline__ float wave_sum(float v) {
#pragma unroll
    for (int o = 1; o < 64; o <<= 1) v += __shfl_xor(v, o);
    return v;
}
__device__ __forceinline__ float wave_max(float v) {
#pragma unroll
    for (int o = 1; o < 64; o <<= 1) v = fmaxf(v, __shfl_xor(v, o));
    return v;
}
__device__ __forceinline__ float siluf(float x) { return x * __builtin_amdgcn_rcpf(1.f + __builtin_amdgcn_exp2f(-LOG2E_ * x)); }
__device__ __forceinline__ float sigmf(float x) { return __builtin_amdgcn_rcpf(1.f + __builtin_amdgcn_exp2f(-LOG2E_ * x)); }
__device__ __forceinline__ int crow(int r, int hi) { return (r & 3) + 8 * (r >> 2) + 4 * hi; }
__device__ __forceinline__ int perm_off(int p) { const int h = p >> 3, j = p & 7; return 8 * (j >> 2) + 4 * h + (j & 3); }
__device__ __forceinline__ int mod_batch(int row) { return row < M_LAT ? (row >> 12) : 4; }

namespace pg8 {
constexpr int BM = 256, BK = 64, HALF = 128, HTB = HALF * BK * 2, STAGE_BYTES = 8 * HTB, NXCD = 8, WGM = 8;
__host__ __device__ __forceinline__ int lds_byte(int r, int c) { const int st = (r >> 4) * 2 + (c >> 5), rr = r & 15, cc = c & 31, ob = rr * 64 + cc * 2; return st * 1024 + (ob ^ (((ob >> 9) & 1) << 5)); }
__host__ __device__ __forceinline__ void stage_rc(int b, int& R, int& C) { const int st = b / 1024, sb = b % 1024, swz = sb ^ (((sb >> 9) & 1) << 5); R = (st >> 1) * 16 + swz / 64; C = (st & 1) * 32 + (swz % 64) / 2; }
__host__ __device__ __forceinline__ int perm32(int rho) { const int n = rho >> 4, i = rho & 15; return 8 * (i >> 2) + 4 * n + (i & 3); }

struct Unit { int pm, pn; };
struct Gemm { const bf16_t* A; const bf16_t* Bt; int M, N, K; };

struct StaticOrder {
    int nM, nN, nwg, G, c;
    __device__ void init(int M, int N, int G_, int c_) { nM = M / BM; nN = N / BM; nwg = nM * nN; G = G_; c = c_; }
    __device__ bool next(int i, Unit& u) const {
        const long L = (long)i * G + c; if (L >= nwg) return false;
        int wgid = (int)L; { const int q = nwg / NXCD, r = nwg % NXCD, xcd = wgid % NXCD, off = wgid / NXCD; wgid = (xcd < r ? xcd * (q + 1) : r * (q + 1) + (xcd - r) * q) + off; }
        const int nig = WGM * nN, gid = wgid / nig, fm = gid * WGM, gsz = (nM - fm) < WGM ? (nM - fm) : WGM;
        u.pm = fm + ((wgid % nig) % gsz); u.pn = (wgid % nig) / gsz; return true;
    }
};

struct EpiBf16 {
    static constexpr bool PERM = true;
    bf16_t* O; int ldc; float* gates; int gate_pn;
    __device__ __forceinline__ void operator()(const f32x4 (&acc)[2][2][4][2], const Unit& u, int wr, int wc, int fr, int fq) const {
        const int row0 = u.pm * BM + wr * 64 + fr; const int col0 = u.pn * BM + wc * 32 + 8 * fq;
        const bool g = gates != nullptr && u.pn == gate_pn && wc == 0 && fq < 2;
#pragma unroll
        for (int ai = 0; ai < 2; ++ai)
#pragma unroll
            for (int m = 0; m < 4; ++m) { const int row = row0 + ai * HALF + m * 16; bf16_t* rowp = O + (size_t)row * ldc + col0;
#pragma unroll
                for (int bj = 0; bj < 2; ++bj) { const f32x4 v0 = acc[ai][bj][m][0], v1 = acc[ai][bj][m][1];
                    u32x4 w; w.x = pk2(v0[0], v0[1]); w.y = pk2(v0[2], v0[3]); w.z = pk2(v1[0], v1[1]); w.w = pk2(v1[2], v1[3]);
                    *(u32x4*)(rowp + bj * HALF) = w;
                    if (bj == 0 && g) { *(f32x4*)(gates + (size_t)row * 16 + 8 * fq) = v0; *(f32x4*)(gates + (size_t)row * 16 + 8 * fq + 4) = v1; } } }
    }
};
struct EpiSwiGLU {
    static constexpr bool PERM = true;
    bf16_t* O; int ldc;
    __device__ __forceinline__ void operator()(const f32x4 (&acc)[2][2][4][2], const Unit& u, int wr, int wc, int fr, int fq) const {
        const int row0 = u.pm * BM + wr * 64 + fr; const int col0 = u.pn * HALF + wc * 32 + 8 * fq;
#pragma unroll
        for (int ai = 0; ai < 2; ++ai)
#pragma unroll
            for (int m = 0; m < 4; ++m) { const int row = row0 + ai * HALF + m * 16;
                float o[8];
#pragma unroll
                for (int n = 0; n < 2; ++n)
#pragma unroll
                    for (int i = 0; i < 4; ++i) { const float gt = acc[ai][0][m][n][i], up = acc[ai][1][m][n][i]; o[4 * n + i] = siluf(gt) * up; }
                *(u32x4*)(O + (size_t)row * ldc + col0) = pack8(o); }
    }
};
struct EpiRes {
    static constexpr bool PERM = false;
    const float* res_lat; const float* res_ctx; float* out_lat; float* out_ctx; const float* gate;
    __device__ __forceinline__ void operator()(const f32x4 (&acc)[2][2][4][2], const Unit& u, int wr, int wc, int fr, int fq) const {
        const int row0 = u.pm * BM + wr * 64 + fr; const int col0 = u.pn * BM + wc * 32 + 4 * fq;
#pragma unroll
        for (int ai = 0; ai < 2; ++ai)
#pragma unroll
            for (int m = 0; m < 4; ++m) { const int row = row0 + ai * HALF + m * 16;
                const float* rp = row < M_LAT ? res_lat + (size_t)row * DM : res_ctx + (size_t)(row - M_LAT) * DM;
                float* op = row < M_LAT ? out_lat + (size_t)row * DM : out_ctx + (size_t)(row - M_LAT) * DM;
                const float* gp = gate + (size_t)mod_batch(row) * 6 * DM;
#pragma unroll
                for (int bj = 0; bj < 2; ++bj)
#pragma unroll
                    for (int n = 0; n < 2; ++n) { const int c = col0 + bj * HALF + n * 16;
                        const f32x4 r = *(const f32x4*)(rp + c), g = *(const f32x4*)(gp + c);
                        *(f32x4*)(op + c) = r + g * acc[ai][bj][m][n]; } }
    }
};

template <class Epi, bool ALIGN_EPI = true>
__device__ __forceinline__ void gemm_phase(LAS unsigned char* lds, const Gemm g, const StaticOrder& S, const Epi& E) {
    int tid = threadIdx.x; asm volatile("" : "+v"(tid)); const int wid = __builtin_amdgcn_readfirstlane(tid >> 6), lane = tid & 63, wr = wid >> 2, wc = wid & 3, fr = lane & 15, fq = lane >> 4;
    int K = g.K; asm volatile("" : "+s"(K)); const int nt = K / BK;
    unsigned voffA[2], voffB[2];
#pragma unroll
    for (int i = 0; i < 2; ++i) { int R, C; stage_rc(tid * 16 + i * 8192, R, C); const int Rb = Epi::PERM ? ((R & ~31) + perm32(R & 31)) : R;
        voffA[i] = (unsigned)(R * K + C) * 2u; voffB[i] = (unsigned)(Rb * K + C) * 2u; }
    const size_t kstep = (size_t)(BK * 2);
    const size_t hstep = (size_t)HALF * K * 2;
    const size_t tstep = 2 * hstep;
    const unsigned ldsw = (unsigned)wid * 1024u;
    const int aoff = lds_byte(wr * 64 + fr, fq * 8), boff = lds_byte(wc * 32 + fr, fq * 8);
#define PG8_SA(b, h) (((b) * 2 + (h)) * HTB)
#define PG8_SB(b, h) ((4 + (b) * 2 + (h)) * HTB)
#define PG8_STAGE(bufoff, gbase, voff) do { _Pragma("unroll") for (int _i = 0; _i < 2; ++_i) \
        __builtin_amdgcn_global_load_lds((const unsigned*)((const char*)(gbase) + (voff)[_i]), (LAS unsigned*)(lds + (bufoff) + ldsw + _i * 8192), 16, 0, 0); } while (0)
#define PG8_LDA(dst, b, h) do { _Pragma("unroll") for (int m = 0; m < 4; ++m) _Pragma("unroll") for (int k = 0; k < 2; ++k) dst[m][k] = *(const LAS bf16x8*)(lds + PG8_SA(b, h) + aoff + m * 2048 + k * 1024); } while (0)
#define PG8_LDB(dst, b, h) do { _Pragma("unroll") for (int n = 0; n < 2; ++n) _Pragma("unroll") for (int k = 0; k < 2; ++k) dst[n][k] = *(const LAS bf16x8*)(lds + PG8_SB(b, h) + boff + n * 2048 + k * 1024); } while (0)
#define PG8_MMA(ai, bj, At, Bt) do { __builtin_amdgcn_s_setprio(1); _Pragma("unroll") for (int m = 0; m < 4; ++m) _Pragma("unroll") for (int n = 0; n < 2; ++n) _Pragma("unroll") for (int k = 0; k < 2; ++k) \
        acc[ai][bj][m][n] = __builtin_amdgcn_mfma_f32_16x16x32_bf16(Bt[n][k], At[m][k], acc[ai][bj][m][n], 0, 0, 0); __builtin_amdgcn_s_setprio(0); } while (0)
#define PG8_WAIT_V(n) asm volatile("s_waitcnt vmcnt(" #n ")" ::: "memory")
#define PG8_WAIT_L(n) asm volatile("s_waitcnt lgkmcnt(" #n ")" ::: "memory")
#define PG8_BAR __builtin_amdgcn_s_barrier()
#define PG8_SCHED __builtin_amdgcn_sched_barrier(0)
    Unit cur, nxt; int ui = 0;
    if (!S.next(0, cur)) return;
    f32x4 acc[2][2][4][2];
#pragma unroll
    for (int a = 0; a < 2; ++a)
#pragma unroll
        for (int b = 0; b < 2; ++b)
#pragma unroll
            for (int m = 0; m < 4; ++m)
#pragma unroll
                for (int n = 0; n < 2; ++n) acc[a][b][m][n] = (f32x4){0.f, 0.f, 0.f, 0.f};
    bf16x8 At[4][2], B0[2][2], B1[2][2];
    const char* cA = (const char*)g.A + (size_t)cur.pm * tstep; const char* cB = (const char*)g.Bt + (size_t)cur.pn * tstep;
    PG8_STAGE(PG8_SB(0, 0), cB, voffB); PG8_STAGE(PG8_SB(0, 1), cB + hstep, voffB); PG8_STAGE(PG8_SA(0, 0), cA, voffA); PG8_STAGE(PG8_SA(0, 1), cA + hstep, voffA);
    if (wr == 1) PG8_BAR;
    PG8_WAIT_V(2); PG8_BAR;
    PG8_STAGE(PG8_SB(1, 0), cB + kstep, voffB); PG8_STAGE(PG8_SA(1, 0), cA + kstep, voffA); PG8_STAGE(PG8_SB(1, 1), cB + hstep + kstep, voffB);
    PG8_WAIT_V(6); PG8_BAR;
    for (;;) {
        const bool has_next = S.next(ui + 1, nxt);
        const char* nA = has_next ? (const char*)g.A + (size_t)nxt.pm * tstep : cA; const char* nB = has_next ? (const char*)g.Bt + (size_t)nxt.pn * tstep : cB;
        for (int t = 0; t < nt; t += 2) {
            const bool last = (t == nt - 2);
            const char* a1 = cA + (size_t)(t + 1) * kstep;
            const char* a2 = last ? nA : cA + (size_t)(t + 2) * kstep; const char* b2 = last ? nB : cB + (size_t)(t + 2) * kstep;
            const char* a3 = a2 + kstep; const char* b3 = b2 + kstep;
            PG8_LDB(B0, 0, 0); PG8_LDB(B1, 0, 1); PG8_SCHED; PG8_LDA(At, 0, 0); PG8_STAGE(PG8_SA(1, 1), a1 + hstep, voffA);
            PG8_WAIT_V(8); PG8_WAIT_L(0); PG8_BAR; PG8_MMA(0, 0, At, B0); PG8_MMA(0, 1, At, B1); PG8_BAR; PG8_SCHED;
            PG8_LDA(At, 0, 1); PG8_STAGE(PG8_SB(0, 0), b2, voffB); PG8_STAGE(PG8_SB(0, 1), b2 + hstep, voffB); PG8_STAGE(PG8_SA(0, 0), a2, voffA);
            PG8_WAIT_V(8); PG8_WAIT_L(0); PG8_BAR; PG8_MMA(1, 0, At, B0); PG8_MMA(1, 1, At, B1); PG8_BAR; PG8_SCHED;
            PG8_LDB(B0, 1, 0); PG8_LDB(B1, 1, 1); PG8_SCHED; PG8_LDA(At, 1, 0); PG8_STAGE(PG8_SA(0, 1), a2 + hstep, voffA);
            PG8_WAIT_V(8); PG8_WAIT_L(0); PG8_BAR; PG8_MMA(0, 0, At, B0); PG8_MMA(0, 1, At, B1); PG8_BAR; PG8_SCHED;
            PG8_LDA(At, 1, 1); PG8_STAGE(PG8_SB(1, 0), b3, voffB); PG8_STAGE(PG8_SB(1, 1), b3 + hstep, voffB); PG8_STAGE(PG8_SA(1, 0), a3, voffA);
            PG8_WAIT_V(8); PG8_WAIT_L(0); PG8_BAR; PG8_MMA(1, 0, At, B0); PG8_MMA(1, 1, At, B1); PG8_BAR; PG8_SCHED;
        }
        if constexpr (ALIGN_EPI) { if (wr == 0) PG8_BAR; }
        E(acc, cur, wr, wc, fr, fq);
        if (!has_next) break;
#pragma unroll
        for (int a = 0; a < 2; ++a)
#pragma unroll
            for (int b = 0; b < 2; ++b)
#pragma unroll
                for (int m = 0; m < 4; ++m)
#pragma unroll
                    for (int n = 0; n < 2; ++n) acc[a][b][m][n] = (f32x4){0.f, 0.f, 0.f, 0.f};
        cur = nxt; cA = nA; cB = nB; ++ui;
        if constexpr (ALIGN_EPI) { if (wr == 1) PG8_BAR; }
    }
    PG8_WAIT_V(0);
    if constexpr (!ALIGN_EPI) { if (wr == 0) PG8_BAR; }
    PG8_BAR;
#undef PG8_SA
#undef PG8_SB
#undef PG8_STAGE
#undef PG8_LDA
#undef PG8_LDB
#undef PG8_MMA
#undef PG8_WAIT_V
#undef PG8_WAIT_L
#undef PG8_BAR
#undef PG8_SCHED
}
}


#define XB_TMO      128
#define XB_XCNT(j)  (256  + 64 * (j))
#define XB_XSUB(j)  (1280 + 64 * (j))
#define XB_XGEN(j)  (2304 + 64 * (j))
#define XB_TOP      3328
#define XB_TOPGEN   3392
#define XCD_BAR_WORDS 3456
#define XB_SPIN_CAP (1u << 22)
__device__ __forceinline__ unsigned xb_ld(unsigned* p)              { return __hip_atomic_load(p, __ATOMIC_RELAXED, __HIP_MEMORY_SCOPE_AGENT); }
__device__ __forceinline__ unsigned xb_add(unsigned* p, unsigned v) { return __hip_atomic_fetch_add(p, v, __ATOMIC_RELAXED, __HIP_MEMORY_SCOPE_AGENT); }
__device__ __forceinline__ unsigned xb_xcc_id() { return (unsigned)__builtin_amdgcn_s_getreg((3 << 11) | 20) & 0xFu; }
#define XB_SPIN(cond, bar) do { unsigned _sp = 0; while (cond) { __builtin_amdgcn_s_sleep(1); \
    if ((++_sp & 255u) == 0u) { if (xb_ld(&(bar)[XB_TMO])) break; if (_sp > XB_SPIN_CAP) { atomicAdd(&(bar)[XB_TMO], 1u); break; } } } } while (0)
struct XcdBarrier { unsigned* bar; unsigned x; volatile LAS unsigned* st; };
__device__ __forceinline__ XcdBarrier xcd_barrier_post(unsigned* bar, volatile LAS unsigned* st) {
    XcdBarrier b; b.bar = bar; b.x = xb_xcc_id(); b.st = st;
    if (threadIdx.x == 0) (void)xb_add(&bar[XB_XCNT(b.x)], 1u);
    return b;
}
__device__ __forceinline__ void xcd_barrier_complete(unsigned* bar, unsigned x, unsigned& nloc, unsigned& nx) {
    const unsigned G = gridDim.x * gridDim.y * gridDim.z;
    unsigned sum, cnt, mine, sp = 0u;
    for (;;) {
        sum = 0u; cnt = 0u; mine = 0u;
#pragma unroll
        for (unsigned j = 0; j < 16; ++j) { const unsigned c = xb_ld(&bar[XB_XCNT(j)]); sum += c; cnt += (c > 0u) ? 1u : 0u; mine = (j == x) ? c : mine; }
        if (sum == G) break;
        __builtin_amdgcn_s_sleep(1);
        if ((++sp & 255u) == 0u) { if (xb_ld(&bar[XB_TMO])) break; if (sp > XB_SPIN_CAP) { atomicAdd(&bar[XB_TMO], 1u); break; } }
    }
    nloc = mine > 0u ? mine : 1u; nx = cnt > 0u ? cnt : 1u;
}
__device__ __forceinline__ void xcd_barrier(unsigned char* wsb) {
    XcdBarrier b; b.bar = (unsigned*)(wsb + WS_BAR); b.x = 0; b.st = (volatile LAS unsigned*)(135168 + 64);
    asm volatile("s_waitcnt vmcnt(0)" ::: "memory");
    __syncthreads();
    if (threadIdx.x == 0) {
        unsigned* bar = b.bar; b.x = xb_xcc_id();
        __builtin_amdgcn_s_waitcnt(0);
        unsigned nloc = b.st[0], nx = b.st[1];
        if (nloc == 0u) { xcd_barrier_complete(bar, b.x, nloc, nx); b.st[0] = nloc; b.st[1] = nx; }
        const unsigned old = xb_add(&bar[XB_XSUB(b.x)], 1u);
        const unsigned gen = old / nloc;
        if (old + 1u == (gen + 1u) * nloc) {
            __builtin_amdgcn_fence(__ATOMIC_RELEASE, "agent");
            asm volatile("s_waitcnt vmcnt(0)" ::: "memory");
            const unsigned og = xb_add(&bar[XB_TOP], 1u);
            const unsigned tg = og / nx;
            if (og + 1u == (tg + 1u) * nx) xb_add(&bar[XB_TOPGEN], 1u);
            else XB_SPIN(xb_ld(&bar[XB_TOPGEN]) == tg, bar);
            __builtin_amdgcn_fence(__ATOMIC_ACQUIRE, "agent");
            xb_add(&bar[XB_XGEN(b.x)], 1u);
            asm volatile("s_waitcnt vmcnt(0)" ::: "memory");
        } else {
            XB_SPIN(xb_ld(&bar[XB_XGEN(b.x)]) == gen, bar);
            __builtin_amdgcn_fence(__ATOMIC_ACQUIRE, "agent");
            asm volatile("s_waitcnt vmcnt(0)" ::: "memory");
        }
    }
    __syncthreads();
}

struct Params { const float* in[24]; float* out; unsigned char* ws; };
struct PRef {
    typedef const __attribute__((address_space(4))) char* kptr_t;
    __device__ __forceinline__ kptr_t base() const { kptr_t ka = (kptr_t)__builtin_amdgcn_kernarg_segment_ptr(); asm volatile("" : "+s"(ka)); return ka; }
    __device__ __forceinline__ const float* in(int i) const { return *(const float* const __attribute__((address_space(4)))*)(base() + 8 * i); }
    __device__ __forceinline__ float* out() const { return *(float* const __attribute__((address_space(4)))*)(base() + 8 * 24); }
    __device__ __forceinline__ unsigned char* ws() const { return *(unsigned char* const __attribute__((address_space(4)))*)(base() + 8 * 25); }
};
enum { I_X = 0, I_C, I_CTX, I_CCTX, I_MODW, I_MODB, I_N1G, I_N2G, I_WIN, I_DAQKG, I_DALAM, I_DAOUTG, I_CONVW, I_CONVB, I_GATEB, I_MLOUTG, I_QNG, I_KVNG, I_WUQ, I_WUKV, I_MLAQKG, I_WOUT, I_WGU, I_WDN };

struct Ctx {
    unsigned char* lds;
    int tid, lane, wave, gw, ngw, nwg, wg; unsigned l3off;
};

__device__ __forceinline__ Ctx fresh(const Ctx& X) {
    Ctx Y = X; int t = X.tid; asm volatile("" : "+v"(t)); Y.tid = t; Y.lane = t & 63; Y.wave = __builtin_amdgcn_readfirstlane(t >> 6); return Y;
}
template <int MODE>
__device__ __forceinline__ void transpose_item(const float* W, int K, int N, bf16_t* WT, float* scr, int item, int nblk, int lane) {
    const int kb = item / nblk, nb = item % nblk, k0 = 64 * kb, n0 = 32 * nb;
    const int ncol = n0 + (lane & 31); const bool ok = ncol < N;
#pragma unroll 8
    for (int i = 0; i < 32; ++i) { const int kk = 2 * i + (lane >> 5); scr[kk * 33 + (lane & 31)] = ok ? W[(size_t)(k0 + kk) * N + ncol] : 0.f; }
    asm volatile("s_waitcnt lgkmcnt(0)" ::: "memory");
    const int c = lane & 7;
#pragma unroll
    for (int j = 0; j < 4; ++j) { const int n = (lane >> 3) + 8 * j; const float* s = scr + (8 * c) * 33 + n;
        u32x4 o; o.x = pk2(s[0 * 33], s[1 * 33]); o.y = pk2(s[2 * 33], s[3 * 33]); o.z = pk2(s[4 * 33], s[5 * 33]); o.w = pk2(s[6 * 33], s[7 * 33]);
        int nn = n0 + n;
        if (MODE == 1) { const int up = nn >= FF ? 1 : 0; const int hcol = nn - up * FF; nn = (hcol >> 7) * 256 + up * 128 + (hcol & 127); }
        *(u32x4*)(WT + (size_t)nn * K + k0 + 8 * c) = o; }
    asm volatile("s_waitcnt lgkmcnt(0)" ::: "memory");
}
__device__ __forceinline__ void convert_weights(const Ctx& X0, const PRef& P, int l) {
    const Ctx X = fresh(X0);
    float* scr = (float*)(X.lds + X.wave * 16384);
    unsigned char* ws = P.ws();
    constexpr int I_IN = (DM / 64) * (NPROJ / 32), I_OUT = (DM / 64) * (DM / 32), I_GU = (DM / 64) * (2 * FF / 32), I_DN = (FF / 64) * (DM / 32), I_UQ = (512 / 64) * (1536 / 32), I_UKV = (256 / 64) * (2048 / 32);
    constexpr int NITEMS = I_IN + I_OUT + I_GU + I_DN + I_UQ + I_UKV;
    for (int it = X.gw; it < NITEMS; it += X.ngw) {
        int r = it;
        if (r < I_IN) { transpose_item<0>(P.in(I_WIN) + (size_t)l * DM * IN_W, DM, IN_W, (bf16_t*)(ws + WS_WIN), scr, r, NPROJ / 32, X.lane); continue; } r -= I_IN;
        if (r < I_OUT) { transpose_item<0>(P.in(I_WOUT) + (size_t)l * DM * DM, DM, DM, (bf16_t*)(ws + WS_WOUT), scr, r, DM / 32, X.lane); continue; } r -= I_OUT;
        if (r < I_GU) { transpose_item<1>(P.in(I_WGU) + (size_t)l * DM * 2 * FF, DM, 2 * FF, (bf16_t*)(ws + WS_WGU), scr, r, 2 * FF / 32, X.lane); continue; } r -= I_GU;
        if (r < I_DN) { transpose_item<0>(P.in(I_WDN) + (size_t)l * FF * DM, FF, DM, (bf16_t*)(ws + WS_WDN), scr, r, DM / 32, X.lane); continue; } r -= I_DN;
        if (r < I_UQ) { transpose_item<0>(P.in(I_WUQ) + (size_t)l * 512 * 1536, 512, 1536, (bf16_t*)(ws + WS_WUQ), scr, r, 1536 / 32, X.lane); continue; } r -= I_UQ;
        transpose_item<0>(P.in(I_WUKV) + (size_t)l * 256 * 2048, 256, 2048, (bf16_t*)(ws + WS_WUKV), scr, r, 2048 / 32, X.lane);
    }
}
__device__ __forceinline__ void mod_gemv(const Ctx& X0, const PRef& P) {
    const Ctx X = fresh(X0);
    float* sc = (float*)X.lds;
    float* red = (float*)(X.lds + 40960);
    for (int i = X.tid; i < 5 * DM; i += 512) { const int mb = i / DM, k = i % DM; const float v = mb < 4 ? P.in(I_C)[mb * DM + k] : P.in(I_CCTX)[k]; sc[i] = siluf(v); }
    __syncthreads();
    float* mod = (float*)(P.ws() + WS_MOD);
    const int kq = X.tid >> 4, c4 = X.tid & 15;
    for (int task = X.wg; task < DEPTH * 192; task += X.nwg) {
        const int l = task / 192, n0 = (task % 192) * 64;
        const float* W = P.in(I_MODW) + (size_t)l * DM * 6 * DM + n0 + 4 * c4;
        f32x4 a[5];
#pragma unroll
        for (int mb = 0; mb < 5; ++mb) a[mb] = (f32x4){0.f, 0.f, 0.f, 0.f};
#pragma unroll 8
        for (int i = 0; i < 64; ++i) { const int k = kq + 32 * i; const f32x4 w = *(const f32x4*)(W + (size_t)k * 6 * DM);
#pragma unroll
            for (int mb = 0; mb < 5; ++mb) a[mb] += w * sc[mb * DM + k]; }
#pragma unroll
        for (int mb = 0; mb < 5; ++mb) *(f32x4*)(red + (kq * 5 + mb) * 64 + 4 * c4) = a[mb];
        __syncthreads();
        if (X.tid < 320) { const int mb = X.tid >> 6, cc = X.tid & 63; float s = 0.f;
#pragma unroll 8
            for (int q = 0; q < 32; ++q) s += red[(q * 5 + mb) * 64 + cc];
            mod[((size_t)l * 5 + mb) * 6 * DM + n0 + cc] = s + P.in(I_MODB)[(size_t)l * 6 * DM + n0 + cc]; }
        __syncthreads();
    }
}

__device__ __forceinline__ void modulate_phase(const Ctx& X0, const float* src_lat, const float* src_ctx, const float* g, const float* modl, int shift_off, int scale_off, bf16_t* A, int nrows) {
    const Ctx X = fresh(X0);
    const int rpw = (nrows + X.ngw - 1) / X.ngw;
    int row = X.gw * rpw; const int rend = min(row + rpw, nrows);
    f32x4 v[8], nx[8], gm[8], sh[8];
    int cur_mb = -1;
    if (row < rend) { const float* src = row < M_LAT ? src_lat + (size_t)row * DM : src_ctx + (size_t)(row - M_LAT) * DM;
#pragma unroll
        for (int j = 0; j < 8; ++j) v[j] = *(const f32x4*)(src + X.lane * 4 + 256 * j); }
    for (; row < rend; ++row) {
        const int nrow = row + 1;
        if (nrow < rend) { const float* src = nrow < M_LAT ? src_lat + (size_t)nrow * DM : src_ctx + (size_t)(nrow - M_LAT) * DM;
#pragma unroll
            for (int j = 0; j < 8; ++j) nx[j] = *(const f32x4*)(src + X.lane * 4 + 256 * j); }
        const int mb = mod_batch(row);
        if (mb != cur_mb) { cur_mb = mb; const float* mp = modl + (size_t)mb * 6 * DM;
#pragma unroll
            for (int j = 0; j < 8; ++j) { const int col = X.lane * 4 + 256 * j; gm[j] = *(const f32x4*)(g + col) * (*(const f32x4*)(mp + scale_off + col) + 1.0f); sh[j] = *(const f32x4*)(mp + shift_off + col); } }
        float ss = 0.f;
#pragma unroll
        for (int j = 0; j < 8; ++j) ss += (v[j][0] * v[j][0] + v[j][1] * v[j][1]) + (v[j][2] * v[j][2] + v[j][3] * v[j][3]);
        const float rstd = rsqrtf(wave_sum(ss) * (1.f / DM) + EPS);
#pragma unroll
        for (int j = 0; j < 8; ++j) { const int col = X.lane * 4 + 256 * j;
            const f32x4 y = (v[j] * rstd) * gm[j] + sh[j];
            u32x2 w; w.x = pk2(y[0], y[1]); w.y = pk2(y[2], y[3]);
            *(u32x2*)(A + (size_t)row * DM + col) = w; }
#pragma unroll
        for (int j = 0; j < 8; ++j) v[j] = nx[j];
    }
}

struct ChunkId { int b, j, row0, tok0, is_lat, seglen; };
__device__ __forceinline__ ChunkId chunk_of_unit(int u) {
    ChunkId c;
    if (u < 256) { c.b = u >> 6; c.j = u & 63; c.row0 = c.b * SEQ + 64 * c.j; c.tok0 = CTXL + 64 * c.j; c.is_lat = 1; c.seglen = SEQ; }
    else { const int uu = u - 256; c.b = uu >> 2; c.j = uu & 3; c.row0 = M_LAT + c.b * CTXL + 64 * c.j; c.tok0 = 64 * c.j; c.is_lat = 0; c.seglen = CTXL; }
    return c;
}
__device__ __forceinline__ int row_of_tokchunk(int b, int jt) { return jt < 4 ? M_LAT + b * CTXL + 64 * jt : b * SEQ + 64 * (jt - 4); }

constexpr int TSTR = 520;
__device__ __forceinline__ void write_vt(const Ctx& X, const bf16_t* tile, bf16_t* img, size_t img_row0, int tok0) {
#pragma unroll 2
    for (int it = 0; it < 8; ++it) { const int task = it * 512 + X.tid; const int k = task & 7, c = task >> 3;
        float v[8];
#pragma unroll
        for (int jj = 0; jj < 8; ++jj) { const int i = 16 * (k >> 1) + 8 * (jj >> 2) + 4 * (k & 1) + (jj & 3); v[jj] = bf1(tile[i * TSTR + c]); }
        *(u32x4*)(img + (img_row0 + c) * TK + tok0 + 8 * k) = pack8(v); }
}
template <class F>
__device__ __forceinline__ void load_tile(const Ctx& X, bf16_t* tile, const bf16_t* src, size_t rstride, F colmap) {
#pragma unroll 4
    for (int it = 0; it < 8; ++it) { const int ch = it * 512 + X.tid; const int i = ch >> 6, cc = ch & 63;
        const u32x4 w = *(const u32x4*)(src + (size_t)i * rstride + colmap(cc));
        *(u32x4*)(tile + i * TSTR + 8 * cc) = w; }
}

__device__ __forceinline__ void rope_cs(int sub, int prow, int pcol, float* cs, float* sn) {
    const float pos = (float)((sub < 4) ? prow : pcol);
#pragma unroll
    for (int e = 0; e < 8; ++e) { const int fi = (sub & 1) * 8 + e; const float inv = exp2f(-(float)fi * (13.287712379549449f / 16.0f)); const float a = pos * inv; cs[e] = __cosf(a); sn[e] = __sinf(a); }
}
__device__ __forceinline__ void rope_apply(int sub, float* y, const float* cs, const float* sn) {
#pragma unroll
    for (int e = 0; e < 8; ++e) { const float p = __shfl_xor(y[e], 2); y[e] = (sub & 2) ? (y[e] * cs[e] + p * sn[e]) : (y[e] * cs[e] - p * sn[e]); }
}

__device__ __forceinline__ void prep_phase(const Ctx& X0, const PRef& P, int l) {
    const Ctx X = fresh(X0);
    unsigned char* ws = P.ws();
    const bf16_t* proj = (const bf16_t*)(ws + WS_PROJ);
    bf16_t* tile = (bf16_t*)X.lds;
    const float* qkg = P.in(I_DAQKG) + l * 128;
    const float* convw = P.in(I_CONVW) + (size_t)l * 3 * 1024; const float* convb = P.in(I_CONVB) + l * 1024;
    const float* qng = P.in(I_QNG) + l * 512; const float* kvng = P.in(I_KVNG) + l * 256;
    const int lane = X.lane, sub = lane & 7;
    const float qscale = 0.125f * LOG2E;
    for (int uu = X.wg; uu < 4 * 272; uu += X.nwg) {
        const int part = uu / 272, u = uu % 272;
        const ChunkId c = chunk_of_unit(u);
        if (part == 0) {
        for (int i = X.wave; i < 64; i += 8) {
            const int row = c.row0 + i, tok = c.tok0 + i;
            const bf16_t* pr = proj + (size_t)row * NPROJ;
            float cs[8], sn[8];
            if (c.is_lat) rope_cs(sub, c.j, i, cs, sn);
#pragma unroll
            for (int qk = 0; qk < 2; ++qk) {
                float y[8]; unpack8(*(const u32x4*)(pr + (qk ? C_DAK : C_DAQ) + 8 * lane), y);
                float ss = 0.f;
#pragma unroll
                for (int e = 0; e < 8; ++e) ss += y[e] * y[e];
                ss += __shfl_xor(ss, 1); ss += __shfl_xor(ss, 2); ss += __shfl_xor(ss, 4);
                const float rstd = rsqrtf(ss * (1.f / 64.f) + EPS);
#pragma unroll
                for (int e = 0; e < 8; ++e) y[e] = y[e] * rstd * qkg[qk * 64 + 8 * sub + e];
                if (c.is_lat) rope_apply(sub, y, cs, sn);
                const int head = lane >> 4, comp = (lane >> 3) & 1;
                if (qk == 0) {
#pragma unroll
                    for (int e = 0; e < 8; ++e) y[e] *= qscale;
                    *(u32x4*)((bf16_t*)(ws + WS_QDA) + ((size_t)head * M_ALL + row) * 128 + comp * 64 + 8 * sub) = pack8(y);
                } else {
                    *(u32x4*)((bf16_t*)(ws + WS_KDA) + ((size_t)(c.b * 4 + head) * TK + tok) * 128 + comp * 64 + 8 * sub) = pack8(y);
                }
            }
            {
                float y[8]; unpack8(*(const u32x4*)(pr + C_CQ + 8 * lane), y);
                float ss = 0.f;
#pragma unroll
                for (int e = 0; e < 8; ++e) ss += y[e] * y[e];
                const float rstd = rsqrtf(wave_sum(ss) * (1.f / 512.f) + EPS);
#pragma unroll
                for (int e = 0; e < 8; ++e) y[e] = y[e] * rstd * qng[8 * lane + e];
                *(u32x4*)((bf16_t*)(ws + WS_CQN) + (size_t)row * 512 + 8 * lane) = pack8(y);
            }
            {
                float y[8];
                if (lane < 32) unpack8(*(const u32x4*)(pr + C_CKV + 8 * lane), y);
                else {
#pragma unroll
                    for (int e = 0; e < 8; ++e) y[e] = 0.f;
                }
                float ss = 0.f;
#pragma unroll
                for (int e = 0; e < 8; ++e) ss += y[e] * y[e];
                const float rstd = rsqrtf(wave_sum(ss) * (1.f / 256.f) + EPS);
                if (lane < 32) {
#pragma unroll
                    for (int e = 0; e < 8; ++e) y[e] = y[e] * rstd * kvng[8 * lane + e];
                    *(u32x4*)((bf16_t*)(ws + WS_CKVN) + (size_t)row * 256 + 8 * lane) = pack8(y);
                }
            }
            if (lane < 8) *(u32x4*)((bf16_t*)(ws + WS_KPE) + (size_t)row * 64 + 8 * lane) = *(const u32x4*)(pr + C_KPE + 8 * lane);
            *(u32x4*)((bf16_t*)(ws + WS_OCOPY) + (size_t)row * 512 + 8 * lane) = *(const u32x4*)(pr + C_MLO + 8 * lane);
        }
        } else if (part == 1) {
        for (int i = X.wave; i < 64; i += 8) {
            const int row = c.row0 + i, tseg = 64 * c.j + i, tok = c.tok0 + i;
            const bf16_t* pr = proj + (size_t)row * NPROJ;
#pragma unroll
            for (int qk = 0; qk < 2; ++qk) {
                const int ch0 = qk * 512 + 8 * lane;
                float xm[8], x0[8], xp[8];
                unpack8(*(const u32x4*)(pr + C_MLQ + ch0), x0);
                if (tseg > 0) unpack8(*(const u32x4*)(pr - NPROJ + C_MLQ + ch0), xm);
                else {
#pragma unroll
                    for (int e = 0; e < 8; ++e) xm[e] = 0.f;
                }
                if (tseg < c.seglen - 1) unpack8(*(const u32x4*)(pr + NPROJ + C_MLQ + ch0), xp);
                else {
#pragma unroll
                    for (int e = 0; e < 8; ++e) xp[e] = 0.f;
                }
                float y[8];
#pragma unroll
                for (int e = 0; e < 8; ++e) { const float v = convb[ch0 + e] + convw[ch0 + e] * xm[e] + convw[1024 + ch0 + e] * x0[e] + convw[2048 + ch0 + e] * xp[e]; y[e] = siluf(v) * (qk ? 0.08838834764831845f : 1.0f); }
                const int head = lane >> 4, d = 8 * (lane & 15);
                const u32x4 w = pack8(y);
                *(u32x4*)((bf16_t*)(ws + (qk ? WS_KML : WS_QML)) + ((size_t)(c.b * 4 + head) * TK + tok) * 128 + d) = w;
                if (qk) *(u32x4*)(tile + i * TSTR + 8 * lane) = w;
            }
        }
        __syncthreads();
        write_vt(X, tile, (bf16_t*)(ws + WS_KTML), (size_t)c.b * 512, c.tok0);
        __syncthreads();
        } else if (part == 2) {
        load_tile(X, tile, proj + (size_t)c.row0 * NPROJ, NPROJ, [](int cc) { return C_DAV + 8 * cc; });
        __syncthreads();
        write_vt(X, tile, (bf16_t*)(ws + WS_VTDA), (size_t)c.b * 512, c.tok0);
        __syncthreads();
        } else {
        load_tile(X, tile, proj + (size_t)c.row0 * NPROJ, NPROJ, [](int cc) { return C_MLV + 8 * cc; });
        __syncthreads();
        write_vt(X, tile, (bf16_t*)(ws + WS_VTML), (size_t)c.b * 512, c.tok0);
        __syncthreads();
        }
    }
}

__device__ __forceinline__ void mla_prep_phase(const Ctx& X0, const PRef& P, int l) {
    const Ctx X = fresh(X0);
    unsigned char* ws = P.ws();
    const bf16_t* qup = (const bf16_t*)(ws + WS_QUP); const bf16_t* kvup = (const bf16_t*)(ws + WS_KVUP); const bf16_t* kpe = (const bf16_t*)(ws + WS_KPE);
    bf16_t* tile = (bf16_t*)X.lds;
    const float* g = P.in(I_MLAQKG) + l * 2 * 192;
    const int lane = X.lane, sub = lane & 7, head = lane >> 3;
    const float qscale = 0.07216878364870322f * LOG2E;
    for (int uu = X.wg; uu < 3 * 272; uu += X.nwg) {
        const int part = uu / 272, u = uu % 272;
        const ChunkId c = chunk_of_unit(u);
        if (part == 0) {
        for (int i = X.wave; i < 64; i += 8) {
            const int row = c.row0 + i, tok = c.tok0 + i;
            float cs[8], sn[8];
            if (c.is_lat) rope_cs(sub, c.j, i, cs, sn);
#pragma unroll
            for (int qk = 0; qk < 2; ++qk) {
                float y[3][8];
                if (qk == 0) {
#pragma unroll
                    for (int cc = 0; cc < 3; ++cc) unpack8(*(const u32x4*)(qup + (size_t)row * 1536 + head * 192 + 64 * cc + 8 * sub), y[cc]);
                } else {
#pragma unroll
                    for (int cc = 0; cc < 2; ++cc) unpack8(*(const u32x4*)(kvup + (size_t)row * 2048 + head * 256 + 64 * cc + 8 * sub), y[cc]);
                    unpack8(*(const u32x4*)(kpe + (size_t)row * 64 + 8 * sub), y[2]);
                }
                float ss = 0.f;
#pragma unroll
                for (int cc = 0; cc < 3; ++cc)
#pragma unroll
                    for (int e = 0; e < 8; ++e) ss += y[cc][e] * y[cc][e];
                ss += __shfl_xor(ss, 1); ss += __shfl_xor(ss, 2); ss += __shfl_xor(ss, 4);
                const float rstd = rsqrtf(ss * (1.f / 192.f) + EPS);
#pragma unroll
                for (int cc = 0; cc < 3; ++cc)
#pragma unroll
                    for (int e = 0; e < 8; ++e) y[cc][e] = y[cc][e] * rstd * g[qk * 192 + 64 * cc + 8 * sub + e];
                if (c.is_lat) rope_apply(sub, y[2], cs, sn);
                bf16_t* dst;
                if (qk == 0) {
#pragma unroll
                    for (int cc = 0; cc < 3; ++cc)
#pragma unroll
                        for (int e = 0; e < 8; ++e) y[cc][e] *= qscale;
                    dst = (bf16_t*)(ws + WS_QM) + ((size_t)head * M_ALL + row) * 192;
                } else dst = (bf16_t*)(ws + WS_KM) + ((size_t)(c.b * 8 + head) * TK + tok) * 192;
#pragma unroll
                for (int cc = 0; cc < 3; ++cc) *(u32x4*)(dst + 64 * cc + 8 * sub) = pack8(y[cc]);
            }
        }
        } else {
            const int p = part - 1;
            load_tile(X, tile, kvup + (size_t)c.row0 * 2048, 2048, [p](int cc) { return (4 * p + (cc >> 4)) * 256 + 128 + 8 * (cc & 15); });
            __syncthreads();
            write_vt(X, tile, (bf16_t*)(ws + WS_VTM), (size_t)(c.b * 8 + 4 * p) * 128, c.tok0);
            __syncthreads();
        }
    }
}

__device__ __forceinline__ void ml_gates(const float* gates, const float* gb, int b, int jt, int dir, int h, int lane, float& ig, float& lf, float& pre, float& total) {
    const int row = row_of_tokchunk(b, jt) + lane;
    ig = gates[(size_t)row * 16 + dir * 8 + h] + gb[dir * 8 + h];
    const float fg = gates[(size_t)row * 16 + dir * 8 + 4 + h] + gb[dir * 8 + 4 + h];
    lf = fminf(fg, 0.f) - log1pf(__expf(-fabsf(fg)));
    float s = lf;
#pragma unroll
    for (int o = 1; o < 64; o <<= 1) { const float t = __shfl_up(s, o); if (lane >= o) s += t; }
    pre = s; total = __shfl(s, 63);
}
constexpr int KSTR = 72;
constexpr int QSTR = 136;
__device__ __forceinline__ void mlstm_a_phase(const Ctx& X0, const PRef& P, int l) {
    const Ctx X = fresh(X0);
    unsigned char* ws = P.ws();
    const float* gates = (const float*)(ws + WS_GATES); const float* gb = P.in(I_GATEB) + l * 16;
    bf16_t* Kt = (bf16_t*)X.lds;
    bf16_t* Vw = (bf16_t*)(X.lds + 128 * KSTR * 2);
    float* wtab = (float*)(X.lds + 3 * 128 * KSTR * 2);
    const int lane = X.lane, r32 = lane & 31, hi = lane >> 5;
    for (int u = X.wg; u < 16 * NCH; u += X.nwg) {
        const int bh = u / NCH, jt = u % NCH, b = bh >> 2, h = bh & 3, tok0 = 64 * jt;
        if (X.wave < 2) {
            const int dir = X.wave; float ig, lf, pre, total; ml_gates(gates, gb, b, jt, dir, h, lane, ig, lf, pre, total);
            const float cum = dir == 0 ? pre : total - pre + lf;
            const float wlog = total - cum + ig; const float mloc = wave_max(wlog);
            wtab[dir * 64 + lane] = __expf(wlog - mloc);
            if (lane == 0) { float* cs = (float*)(ws + WS_CSTAT) + ((size_t)(bh * 2 + dir) * NCH + jt) * 4; cs[0] = total; cs[1] = mloc; }
        }
        u32x4 vr[2];
#pragma unroll
        for (int it = 0; it < 2; ++it) { const int ch = it * 512 + X.tid; const int rr = ch >> 3, k = ch & 7;
            *(u32x4*)(Kt + rr * KSTR + 8 * k) = *(const u32x4*)((const bf16_t*)(ws + WS_KTML) + ((size_t)bh * 128 + rr) * TK + tok0 + 8 * k);
            vr[it] = *(const u32x4*)((const bf16_t*)(ws + WS_VTML) + ((size_t)bh * 128 + rr) * TK + tok0 + 8 * k); }
        __syncthreads();
#pragma unroll
        for (int it = 0; it < 2; ++it) { const int ch = it * 512 + X.tid; const int rr = ch >> 3, k = ch & 7;
            float v[8]; unpack8(vr[it], v);
#pragma unroll
            for (int dir = 0; dir < 2; ++dir) { float o[8];
#pragma unroll
                for (int jj = 0; jj < 8; ++jj) { const int i = 16 * (k >> 1) + 8 * (jj >> 2) + 4 * (k & 1) + (jj & 3); o[jj] = v[jj] * wtab[dir * 64 + i]; }
                *(u32x4*)(Vw + (dir * 128 + rr) * KSTR + 8 * k) = pack8(o); } }
        __syncthreads();
        {
            const int dir = X.wave >> 2, dvb = X.wave & 3;
            bf16_t* U = (bf16_t*)(ws + WS_AB) + ((size_t)(bh * 2 + dir) * NCH + jt) * 16384;
            bf16x8 a[4];
#pragma unroll
            for (int ks = 0; ks < 4; ++ks) a[ks] = *(const bf16x8*)(Vw + (dir * 128 + 32 * dvb + r32) * KSTR + 16 * ks + 8 * hi);
            for (int dkb = 0; dkb < 4; ++dkb) {
                f32x16 acc;
#pragma unroll
                for (int r = 0; r < 16; ++r) acc[r] = 0.f;
#pragma unroll
                for (int ks = 0; ks < 4; ++ks) { const bf16x8 bb = *(const bf16x8*)(Kt + (32 * dkb + r32) * KSTR + 16 * ks + 8 * hi); acc = __builtin_amdgcn_mfma_f32_32x32x16_bf16(a[ks], bb, acc, 0, 0, 0); }
#pragma unroll
                for (int r = 0; r < 16; ++r) U[(32 * dvb + crow(r, hi)) * 128 + 32 * dkb + r32] = (bf16_t)(pk2(acc[r], 0.f) & 0xffffu);
            }
        }
        if (X.tid < 256) { const int dir = X.tid >> 7, dk = X.tid & 127; float s = 0.f;
#pragma unroll 8
            for (int p = 0; p < 64; ++p) { const int i = (p & ~15) + perm_off(p & 15); s += wtab[dir * 64 + i] * bf1(Kt[dk * KSTR + p]); }
            ((float*)(ws + WS_NU))[((size_t)(bh * 2 + dir) * NCH + jt) * 128 + dk] = s; }
        __syncthreads();
    }
}
__device__ __forceinline__ int ml_jmap(int dir, int c) { return dir == 0 ? c : (c < 4 ? 3 - c : 71 - c); }
__device__ __forceinline__ void mlstm_scan_phase(const Ctx& X0, const PRef& P) {
    const Ctx X = fresh(X0);
    unsigned char* ws = P.ws();
    float* cstat = (float*)(ws + WS_CSTAT);
    const int gtid = X.wg * 512 + X.tid, nthr = X.nwg * 512;
    for (int task = gtid; task < 65536 + 1024; task += nthr) {
        float m = 0.f;
        if (task < 65536) {
            const int seq = task >> 11, e = task & 2047, dir = seq & 1;
            const bf16_t* __restrict__ U = (const bf16_t*)(ws + WS_AB); bf16_t* __restrict__ S = (bf16_t*)(ws + WS_CSNAP);
            float C[8];
#pragma unroll
            for (int i = 0; i < 8; ++i) C[i] = 0.f;
            for (int cb = 0; cb < 4; ++cb) {
                u32x4 uu[17]; float tot[17], mlc[17];
#pragma unroll
                for (int i = 0; i < 17; ++i) { const size_t base = (size_t)seq * NCH + ml_jmap(dir, cb * 17 + i);
                    uu[i] = *(const u32x4*)(U + base * 16384 + 8 * e); tot[i] = cstat[base * 4]; mlc[i] = cstat[base * 4 + 1]; }
#pragma unroll
                for (int i = 0; i < 17; ++i) { const size_t base = (size_t)seq * NCH + ml_jmap(dir, cb * 17 + i);
                    *(u32x4*)(S + base * 16384 + 8 * e) = pack8(C);
                    if (e == 0) cstat[base * 4 + 2] = m;
                    const float mn = fmaxf(tot[i] + m, mlc[i]); const float dec = __expf(tot[i] + m - mn), sc = __expf(mlc[i] - mn);
                    float u8[8]; unpack8(uu[i], u8);
#pragma unroll
                    for (int q = 0; q < 8; ++q) C[q] = C[q] * dec + u8[q] * sc;
                    m = mn; }
            }
        } else {
            const int t2 = task - 65536, seq = t2 >> 5, e4 = t2 & 31, dir = seq & 1;
            const float* __restrict__ NU = (const float*)(ws + WS_NU); float* __restrict__ NS = (float*)(ws + WS_NSNAP);
            f32x4 C = (f32x4){0.f, 0.f, 0.f, 0.f};
            for (int cb = 0; cb < 4; ++cb) {
                f32x4 uu[17]; float tot[17], mlc[17];
#pragma unroll
                for (int i = 0; i < 17; ++i) { const size_t base = (size_t)seq * NCH + ml_jmap(dir, cb * 17 + i);
                    uu[i] = *(const f32x4*)(NU + base * 128 + 4 * e4); tot[i] = cstat[base * 4]; mlc[i] = cstat[base * 4 + 1]; }
#pragma unroll
                for (int i = 0; i < 17; ++i) { const size_t base = (size_t)seq * NCH + ml_jmap(dir, cb * 17 + i);
                    *(f32x4*)(NS + base * 128 + 4 * e4) = C;
                    const float mn = fmaxf(tot[i] + m, mlc[i]); const float dec = __expf(tot[i] + m - mn), sc = __expf(mlc[i] - mn);
                    C = C * dec + uu[i] * sc; m = mn; }
            }
        }
    }
}
__device__ __forceinline__ void mlstm_c_unit(const Ctx& X0, const PRef& P, int l, int u) {
    const Ctx X = fresh(X0);
    unsigned char* ws = P.ws();
    const float* gates = (const float*)(ws + WS_GATES); const float* gb = P.in(I_GATEB) + l * 16;
    const float* cstat = (const float*)(ws + WS_CSTAT);
    bf16_t* Qt = (bf16_t*)X.lds;
    bf16_t* Kn = (bf16_t*)(X.lds + 64 * QSTR * 2);
    bf16_t* Vt = (bf16_t*)(X.lds + 2 * 64 * QSTR * 2);
    float* tab = (float*)(X.lds + 2 * 64 * QSTR * 2 + 128 * KSTR * 2);
    float* t_a = tab, *t_c1 = tab + 128, *t_wp = tab + 256, *t_em = tab + 384, *t_n = tab + 512, *t_red = tab + 768;
    const int lane = X.lane, r32 = lane & 31, hi = lane >> 5;
    const int bh = u / NCH, jt = u % NCH, b = bh >> 2, h = bh & 3, tok0 = 64 * jt;
    if (X.wave < 2) {
        const int dir = X.wave; float ig, lf, pre, total; ml_gates(gates, gb, b, jt, dir, h, lane, ig, lf, pre, total);
        const float cum = dir == 0 ? pre : total - pre + lf;
        const float a = ig - cum; float pm = a;
#pragma unroll
        for (int o = 1; o < 64; o <<= 1) { const float t = dir == 0 ? __shfl_up(pm, o) : __shfl_down(pm, o); const bool ok = dir == 0 ? (lane >= o) : (lane + o < 64); if (ok) pm = fmaxf(pm, t); }
        const float mc = cstat[((size_t)(bh * 2 + dir) * NCH + jt) * 4 + 2];
        const float mt = cum + fmaxf(mc, pm);
        t_a[dir * 64 + lane] = a; t_c1[dir * 64 + lane] = cum - mt; t_wp[dir * 64 + lane] = __expf(cum + mc - mt); t_em[dir * 64 + lane] = __expf(-mt);
    }
#pragma unroll
    for (int it = 0; it < 2; ++it) { const int ch = it * 512 + X.tid;
        { const int i = ch >> 4, k = ch & 15;
          *(u32x4*)(Qt + i * QSTR + 8 * k) = *(const u32x4*)((const bf16_t*)(ws + WS_QML) + ((size_t)bh * TK + tok0 + i) * 128 + 8 * k);
          *(u32x4*)(Kn + i * QSTR + 8 * k) = *(const u32x4*)((const bf16_t*)(ws + WS_KML) + ((size_t)bh * TK + tok0 + i) * 128 + 8 * k); }
        { const int rr = ch >> 3, k = ch & 7;
          *(u32x4*)(Vt + rr * KSTR + 8 * k) = *(const u32x4*)((const bf16_t*)(ws + WS_VTML) + ((size_t)bh * 128 + rr) * TK + tok0 + 8 * k); } }
    if (X.tid < 256) t_n[X.tid] = ((const float*)(ws + WS_NSNAP))[((size_t)(bh * 2 + (X.tid >> 7)) * NCH + jt) * 128 + (X.tid & 127)];
    __syncthreads();
    const int tb = X.wave & 1, db = X.wave >> 1, t = 32 * tb + r32;
    bf16x8 qf[8];
#pragma unroll
    for (int ks = 0; ks < 8; ++ks) qf[ks] = *(const bf16x8*)(Qt + t * QSTR + 16 * ks + 8 * hi);
    f32x16 st[2];
#pragma unroll
    for (int sb = 0; sb < 2; ++sb) {
#pragma unroll
        for (int r = 0; r < 16; ++r) st[sb][r] = 0.f;
#pragma unroll
        for (int ks = 0; ks < 8; ++ks) { const bf16x8 kf = *(const bf16x8*)(Kn + (32 * sb + r32) * QSTR + 16 * ks + 8 * hi); st[sb] = __builtin_amdgcn_mfma_f32_32x32x16_bf16(kf, qf[ks], st[sb], 0, 0, 0); }
    }
    f32x16 hsum;
#pragma unroll
    for (int r = 0; r < 16; ++r) hsum[r] = 0.f;
#pragma unroll
    for (int dir = 0; dir < 2; ++dir) {
        const float c1 = t_c1[dir * 64 + t], wp = t_wp[dir * 64 + t], em = t_em[dir * 64 + t];
        float rs = 0.f; u32x4 pw[2][2];
#pragma unroll
        for (int sb = 0; sb < 2; ++sb) { float p[16];
#pragma unroll
            for (int r = 0; r < 16; ++r) { const int s = 32 * sb + crow(r, hi); const bool ok = dir == 0 ? (s <= t) : (s >= t);
                const float dm = ok ? __expf(t_a[dir * 64 + s] + c1) : 0.f; p[r] = st[sb][r] * dm; rs += p[r]; }
            pw[sb][0] = pack8(p); pw[sb][1] = pack8(p + 8); }
        rs += __shfl_xor(rs, 32);
        float qn = 0.f;
#pragma unroll
        for (int ks = 0; ks < 8; ++ks) { float q8[8]; unpack8(__builtin_bit_cast(u32x4, qf[ks]), q8);
#pragma unroll
            for (int e = 0; e < 8; ++e) qn += q8[e] * t_n[dir * 128 + 16 * ks + 8 * hi + e]; }
        qn += __shfl_xor(qn, 32);
        const float den = rs + wp * qn; const float rden = 1.f / fmaxf(fabsf(den), em);
        f32x16 acc;
#pragma unroll
        for (int r = 0; r < 16; ++r) acc[r] = 0.f;
        const bf16_t* Cs = (const bf16_t*)(ws + WS_CSNAP) + ((size_t)(bh * 2 + dir) * NCH + jt) * 16384 + (size_t)(32 * db + r32) * 128;
#pragma unroll
        for (int ks = 0; ks < 8; ++ks) { const bf16x8 cf = *(const bf16x8*)(Cs + 16 * ks + 8 * hi); acc = __builtin_amdgcn_mfma_f32_32x32x16_bf16(cf, qf[ks], acc, 0, 0, 0); }
#pragma unroll
        for (int r = 0; r < 16; ++r) acc[r] *= wp;
#pragma unroll
        for (int sb = 0; sb < 2; ++sb)
#pragma unroll
            for (int s2 = 0; s2 < 2; ++s2) { const bf16x8 vf = *(const bf16x8*)(Vt + (32 * db + r32) * KSTR + 32 * sb + 16 * s2 + 8 * hi);
                acc = __builtin_amdgcn_mfma_f32_32x32x16_bf16(vf, __builtin_bit_cast(bf16x8, pw[sb][s2]), acc, 0, 0, 0); }
#pragma unroll
        for (int r = 0; r < 16; ++r) hsum[r] += acc[r] * rden;
    }
    float ss = 0.f;
#pragma unroll
    for (int r = 0; r < 16; ++r) ss += hsum[r] * hsum[r];
    ss += __shfl_xor(ss, 32);
    if (hi == 0) t_red[(tb * 4 + db) * 32 + r32] = ss;
    __syncthreads();
    const float tot = t_red[(tb * 4 + 0) * 32 + r32] + t_red[(tb * 4 + 1) * 32 + r32] + t_red[(tb * 4 + 2) * 32 + r32] + t_red[(tb * 4 + 3) * 32 + r32];
    const float rstd = rsqrtf(tot * (1.f / 128.f) + EPS);
    const int row = row_of_tokchunk(b, jt) + t;
    const float* og = P.in(I_MLOUTG) + l * 512 + h * 128;
    const bf16_t* oc = (const bf16_t*)(ws + WS_OCOPY) + (size_t)row * 512 + h * 128;
    bf16_t* mix = (bf16_t*)(ws + WS_AB) + (size_t)row * DM + 512 + h * 128;
#pragma unroll
    for (int q = 0; q < 4; ++q) { const int dv = 32 * db + 8 * q + 4 * hi;
        const u32x2 ow = *(const u32x2*)(oc + dv); const f32x4 gg = *(const f32x4*)(og + dv);
        const float o0 = hsum[4 * q + 0] * rstd * gg[0] * sigmf(bflo(ow.x)), o1 = hsum[4 * q + 1] * rstd * gg[1] * sigmf(bfhi(ow.x));
        const float o2 = hsum[4 * q + 2] * rstd * gg[2] * sigmf(bflo(ow.y)), o3 = hsum[4 * q + 3] * rstd * gg[3] * sigmf(bfhi(ow.y));
        u32x2 w; w.x = pk2(o0, o1); w.y = pk2(o2, o3); *(u32x2*)(mix + dv) = w; }
    __syncthreads();
}

template <int DQK, int KROW>
struct AttnCore {
    static constexpr int NKS = DQK / 16, NKC1 = KROW / 8 + 1, KS = NKC1 * 8, KT_B = 64 * NKC1 * 16, VT_B = 128 * 9 * 16, SLOT_B = KT_B + VT_B;
    static constexpr int NBK = KT_B / 1024, NBV = VT_B / 1024, NB = NBK + NBV, NI = (NB + 7) / 8;
    static_assert(KT_B % 1024 == 0 && VT_B % 1024 == 0 && 8 * NI - NB <= 8 && 3 * SLOT_B <= 135168, "attention LDS geometry");
    static __device__ __forceinline__ void run(const Ctx& X, const bf16_t* Qrow, int kcol, const bf16_t* K, const bf16_t* Vt, int nt, f32x16 (&o)[4]) {
        const int lane = X.lane, r32 = lane & 31, hi = lane >> 5;
        LAS unsigned char* l3 = (LAS unsigned char*)0 + X.l3off;
        bf16x8 qf[NKS];
#pragma unroll
        for (int ks = 0; ks < NKS; ++ks) qf[ks] = *(const bf16x8*)(Qrow + 16 * ks + 8 * hi);
        unsigned goff[NI]; int bsel[NI];
#pragma unroll
        for (int i = 0; i < NI; ++i) {
            int bidx = X.wave + 8 * i; if (bidx >= NB) bidx -= NB;
            bsel[i] = bidx;
            if (bidx < NBK) { const int c = bidx * 64 + lane; const int row = c / NKC1; int col = c % NKC1; if (col > NKC1 - 2) col = NKC1 - 2; goff[i] = (unsigned)(row * KROW + 8 * col) * 2u; }
            else { const int c = (bidx - NBK) * 64 + lane; const int row = c / 9; int col = c % 9; if (col > 7) col = 7; goff[i] = (unsigned)(row * TK + 8 * col) * 2u; }
        }
        asm volatile("s_waitcnt vmcnt(0)" ::: "memory");
#pragma unroll
        for (int ks = 0; ks < NKS; ++ks) asm volatile("" : "+v"(qf[ks]));
        auto issue = [&](int t, int slotoff) {
#pragma unroll
            for (int i = 0; i < NI; ++i) {
                const char* base = bsel[i] < NBK ? (const char*)K + (size_t)t * (64 * KROW * 2) : (const char*)Vt + (size_t)t * 128;
                __builtin_amdgcn_global_load_lds((const unsigned*)(base + goff[i]), (LAS unsigned*)(l3 + slotoff + bsel[i] * 1024), 16, 0, 0);
            }
        };
#pragma unroll
        for (int d = 0; d < 4; ++d)
#pragma unroll
            for (int r = 0; r < 16; ++r) o[d][r] = 0.f;
        float mrun = -1e30f, lrun = 0.f;
        issue(0, 0); issue(1, SLOT_B);
        asm volatile("s_waitcnt vmcnt(%0)" :: "i"(NI) : "memory");
        __builtin_amdgcn_s_barrier(); asm volatile("" ::: "memory");
        int s_cur = 0, s_nn = 2 * SLOT_B;
        for (int t = 0; t < nt; ++t) {
            if (t + 2 < nt) issue(t + 2, s_nn);
            const LAS bf16_t* kt = (const LAS bf16_t*)(l3 + s_cur) + r32 * KS + kcol + 8 * hi; const LAS bf16_t* vt = (const LAS bf16_t*)(l3 + s_cur + KT_B) + r32 * KSTR + 8 * hi;
            f32x16 s0, s1;
#pragma unroll
            for (int r = 0; r < 16; ++r) { s0[r] = 0.f; s1[r] = 0.f; }
            {
                bf16x8 a0 = *(const LAS bf16x8*)(kt), a1 = *(const LAS bf16x8*)(kt + 32 * KS);
                __builtin_amdgcn_sched_group_barrier(0x100, 2, 0);
#pragma unroll
                for (int ks = 0; ks < NKS; ++ks) {
                    bf16x8 b0 = a0, b1 = a1;
                    if (ks + 1 < NKS) { b0 = *(const LAS bf16x8*)(kt + 16 * (ks + 1)); b1 = *(const LAS bf16x8*)(kt + 32 * KS + 16 * (ks + 1)); }
                    s0 = __builtin_amdgcn_mfma_f32_32x32x16_bf16(a0, qf[ks], s0, 0, 0, 0);
                    s1 = __builtin_amdgcn_mfma_f32_32x32x16_bf16(a1, qf[ks], s1, 0, 0, 0);
                    if (ks + 1 < NKS) __builtin_amdgcn_sched_group_barrier(0x100, 2, 0);
                    __builtin_amdgcn_sched_group_barrier(0x008, 2, 0);
                    a0 = b0; a1 = b1;
                }
            }
            bf16x8 vf[4];
#pragma unroll
            for (int d = 0; d < 4; ++d) vf[d] = *(const LAS bf16x8*)(vt + 32 * d * KSTR);
            float mx = fmaxf(s0[0], s1[0]);
#pragma unroll
            for (int r = 1; r < 16; ++r) mx = fmaxf(fmaxf(mx, s0[r]), s1[r]);
            mx = fmaxf(mx, __shfl_xor(mx, 32));
            if (__any(mx - mrun > RESC_THR)) {
                const float mnew = fmaxf(mrun, mx); const float alpha = __builtin_amdgcn_exp2f(mrun - mnew); mrun = mnew; lrun *= alpha;
#pragma unroll
                for (int d = 0; d < 4; ++d) o[d] = o[d] * alpha;
            }
            s0 = s0 - mrun; s1 = s1 - mrun;
#pragma unroll
            for (int r = 0; r < 16; ++r) { s0[r] = __builtin_amdgcn_exp2f(s0[r]); s1[r] = __builtin_amdgcn_exp2f(s1[r]); }
            { const f32x16 sm = s0 + s1;
              lrun += ((sm[0] + sm[1]) + (sm[2] + sm[3])) + ((sm[4] + sm[5]) + (sm[6] + sm[7])) + (((sm[8] + sm[9]) + (sm[10] + sm[11])) + ((sm[12] + sm[13]) + (sm[14] + sm[15]))); }
            bf16x8 pf[4];
            { float p[16];
#pragma unroll
              for (int r = 0; r < 16; ++r) p[r] = s0[r];
              pf[0] = __builtin_bit_cast(bf16x8, pack8(p)); pf[1] = __builtin_bit_cast(bf16x8, pack8(p + 8));
#pragma unroll
              for (int r = 0; r < 16; ++r) p[r] = s1[r];
              pf[2] = __builtin_bit_cast(bf16x8, pack8(p)); pf[3] = __builtin_bit_cast(bf16x8, pack8(p + 8)); }
#pragma unroll
            for (int g = 0; g < 4; ++g) {
                bf16x8 vn[4];
                if (g + 1 < 4) {
#pragma unroll
                    for (int d = 0; d < 4; ++d) vn[d] = *(const LAS bf16x8*)(vt + 32 * d * KSTR + 16 * (g + 1));
                }
#pragma unroll
                for (int d = 0; d < 4; ++d) o[d] = __builtin_amdgcn_mfma_f32_32x32x16_bf16(vf[d], pf[g], o[d], 0, 0, 0);
                if (g + 1 < 4) {
                    __builtin_amdgcn_sched_group_barrier(0x100, 4, 0);
#pragma unroll
                    for (int d = 0; d < 4; ++d) vf[d] = vn[d];
                }
                __builtin_amdgcn_sched_group_barrier(0x008, 4, 0);
            }
            if (t + 2 < nt) asm volatile("s_waitcnt vmcnt(%0)" :: "i"(NI) : "memory");
            else asm volatile("s_waitcnt vmcnt(0)" ::: "memory");
            asm volatile("s_waitcnt lgkmcnt(0)" ::: "memory");
            __builtin_amdgcn_s_barrier(); asm volatile("" ::: "memory");
            s_cur = (s_cur == 2 * SLOT_B) ? 0 : s_cur + SLOT_B; s_nn = (s_nn == 2 * SLOT_B) ? 0 : s_nn + SLOT_B;
        }
        lrun += __shfl_xor(lrun, 32);
        const float rl = 1.f / lrun;
#pragma unroll
        for (int d = 0; d < 4; ++d) o[d] = o[d] * rl;
    }
};

template <int DQK, int KROW>
struct AttnCoreP {
    static constexpr int NKS = DQK / 16, NKC1 = KROW / 8 + 1, KS = NKC1 * 8, KT_B = 64 * NKC1 * 16, VT_B = 128 * 9 * 16, SLOT_B = KT_B + VT_B;
    static constexpr int NBK = KT_B / 1024, NBV = VT_B / 1024, NB = NBK + NBV, NI = (NB + 7) / 8;
    static_assert(KT_B % 1024 == 0 && VT_B % 1024 == 0 && 8 * NI - NB <= 8 && 3 * SLOT_B <= 135168, "attention LDS geometry");
    static __device__ __forceinline__ void run(const Ctx& X, const bf16_t* Qrow, int kcol, const bf16_t* K, const bf16_t* Vt, int nt, f32x16 (&o)[4]) {
        const int lane = X.lane, r32 = lane & 31, hi = lane >> 5, role = X.wave >> 2;
        LAS unsigned char* l3 = (LAS unsigned char*)0 + X.l3off;
        bf16x8 qf[NKS];
#pragma unroll
        for (int ks = 0; ks < NKS; ++ks) qf[ks] = *(const bf16x8*)(Qrow + 16 * ks + 8 * hi);
        unsigned goff[NI]; int bsel[NI];
#pragma unroll
        for (int i = 0; i < NI; ++i) {
            int bidx = X.wave + 8 * i; if (bidx >= NB) bidx -= NB;
            bsel[i] = bidx;
            if (bidx < NBK) { const int c = bidx * 64 + lane; const int row = c / NKC1; int col = c % NKC1; if (col > NKC1 - 2) col = NKC1 - 2; goff[i] = (unsigned)(row * KROW + 8 * col) * 2u; }
            else { const int c = (bidx - NBK) * 64 + lane; const int row = c / 9; int col = c % 9; if (col > 7) col = 7; goff[i] = (unsigned)(row * TK + 8 * col) * 2u; }
        }
        asm volatile("s_waitcnt vmcnt(0)" ::: "memory");
#pragma unroll
        for (int ks = 0; ks < NKS; ++ks) asm volatile("" : "+v"(qf[ks]));
        auto issue = [&](int tk, int ks_off, bool doK, int tv, int vs_off, bool doV) {
#pragma unroll
            for (int i = 0; i < NI; ++i) {
                const bool isK = bsel[i] < NBK;
                if (isK ? doK : doV) {
                    const char* base = isK ? (const char*)K + (size_t)tk * (64 * KROW * 2) : (const char*)Vt + (size_t)tv * 128;
                    __builtin_amdgcn_global_load_lds((const unsigned*)(base + goff[i]), (LAS unsigned*)(l3 + (isK ? ks_off : vs_off) + bsel[i] * 1024), 16, 0, 0);
                }
            }
        };
#pragma unroll
        for (int d = 0; d < 4; ++d)
#pragma unroll
            for (int r = 0; r < 16; ++r) o[d][r] = 0.f;
        float mrun = -1e30f, lrun = 0.f;
        issue(0, 0, true, 0, 0, true); issue(1, SLOT_B, true, 1, SLOT_B, true); issue(2, 2 * SLOT_B, nt > 2, 0, 0, false);
        asm volatile("s_waitcnt vmcnt(0)" ::: "memory");
        __builtin_amdgcn_s_barrier(); asm volatile("" ::: "memory");
        f32x16 sc0, sc1;
        {
            const LAS bf16_t* kt = (const LAS bf16_t*)(l3) + r32 * KS + kcol + 8 * hi;
#pragma unroll
            for (int r = 0; r < 16; ++r) { sc0[r] = 0.f; sc1[r] = 0.f; }
#pragma unroll
            for (int ks = 0; ks < NKS; ++ks) {
                const bf16x8 a0 = *(const LAS bf16x8*)(kt + 16 * ks), a1 = *(const LAS bf16x8*)(kt + 32 * KS + 16 * ks);
                sc0 = __builtin_amdgcn_mfma_f32_32x32x16_bf16(a0, qf[ks], sc0, 0, 0, 0);
                sc1 = __builtin_amdgcn_mfma_f32_32x32x16_bf16(a1, qf[ks], sc1, 0, 0, 0);
            }
        }
        int s0off = 0, s1off = SLOT_B, s2off = 2 * SLOT_B;
        for (int t = 0; t < nt; ++t) {
            issue(t + 3, s0off, t + 3 < nt, t + 2, s2off, t + 2 < nt);
            const bool hasN = t + 1 < nt;
            const LAS bf16_t* kt = (const LAS bf16_t*)(l3 + s1off) + r32 * KS + kcol + 8 * hi;
            const LAS bf16_t* vt = (const LAS bf16_t*)(l3 + s0off + KT_B) + r32 * KSTR + 8 * hi;
            f32x16 sn0, sn1;
            auto qk_next = [&]() {
#pragma unroll
                for (int r = 0; r < 16; ++r) { sn0[r] = 0.f; sn1[r] = 0.f; }
                bf16x8 a0 = *(const LAS bf16x8*)(kt), a1 = *(const LAS bf16x8*)(kt + 32 * KS);
                __builtin_amdgcn_sched_group_barrier(0x100, 2, 0);
#pragma unroll
                for (int ks = 0; ks < NKS; ++ks) {
                    bf16x8 b0 = a0, b1 = a1;
                    if (ks + 1 < NKS) { b0 = *(const LAS bf16x8*)(kt + 16 * (ks + 1)); b1 = *(const LAS bf16x8*)(kt + 32 * KS + 16 * (ks + 1)); }
                    sn0 = __builtin_amdgcn_mfma_f32_32x32x16_bf16(a0, qf[ks], sn0, 0, 0, 0);
                    sn1 = __builtin_amdgcn_mfma_f32_32x32x16_bf16(a1, qf[ks], sn1, 0, 0, 0);
                    if (ks + 1 < NKS) __builtin_amdgcn_sched_group_barrier(0x100, 2, 0);
                    __builtin_amdgcn_sched_group_barrier(0x008, 2, 0);
                    a0 = b0; a1 = b1;
                }
            };
            if (role == 0 && hasN) qk_next();
            float mx = fmaxf(sc0[0], sc1[0]);
#pragma unroll
            for (int r = 1; r < 16; ++r) mx = fmaxf(fmaxf(mx, sc0[r]), sc1[r]);
            mx = fmaxf(mx, __shfl_xor(mx, 32));
            if (__any(mx - mrun > RESC_THR)) {
                const float mnew = fmaxf(mrun, mx); const float alpha = __builtin_amdgcn_exp2f(mrun - mnew); mrun = mnew; lrun *= alpha;
#pragma unroll
                for (int d = 0; d < 4; ++d) o[d] = o[d] * alpha;
            }
            sc0 = sc0 - mrun; sc1 = sc1 - mrun;
#pragma unroll
            for (int r = 0; r < 16; ++r) { sc0[r] = __builtin_amdgcn_exp2f(sc0[r]); sc1[r] = __builtin_amdgcn_exp2f(sc1[r]); }
            { const f32x16 sm = sc0 + sc1;
              lrun += ((sm[0] + sm[1]) + (sm[2] + sm[3])) + ((sm[4] + sm[5]) + (sm[6] + sm[7])) + (((sm[8] + sm[9]) + (sm[10] + sm[11])) + ((sm[12] + sm[13]) + (sm[14] + sm[15]))); }
            bf16x8 pf[4];
            { float p[16];
#pragma unroll
              for (int r = 0; r < 16; ++r) p[r] = sc0[r];
              pf[0] = __builtin_bit_cast(bf16x8, pack8(p)); pf[1] = __builtin_bit_cast(bf16x8, pack8(p + 8));
#pragma unroll
              for (int r = 0; r < 16; ++r) p[r] = sc1[r];
              pf[2] = __builtin_bit_cast(bf16x8, pack8(p)); pf[3] = __builtin_bit_cast(bf16x8, pack8(p + 8)); }
            bf16x8 vf[4];
#pragma unroll
            for (int d = 0; d < 4; ++d) vf[d] = *(const LAS bf16x8*)(vt + 32 * d * KSTR);
#pragma unroll
            for (int g = 0; g < 4; ++g) {
                bf16x8 vn[4];
                if (g + 1 < 4) {
#pragma unroll
                    for (int d = 0; d < 4; ++d) vn[d] = *(const LAS bf16x8*)(vt + 32 * d * KSTR + 16 * (g + 1));
                }
#pragma unroll
                for (int d = 0; d < 4; ++d) o[d] = __builtin_amdgcn_mfma_f32_32x32x16_bf16(vf[d], pf[g], o[d], 0, 0, 0);
                if (g + 1 < 4) {
#pragma unroll
                    for (int d = 0; d < 4; ++d) vf[d] = vn[d];
                }
            }
            if (role != 0 && hasN) qk_next();
            if (t + 3 < nt) asm volatile("s_waitcnt vmcnt(%0)" :: "i"(NI) : "memory");
            else asm volatile("s_waitcnt vmcnt(0)" ::: "memory");
            asm volatile("s_waitcnt lgkmcnt(0)" ::: "memory");
            __builtin_amdgcn_s_barrier(); asm volatile("" ::: "memory");
            sc0 = sn0; sc1 = sn1;
            const int tmp = s0off; s0off = s1off; s1off = s2off; s2off = tmp;
        }
        lrun += __shfl_xor(lrun, 32);
        const float rl = 1.f / lrun;
#pragma unroll
        for (int d = 0; d < 4; ++d) o[d] = o[d] * rl;
    }
};

__device__ __forceinline__ void mla_attn_unit(const Ctx& X0, const PRef& P, int b, int h, int q0, int is_ctx) {
    const Ctx X = fresh(X0);
    unsigned char* ws = P.ws();
    const int lane = X.lane, r32 = lane & 31, hi = lane >> 5;
    const int row = (is_ctx ? M_LAT + b * CTXL : b * SEQ) + q0 + 32 * X.wave + r32;
    const bf16_t* Q = (const bf16_t*)(ws + WS_QM) + ((size_t)h * M_ALL + row) * 192;
    const bf16_t* K = (const bf16_t*)(ws + WS_KM) + (size_t)(b * 8 + h) * TK * 192;
    const bf16_t* Vt = (const bf16_t*)(ws + WS_VTM) + (size_t)(b * 8 + h) * 128 * TK;
    f32x16 o[4];
    AttnCore<192, 192>::run(X, Q, 0, K, Vt, is_ctx ? 4 : NCH, o);
    bf16_t* mix = (bf16_t*)(ws + WS_AB) + (size_t)row * DM + 1024 + h * 128;
#pragma unroll
    for (int d = 0; d < 4; ++d)
#pragma unroll
        for (int q = 0; q < 4; ++q) { u32x2 w; w.x = pk2(o[d][4 * q], o[d][4 * q + 1]); w.y = pk2(o[d][4 * q + 2], o[d][4 * q + 3]); *(u32x2*)(mix + 32 * d + 8 * q + 4 * hi) = w; }
}
__device__ __forceinline__ void da_attn_unit(const Ctx& X0, const PRef& P, int l, int b, int h, int q0, int is_ctx, float lam, float lam_init) {
    const Ctx X = fresh(X0);
    unsigned char* ws = P.ws();
    const int lane = X.lane, r32 = lane & 31, hi = lane >> 5;
    const int comp = X.wave >> 2, qs = X.wave & 3;
    const int row = (is_ctx ? M_LAT + b * CTXL : b * SEQ) + q0 + 32 * qs + r32;
    const bf16_t* Q = (const bf16_t*)(ws + WS_QDA) + ((size_t)h * M_ALL + row) * 128 + comp * 64;
    const bf16_t* K = (const bf16_t*)(ws + WS_KDA) + (size_t)(b * 4 + h) * TK * 128;
    const bf16_t* Vt = (const bf16_t*)(ws + WS_VTDA) + (size_t)(b * 4 + h) * 128 * TK;
    f32x16 o[4];
    AttnCoreP<64, 128>::run(X, Q, comp * 64, K, Vt, is_ctx ? 4 : NCH, o);
    float* xch = (float*)X.lds;
    if (comp == 1) {
#pragma unroll
        for (int d = 0; d < 4; ++d)
#pragma unroll
            for (int r = 0; r < 16; ++r) xch[(qs * 64 + d * 16 + r) * 64 + lane] = o[d][r];
    }
    __syncthreads();
    if (comp == 0) {
        float ss = 0.f;
#pragma unroll
        for (int d = 0; d < 4; ++d)
#pragma unroll
            for (int r = 0; r < 16; ++r) { o[d][r] -= lam * xch[(qs * 64 + d * 16 + r) * 64 + lane]; ss += o[d][r] * o[d][r]; }
        ss += __shfl_xor(ss, 32);
        float li_ = lam_init; asm volatile("" : "+s"(li_));
        const float rstd = rsqrtf(ss * (1.f / 128.f) + EPS) * (1.f - li_);
        const float* og = P.in(I_DAOUTG) + l * 128;
        bf16_t* mix = (bf16_t*)(ws + WS_AB) + (size_t)row * DM + h * 128;
#pragma unroll
        for (int d = 0; d < 4; ++d)
#pragma unroll
            for (int q = 0; q < 4; ++q) { const int dv = 32 * d + 8 * q + 4 * hi; const f32x4 gg = *(const f32x4*)(og + dv);
                u32x2 w; w.x = pk2(o[d][4 * q] * rstd * gg[0], o[d][4 * q + 1] * rstd * gg[1]); w.y = pk2(o[d][4 * q + 2] * rstd * gg[2], o[d][4 * q + 3] * rstd * gg[3]);
                *(u32x2*)(mix + dv) = w; }
    }
    __syncthreads();
}

__device__ __forceinline__ void mixer_phase(const Ctx& X, const PRef& P, int l) {
    const bool need_ctx = l < DEPTH - 1;
    STAMPN(20);
    const int vcu = (X.nwg % 8 == 0) ? (X.wg % 8) * (X.nwg / 8) + X.wg / 8 : X.wg;
    if (EN(13)) for (int u = vcu; u < 512; u += X.nwg) mla_attn_unit(X, P, u >> 7, (u >> 4) & 7, (u & 15) * 256, 0);
    STAMPN(11);
    float lam, lam_init;
    { const float* lp = P.in(I_DALAM) + l * 256;
      float s1 = 0.f, s2 = 0.f;
      for (int i = 0; i < 64; ++i) { s1 += lp[i] * lp[64 + i]; s2 += lp[128 + i] * lp[192 + i]; }
      const float li = 0.8f - 0.6f * expf(-0.3f * (float)l);
      const float la = expf(s1) - expf(s2) + li;
      lam = __builtin_bit_cast(float, __builtin_amdgcn_readfirstlane(__builtin_bit_cast(int, la)));
      lam_init = __builtin_bit_cast(float, __builtin_amdgcn_readfirstlane(__builtin_bit_cast(int, li))); }
    if (EN(14)) for (int v = vcu; v < 512; v += X.nwg) da_attn_unit(X, P, l, v >> 7, (v >> 5) & 3, (v & 31) * 128, 0, lam, lam_init);
    STAMPN(12);
    if (EN(15)) for (int u = X.wg; u < 16 * NCH; u += X.nwg) mlstm_c_unit(X, P, l, u);
    STAMPN(13);
    if (need_ctx) {
        if (EN(13)) for (int v = X.wg; v < 32; v += X.nwg) mla_attn_unit(X, P, v >> 3, v & 7, 0, 1);
        if (EN(14)) for (int v = X.nwg - 1 - X.wg; v < 32; v += X.nwg) da_attn_unit(X, P, l, v >> 3, (v >> 1) & 3, (v & 1) * 128, 1, lam, lam_init);
    }
}

__global__ void __launch_bounds__(512, 2) fwd_megakernel(Params Pk) {
    const PRef P;
    extern __shared__ __attribute__((aligned(16))) unsigned char lds[];
    cg::grid_group grid = cg::this_grid();
    Ctx X; X.lds = lds; X.tid = threadIdx.x; X.lane = X.tid & 63; X.wave = __builtin_amdgcn_readfirstlane(X.tid >> 6);
    X.nwg = gridDim.x; X.wg = blockIdx.x; X.gw = X.wg * 8 + X.wave; X.ngw = X.nwg * 8;
    LAS unsigned char* lds3 = (LAS unsigned char*)lds; X.l3off = (unsigned)(uintptr_t)lds3;
    unsigned char* ws = P.ws();
    if (threadIdx.x < 16) ((LAS unsigned*)(lds3 + 135168 + 64))[threadIdx.x] = 0u;
    __syncthreads();
    (void)xcd_barrier_post((unsigned*)(ws + WS_BAR), (volatile LAS unsigned*)(lds3 + 135168 + 64));
    float* R_lat = P.out(); float* R_ctx = (float*)(ws + WS_RCTX);
    bf16_t* AB = (bf16_t*)(ws + WS_AB);

#ifdef PROBE_CAT
    if (blockIdx.x == 0 && threadIdx.x == 0) { volatile unsigned long long* tp_ = (volatile unsigned long long*)(P.ws() + WS_END); tp_[0] = __builtin_amdgcn_s_memrealtime(); tp_[1] = 0; tp_[2] = 0; }
#endif
    if (EN(0)) mod_gemv(X, P);
    if (EN(1)) convert_weights(X, P, 0);
    grid.sync();
#ifdef PROBE_CAT
    STAMP(0);
#endif
    for (int l = 0; l < DEPTH; ++l) {
        const float* modl = (const float*)(ws + WS_MOD) + (size_t)l * 5 * 6 * DM;
        const float* xin_lat = l == 0 ? P.in(I_X) : R_lat; const float* xin_ctx = l == 0 ? P.in(I_CTX) : R_ctx;
        const int Mfin = l < DEPTH - 1 ? M_ALL : M_LAT;
        if (EN(2)) modulate_phase(X, xin_lat, xin_ctx, P.in(I_N1G) + l * DM, modl, 0 * DM, 1 * DM, AB, M_ALL);
        if (EN(1)) if (l > 0) convert_weights(X, P, l);
        STAMP(1);
        if (EN(3)) { pg8::Gemm g{AB, (const bf16_t*)(ws + WS_WIN), M_ALL, NPROJ, DM}; pg8::StaticOrder S; S.init(M_ALL, NPROJ, X.nwg, X.wg);
          pg8::EpiBf16 E{(bf16_t*)(ws + WS_PROJ), NPROJ, (float*)(ws + WS_GATES), C_GATE / 256};
          pg8::gemm_phase<pg8::EpiBf16>(lds3, g, S, E); }
        STAMP(2);
        if (EN(4)) prep_phase(X, P, l);
        STAMP(3);
        if (EN(5)) { pg8::Gemm g{(const bf16_t*)(ws + WS_CQN), (const bf16_t*)(ws + WS_WUQ), M_ALL, 1536, 512}; pg8::StaticOrder S; S.init(M_ALL, 1536, X.nwg, X.wg);
          pg8::EpiBf16 E{(bf16_t*)(ws + WS_QUP), 1536, nullptr, 0};
          pg8::gemm_phase<pg8::EpiBf16>(lds3, g, S, E); }
        if (EN(5)) { pg8::Gemm g{(const bf16_t*)(ws + WS_CKVN), (const bf16_t*)(ws + WS_WUKV), M_ALL, 2048, 256}; pg8::StaticOrder S; S.init(M_ALL, 2048, X.nwg, X.wg);
          pg8::EpiBf16 E{(bf16_t*)(ws + WS_KVUP), 2048, nullptr, 0};
          pg8::gemm_phase<pg8::EpiBf16>(lds3, g, S, E); }
        __syncthreads();
        if (EN(6)) mlstm_a_phase(X, P, l);
        STAMP(4);
        if (EN(7)) mla_prep_phase(X, P, l);
        if (EN(8)) mlstm_scan_phase(X, P);
        STAMP(5);
        if (EN(9)) mixer_phase(X, P, l);
        STAMP(6);
        if (EN(10)) { pg8::Gemm g{AB, (const bf16_t*)(ws + WS_WOUT), Mfin, DM, DM}; pg8::StaticOrder S; S.init(Mfin, DM, X.nwg, X.wg);
          pg8::EpiRes E{xin_lat, xin_ctx, R_lat, R_ctx, modl + 2 * DM};
          pg8::gemm_phase<pg8::EpiRes>(lds3, g, S, E); }
        STAMP(7);
        if (EN(2)) modulate_phase(X, R_lat, R_ctx, P.in(I_N2G) + l * DM, modl, 3 * DM, 4 * DM, AB, Mfin);
        STAMP(1);
        if (EN(11)) { pg8::Gemm g{AB, (const bf16_t*)(ws + WS_WGU), Mfin, 2 * FF, DM}; pg8::StaticOrder S; S.init(Mfin, 2 * FF, X.nwg, X.wg);
          pg8::EpiSwiGLU E{(bf16_t*)(ws + WS_HID), FF};
          pg8::gemm_phase<pg8::EpiSwiGLU>(lds3, g, S, E); }
        STAMP(9);
        if (EN(12)) { pg8::Gemm g{(const bf16_t*)(ws + WS_HID), (const bf16_t*)(ws + WS_WDN), Mfin, DM, FF}; pg8::StaticOrder S; S.init(Mfin, DM, X.nwg, X.wg);
          pg8::EpiRes E{R_lat, R_ctx, R_lat, R_ctx, modl + 5 * DM};
          pg8::gemm_phase<pg8::EpiRes>(lds3, g, S, E); }
#ifdef PROBE_CAT
        STAMP(10);
#else
        if (l + 1 < DEPTH) xcd_barrier(P.ws());
#endif
    }
#ifdef PROBE_CAT
    if (blockIdx.x == 0 && threadIdx.x == 0) P.out()[0] += (float)(((volatile unsigned long long*)(P.ws() + WS_END))[1]) * (0.01f / PROBE_SCALE);
#endif
}

extern "C" void kernel_launch(void* const* d_in, const int* in_sizes, int n_in, void* d_out, int out_size, void* d_ws, size_t ws_size, hipStream_t stream) {
    static int grid = 0;
    if (grid == 0) {
        if (n_in != 24 || ws_size < WS_END) { fprintf(stderr, "kernel_launch: unexpected inputs (n_in %d, ws %zu)\n", n_in, ws_size); grid = -1; return; }
        int dev = 0, cus = 0, per_cu = 0;
        (void)hipGetDevice(&dev); (void)hipDeviceGetAttribute(&cus, hipDeviceAttributeMultiprocessorCount, dev);
        if (hipFuncSetAttribute((const void*)fwd_megakernel, hipFuncAttributeMaxDynamicSharedMemorySize, LDS_BYTES) != hipSuccess) { fprintf(stderr, "kernel_launch: hipFuncSetAttribute failed\n"); grid = -1; return; }
        (void)hipOccupancyMaxActiveBlocksPerMultiprocessor(&per_cu, (const void*)fwd_megakernel, 512, LDS_BYTES);
        (void)hipGetLastError();
        if (per_cu < 1) { fprintf(stderr, "kernel_launch: occupancy query says %d\n", per_cu); per_cu = 1; }
        grid = cus;
    }
    if (grid < 0) return;
    if (hipMemsetAsync((char*)d_ws + WS_BAR, 0, XCD_BAR_WORDS * 4, stream) != hipSuccess) { fprintf(stderr, "kernel_launch: memset failed\n"); return; }
    Params p{};
    for (int i = 0; i < 24; ++i) p.in[i] = (const float*)d_in[i];
    p.out = (float*)d_out; p.ws = (unsigned char*)d_ws;
    void* args[] = {&p};
    hipError_t e = hipLaunchCooperativeKernel((const void*)fwd_megakernel, dim3(grid), dim3(512), args, LDS_BYTES, stream);
    if (e != hipSuccess) fprintf(stderr, "cooperative launch failed: %s (grid %d)\n", hipGetErrorString(e), grid);
}
```

```cpp
#include <hip/hip_runtime.h>
#include <hip/hip_cooperative_groups.h>
#include <cstdio>
#include <cstdint>
namespace cg = cooperative_groups;

#define LAS __attribute__((address_space(3)))
typedef unsigned short bf16_t;
typedef short bf16x8 __attribute__((ext_vector_type(8)));
typedef float f32x4 __attribute__((ext_vector_type(4)));
typedef float f32x16 __attribute__((ext_vector_type(16)));
typedef unsigned u32x4 __attribute__((ext_vector_type(4)));
typedef unsigned u32x2 __attribute__((ext_vector_type(2)));

constexpr int DM = 2048, BATCH = 4, SEQ = 4096, CTXL = 256, DEPTH = 2;
constexpr int M_LAT = BATCH * SEQ, M_CTX = BATCH * CTXL, M_ALL = M_LAT + M_CTX;
constexpr int TK = CTXL + SEQ;
constexpr int NCH = TK / 64;
constexpr int IN_W = 4432, NPROJ = 4608, FF = 5632;
constexpr int C_DAQ = 0, C_DAK = 512, C_DAV = 1024, C_MLQ = 1536, C_MLK = 2048, C_MLV = 2560, C_MLO = 3072, C_GATE = 3584, C_CQ = 3600, C_CKV = 4112, C_KPE = 4368;
constexpr float EPS = 1e-6f;
constexpr float LOG2E = 1.4426950408889634f;
constexpr float RESC_THR = 8.0f;

constexpr size_t MiB = 1u << 20;
constexpr size_t WS_WIN = 0, WS_WOUT = 18 * MiB, WS_WGU = 26 * MiB, WS_WDN = 70 * MiB, WS_WUQ = 92 * MiB, WS_WUKV = 94 * MiB, WS_MOD = 95 * MiB, WS_RCTX = 96 * MiB;
constexpr size_t WS_AB = 104 * MiB;
constexpr size_t WS_PROJ = 172 * MiB;
constexpr size_t WS_QUP = 172 * MiB, WS_KVUP = 223 * MiB, WS_HID = 172 * MiB;
constexpr size_t WS_GATES = 325 * MiB, WS_CQN = 327 * MiB, WS_CKVN = 344 * MiB, WS_KPE = 353 * MiB, WS_OCOPY = 356 * MiB;
constexpr size_t WS_QDA = 373 * MiB, WS_KDA = 390 * MiB, WS_VTDA = 407 * MiB, WS_QML = 424 * MiB, WS_KML = 441 * MiB, WS_KTML = 458 * MiB, WS_VTML = 475 * MiB;
constexpr size_t WS_QM = 492 * MiB, WS_KM = 543 * MiB, WS_VTM = 594 * MiB, WS_CSNAP = 628 * MiB, WS_NSNAP = 696 * MiB, WS_NU = 698 * MiB, WS_CSTAT = 700 * MiB, WS_BAR = 701 * MiB, WS_END = 702 * MiB;
static_assert((size_t)NPROJ * DM * 2 <= 18 * MiB && (size_t)2 * FF * DM * 2 <= 44 * MiB && (size_t)M_ALL * NPROJ * 2 <= 153 * MiB, "ws map");
static_assert(WS_HID + (size_t)M_ALL * FF * 2 <= WS_QDA, "hid overlay");
static_assert(WS_END <= 768 * MiB, "ws fits the guaranteed minimum");

constexpr int LDS_BYTES = 140 * 1024;
#ifndef PH_EN
#define PH_EN 0xFFFF
#endif
#define EN(k) ((PH_EN >> (k)) & 1)
#ifdef PROBE_CAT
#define STAMP(cat) do { xcd_barrier(P.ws()); if (blockIdx.x == 0 && threadIdx.x == 0) { volatile unsigned long long* tp_ = (volatile unsigned long long*)(P.ws() + WS_END); const unsigned long long t1_ = __builtin_amdgcn_s_memrealtime(); if ((1 << (cat)) & PROBE_CAT) tp_[1] += t1_ - tp_[0]; if ((1 << (cat)) & PROBE_CAT2) tp_[2] += t1_ - tp_[0]; tp_[0] = t1_; } } while (0)
#define STAMPN(cat) do { __syncthreads(); if (blockIdx.x == 0 && threadIdx.x == 0) { volatile unsigned long long* tp_ = (volatile unsigned long long*)(P.ws() + WS_END); const unsigned long long t1_ = __builtin_amdgcn_s_memrealtime(); if ((1 << (cat)) & PROBE_CAT) tp_[1] += t1_ - tp_[0]; tp_[0] = t1_; } } while (0)
#else
#define STAMPN(cat) do {} while (0)
#define STAMP(cat) xcd_barrier(P.ws())
#endif

#define LOG2E_ 1.4426950408889634f
__device__ __forceinline__ unsigned f2bf(float f) { unsigned u = __builtin_bit_cast(unsigned, f); return (u + 0x7fffu + ((u >> 16) & 1u)) >> 16; }
typedef float f32x2_t __attribute__((ext_vector_type(2))); typedef __bf16 bf16x2_t __attribute__((ext_vector_type(2)));
__device__ __forceinline__ unsigned pk2(float lo, float hi) { f32x2_t v = {lo, hi}; bf16x2_t b = __builtin_convertvector(v, bf16x2_t); return __builtin_bit_cast(unsigned, b); }
__device__ __forceinline__ float bflo(unsigned w) { return __builtin_bit_cast(float, w << 16); }
__device__ __forceinline__ float bfhi(unsigned w) { return __builtin_bit_cast(float, w & 0xffff0000u); }
__device__ __forceinline__ float bf1(bf16_t h) { return __builtin_bit_cast(float, (unsigned)h << 16); }
__device__ __forceinline__ void unpack8(const u32x4 w, float* v) { v[0] = bflo(w.x); v[1] = bfhi(w.x); v[2] = bflo(w.y); v[3] = bfhi(w.y); v[4] = bflo(w.z); v[5] = bfhi(w.z); v[6] = bflo(w.w); v[7] = bfhi(w.w); }
__device__ __forceinline__ u32x4 pack8(const float* v) { u32x4 w; w.x = pk2(v[0], v[1]); w.y = pk2(v[2], v[3]); w.z = pk2(v[4], v[5]); w.w = pk2(v[6], v[7]); return w; }
__device__ __forceinline__ float wave_sum(float v) {
#pragma unroll
    for (int o = 1; o < 64; o <<= 1) v += __shfl_xor(v, o);
    return v;
}
__device__ __forceinline__ float wave_max(float v) {
#pragma unroll
    for (int o = 1; o < 64; o <<= 1) v = fmaxf(v, __shfl_xor(v, o));
    return v;
}
__device__ __forceinline__ float siluf(float x) { return x * __builtin_amdgcn_rcpf(1.f + __builtin_amdgcn_exp2f(-LOG2E_ * x)); }
__device__ __forceinline__ float sigmf(float x) { return __builtin_amdgcn_rcpf(1.f + __builtin_amdgcn_exp2f(-LOG2E_ * x)); }
__device__ __forceinline__ int crow(int r, int hi) { return (r & 3) + 8 * (r >> 2) + 4 * hi; }
__device__ __forceinline__ int perm_off(int p) { const int h = p >> 3, j = p & 7; return 8 * (j >> 2) + 4 * h + (j & 3); }
__device__ __forceinline__ int mod_batch(int row) { return row < M_LAT ? (row >> 12) : 4; }

namespace pg8 {
constexpr int BM = 256, BK = 64, HALF = 128, HTB = HALF * BK * 2, STAGE_BYTES = 8 * HTB, NXCD = 8, WGM = 8;
__host__ __device__ __forceinline__ int lds_byte(int r, int c) { const int st = (r >> 4) * 2 + (c >> 5), rr = r & 15, cc = c & 31, ob = rr * 64 + cc * 2; return st * 1024 + (ob ^ (((ob >> 9) & 1) << 5)); }
__host__ __device__ __forceinline__ void stage_rc(int b, int& R, int& C) { const int st = b / 1024, sb = b % 1024, swz = sb ^ (((sb >> 9) & 1) << 5); R = (st >> 1) * 16 + swz / 64; C = (st & 1) * 32 + (swz % 64) / 2; }
__host__ __device__ __forceinline__ int perm32(int rho) { const int n = rho >> 4, i = rho & 15; return 8 * (i >> 2) + 4 * n + (i & 3); }

struct Unit { int pm, pn; };
struct Gemm { const bf16_t* A; const bf16_t* Bt; int M, N, K; };

struct StaticOrder {
    int nM, nN, nwg, G, c;
    __device__ void init(int M, int N, int G_, int c_) { nM = M / BM; nN = N / BM; nwg = nM * nN; G = G_; c = c_; }
    __device__ bool next(int i, Unit& u) const {
        const long L = (long)i * G + c; if (L >= nwg) return false;
        int wgid = (int)L; { const int q = nwg / NXCD, r = nwg % NXCD, xcd = wgid % NXCD, off = wgid / NXCD; wgid = (xcd < r ? xcd * (q + 1) : r * (q + 1) + (xcd - r) * q) + off; }
        const int nig = WGM * nN, gid = wgid / nig, fm = gid * WGM, gsz = (nM - fm) < WGM ? (nM - fm) : WGM;
        u.pm = fm + ((wgid % nig) % gsz); u.pn = (wgid % nig) / gsz; return true;
    }
};

struct EpiBf16 {
    static constexpr bool PERM = true;
    bf16_t* O; int ldc; float* gates; int gate_pn;
    __device__ __forceinline__ void operator()(const f32x4 (&acc)[2][2][4][2], const Unit& u, int wr, int wc, int fr, int fq) const {
        const int row0 = u.pm * BM + wr * 64 + fr; const int col0 = u.pn * BM + wc * 32 + 8 * fq;
        const bool g = gates != nullptr && u.pn == gate_pn && wc == 0 && fq < 2;
#pragma unroll
        for (int ai = 0; ai < 2; ++ai)
#pragma unroll
            for (int m = 0; m < 4; ++m) { const int row = row0 + ai * HALF + m * 16; bf16_t* rowp = O + (size_t)row * ldc + col0;
#pragma unroll
                for (int bj = 0; bj < 2; ++bj) { const f32x4 v0 = acc[ai][bj][m][0], v1 = acc[ai][bj][m][1];
                    u32x4 w; w.x = pk2(v0[0], v0[1]); w.y = pk2(v0[2], v0[3]); w.z = pk2(v1[0], v1[1]); w.w = pk2(v1[2], v1[3]);
                    *(u32x4*)(rowp + bj * HALF) = w;
                    if (bj == 0 && g) { *(f32x4*)(gates + (size_t)row * 16 + 8 * fq) = v0; *(f32x4*)(gates + (size_t)row * 16 + 8 * fq + 4) = v1; } } }
    }
};
struct EpiSwiGLU {
    static constexpr bool PERM = true;
    bf16_t* O; int ldc;
    __device__ __forceinline__ void operator()(const f32x4 (&acc)[2][2][4][2], const Unit& u, int wr, int wc, int fr, int fq) const {
        const int row0 = u.pm * BM + wr * 64 + fr; const int col0 = u.pn * HALF + wc * 32 + 8 * fq;
#pragma unroll
        for (int ai = 0; ai < 2; ++ai)
#pragma unroll
            for (int m = 0; m < 4; ++m) { const int row = row0 + ai * HALF + m * 16;
                float o[8];
#pragma unroll
                for (int n = 0; n < 2; ++n)
#pragma unroll
                    for (int i = 0; i < 4; ++i) { const float gt = acc[ai][0][m][n][i], up = acc[ai][1][m][n][i]; o[4 * n + i] = siluf(gt) * up; }
                *(u32x4*)(O + (size_t)row * ldc + col0) = pack8(o); }
    }
};
struct EpiRes {
    static constexpr bool PERM = false;
    const float* res_lat; const float* res_ctx; float* out_lat; float* out_ctx; const float* gate;
    __device__ __forceinline__ void operator()(const f32x4 (&acc)[2][2][4][2], const Unit& u, int wr, int wc, int fr, int fq) const {
        const int row0 = u.pm * BM + wr * 64 + fr; const int col0 = u.pn * BM + wc * 32 + 4 * fq;
#pragma unroll
        for (int ai = 0; ai < 2; ++ai)
#pragma unroll
            for (int m = 0; m < 4; ++m) { const int row = row0 + ai * HALF + m * 16;
                const float* rp = row < M_LAT ? res_lat + (size_t)row * DM : res_ctx + (size_t)(row - M_LAT) * DM;
                float* op = row < M_LAT ? out_lat + (size_t)row * DM : out_ctx + (size_t)(row - M_LAT) * DM;
                const float* gp = gate + (size_t)mod_batch(row) * 6 * DM;
#pragma unroll
                for (int bj = 0; bj < 2; ++bj)
#pragma unroll
                    for (int n = 0; n < 2; ++n) { const int c = col0 + bj * HALF + n * 16;
                        const f32x4 r = *(const f32x4*)(rp + c), g = *(const f32x4*)(gp + c);
                        *(f32x4*)(op + c) = r + g * acc[ai][bj][m][n]; } }
    }
};

template <class Epi, bool ALIGN_EPI = true>
__device__ __forceinline__ void gemm_phase(LAS unsigned char* lds, const Gemm g, const StaticOrder& S, const Epi& E) {
    int tid = threadIdx.x; asm volatile("" : "+v"(tid)); const int wid = __builtin_amdgcn_readfirstlane(tid >> 6), lane = tid & 63, wr = wid >> 2, wc = wid & 3, fr = lane & 15, fq = lane >> 4;
    int K = g.K; asm volatile("" : "+s"(K)); const int nt = K / BK;
    unsigned voffA[2], voffB[2];
#pragma unroll
    for (int i = 0; i < 2; ++i) { int R, C; stage_rc(tid * 16 + i * 8192, R, C); const int Rb = Epi::PERM ? ((R & ~31) + perm32(R & 31)) : R;
        voffA[i] = (unsigned)(R * K + C) * 2u; voffB[i] = (unsigned)(Rb * K + C) * 2u; }
    const size_t kstep = (size_t)(BK * 2);
    const size_t hstep = (size_t)HALF * K * 2;
    const size_t tstep = 2 * hstep;
    const unsigned ldsw = (unsigned)wid * 1024u;
    const int aoff = lds_byte(wr * 64 + fr, fq * 8), boff = lds_byte(wc * 32 + fr, fq * 8);
#define PG8_SA(b, h) (((b) * 2 + (h)) * HTB)
#define PG8_SB(b, h) ((4 + (b) * 2 + (h)) * HTB)
#define PG8_STAGE(bufoff, gbase, voff) do { _Pragma("unroll") for (int _i = 0; _i < 2; ++_i) \
        __builtin_amdgcn_global_load_lds((const unsigned*)((const char*)(gbase) + (voff)[_i]), (LAS unsigned*)(lds + (bufoff) + ldsw + _i * 8192), 16, 0, 0); } while (0)
#define PG8_LDA(dst, b, h) do { _Pragma("unroll") for (int m = 0; m < 4; ++m) _Pragma("unroll") for (int k = 0; k < 2; ++k) dst[m][k] = *(const LAS bf16x8*)(lds + PG8_SA(b, h) + aoff + m * 2048 + k * 1024); } while (0)
#define PG8_LDB(dst, b, h) do { _Pragma("unroll") for (int n = 0; n < 2; ++n) _Pragma("unroll") for (int k = 0; k < 2; ++k) dst[n][k] = *(const LAS bf16x8*)(lds + PG8_SB(b, h) + boff + n * 2048 + k * 1024); } while (0)
#define PG8_MMA(ai, bj, At, Bt) do { __builtin_amdgcn_s_setprio(1); _Pragma("unroll") for (int m = 0; m < 4; ++m) _Pragma("unroll") for (int n = 0; n < 2; ++n) _Pragma("unroll") for (int k = 0; k < 2; ++k) \
        acc[ai][bj][m][n] = __builtin_amdgcn_mfma_f32_16x16x32_bf16(Bt[n][k], At[m][k], acc[ai][bj][m][n], 0, 0, 0); __builtin_amdgcn_s_setprio(0); } while (0)
#define PG8_WAIT_V(n) asm volatile("s_waitcnt vmcnt(" #n ")" ::: "memory")
#define PG8_WAIT_L(n) asm volatile("s_waitcnt lgkmcnt(" #n ")" ::: "memory")
#define PG8_BAR __builtin_amdgcn_s_barrier()
#define PG8_SCHED __builtin_amdgcn_sched_barrier(0)
    Unit cur, nxt; int ui = 0;
    if (!S.next(0, cur)) return;
    f32x4 acc[2][2][4][2];
#pragma unroll
    for (int a = 0; a < 2; ++a)
#pragma unroll
        for (int b = 0; b < 2; ++b)
#pragma unroll
            for (int m = 0; m < 4; ++m)
#pragma unroll
                for (int n = 0; n < 2; ++n) acc[a][b][m][n] = (f32x4){0.f, 0.f, 0.f, 0.f};
    bf16x8 At[4][2], B0[2][2], B1[2][2];
    const char* cA = (const char*)g.A + (size_t)cur.pm * tstep; const char* cB = (const char*)g.Bt + (size_t)cur.pn * tstep;
    PG8_STAGE(PG8_SB(0, 0), cB, voffB); PG8_STAGE(PG8_SB(0, 1), cB + hstep, voffB); PG8_STAGE(PG8_SA(0, 0), cA, voffA); PG8_STAGE(PG8_SA(0, 1), cA + hstep, voffA);
    if (wr == 1) PG8_BAR;
    PG8_WAIT_V(2); PG8_BAR;
    PG8_STAGE(PG8_SB(1, 0), cB + kstep, voffB); PG8_STAGE(PG8_SA(1, 0), cA + kstep, voffA); PG8_STAGE(PG8_SB(1, 1), cB + hstep + kstep, voffB);
    PG8_WAIT_V(6); PG8_BAR;
    for (;;) {
        const bool has_next = S.next(ui + 1, nxt);
        const char* nA = has_next ? (const char*)g.A + (size_t)nxt.pm * tstep : cA; const char* nB = has_next ? (const char*)g.Bt + (size_t)nxt.pn * tstep : cB;
        for (int t = 0; t < nt; t += 2) {
            const bool last = (t == nt - 2);
            const char* a1 = cA + (size_t)(t + 1) * kstep;
            const char* a2 = last ? nA : cA + (size_t)(t + 2) * kstep; const char* b2 = last ? nB : cB + (size_t)(t + 2) * kstep;
            const char* a3 = a2 + kstep; const char* b3 = b2 + kstep;
            PG8_LDB(B0, 0, 0); PG8_LDB(B1, 0, 1); PG8_SCHED; PG8_LDA(At, 0, 0); PG8_STAGE(PG8_SA(1, 1), a1 + hstep, voffA);
            PG8_WAIT_V(8); PG8_WAIT_L(0); PG8_BAR; PG8_MMA(0, 0, At, B0); PG8_MMA(0, 1, At, B1); PG8_BAR; PG8_SCHED;
            PG8_LDA(At, 0, 1); PG8_STAGE(PG8_SB(0, 0), b2, voffB); PG8_STAGE(PG8_SB(0, 1), b2 + hstep, voffB); PG8_STAGE(PG8_SA(0, 0), a2, voffA);
            PG8_WAIT_V(8); PG8_WAIT_L(0); PG8_BAR; PG8_MMA(1, 0, At, B0); PG8_MMA(1, 1, At, B1); PG8_BAR; PG8_SCHED;
            PG8_LDB(B0, 1, 0); PG8_LDB(B1, 1, 1); PG8_SCHED; PG8_LDA(At, 1, 0); PG8_STAGE(PG8_SA(0, 1), a2 + hstep, voffA);
            PG8_WAIT_V(8); PG8_WAIT_L(0); PG8_BAR; PG8_MMA(0, 0, At, B0); PG8_MMA(0, 1, At, B1); PG8_BAR; PG8_SCHED;
            PG8_LDA(At, 1, 1); PG8_STAGE(PG8_SB(1, 0), b3, voffB); PG8_STAGE(PG8_SB(1, 1), b3 + hstep, voffB); PG8_STAGE(PG8_SA(1, 0), a3, voffA);
            PG8_WAIT_V(8); PG8_WAIT_L(0); PG8_BAR; PG8_MMA(1, 0, At, B0); PG8_MMA(1, 1, At, B1); PG8_BAR; PG8_SCHED;
        }
        if constexpr (ALIGN_EPI) { if (wr == 0) PG8_BAR; }
        E(acc, cur, wr, wc, fr, fq);
        if (!has_next) break;
#pragma unroll
        for (int a = 0; a < 2; ++a)
#pragma unroll
            for (int b = 0; b < 2; ++b)
#pragma unroll
                for (int m = 0; m < 4; ++m)
#pragma unroll
                    for (int n = 0; n < 2; ++n) acc[a][b][m][n] = (f32x4){0.f, 0.f, 0.f, 0.f};
        cur = nxt; cA = nA; cB = nB; ++ui;
        if constexpr (ALIGN_EPI) { if (wr == 1) PG8_BAR; }
    }
    PG8_WAIT_V(0);
    if constexpr (!ALIGN_EPI) { if (wr == 0) PG8_BAR; }
    PG8_BAR;
#undef PG8_SA
#undef PG8_SB
#undef PG8_STAGE
#undef PG8_LDA
#undef PG8_LDB
#undef PG8_MMA
#undef PG8_WAIT_V
#undef PG8_WAIT_L
#undef PG8_BAR
#undef PG8_SCHED
}
}


#define XB_TMO      128
#define XB_XCNT(j)  (256  + 64 * (j))
#define XB_XSUB(j)  (1280 + 64 * (j))
#define XB_XGEN(j)  (2304 + 64 * (j))
#define XB_TOP      3328
#define XB_TOPGEN   3392
#define XCD_BAR_WORDS 3456
#define XB_SPIN_CAP (1u << 22)
__device__ __forceinline__ unsigned xb_ld(unsigned* p)              { return __hip_atomic_load(p, __ATOMIC_RELAXED, __HIP_MEMORY_SCOPE_AGENT); }
__device__ __forceinline__ unsigned xb_add(unsigned* p, unsigned v) { return __hip_atomic_fetch_add(p, v, __ATOMIC_RELAXED, __HIP_MEMORY_SCOPE_AGENT); }
__device__ __forceinline__ unsigned xb_xcc_id() { return (unsigned)__builtin_amdgcn_s_getreg((3 << 11) | 20) & 0xFu; }
#define XB_SPIN(cond, bar) do { unsigned _sp = 0; while (cond) { __builtin_amdgcn_s_sleep(1); \
    if ((++_sp & 255u) == 0u) { if (xb_ld(&(bar)[XB_TMO])) break; if (_sp > XB_SPIN_CAP) { atomicAdd(&(bar)[XB_TMO], 1u); break; } } } } while (0)
struct XcdBarrier { unsigned* bar; unsigned x; volatile LAS unsigned* st; };
__device__ __forceinline__ XcdBarrier xcd_barrier_post(unsigned* bar, volatile LAS unsigned* st) {
    XcdBarrier b; b.bar = bar; b.x = xb_xcc_id(); b.st = st;
    if (threadIdx.x == 0) (void)xb_add(&bar[XB_XCNT(b.x)], 1u);
    return b;
}
__device__ __forceinline__ void xcd_barrier_complete(unsigned* bar, unsigned x, unsigned& nloc, unsigned& nx) {
    const unsigned G = gridDim.x * gridDim.y * gridDim.z;
    unsigned sum, cnt, mine, sp = 0u;
    for (;;) {
        sum = 0u; cnt = 0u; mine = 0u;
#pragma unroll
        for (unsigned j = 0; j < 16; ++j) { const unsigned c = xb_ld(&bar[XB_XCNT(j)]); sum += c; cnt += (c > 0u) ? 1u : 0u; mine = (j == x) ? c : mine; }
        if (sum == G) break;
        __builtin_amdgcn_s_sleep(1);
        if ((++sp & 255u) == 0u) { if (xb_ld(&bar[XB_TMO])) break; if (sp > XB_SPIN_CAP) { atomicAdd(&bar[XB_TMO], 1u); break; } }
    }
    nloc = mine > 0u ? mine : 1u; nx = cnt > 0u ? cnt : 1u;
}
__device__ __forceinline__ void xcd_barrier(unsigned char* wsb) {
    XcdBarrier b; b.bar = (unsigned*)(wsb + WS_BAR); b.x = 0; b.st = (volatile LAS unsigned*)(135168 + 64);
    asm volatile("s_waitcnt vmcnt(0)" ::: "memory");
    __syncthreads();
    if (threadIdx.x == 0) {
        unsigned* bar = b.bar; b.x = xb_xcc_id();
        __builtin_amdgcn_s_waitcnt(0);
        unsigned nloc = b.st[0], nx = b.st[1];
        if (nloc == 0u) { xcd_barrier_complete(bar, b.x, nloc, nx); b.st[0] = nloc; b.st[1] = nx; }
        const unsigned old = xb_add(&bar[XB_XSUB(b.x)], 1u);
        const unsigned gen = old / nloc;
        if (old + 1u == (gen + 1u) * nloc) {
            __builtin_amdgcn_fence(__ATOMIC_RELEASE, "agent");
            asm volatile("s_waitcnt vmcnt(0)" ::: "memory");
            const unsigned og = xb_add(&bar[XB_TOP], 1u);
            const unsigned tg = og / nx;
            if (og + 1u == (tg + 1u) * nx) xb_add(&bar[XB_TOPGEN], 1u);
            else XB_SPIN(xb_ld(&bar[XB_TOPGEN]) == tg, bar);
            __builtin_amdgcn_fence(__ATOMIC_ACQUIRE, "agent");
            xb_add(&bar[XB_XGEN(b.x)], 1u);
            asm volatile("s_waitcnt vmcnt(0)" ::: "memory");
        } else {
            XB_SPIN(xb_ld(&bar[XB_XGEN(b.x)]) == gen, bar);
            __builtin_amdgcn_fence(__ATOMIC_ACQUIRE, "agent");
            asm volatile("s_waitcnt vmcnt(0)" ::: "memory");
        }
    }
    __syncthreads();
}

struct Params { const float* in[24]; float* out; unsigned char* ws; };
struct PRef {
    typedef const __attribute__((address_space(4))) char* kptr_t;
    __device__ __forceinline__ kptr_t base() const { kptr_t ka = (kptr_t)__builtin_amdgcn_kernarg_segment_ptr(); asm volatile("" : "+s"(ka)); return ka; }
    __device__ __forceinline__ const float* in(int i) const { return *(const float* const __attribute__((address_space(4)))*)(base() + 8 * i); }
    __device__ __forceinline__ float* out() const { return *(float* const __attribute__((address_space(4)))*)(base() + 8 * 24); }
    __device__ __forceinline__ unsigned char* ws() const { return *(unsigned char* const __attribute__((address_space(4)))*)(base() + 8 * 25); }
};
enum { I_X = 0, I_C, I_CTX, I_CCTX, I_MODW, I_MODB, I_N1G, I_N2G, I_WIN, I_DAQKG, I_DALAM, I_DAOUTG, I_CONVW, I_CONVB, I_GATEB, I_MLOUTG, I_QNG, I_KVNG, I_WUQ, I_WUKV, I_MLAQKG, I_WOUT, I_WGU, I_WDN };

struct Ctx {
    unsigned char* lds;
    int tid, lane, wave, gw, ngw, nwg, wg; unsigned l3off;
};

__device__ __forceinline__ Ctx fresh(const Ctx& X) {
    Ctx Y = X; int t = X.tid; asm volatile("" : "+v"(t)); Y.tid = t; Y.lane = t & 63; Y.wave = __builtin_amdgcn_readfirstlane(t >> 6); return Y;
}
template <int MODE>
__device__ __forceinline__ void transpose_item(const float* W, int K, int N, bf16_t* WT, float* scr, int item, int nblk, int lane) {
    const int kb = item / nblk, nb = item % nblk, k0 = 64 * kb, n0 = 32 * nb;
    const int ncol = n0 + (lane & 31); const bool ok = ncol < N;
#pragma unroll 8
    for (int i = 0; i < 32; ++i) { const int kk = 2 * i + (lane >> 5); scr[kk * 33 + (lane & 31)] = ok ? W[(size_t)(k0 + kk) * N + ncol] : 0.f; }
    asm volatile("s_waitcnt lgkmcnt(0)" ::: "memory");
    const int c = lane & 7;
#pragma unroll
    for (int j = 0; j < 4; ++j) { const int n = (lane >> 3) + 8 * j; const float* s = scr + (8 * c) * 33 + n;
        u32x4 o; o.x = pk2(s[0 * 33], s[1 * 33]); o.y = pk2(s[2 * 33], s[3 * 33]); o.z = pk2(s[4 * 33], s[5 * 33]); o.w = pk2(s[6 * 33], s[7 * 33]);
        int nn = n0 + n;
        if (MODE == 1) { const int up = nn >= FF ? 1 : 0; const int hcol = nn - up * FF; nn = (hcol >> 7) * 256 + up * 128 + (hcol & 127); }
        *(u32x4*)(WT + (size_t)nn * K + k0 + 8 * c) = o; }
    asm volatile("s_waitcnt lgkmcnt(0)" ::: "memory");
}
__device__ __forceinline__ void convert_weights(const Ctx& X0, const PRef& P, int l, int part, int wg_lo) {
    const Ctx X = fresh(X0);
    const int vwg = X.wg - wg_lo; if (vwg < 0) return;
    const int gwv = vwg * 8 + X.wave, ngwv = (X.nwg - wg_lo) * 8;
    float* scr = (float*)(X.lds + X.wave * 16384);
    unsigned char* ws = P.ws();
    constexpr int I_IN = (DM / 64) * (NPROJ / 32), I_OUT = (DM / 64) * (DM / 32), I_GU = (DM / 64) * (2 * FF / 32), I_DN = (FF / 64) * (DM / 32), I_UQ = (512 / 64) * (1536 / 32), I_UKV = (256 / 64) * (2048 / 32);
    constexpr int NITEMS = I_IN + I_OUT + I_GU + I_DN + I_UQ + I_UKV;
    const int it_lo = part == 2 ? NITEMS - I_DN : 0, it_hi = part == 1 ? NITEMS - I_DN : NITEMS;
    for (int it = it_lo + gwv; it < it_hi; it += ngwv) {
        int r = it;
        if (r < I_IN) { transpose_item<0>(P.in(I_WIN) + (size_t)l * DM * IN_W, DM, IN_W, (bf16_t*)(ws + WS_WIN), scr, r, NPROJ / 32, X.lane); continue; } r -= I_IN;
        if (r < I_OUT) { transpose_item<0>(P.in(I_WOUT) + (size_t)l * DM * DM, DM, DM, (bf16_t*)(ws + WS_WOUT), scr, r, DM / 32, X.lane); continue; } r -= I_OUT;
        if (r < I_GU) { transpose_item<1>(P.in(I_WGU) + (size_t)l * DM * 2 * FF, DM, 2 * FF, (bf16_t*)(ws + WS_WGU), scr, r, 2 * FF / 32, X.lane); continue; } r -= I_GU;
        if (r < I_UQ) { transpose_item<0>(P.in(I_WUQ) + (size_t)l * 512 * 1536, 512, 1536, (bf16_t*)(ws + WS_WUQ), scr, r, 1536 / 32, X.lane); continue; } r -= I_UQ;
        if (r < I_UKV) { transpose_item<0>(P.in(I_WUKV) + (size_t)l * 256 * 2048, 256, 2048, (bf16_t*)(ws + WS_WUKV), scr, r, 2048 / 32, X.lane); continue; } r -= I_UKV;
        transpose_item<0>(P.in(I_WDN) + (size_t)l * FF * DM, FF, DM, (bf16_t*)(ws + WS_WDN), scr, r, DM / 32, X.lane);
    }
}
__device__ __forceinline__ void mod_gemv(const Ctx& X0, const PRef& P, int l_lo, int l_hi, int wg_lo) {
    const Ctx X = fresh(X0);
    const int vwg = X.wg - wg_lo; if (vwg < 0) return;
    float* sc = (float*)X.lds;
    float* red = (float*)(X.lds + 40960);
    for (int i = X.tid; i < 5 * DM; i += 512) { const int mb = i / DM, k = i % DM; const float v = mb < 4 ? P.in(I_C)[mb * DM + k] : P.in(I_CCTX)[k]; sc[i] = siluf(v); }
    __syncthreads();
    float* mod = (float*)(P.ws() + WS_MOD);
    const int kq = X.tid >> 4, c4 = X.tid & 15;
    for (int task = vwg; task < (l_hi - l_lo) * 192; task += X.nwg - wg_lo) {
        const int l = l_lo + task / 192, n0 = (task % 192) * 64;
        const float* W = P.in(I_MODW) + (size_t)l * DM * 6 * DM + n0 + 4 * c4;
        f32x4 a[5];
#pragma unroll
        for (int mb = 0; mb < 5; ++mb) a[mb] = (f32x4){0.f, 0.f, 0.f, 0.f};
#pragma unroll 8
        for (int i = 0; i < 64; ++i) { const int k = kq + 32 * i; const f32x4 w = *(const f32x4*)(W + (size_t)k * 6 * DM);
#pragma unroll
            for (int mb = 0; mb < 5; ++mb) a[mb] += w * sc[mb * DM + k]; }
#pragma unroll
        for (int mb = 0; mb < 5; ++mb) *(f32x4*)(red + (kq * 5 + mb) * 64 + 4 * c4) = a[mb];
        __syncthreads();
        if (X.tid < 320) { const int mb = X.tid >> 6, cc = X.tid & 63; float s = 0.f;
#pragma unroll 8
            for (int q = 0; q < 32; ++q) s += red[(q * 5 + mb) * 64 + cc];
            mod[((size_t)l * 5 + mb) * 6 * DM + n0 + cc] = s + P.in(I_MODB)[(size_t)l * 6 * DM + n0 + cc]; }
        __syncthreads();
    }
}

__device__ __forceinline__ void modulate_phase(const Ctx& X0, const float* src_lat, const float* src_ctx, const float* g, const float* modl, int shift_off, int scale_off, bf16_t* A, int nrows) {
    const Ctx X = fresh(X0);
    const int rpw = (nrows + X.ngw - 1) / X.ngw;
    int row = X.gw * rpw; const int rend = min(row + rpw, nrows);
    f32x4 v[8], nx[8], gm[8], sh[8];
    int cur_mb = -1;
    if (row < rend) { const float* src = row < M_LAT ? src_lat + (size_t)row * DM : src_ctx + (size_t)(row - M_LAT) * DM;
#pragma unroll
        for (int j = 0; j < 8; ++j) v[j] = *(const f32x4*)(src + X.lane * 4 + 256 * j); }
    for (; row < rend; ++row) {
        const int nrow = row + 1;
        if (nrow < rend) { const float* src = nrow < M_LAT ? src_lat + (size_t)nrow * DM : src_ctx + (size_t)(nrow - M_LAT) * DM;
#pragma unroll
            for (int j = 0; j < 8; ++j) nx[j] = *(const f32x4*)(src + X.lane * 4 + 256 * j); }
        const int mb = mod_batch(row);
        if (mb != cur_mb) { cur_mb = mb; const float* mp = modl + (size_t)mb * 6 * DM;
#pragma unroll
            for (int j = 0; j < 8; ++j) { const int col = X.lane * 4 + 256 * j; gm[j] = *(const f32x4*)(g + col) * (*(const f32x4*)(mp + scale_off + col) + 1.0f); sh[j] = *(const f32x4*)(mp + shift_off + col); } }
        float ss = 0.f;
#pragma unroll
        for (int j = 0; j < 8; ++j) ss += (v[j][0] * v[j][0] + v[j][1] * v[j][1]) + (v[j][2] * v[j][2] + v[j][3] * v[j][3]);
        const float rstd = rsqrtf(wave_sum(ss) * (1.f / DM) + EPS);
#pragma unroll
        for (int j = 0; j < 8; ++j) { const int col = X.lane * 4 + 256 * j;
            const f32x4 y = (v[j] * rstd) * gm[j] + sh[j];
            u32x2 w; w.x = pk2(y[0], y[1]); w.y = pk2(y[2], y[3]);
            *(u32x2*)(A + (size_t)row * DM + col) = w; }
#pragma unroll
        for (int j = 0; j < 8; ++j) v[j] = nx[j];
    }
}

struct ChunkId { int b, j, row0, tok0, is_lat, seglen; };
__device__ __forceinline__ ChunkId chunk_of_unit(int u) {
    ChunkId c;
    if (u < 256) { c.b = u >> 6; c.j = u & 63; c.row0 = c.b * SEQ + 64 * c.j; c.tok0 = CTXL + 64 * c.j; c.is_lat = 1; c.seglen = SEQ; }
    else { const int uu = u - 256; c.b = uu >> 2; c.j = uu & 3; c.row0 = M_LAT + c.b * CTXL + 64 * c.j; c.tok0 = 64 * c.j; c.is_lat = 0; c.seglen = CTXL; }
    return c;
}
__device__ __forceinline__ int row_of_tokchunk(int b, int jt) { return jt < 4 ? M_LAT + b * CTXL + 64 * jt : b * SEQ + 64 * (jt - 4); }

constexpr int TSTR = 520;
__device__ __forceinline__ void write_vt(const Ctx& X, const bf16_t* tile, bf16_t* img, size_t img_row0, int tok0) {
#pragma unroll 2
    for (int it = 0; it < 8; ++it) { const int task = it * 512 + X.tid; const int k = task & 7, c = task >> 3;
        float v[8];
#pragma unroll
        for (int jj = 0; jj < 8; ++jj) { const int i = 16 * (k >> 1) + 8 * (jj >> 2) + 4 * (k & 1) + (jj & 3); v[jj] = bf1(tile[i * TSTR + c]); }
        *(u32x4*)(img + (img_row0 + c) * TK + tok0 + 8 * k) = pack8(v); }
}
template <class F>
__device__ __forceinline__ void load_tile(const Ctx& X, bf16_t* tile, const bf16_t* src, size_t rstride, F colmap) {
#pragma unroll 4
    for (int it = 0; it < 8; ++it) { const int ch = it * 512 + X.tid; const int i = ch >> 6, cc = ch & 63;
        const u32x4 w = *(const u32x4*)(src + (size_t)i * rstride + colmap(cc));
        *(u32x4*)(tile + i * TSTR + 8 * cc) = w; }
}

__device__ __forceinline__ void rope_cs(int sub, int prow, int pcol, float* cs, float* sn) {
    const float pos = (float)((sub < 4) ? prow : pcol);
#pragma unroll
    for (int e = 0; e < 8; ++e) { const int fi = (sub & 1) * 8 + e; const float inv = exp2f(-(float)fi * (13.287712379549449f / 16.0f)); const float a = pos * inv; cs[e] = __cosf(a); sn[e] = __sinf(a); }
}
__device__ __forceinline__ void rope_apply(int sub, float* y, const float* cs, const float* sn) {
#pragma unroll
    for (int e = 0; e < 8; ++e) { const float p = __shfl_xor(y[e], 2); y[e] = (sub & 2) ? (y[e] * cs[e] + p * sn[e]) : (y[e] * cs[e] - p * sn[e]); }
}

__device__ __forceinline__ void prep_phase(const Ctx& X0, const PRef& P, int l) {
    const Ctx X = fresh(X0);
    unsigned char* ws = P.ws();
    const bf16_t* proj = (const bf16_t*)(ws + WS_PROJ);
    bf16_t* tile = (bf16_t*)X.lds;
    const float* qkg = P.in(I_DAQKG) + l * 128;
    const float* convw = P.in(I_CONVW) + (size_t)l * 3 * 1024; const float* convb = P.in(I_CONVB) + l * 1024;
    const float* qng = P.in(I_QNG) + l * 512; const float* kvng = P.in(I_KVNG) + l * 256;
    const int lane = X.lane, sub = lane & 7;
    const float qscale = 0.125f * LOG2E;
    for (int uu = X.wg; uu < 4 * 272; uu += X.nwg) {
        const int part = uu / 272, u = uu % 272;
        const ChunkId c = chunk_of_unit(u);
        if (part == 0) {
        for (int i = X.wave; i < 64; i += 8) {
            const int row = c.row0 + i, tok = c.tok0 + i;
            const bf16_t* pr = proj + (size_t)row * NPROJ;
            float cs[8], sn[8];
            if (c.is_lat) rope_cs(sub, c.j, i, cs, sn);
#pragma unroll
            for (int qk = 0; qk < 2; ++qk) {
                float y[8]; unpack8(*(const u32x4*)(pr + (qk ? C_DAK : C_DAQ) + 8 * lane), y);
                float ss = 0.f;
#pragma unroll
                for (int e = 0; e < 8; ++e) ss += y[e] * y[e];
                ss += __shfl_xor(ss, 1); ss += __shfl_xor(ss, 2); ss += __shfl_xor(ss, 4);
                const float rstd = rsqrtf(ss * (1.f / 64.f) + EPS);
#pragma unroll
                for (int e = 0; e < 8; ++e) y[e] = y[e] * rstd * qkg[qk * 64 + 8 * sub + e];
                if (c.is_lat) rope_apply(sub, y, cs, sn);
                const int head = lane >> 4, comp = (lane >> 3) & 1;
                if (qk == 0) {
#pragma unroll
                    for (int e = 0; e < 8; ++e) y[e] *= qscale;
                    *(u32x4*)((bf16_t*)(ws + WS_QDA) + ((size_t)head * M_ALL + row) * 128 + comp * 64 + 8 * sub) = pack8(y);
                } else {
                    *(u32x4*)((bf16_t*)(ws + WS_KDA) + ((size_t)(c.b * 4 + head) * TK + tok) * 128 + comp * 64 + 8 * sub) = pack8(y);
                }
            }
            {
                float y[8]; unpack8(*(const u32x4*)(pr + C_CQ + 8 * lane), y);
                float ss = 0.f;
#pragma unroll
                for (int e = 0; e < 8; ++e) ss += y[e] * y[e];
                const float rstd = rsqrtf(wave_sum(ss) * (1.f / 512.f) + EPS);
#pragma unroll
                for (int e = 0; e < 8; ++e) y[e] = y[e] * rstd * qng[8 * lane + e];
                *(u32x4*)((bf16_t*)(ws + WS_CQN) + (size_t)row * 512 + 8 * lane) = pack8(y);
            }
            {
                float y[8];
                if (lane < 32) unpack8(*(const u32x4*)(pr + C_CKV + 8 * lane), y);
                else {
#pragma unroll
                    for (int e = 0; e < 8; ++e) y[e] = 0.f;
                }
                float ss = 0.f;
#pragma unroll
                for (int e = 0; e < 8; ++e) ss += y[e] * y[e];
                const float rstd = rsqrtf(wave_sum(ss) * (1.f / 256.f) + EPS);
                if (lane < 32) {
#pragma unroll
                    for (int e = 0; e < 8; ++e) y[e] = y[e] * rstd * kvng[8 * lane + e];
                    *(u32x4*)((bf16_t*)(ws + WS_CKVN) + (size_t)row * 256 + 8 * lane) = pack8(y);
                }
            }
            if (lane < 8) *(u32x4*)((bf16_t*)(ws + WS_KPE) + (size_t)row * 64 + 8 * lane) = *(const u32x4*)(pr + C_KPE + 8 * lane);
            *(u32x4*)((bf16_t*)(ws + WS_OCOPY) + (size_t)row * 512 + 8 * lane) = *(const u32x4*)(pr + C_MLO + 8 * lane);
        }
        } else if (part == 1) {
        for (int i = X.wave; i < 64; i += 8) {
            const int row = c.row0 + i, tseg = 64 * c.j + i, tok = c.tok0 + i;
            const bf16_t* pr = proj + (size_t)row * NPROJ;
#pragma unroll
            for (int qk = 0; qk < 2; ++qk) {
                const int ch0 = qk * 512 + 8 * lane;
                float xm[8], x0[8], xp[8];
                unpack8(*(const u32x4*)(pr + C_MLQ + ch0), x0);
                if (tseg > 0) unpack8(*(const u32x4*)(pr - NPROJ + C_MLQ + ch0), xm);
                else {
#pragma unroll
                    for (int e = 0; e < 8; ++e) xm[e] = 0.f;
                }
                if (tseg < c.seglen - 1) unpack8(*(const u32x4*)(pr + NPROJ + C_MLQ + ch0), xp);
                else {
#pragma unroll
                    for (int e = 0; e < 8; ++e) xp[e] = 0.f;
                }
                float y[8];
#pragma unroll
                for (int e = 0; e < 8; ++e) { const float v = convb[ch0 + e] + convw[ch0 + e] * xm[e] + convw[1024 + ch0 + e] * x0[e] + convw[2048 + ch0 + e] * xp[e]; y[e] = siluf(v) * (qk ? 0.08838834764831845f : 1.0f); }
                const int head = lane >> 4, d = 8 * (lane & 15);
                const u32x4 w = pack8(y);
                *(u32x4*)((bf16_t*)(ws + (qk ? WS_KML : WS_QML)) + ((size_t)(c.b * 4 + head) * TK + tok) * 128 + d) = w;
                if (qk) *(u32x4*)(tile + i * TSTR + 8 * lane) = w;
            }
        }
        __syncthreads();
        write_vt(X, tile, (bf16_t*)(ws + WS_KTML), (size_t)c.b * 512, c.tok0);
        __syncthreads();
        } else if (part == 2) {
        load_tile(X, tile, proj + (size_t)c.row0 * NPROJ, NPROJ, [](int cc) { return C_DAV + 8 * cc; });
        __syncthreads();
        write_vt(X, tile, (bf16_t*)(ws + WS_VTDA), (size_t)c.b * 512, c.tok0);
        __syncthreads();
        } else {
        load_tile(X, tile, proj + (size_t)c.row0 * NPROJ, NPROJ, [](int cc) { return C_MLV + 8 * cc; });
        __syncthreads();
        write_vt(X, tile, (bf16_t*)(ws + WS_VTML), (size_t)c.b * 512, c.tok0);
        __syncthreads();
        }
    }
}

__device__ __forceinline__ void mla_prep_phase(const Ctx& X0, const PRef& P, int l) {
    const Ctx X = fresh(X0);
    unsigned char* ws = P.ws();
    const bf16_t* qup = (const bf16_t*)(ws + WS_QUP); const bf16_t* kvup = (const bf16_t*)(ws + WS_KVUP); const bf16_t* kpe = (const bf16_t*)(ws + WS_KPE);
    bf16_t* tile = (bf16_t*)X.lds;
    const float* g = P.in(I_MLAQKG) + l * 2 * 192;
    const int lane = X.lane, sub = lane & 7, head = lane >> 3;
    const float qscale = 0.07216878364870322f * LOG2E;
    for (int uu = X.wg; uu < 3 * 272; uu += X.nwg) {
        const int part = uu / 272, u = uu % 272;
        const ChunkId c = chunk_of_unit(u);
        if (part == 0) {
        for (int i = X.wave; i < 64; i += 8) {
            const int row = c.row0 + i, tok = c.tok0 + i;
            float cs[8], sn[8];
            if (c.is_lat) rope_cs(sub, c.j, i, cs, sn);
#pragma unroll
            for (int qk = 0; qk < 2; ++qk) {
                float y[3][8];
                if (qk == 0) {
#pragma unroll
                    for (int cc = 0; cc < 3; ++cc) unpack8(*(const u32x4*)(qup + (size_t)row * 1536 + head * 192 + 64 * cc + 8 * sub), y[cc]);
                } else {
#pragma unroll
                    for (int cc = 0; cc < 2; ++cc) unpack8(*(const u32x4*)(kvup + (size_t)row * 2048 + head * 256 + 64 * cc + 8 * sub), y[cc]);
                    unpack8(*(const u32x4*)(kpe + (size_t)row * 64 + 8 * sub), y[2]);
                }
                float ss = 0.f;
#pragma unroll
                for (int cc = 0; cc < 3; ++cc)
#pragma unroll
                    for (int e = 0; e < 8; ++e) ss += y[cc][e] * y[cc][e];
                ss += __shfl_xor(ss, 1); ss += __shfl_xor(ss, 2); ss += __shfl_xor(ss, 4);
                const float rstd = rsqrtf(ss * (1.f / 192.f) + EPS);
#pragma unroll
                for (int cc = 0; cc < 3; ++cc)
#pragma unroll
                    for (int e = 0; e < 8; ++e) y[cc][e] = y[cc][e] * rstd * g[qk * 192 + 64 * cc + 8 * sub + e];
                if (c.is_lat) rope_apply(sub, y[2], cs, sn);
                bf16_t* dst;
                if (qk == 0) {
#pragma unroll
                    for (int cc = 0; cc < 3; ++cc)
#pragma unroll
                        for (int e = 0; e < 8; ++e) y[cc][e] *= qscale;
                    dst = (bf16_t*)(ws + WS_QM) + ((size_t)head * M_ALL + row) * 192;
                } else dst = (bf16_t*)(ws + WS_KM) + ((size_t)(c.b * 8 + head) * TK + tok) * 192;
#pragma unroll
                for (int cc = 0; cc < 3; ++cc) *(u32x4*)(dst + 64 * cc + 8 * sub) = pack8(y[cc]);
            }
        }
        } else {
            const int p = part - 1;
            load_tile(X, tile, kvup + (size_t)c.row0 * 2048, 2048, [p](int cc) { return (4 * p + (cc >> 4)) * 256 + 128 + 8 * (cc & 15); });
            __syncthreads();
            write_vt(X, tile, (bf16_t*)(ws + WS_VTM), (size_t)(c.b * 8 + 4 * p) * 128, c.tok0);
            __syncthreads();
        }
    }
}

__device__ __forceinline__ void ml_gates(const float* gates, const float* gb, int b, int jt, int dir, int h, int lane, float& ig, float& lf, float& pre, float& total) {
    const int row = row_of_tokchunk(b, jt) + lane;
    ig = gates[(size_t)row * 16 + dir * 8 + h] + gb[dir * 8 + h];
    const float fg = gates[(size_t)row * 16 + dir * 8 + 4 + h] + gb[dir * 8 + 4 + h];
    lf = fminf(fg, 0.f) - log1pf(__expf(-fabsf(fg)));
    float s = lf;
#pragma unroll
    for (int o = 1; o < 64; o <<= 1) { const float t = __shfl_up(s, o); if (lane >= o) s += t; }
    pre = s; total = __shfl(s, 63);
}
constexpr int KSTR = 72;
constexpr int QSTR = 136;
__device__ __forceinline__ void mlstm_a_phase(const Ctx& X0, const PRef& P, int l) {
    const Ctx X = fresh(X0);
    unsigned char* ws = P.ws();
    const float* gates = (const float*)(ws + WS_GATES); const float* gb = P.in(I_GATEB) + l * 16;
    bf16_t* Kt = (bf16_t*)X.lds;
    bf16_t* Vw = (bf16_t*)(X.lds + 128 * KSTR * 2);
    float* wtab = (float*)(X.lds + 3 * 128 * KSTR * 2);
    const int lane = X.lane, r32 = lane & 31, hi = lane >> 5;
    for (int u = X.wg; u < 16 * NCH; u += X.nwg) {
        const int bh = u / NCH, jt = u % NCH, b = bh >> 2, h = bh & 3, tok0 = 64 * jt;
        if (X.wave < 2) {
            const int dir = X.wave; float ig, lf, pre, total; ml_gates(gates, gb, b, jt, dir, h, lane, ig, lf, pre, total);
            const float cum = dir == 0 ? pre : total - pre + lf;
            const float wlog = total - cum + ig; const float mloc = wave_max(wlog);
            wtab[dir * 64 + lane] = __expf(wlog - mloc);
            if (lane == 0) { float* cs = (float*)(ws + WS_CSTAT) + ((size_t)(bh * 2 + dir) * NCH + jt) * 4; cs[0] = total; cs[1] = mloc; }
        }
        u32x4 vr[2];
#pragma unroll
        for (int it = 0; it < 2; ++it) { const int ch = it * 512 + X.tid; const int rr = ch >> 3, k = ch & 7;
            *(u32x4*)(Kt + rr * KSTR + 8 * k) = *(const u32x4*)((const bf16_t*)(ws + WS_KTML) + ((size_t)bh * 128 + rr) * TK + tok0 + 8 * k);
            vr[it] = *(const u32x4*)((const bf16_t*)(ws + WS_VTML) + ((size_t)bh * 128 + rr) * TK + tok0 + 8 * k); }
        __syncthreads();
#pragma unroll
        for (int it = 0; it < 2; ++it) { const int ch = it * 512 + X.tid; const int rr = ch >> 3, k = ch & 7;
            float v[8]; unpack8(vr[it], v);
#pragma unroll
            for (int dir = 0; dir < 2; ++dir) { float o[8];
#pragma unroll
                for (int jj = 0; jj < 8; ++jj) { const int i = 16 * (k >> 1) + 8 * (jj >> 2) + 4 * (k & 1) + (jj & 3); o[jj] = v[jj] * wtab[dir * 64 + i]; }
                *(u32x4*)(Vw + (dir * 128 + rr) * KSTR + 8 * k) = pack8(o); } }
        __syncthreads();
        {
            const int dir = X.wave >> 2, dvb = X.wave & 3;
            bf16_t* U = (bf16_t*)(ws + WS_AB) + ((size_t)(bh * 2 + dir) * NCH + jt) * 16384;
            bf16x8 a[4];
#pragma unroll
            for (int ks = 0; ks < 4; ++ks) a[ks] = *(const bf16x8*)(Vw + (dir * 128 + 32 * dvb + r32) * KSTR + 16 * ks + 8 * hi);
            for (int dkb = 0; dkb < 4; ++dkb) {
                f32x16 acc;
#pragma unroll
                for (int r = 0; r < 16; ++r) acc[r] = 0.f;
#pragma unroll
                for (int ks = 0; ks < 4; ++ks) { const bf16x8 bb = *(const bf16x8*)(Kt + (32 * dkb + r32) * KSTR + 16 * ks + 8 * hi); acc = __builtin_amdgcn_mfma_f32_32x32x16_bf16(a[ks], bb, acc, 0, 0, 0); }
#pragma unroll
                for (int r = 0; r < 16; ++r) U[(32 * dvb + crow(r, hi)) * 128 + 32 * dkb + r32] = (bf16_t)(pk2(acc[r], 0.f) & 0xffffu);
            }
        }
        if (X.tid < 256) { const int dir = X.tid >> 7, dk = X.tid & 127; float s = 0.f;
#pragma unroll 8
            for (int p = 0; p < 64; ++p) { const int i = (p & ~15) + perm_off(p & 15); s += wtab[dir * 64 + i] * bf1(Kt[dk * KSTR + p]); }
            ((float*)(ws + WS_NU))[((size_t)(bh * 2 + dir) * NCH + jt) * 128 + dk] = s; }
        __syncthreads();
    }
}
__device__ __forceinline__ int ml_jmap(int dir, int c) { return dir == 0 ? c : (c < 4 ? 3 - c : 71 - c); }
__device__ __forceinline__ void mlstm_scan_phase(const Ctx& X0, const PRef& P) {
    const Ctx X = fresh(X0);
    unsigned char* ws = P.ws();
    float* cstat = (float*)(ws + WS_CSTAT);
    const int gtid = X.wg * 512 + X.tid, nthr = X.nwg * 512;
    for (int task = gtid; task < 65536 + 1024; task += nthr) {
        float m = 0.f;
        if (task < 65536) {
            const int seq = task >> 11, e = task & 2047, dir = seq & 1;
            const bf16_t* __restrict__ U = (const bf16_t*)(ws + WS_AB); bf16_t* __restrict__ S = (bf16_t*)(ws + WS_CSNAP);
            float C[8];
#pragma unroll
            for (int i = 0; i < 8; ++i) C[i] = 0.f;
            for (int cb = 0; cb < 4; ++cb) {
                u32x4 uu[17]; float tot[17], mlc[17];
#pragma unroll
                for (int i = 0; i < 17; ++i) { const size_t base = (size_t)seq * NCH + ml_jmap(dir, cb * 17 + i);
                    uu[i] = *(const u32x4*)(U + base * 16384 + 8 * e); tot[i] = cstat[base * 4]; mlc[i] = cstat[base * 4 + 1]; }
#pragma unroll
                for (int i = 0; i < 17; ++i) { const size_t base = (size_t)seq * NCH + ml_jmap(dir, cb * 17 + i);
                    *(u32x4*)(S + base * 16384 + 8 * e) = pack8(C);
                    if (e == 0) cstat[base * 4 + 2] = m;
                    const float mn = fmaxf(tot[i] + m, mlc[i]); const float dec = __expf(tot[i] + m - mn), sc = __expf(mlc[i] - mn);
                    float u8[8]; unpack8(uu[i], u8);
#pragma unroll
                    for (int q = 0; q < 8; ++q) C[q] = C[q] * dec + u8[q] * sc;
                    m = mn; }
            }
        } else {
            const int t2 = task - 65536, seq = t2 >> 5, e4 = t2 & 31, dir = seq & 1;
            const float* __restrict__ NU = (const float*)(ws + WS_NU); float* __restrict__ NS = (float*)(ws + WS_NSNAP);
            f32x4 C = (f32x4){0.f, 0.f, 0.f, 0.f};
            for (int cb = 0; cb < 4; ++cb) {
                f32x4 uu[17]; float tot[17], mlc[17];
#pragma unroll
                for (int i = 0; i < 17; ++i) { const size_t base = (size_t)seq * NCH + ml_jmap(dir, cb * 17 + i);
                    uu[i] = *(const f32x4*)(NU + base * 128 + 4 * e4); tot[i] = cstat[base * 4]; mlc[i] = cstat[base * 4 + 1]; }
#pragma unroll
                for (int i = 0; i < 17; ++i) { const size_t base = (size_t)seq * NCH + ml_jmap(dir, cb * 17 + i);
                    *(f32x4*)(NS + base * 128 + 4 * e4) = C;
                    const float mn = fmaxf(tot[i] + m, mlc[i]); const float dec = __expf(tot[i] + m - mn), sc = __expf(mlc[i] - mn);
                    C = C * dec + uu[i] * sc; m = mn; }
            }
        }
    }
}
__device__ __forceinline__ void mlstm_c_unit(const Ctx& X0, const PRef& P, int l, int u) {
    const Ctx X = fresh(X0);
    unsigned char* ws = P.ws();
    const float* gates = (const float*)(ws + WS_GATES); const float* gb = P.in(I_GATEB) + l * 16;
    const float* cstat = (const float*)(ws + WS_CSTAT);
    bf16_t* Qt = (bf16_t*)X.lds;
    bf16_t* Kn = (bf16_t*)(X.lds + 64 * QSTR * 2);
    bf16_t* Vt = (bf16_t*)(X.lds + 2 * 64 * QSTR * 2);
    float* tab = (float*)(X.lds + 2 * 64 * QSTR * 2 + 128 * KSTR * 2);
    float* t_a = tab, *t_c1 = tab + 128, *t_wp = tab + 256, *t_em = tab + 384, *t_n = tab + 512, *t_red = tab + 768;
    const int lane = X.lane, r32 = lane & 31, hi = lane >> 5;
    const int bh = u / NCH, jt = u % NCH, b = bh >> 2, h = bh & 3, tok0 = 64 * jt;
    if (X.wave < 2) {
        const int dir = X.wave; float ig, lf, pre, total; ml_gates(gates, gb, b, jt, dir, h, lane, ig, lf, pre, total);
        const float cum = dir == 0 ? pre : total - pre + lf;
        const float a = ig - cum; float pm = a;
#pragma unroll
        for (int o = 1; o < 64; o <<= 1) { const float t = dir == 0 ? __shfl_up(pm, o) : __shfl_down(pm, o); const bool ok = dir == 0 ? (lane >= o) : (lane + o < 64); if (ok) pm = fmaxf(pm, t); }
        const float mc = cstat[((size_t)(bh * 2 + dir) * NCH + jt) * 4 + 2];
        const float mt = cum + fmaxf(mc, pm);
        t_a[dir * 64 + lane] = a; t_c1[dir * 64 + lane] = cum - mt; t_wp[dir * 64 + lane] = __expf(cum + mc - mt); t_em[dir * 64 + lane] = __expf(-mt);
    }
#pragma unroll
    for (int it = 0; it < 2; ++it) { const int ch = it * 512 + X.tid;
        { const int i = ch >> 4, k = ch & 15;
          *(u32x4*)(Qt + i * QSTR + 8 * k) = *(const u32x4*)((const bf16_t*)(ws + WS_QML) + ((size_t)bh * TK + tok0 + i) * 128 + 8 * k);
          *(u32x4*)(Kn + i * QSTR + 8 * k) = *(const u32x4*)((const bf16_t*)(ws + WS_KML) + ((size_t)bh * TK + tok0 + i) * 128 + 8 * k); }
        { const int rr = ch >> 3, k = ch & 7;
          *(u32x4*)(Vt + rr * KSTR + 8 * k) = *(const u32x4*)((const bf16_t*)(ws + WS_VTML) + ((size_t)bh * 128 + rr) * TK + tok0 + 8 * k); } }
    if (X.tid < 256) t_n[X.tid] = ((const float*)(ws + WS_NSNAP))[((size_t)(bh * 2 + (X.tid >> 7)) * NCH + jt) * 128 + (X.tid & 127)];
    __syncthreads();
    const int tb = X.wave & 1, db = X.wave >> 1, t = 32 * tb + r32;
    bf16x8 qf[8];
#pragma unroll
    for (int ks = 0; ks < 8; ++ks) qf[ks] = *(const bf16x8*)(Qt + t * QSTR + 16 * ks + 8 * hi);
    f32x16 st[2];
#pragma unroll
    for (int sb = 0; sb < 2; ++sb) {
#pragma unroll
        for (int r = 0; r < 16; ++r) st[sb][r] = 0.f;
#pragma unroll
        for (int ks = 0; ks < 8; ++ks) { const bf16x8 kf = *(const bf16x8*)(Kn + (32 * sb + r32) * QSTR + 16 * ks + 8 * hi); st[sb] = __builtin_amdgcn_mfma_f32_32x32x16_bf16(kf, qf[ks], st[sb], 0, 0, 0); }
    }
    f32x16 hsum;
#pragma unroll
    for (int r = 0; r < 16; ++r) hsum[r] = 0.f;
#pragma unroll
    for (int dir = 0; dir < 2; ++dir) {
        const float c1 = t_c1[dir * 64 + t], wp = t_wp[dir * 64 + t], em = t_em[dir * 64 + t];
        float rs = 0.f; u32x4 pw[2][2];
#pragma unroll
        for (int sb = 0; sb < 2; ++sb) { float p[16];
#pragma unroll
            for (int r = 0; r < 16; ++r) { const int s = 32 * sb + crow(r, hi); const bool ok = dir == 0 ? (s <= t) : (s >= t);
                const float dm = ok ? __expf(t_a[dir * 64 + s] + c1) : 0.f; p[r] = st[sb][r] * dm; rs += p[r]; }
            pw[sb][0] = pack8(p); pw[sb][1] = pack8(p + 8); }
        rs += __shfl_xor(rs, 32);
        float qn = 0.f;
#pragma unroll
        for (int ks = 0; ks < 8; ++ks) { float q8[8]; unpack8(__builtin_bit_cast(u32x4, qf[ks]), q8);
#pragma unroll
            for (int e = 0; e < 8; ++e) qn += q8[e] * t_n[dir * 128 + 16 * ks + 8 * hi + e]; }
        qn += __shfl_xor(qn, 32);
        const float den = rs + wp * qn; const float rden = 1.f / fmaxf(fabsf(den), em);
        f32x16 acc;
#pragma unroll
        for (int r = 0; r < 16; ++r) acc[r] = 0.f;
        const bf16_t* Cs = (const bf16_t*)(ws + WS_CSNAP) + ((size_t)(bh * 2 + dir) * NCH + jt) * 16384 + (size_t)(32 * db + r32) * 128;
#pragma unroll
        for (int ks = 0; ks < 8; ++ks) { const bf16x8 cf = *(const bf16x8*)(Cs + 16 * ks + 8 * hi); acc = __builtin_amdgcn_mfma_f32_32x32x16_bf16(cf, qf[ks], acc, 0, 0, 0); }
#pragma unroll
        for (int r = 0; r < 16; ++r) acc[r] *= wp;
#pragma unroll
        for (int sb = 0; sb < 2; ++sb)
#pragma unroll
            for (int s2 = 0; s2 < 2; ++s2) { const bf16x8 vf = *(const bf16x8*)(Vt + (32 * db + r32) * KSTR + 32 * sb + 16 * s2 + 8 * hi);
                acc = __builtin_amdgcn_mfma_f32_32x32x16_bf16(vf, __builtin_bit_cast(bf16x8, pw[sb][s2]), acc, 0, 0, 0); }
#pragma unroll
        for (int r = 0; r < 16; ++r) hsum[r] += acc[r] * rden;
    }
    float ss = 0.f;
#pragma unroll
    for (int r = 0; r < 16; ++r) ss += hsum[r] * hsum[r];
    ss += __shfl_xor(ss, 32);
    if (hi == 0) t_red[(tb * 4 + db) * 32 + r32] = ss;
    __syncthreads();
    const float tot = t_red[(tb * 4 + 0) * 32 + r32] + t_red[(tb * 4 + 1) * 32 + r32] + t_red[(tb * 4 + 2) * 32 + r32] + t_red[(tb * 4 + 3) * 32 + r32];
    const float rstd = rsqrtf(tot * (1.f / 128.f) + EPS);
    const int row = row_of_tokchunk(b, jt) + t;
    const float* og = P.in(I_MLOUTG) + l * 512 + h * 128;
    const bf16_t* oc = (const bf16_t*)(ws + WS_OCOPY) + (size_t)row * 512 + h * 128;
    bf16_t* mix = (bf16_t*)(ws + WS_AB) + (size_t)row * DM + 512 + h * 128;
#pragma unroll
    for (int q = 0; q < 4; ++q) { const int dv = 32 * db + 8 * q + 4 * hi;
        const u32x2 ow = *(const u32x2*)(oc + dv); const f32x4 gg = *(const f32x4*)(og + dv);
        const float o0 = hsum[4 * q + 0] * rstd * gg[0] * sigmf(bflo(ow.x)), o1 = hsum[4 * q + 1] * rstd * gg[1] * sigmf(bfhi(ow.x));
        const float o2 = hsum[4 * q + 2] * rstd * gg[2] * sigmf(bflo(ow.y)), o3 = hsum[4 * q + 3] * rstd * gg[3] * sigmf(bfhi(ow.y));
        u32x2 w; w.x = pk2(o0, o1); w.y = pk2(o2, o3); *(u32x2*)(mix + dv) = w; }
    __syncthreads();
}

template <int DQK, int KROW>
struct AttnCore {
    static constexpr int NKS = DQK / 16, NKC1 = KROW / 8 + 1, KS = NKC1 * 8, KT_B = 64 * NKC1 * 16, VT_B = 128 * 9 * 16, SLOT_B = KT_B + VT_B;
    static constexpr int NBK = KT_B / 1024, NBV = VT_B / 1024, NB = NBK + NBV, NI = (NB + 7) / 8;
    static_assert(KT_B % 1024 == 0 && VT_B % 1024 == 0 && 8 * NI - NB <= 8 && 3 * SLOT_B <= 135168, "attention LDS geometry");
    static __device__ __forceinline__ void run(const Ctx& X, const bf16_t* Qrow, int kcol, const bf16_t* K, const bf16_t* Vt, int nt, f32x16 (&o)[4]) {
        const int lane = X.lane, r32 = lane & 31, hi = lane >> 5;
        LAS unsigned char* l3 = (LAS unsigned char*)0 + X.l3off;
        bf16x8 qf[NKS];
#pragma unroll
        for (int ks = 0; ks < NKS; ++ks) qf[ks] = *(const bf16x8*)(Qrow + 16 * ks + 8 * hi);
        unsigned goff[NI]; int bsel[NI];
#pragma unroll
        for (int i = 0; i < NI; ++i) {
            int bidx = X.wave + 8 * i; if (bidx >= NB) bidx -= NB;
            bsel[i] = bidx;
            if (bidx < NBK) { const int c = bidx * 64 + lane; const int row = c / NKC1; int col = c % NKC1; if (col > NKC1 - 2) col = NKC1 - 2; goff[i] = (unsigned)(row * KROW + 8 * col) * 2u; }
            else { const int c = (bidx - NBK) * 64 + lane; const int row = c / 9; int col = c % 9; if (col > 7) col = 7; goff[i] = (unsigned)(row * TK + 8 * col) * 2u; }
        }
        asm volatile("s_waitcnt vmcnt(0)" ::: "memory");
#pragma unroll
        for (int ks = 0; ks < NKS; ++ks) asm volatile("" : "+v"(qf[ks]));
        auto issue = [&](int t, int slotoff) {
#pragma unroll
            for (int i = 0; i < NI; ++i) {
                const char* base = bsel[i] < NBK ? (const char*)K + (size_t)t * (64 * KROW * 2) : (const char*)Vt + (size_t)t * 128;
                __builtin_amdgcn_global_load_lds((const unsigned*)(base + goff[i]), (LAS unsigned*)(l3 + slotoff + bsel[i] * 1024), 16, 0, 0);
            }
        };
#pragma unroll
        for (int d = 0; d < 4; ++d)
#pragma unroll
            for (int r = 0; r < 16; ++r) o[d][r] = 0.f;
        float mrun = -1e30f, lrun = 0.f;
        issue(0, 0); issue(1, SLOT_B);
        asm volatile("s_waitcnt vmcnt(%0)" :: "i"(NI) : "memory");
        __builtin_amdgcn_s_barrier(); asm volatile("" ::: "memory");
        int s_cur = 0, s_nn = 2 * SLOT_B;
        for (int t = 0; t < nt; ++t) {
            if (t + 2 < nt) issue(t + 2, s_nn);
            const LAS bf16_t* kt = (const LAS bf16_t*)(l3 + s_cur) + r32 * KS + kcol + 8 * hi; const LAS bf16_t* vt = (const LAS bf16_t*)(l3 + s_cur + KT_B) + r32 * KSTR + 8 * hi;
            f32x16 s0, s1;
#pragma unroll
            for (int r = 0; r < 16; ++r) { s0[r] = 0.f; s1[r] = 0.f; }
            {
                bf16x8 a0 = *(const LAS bf16x8*)(kt), a1 = *(const LAS bf16x8*)(kt + 32 * KS);
                __builtin_amdgcn_sched_group_barrier(0x100, 2, 0);
#pragma unroll
                for (int ks = 0; ks < NKS; ++ks) {
                    bf16x8 b0 = a0, b1 = a1;
                    if (ks + 1 < NKS) { b0 = *(const LAS bf16x8*)(kt + 16 * (ks + 1)); b1 = *(const LAS bf16x8*)(kt + 32 * KS + 16 * (ks + 1)); }
                    s0 = __builtin_amdgcn_mfma_f32_32x32x16_bf16(a0, qf[ks], s0, 0, 0, 0);
                    s1 = __builtin_amdgcn_mfma_f32_32x32x16_bf16(a1, qf[ks], s1, 0, 0, 0);
                    if (ks + 1 < NKS) __builtin_amdgcn_sched_group_barrier(0x100, 2, 0);
                    __builtin_amdgcn_sched_group_barrier(0x008, 2, 0);
                    a0 = b0; a1 = b1;
                }
            }
            bf16x8 vf[4];
#pragma unroll
            for (int d = 0; d < 4; ++d) vf[d] = *(const LAS bf16x8*)(vt + 32 * d * KSTR);
            float mx = fmaxf(s0[0], s1[0]);
#pragma unroll
            for (int r = 1; r < 16; ++r) mx = fmaxf(fmaxf(mx, s0[r]), s1[r]);
            mx = fmaxf(mx, __shfl_xor(mx, 32));
            if (__any(mx - mrun > RESC_THR)) {
                const float mnew = fmaxf(mrun, mx); const float alpha = __builtin_amdgcn_exp2f(mrun - mnew); mrun = mnew; lrun *= alpha;
#pragma unroll
                for (int d = 0; d < 4; ++d) o[d] = o[d] * alpha;
            }
            s0 = s0 - mrun; s1 = s1 - mrun;
#pragma unroll
            for (int r = 0; r < 16; ++r) { s0[r] = __builtin_amdgcn_exp2f(s0[r]); s1[r] = __builtin_amdgcn_exp2f(s1[r]); }
            { const f32x16 sm = s0 + s1;
              lrun += ((sm[0] + sm[1]) + (sm[2] + sm[3])) + ((sm[4] + sm[5]) + (sm[6] + sm[7])) + (((sm[8] + sm[9]) + (sm[10] + sm[11])) + ((sm[12] + sm[13]) + (sm[14] + sm[15]))); }
            bf16x8 pf[4];
            { float p[16];
#pragma unroll
              for (int r = 0; r < 16; ++r) p[r] = s0[r];
              pf[0] = __builtin_bit_cast(bf16x8, pack8(p)); pf[1] = __builtin_bit_cast(bf16x8, pack8(p + 8));
#pragma unroll
              for (int r = 0; r < 16; ++r) p[r] = s1[r];
              pf[2] = __builtin_bit_cast(bf16x8, pack8(p)); pf[3] = __builtin_bit_cast(bf16x8, pack8(p + 8)); }
#pragma unroll
            for (int g = 0; g < 4; ++g) {
                bf16x8 vn[4];
                if (g + 1 < 4) {
#pragma unroll
                    for (int d = 0; d < 4; ++d) vn[d] = *(const LAS bf16x8*)(vt + 32 * d * KSTR + 16 * (g + 1));
                }
#pragma unroll
                for (int d = 0; d < 4; ++d) o[d] = __builtin_amdgcn_mfma_f32_32x32x16_bf16(vf[d], pf[g], o[d], 0, 0, 0);
                if (g + 1 < 4) {
                    __builtin_amdgcn_sched_group_barrier(0x100, 4, 0);
#pragma unroll
                    for (int d = 0; d < 4; ++d) vf[d] = vn[d];
                }
                __builtin_amdgcn_sched_group_barrier(0x008, 4, 0);
            }
            if (t + 2 < nt) asm volatile("s_waitcnt vmcnt(%0)" :: "i"(NI) : "memory");
            else asm volatile("s_waitcnt vmcnt(0)" ::: "memory");
            asm volatile("s_waitcnt lgkmcnt(0)" ::: "memory");
            __builtin_amdgcn_s_barrier(); asm volatile("" ::: "memory");
            s_cur = (s_cur == 2 * SLOT_B) ? 0 : s_cur + SLOT_B; s_nn = (s_nn == 2 * SLOT_B) ? 0 : s_nn + SLOT_B;
        }
        lrun += __shfl_xor(lrun, 32);
        const float rl = 1.f / lrun;
#pragma unroll
        for (int d = 0; d < 4; ++d) o[d] = o[d] * rl;
    }
};

template <int DQK, int KROW>
struct AttnCoreP {
    static constexpr int NKS = DQK / 16, NKC1 = KROW / 8 + 1, KS = NKC1 * 8, KT_B = 64 * NKC1 * 16, VT_B = 128 * 9 * 16, SLOT_B = KT_B + VT_B;
    static constexpr int NBK = KT_B / 1024, NBV = VT_B / 1024, NB = NBK + NBV, NI = (NB + 7) / 8;
    static_assert(KT_B % 1024 == 0 && VT_B % 1024 == 0 && 8 * NI - NB <= 8 && 3 * SLOT_B <= 135168, "attention LDS geometry");
    static __device__ __forceinline__ void run(const Ctx& X, const bf16_t* Qrow, int kcol, const bf16_t* K, const bf16_t* Vt, int nt, f32x16 (&o)[4]) {
        const int lane = X.lane, r32 = lane & 31, hi = lane >> 5, role = X.wave >> 2;
        LAS unsigned char* l3 = (LAS unsigned char*)0 + X.l3off;
        bf16x8 qf[NKS];
#pragma unroll
        for (int ks = 0; ks < NKS; ++ks) qf[ks] = *(const bf16x8*)(Qrow + 16 * ks + 8 * hi);
        unsigned goff[NI]; int bsel[NI];
#pragma unroll
        for (int i = 0; i < NI; ++i) {
            int bidx = X.wave + 8 * i; if (bidx >= NB) bidx -= NB;
            bsel[i] = bidx;
            if (bidx < NBK) { const int c = bidx * 64 + lane; const int row = c / NKC1; int col = c % NKC1; if (col > NKC1 - 2) col = NKC1 - 2; goff[i] = (unsigned)(row * KROW + 8 * col) * 2u; }
            else { const int c = (bidx - NBK) * 64 + lane; const int row = c / 9; int col = c % 9; if (col > 7) col = 7; goff[i] = (unsigned)(row * TK + 8 * col) * 2u; }
        }
        asm volatile("s_waitcnt vmcnt(0)" ::: "memory");
#pragma unroll
        for (int ks = 0; ks < NKS; ++ks) asm volatile("" : "+v"(qf[ks]));
        auto issue = [&](int tk, int ks_off, bool doK, int tv, int vs_off, bool doV) {
#pragma unroll
            for (int i = 0; i < NI; ++i) {
                const bool isK = bsel[i] < NBK;
                if (isK ? doK : doV) {
                    const char* base = isK ? (const char*)K + (size_t)tk * (64 * KROW * 2) : (const char*)Vt + (size_t)tv * 128;
                    __builtin_amdgcn_global_load_lds((const unsigned*)(base + goff[i]), (LAS unsigned*)(l3 + (isK ? ks_off : vs_off) + bsel[i] * 1024), 16, 0, 0);
                }
            }
        };
#pragma unroll
        for (int d = 0; d < 4; ++d)
#pragma unroll
            for (int r = 0; r < 16; ++r) o[d][r] = 0.f;
        float mrun = -1e30f, lrun = 0.f;
        issue(0, 0, true, 0, 0, true); issue(1, SLOT_B, true, 1, SLOT_B, true); issue(2, 2 * SLOT_B, nt > 2, 0, 0, false);
        asm volatile("s_waitcnt vmcnt(0)" ::: "memory");
        __builtin_amdgcn_s_barrier(); asm volatile("" ::: "memory");
        f32x16 sc0, sc1;
        {
            const LAS bf16_t* kt = (const LAS bf16_t*)(l3) + r32 * KS + kcol + 8 * hi;
#pragma unroll
            for (int r = 0; r < 16; ++r) { sc0[r] = 0.f; sc1[r] = 0.f; }
#pragma unroll
            for (int ks = 0; ks < NKS; ++ks) {
                const bf16x8 a0 = *(const LAS bf16x8*)(kt + 16 * ks), a1 = *(const LAS bf16x8*)(kt + 32 * KS + 16 * ks);
                sc0 = __builtin_amdgcn_mfma_f32_32x32x16_bf16(a0, qf[ks], sc0, 0, 0, 0);
                sc1 = __builtin_amdgcn_mfma_f32_32x32x16_bf16(a1, qf[ks], sc1, 0, 0, 0);
            }
        }
        int s0off = 0, s1off = SLOT_B, s2off = 2 * SLOT_B;
        for (int t = 0; t < nt; ++t) {
            issue(t + 3, s0off, t + 3 < nt, t + 2, s2off, t + 2 < nt);
            const bool hasN = t + 1 < nt;
            const LAS bf16_t* kt = (const LAS bf16_t*)(l3 + s1off) + r32 * KS + kcol + 8 * hi;
            const LAS bf16_t* vt = (const LAS bf16_t*)(l3 + s0off + KT_B) + r32 * KSTR + 8 * hi;
            f32x16 sn0, sn1;
            auto qk_next = [&]() {
#pragma unroll
                for (int r = 0; r < 16; ++r) { sn0[r] = 0.f; sn1[r] = 0.f; }
                bf16x8 a0 = *(const LAS bf16x8*)(kt), a1 = *(const LAS bf16x8*)(kt + 32 * KS);
                __builtin_amdgcn_sched_group_barrier(0x100, 2, 0);
#pragma unroll
                for (int ks = 0; ks < NKS; ++ks) {
                    bf16x8 b0 = a0, b1 = a1;
                    if (ks + 1 < NKS) { b0 = *(const LAS bf16x8*)(kt + 16 * (ks + 1)); b1 = *(const LAS bf16x8*)(kt + 32 * KS + 16 * (ks + 1)); }
                    sn0 = __builtin_amdgcn_mfma_f32_32x32x16_bf16(a0, qf[ks], sn0, 0, 0, 0);
                    sn1 = __builtin_amdgcn_mfma_f32_32x32x16_bf16(a1, qf[ks], sn1, 0, 0, 0);
                    if (ks + 1 < NKS) __builtin_amdgcn_sched_group_barrier(0x100, 2, 0);
                    __builtin_amdgcn_sched_group_barrier(0x008, 2, 0);
                    a0 = b0; a1 = b1;
                }
            };
            if (role == 0 && hasN) qk_next();
            float mx = fmaxf(sc0[0], sc1[0]);
#pragma unroll
            for (int r = 1; r < 16; ++r) mx = fmaxf(fmaxf(mx, sc0[r]), sc1[r]);
            mx = fmaxf(mx, __shfl_xor(mx, 32));
            if (__any(mx - mrun > RESC_THR)) {
                const float mnew = fmaxf(mrun, mx); const float alpha = __builtin_amdgcn_exp2f(mrun - mnew); mrun = mnew; lrun *= alpha;
#pragma unroll
                for (int d = 0; d < 4; ++d) o[d] = o[d] * alpha;
            }
            sc0 = sc0 - mrun; sc1 = sc1 - mrun;
#pragma unroll
            for (int r = 0; r < 16; ++r) { sc0[r] = __builtin_amdgcn_exp2f(sc0[r]); sc1[r] = __builtin_amdgcn_exp2f(sc1[r]); }
            { const f32x16 sm = sc0 + sc1;
              lrun += ((sm[0] + sm[1]) + (sm[2] + sm[3])) + ((sm[4] + sm[5]) + (sm[6] + sm[7])) + (((sm[8] + sm[9]) + (sm[10] + sm[11])) + ((sm[12] + sm[13]) + (sm[14] + sm[15]))); }
            bf16x8 pf[4];
            { float p[16];
#pragma unroll
              for (int r = 0; r < 16; ++r) p[r] = sc0[r];
              pf[0] = __builtin_bit_cast(bf16x8, pack8(p)); pf[1] = __builtin_bit_cast(bf16x8, pack8(p + 8));
#pragma unroll
              for (int r = 0; r < 16; ++r) p[r] = sc1[r];
              pf[2] = __builtin_bit_cast(bf16x8, pack8(p)); pf[3] = __builtin_bit_cast(bf16x8, pack8(p + 8)); }
            bf16x8 vf[4];
#pragma unroll
            for (int d = 0; d < 4; ++d) vf[d] = *(const LAS bf16x8*)(vt + 32 * d * KSTR);
#pragma unroll
            for (int g = 0; g < 4; ++g) {
                bf16x8 vn[4];
                if (g + 1 < 4) {
#pragma unroll
                    for (int d = 0; d < 4; ++d) vn[d] = *(const LAS bf16x8*)(vt + 32 * d * KSTR + 16 * (g + 1));
                }
#pragma unroll
                for (int d = 0; d < 4; ++d) o[d] = __builtin_amdgcn_mfma_f32_32x32x16_bf16(vf[d], pf[g], o[d], 0, 0, 0);
                if (g + 1 < 4) {
#pragma unroll
                    for (int d = 0; d < 4; ++d) vf[d] = vn[d];
                }
            }
            if (role != 0 && hasN) qk_next();
            if (t + 3 < nt) asm volatile("s_waitcnt vmcnt(%0)" :: "i"(NI) : "memory");
            else asm volatile("s_waitcnt vmcnt(0)" ::: "memory");
            asm volatile("s_waitcnt lgkmcnt(0)" ::: "memory");
            __builtin_amdgcn_s_barrier(); asm volatile("" ::: "memory");
            sc0 = sn0; sc1 = sn1;
            const int tmp = s0off; s0off = s1off; s1off = s2off; s2off = tmp;
        }
        lrun += __shfl_xor(lrun, 32);
        const float rl = 1.f / lrun;
#pragma unroll
        for (int d = 0; d < 4; ++d) o[d] = o[d] * rl;
    }
};

__device__ __forceinline__ void mla_attn_unit(const Ctx& X0, const PRef& P, int b, int h, int q0, int is_ctx) {
    const Ctx X = fresh(X0);
    unsigned char* ws = P.ws();
    const int lane = X.lane, r32 = lane & 31, hi = lane >> 5;
    const int row = (is_ctx ? M_LAT + b * CTXL : b * SEQ) + q0 + 32 * X.wave + r32;
    const bf16_t* Q = (const bf16_t*)(ws + WS_QM) + ((size_t)h * M_ALL + row) * 192;
    const bf16_t* K = (const bf16_t*)(ws + WS_KM) + (size_t)(b * 8 + h) * TK * 192;
    const bf16_t* Vt = (const bf16_t*)(ws + WS_VTM) + (size_t)(b * 8 + h) * 128 * TK;
    f32x16 o[4];
    AttnCore<192, 192>::run(X, Q, 0, K, Vt, is_ctx ? 4 : NCH, o);
    bf16_t* mix = (bf16_t*)(ws + WS_AB) + (size_t)row * DM + 1024 + h * 128;
#pragma unroll
    for (int d = 0; d < 4; ++d)
#pragma unroll
        for (int q = 0; q < 4; ++q) { u32x2 w; w.x = pk2(o[d][4 * q], o[d][4 * q + 1]); w.y = pk2(o[d][4 * q + 2], o[d][4 * q + 3]); *(u32x2*)(mix + 32 * d + 8 * q + 4 * hi) = w; }
}
__device__ __forceinline__ void da_attn_unit(const Ctx& X0, const PRef& P, int l, int b, int h, int q0, int is_ctx, float lam, float lam_init) {
    const Ctx X = fresh(X0);
    unsigned char* ws = P.ws();
    const int lane = X.lane, r32 = lane & 31, hi = lane >> 5;
    const int comp = X.wave >> 2, qs = X.wave & 3;
    const int row = (is_ctx ? M_LAT + b * CTXL : b * SEQ) + q0 + 32 * qs + r32;
    const bf16_t* Q = (const bf16_t*)(ws + WS_QDA) + ((size_t)h * M_ALL + row) * 128 + comp * 64;
    const bf16_t* K = (const bf16_t*)(ws + WS_KDA) + (size_t)(b * 4 + h) * TK * 128;
    const bf16_t* Vt = (const bf16_t*)(ws + WS_VTDA) + (size_t)(b * 4 + h) * 128 * TK;
    f32x16 o[4];
    AttnCoreP<64, 128>::run(X, Q, comp * 64, K, Vt, is_ctx ? 4 : NCH, o);
    float* xch = (float*)X.lds;
    if (comp == 1) {
#pragma unroll
        for (int d = 0; d < 4; ++d)
#pragma unroll
            for (int r = 0; r < 16; ++r) xch[(qs * 64 + d * 16 + r) * 64 + lane] = o[d][r];
    }
    __syncthreads();
    if (comp == 0) {
        float ss = 0.f;
#pragma unroll
        for (int d = 0; d < 4; ++d)
#pragma unroll
            for (int r = 0; r < 16; ++r) { o[d][r] -= lam * xch[(qs * 64 + d * 16 + r) * 64 + lane]; ss += o[d][r] * o[d][r]; }
        ss += __shfl_xor(ss, 32);
        float li_ = lam_init; asm volatile("" : "+s"(li_));
        const float rstd = rsqrtf(ss * (1.f / 128.f) + EPS) * (1.f - li_);
        const float* og = P.in(I_DAOUTG) + l * 128;
        bf16_t* mix = (bf16_t*)(ws + WS_AB) + (size_t)row * DM + h * 128;
#pragma unroll
        for (int d = 0; d < 4; ++d)
#pragma unroll
            for (int q = 0; q < 4; ++q) { const int dv = 32 * d + 8 * q + 4 * hi; const f32x4 gg = *(const f32x4*)(og + dv);
                u32x2 w; w.x = pk2(o[d][4 * q] * rstd * gg[0], o[d][4 * q + 1] * rstd * gg[1]); w.y = pk2(o[d][4 * q + 2] * rstd * gg[2], o[d][4 * q + 3] * rstd * gg[3]);
                *(u32x2*)(mix + dv) = w; }
    }
    __syncthreads();
}

__device__ __forceinline__ void mixer_phase(const Ctx& X, const PRef& P, int l) {
    const bool need_ctx = l < DEPTH - 1;
    STAMPN(20);
    const int vcu = (X.nwg % 8 == 0) ? (X.wg % 8) * (X.nwg / 8) + X.wg / 8 : X.wg;
    if (EN(13)) for (int u = vcu; u < 512; u += X.nwg) mla_attn_unit(X, P, u >> 7, (u >> 4) & 7, (u & 15) * 256, 0);
    STAMPN(11);
    float lam, lam_init;
    { const float* lp = P.in(I_DALAM) + l * 256;
      float s1 = 0.f, s2 = 0.f;
      for (int i = 0; i < 64; ++i) { s1 += lp[i] * lp[64 + i]; s2 += lp[128 + i] * lp[192 + i]; }
      const float li = 0.8f - 0.6f * expf(-0.3f * (float)l);
      const float la = expf(s1) - expf(s2) + li;
      lam = __builtin_bit_cast(float, __builtin_amdgcn_readfirstlane(__builtin_bit_cast(int, la)));
      lam_init = __builtin_bit_cast(float, __builtin_amdgcn_readfirstlane(__builtin_bit_cast(int, li))); }
    if (EN(14)) for (int v = vcu; v < 512; v += X.nwg) da_attn_unit(X, P, l, v >> 7, (v >> 5) & 3, (v & 31) * 128, 0, lam, lam_init);
    STAMPN(12);
    if (EN(15)) for (int u = X.wg; u < 16 * NCH; u += X.nwg) mlstm_c_unit(X, P, l, u);
    STAMPN(13);
    if (need_ctx) {
        if (EN(13)) for (int v = X.wg; v < 32; v += X.nwg) mla_attn_unit(X, P, v >> 3, v & 7, 0, 1);
        if (EN(14)) for (int v = X.nwg - 1 - X.wg; v < 32; v += X.nwg) da_attn_unit(X, P, l, v >> 3, (v >> 1) & 3, (v & 1) * 128, 1, lam, lam_init);
    }
}

__global__ void __launch_bounds__(512, 2) fwd_megakernel(Params Pk) {
    const PRef P;
    extern __shared__ __attribute__((aligned(16))) unsigned char lds[];
    cg::grid_group grid = cg::this_grid();
    Ctx X; X.lds = lds; X.tid = threadIdx.x; X.lane = X.tid & 63; X.wave = __builtin_amdgcn_readfirstlane(X.tid >> 6);
    X.nwg = gridDim.x; X.wg = blockIdx.x; X.gw = X.wg * 8 + X.wave; X.ngw = X.nwg * 8;
    LAS unsigned char* lds3 = (LAS unsigned char*)lds; X.l3off = (unsigned)(uintptr_t)lds3;
    unsigned char* ws = P.ws();
    if (threadIdx.x < 16) ((LAS unsigned*)(lds3 + 135168 + 64))[threadIdx.x] = 0u;
    __syncthreads();
    (void)xcd_barrier_post((unsigned*)(ws + WS_BAR), (volatile LAS unsigned*)(lds3 + 135168 + 64));
    float* R_lat = P.out(); float* R_ctx = (float*)(ws + WS_RCTX);
    bf16_t* AB = (bf16_t*)(ws + WS_AB);

#ifdef PROBE_CAT
    if (blockIdx.x == 0 && threadIdx.x == 0) { volatile unsigned long long* tp_ = (volatile unsigned long long*)(P.ws() + WS_END); tp_[0] = __builtin_amdgcn_s_memrealtime(); tp_[1] = 0; tp_[2] = 0; }
#endif
    const int tail_lo = X.nwg > 64 ? 32 : 0;
    if (EN(0)) mod_gemv(X, P, 0, 1, 0);
    if (EN(1)) convert_weights(X, P, 0, 0, 0);
    grid.sync();
#ifdef PROBE_CAT
    STAMP(0);
#endif
    for (int l = 0; l < DEPTH; ++l) {
        const float* modl = (const float*)(ws + WS_MOD) + (size_t)l * 5 * 6 * DM;
        const float* xin_lat = l == 0 ? P.in(I_X) : R_lat; const float* xin_ctx = l == 0 ? P.in(I_CTX) : R_ctx;
        const int Mfin = l < DEPTH - 1 ? M_ALL : M_LAT;
        if (EN(2)) modulate_phase(X, xin_lat, xin_ctx, P.in(I_N1G) + l * DM, modl, 0 * DM, 1 * DM, AB, M_ALL);
        if (EN(1)) if (l > 0) convert_weights(X, P, l, 2, 0);
        STAMP(1);
        if (EN(3)) { pg8::Gemm g{AB, (const bf16_t*)(ws + WS_WIN), M_ALL, NPROJ, DM}; pg8::StaticOrder S; S.init(M_ALL, NPROJ, X.nwg, X.wg);
          pg8::EpiBf16 E{(bf16_t*)(ws + WS_PROJ), NPROJ, (float*)(ws + WS_GATES), C_GATE / 256};
          pg8::gemm_phase<pg8::EpiBf16>(lds3, g, S, E); }
        STAMP(2);
        if (EN(4)) prep_phase(X, P, l);
        STAMP(3);
        if (EN(5)) { pg8::Gemm g{(const bf16_t*)(ws + WS_CQN), (const bf16_t*)(ws + WS_WUQ), M_ALL, 1536, 512}; pg8::StaticOrder S; S.init(M_ALL, 1536, X.nwg, X.wg);
          pg8::EpiBf16 E{(bf16_t*)(ws + WS_QUP), 1536, nullptr, 0};
          pg8::gemm_phase<pg8::EpiBf16>(lds3, g, S, E); }
        if (EN(5)) { pg8::Gemm g{(const bf16_t*)(ws + WS_CKVN), (const bf16_t*)(ws + WS_WUKV), M_ALL, 2048, 256}; pg8::StaticOrder S; S.init(M_ALL, 2048, X.nwg, X.wg);
          pg8::EpiBf16 E{(bf16_t*)(ws + WS_KVUP), 2048, nullptr, 0};
          pg8::gemm_phase<pg8::EpiBf16>(lds3, g, S, E); }
        __syncthreads();
        if (EN(6)) mlstm_a_phase(X, P, l);
        STAMP(4);
        if (EN(7)) mla_prep_phase(X, P, l);
        if (EN(8)) mlstm_scan_phase(X, P);
        STAMP(5);
        if (EN(9)) mixer_phase(X, P, l);
        STAMP(6);
        if (EN(10)) { pg8::Gemm g{AB, (const bf16_t*)(ws + WS_WOUT), Mfin, DM, DM}; pg8::StaticOrder S; S.init(Mfin, DM, X.nwg, X.wg);
          pg8::EpiRes E{xin_lat, xin_ctx, R_lat, R_ctx, modl + 2 * DM};
          pg8::gemm_phase<pg8::EpiRes>(lds3, g, S, E); }
        if (EN(0)) if (l + 1 < DEPTH) { __syncthreads(); mod_gemv(X, P, l + 1, l + 2, tail_lo); }
        STAMP(7);
        if (EN(2)) modulate_phase(X, R_lat, R_ctx, P.in(I_N2G) + l * DM, modl, 3 * DM, 4 * DM, AB, Mfin);
        STAMP(1);
        if (EN(11)) { pg8::Gemm g{AB, (const bf16_t*)(ws + WS_WGU), Mfin, 2 * FF, DM}; pg8::StaticOrder S; S.init(Mfin, 2 * FF, X.nwg, X.wg);
          pg8::EpiSwiGLU E{(bf16_t*)(ws + WS_HID), FF};
          pg8::gemm_phase<pg8::EpiSwiGLU>(lds3, g, S, E); }
        STAMP(9);
        if (EN(12)) { pg8::Gemm g{(const bf16_t*)(ws + WS_HID), (const bf16_t*)(ws + WS_WDN), Mfin, DM, FF}; pg8::StaticOrder S; S.init(Mfin, DM, X.nwg, X.wg);
          pg8::EpiRes E{R_lat, R_ctx, R_lat, R_ctx, modl + 5 * DM};
          pg8::gemm_phase<pg8::EpiRes>(lds3, g, S, E); }
        if (EN(1)) if (l + 1 < DEPTH) { __syncthreads(); convert_weights(X, P, l + 1, 1, tail_lo); }
#ifdef PROBE_CAT
        STAMP(10);
#else
        if (l + 1 < DEPTH) xcd_barrier(P.ws());
#endif
    }
#ifdef PROBE_CAT
    if (blockIdx.x == 0 && threadIdx.x == 0) P.out()[0] += (float)(((volatile unsigned long long*)(P.ws() + WS_END))[1]) * (0.01f / PROBE_SCALE);
#endif
}

extern "C" void kernel_launch(void* const* d_in, const int* in_sizes, int n_in, void* d_out, int out_size, void* d_ws, size_t ws_size, hipStream_t stream) {
    static int grid = 0;
    if (grid == 0) {
        if (n_in != 24 || ws_size < WS_END) { fprintf(stderr, "kernel_launch: unexpected inputs (n_in %d, ws %zu)\n", n_in, ws_size); grid = -1; return; }
        int dev = 0, cus = 0, per_cu = 0;
        (void)hipGetDevice(&dev); (void)hipDeviceGetAttribute(&cus, hipDeviceAttributeMultiprocessorCount, dev);
        if (hipFuncSetAttribute((const void*)fwd_megakernel, hipFuncAttributeMaxDynamicSharedMemorySize, LDS_BYTES) != hipSuccess) { fprintf(stderr, "kernel_launch: hipFuncSetAttribute failed\n"); grid = -1; return; }
        (void)hipOccupancyMaxActiveBlocksPerMultiprocessor(&per_cu, (const void*)fwd_megakernel, 512, LDS_BYTES);
        (void)hipGetLastError();
        if (per_cu < 1) { fprintf(stderr, "kernel_launch: occupancy query says %d\n", per_cu); per_cu = 1; }
        grid = cus;
    }
    if (grid < 0) return;
    if (hipMemsetAsync((char*)d_ws + WS_BAR, 0, XCD_BAR_WORDS * 4, stream) != hipSuccess) { fprintf(stderr, "kernel_launch: memset failed\n"); return; }
    Params p{};
    for (int i = 0; i < 24; ++i) p.in[i] = (const float*)d_in[i];
    p.out = (float*)d_out; p.ws = (unsigned char*)d_ws;
    void* args[] = {&p};
    hipError_t e = hipLaunchCooperativeKernel((const void*)fwd_megakernel, dim3(grid), dim3(512), args, LDS_BYTES, stream);
    if (e != hipSuccess) fprintf(stderr, "cooperative launch failed: %s (grid %d)\n", hipGetErrorString(e), grid);
}
```

```cpp
#include <hip/hip_runtime.h>
#include <hip/hip_cooperative_groups.h>
#include <cstdio>
#include <cstdint>
namespace cg = cooperative_groups;

#define LAS __attribute__((address_space(3)))
typedef unsigned short bf16_t;
typedef short bf16x8 __attribute__((ext_vector_type(8)));
typedef float f32x4 __attribute__((ext_vector_type(4)));
typedef float f32x16 __attribute__((ext_vector_type(16)));
typedef unsigned u32x4 __attribute__((ext_vector_type(4)));
typedef unsigned u32x2 __attribute__((ext_vector_type(2)));

constexpr int DM = 2048, BATCH = 4, SEQ = 4096, CTXL = 256, DEPTH = 2;
constexpr int M_LAT = BATCH * SEQ, M_CTX = BATCH * CTXL, M_ALL = M_LAT + M_CTX;
constexpr int TK = CTXL + SEQ;
constexpr int NCH = TK / 64;
constexpr int IN_W = 4432, NPROJ = 4608, FF = 5632;
constexpr int C_DAQ = 0, C_DAK = 512, C_DAV = 1024, C_MLQ = 1536, C_MLK = 2048, C_MLV = 2560, C_MLO = 3072, C_GATE = 3584, C_CQ = 3600, C_CKV = 4112, C_KPE = 4368;
constexpr float EPS = 1e-6f;
constexpr float LOG2E = 1.4426950408889634f;
constexpr float RESC_THR = 8.0f;

constexpr size_t MiB = 1u << 20;
constexpr size_t WS_WIN = 0, WS_WOUT = 18 * MiB, WS_WGU = 26 * MiB, WS_WDN = 70 * MiB, WS_WUQ = 92 * MiB, WS_WUKV = 94 * MiB, WS_MOD = 95 * MiB, WS_RCTX = 96 * MiB;
constexpr size_t WS_AB = 104 * MiB;
constexpr size_t WS_PROJ = 172 * MiB;
constexpr size_t WS_QUP = 172 * MiB, WS_KVUP = 223 * MiB, WS_HID = 172 * MiB;
constexpr size_t WS_GATES = 325 * MiB, WS_CQN = 327 * MiB, WS_CKVN = 344 * MiB, WS_KPE = 353 * MiB, WS_OCOPY = 356 * MiB;
constexpr size_t WS_QDA = 373 * MiB, WS_KDA = 390 * MiB, WS_VTDA = 407 * MiB, WS_QML = 424 * MiB, WS_KML = 441 * MiB, WS_KTML = 458 * MiB, WS_VTML = 475 * MiB;
constexpr size_t WS_QM = 492 * MiB, WS_KM = 543 * MiB, WS_VTM = 594 * MiB, WS_CSNAP = 628 * MiB, WS_NSNAP = 696 * MiB, WS_NU = 698 * MiB, WS_CSTAT = 700 * MiB, WS_BAR = 701 * MiB, WS_END = 702 * MiB;
static_assert((size_t)NPROJ * DM * 2 <= 18 * MiB && (size_t)2 * FF * DM * 2 <= 44 * MiB && (size_t)M_ALL * NPROJ * 2 <= 153 * MiB, "ws map");
static_assert(WS_HID + (size_t)M_ALL * FF * 2 <= WS_QDA, "hid overlay");
static_assert(WS_END <= 768 * MiB, "ws fits the guaranteed minimum");

constexpr int LDS_BYTES = 140 * 1024;
#ifndef PH_EN
#define PH_EN 0xFFFF
#endif
#define EN(k) ((PH_EN >> (k)) & 1)
#ifdef PROBE_CAT
#define STAMP(cat) do { xcd_barrier(P.ws()); if (blockIdx.x == 0 && threadIdx.x == 0) { volatile unsigned long long* tp_ = (volatile unsigned long long*)(P.ws() + WS_END); const unsigned long long t1_ = __builtin_amdgcn_s_memrealtime(); if ((1 << (cat)) & PROBE_CAT) tp_[1] += t1_ - tp_[0]; if ((1 << (cat)) & PROBE_CAT2) tp_[2] += t1_ - tp_[0]; tp_[0] = t1_; } } while (0)
#define STAMPN(cat) do { __syncthreads(); if (blockIdx.x == 0 && threadIdx.x == 0) { volatile unsigned long long* tp_ = (volatile unsigned long long*)(P.ws() + WS_END); const unsigned long long t1_ = __builtin_amdgcn_s_memrealtime(); if ((1 << (cat)) & PROBE_CAT) tp_[1] += t1_ - tp_[0]; tp_[0] = t1_; } } while (0)
#else
#define STAMPN(cat) do {} while (0)
#define STAMP(cat) xcd_barrier(P.ws())
#endif

#define LOG2E_ 1.4426950408889634f
__device__ __forceinline__ unsigned f2bf(float f) { unsigned u = __builtin_bit_cast(unsigned, f); return (u + 0x7fffu + ((u >> 16) & 1u)) >> 16; }
typedef float f32x2_t __attribute__((ext_vector_type(2))); typedef __bf16 bf16x2_t __attribute__((ext_vector_type(2)));
__device__ __forceinline__ unsigned pk2(float lo, float hi) { f32x2_t v = {lo, hi}; bf16x2_t b = __builtin_convertvector(v, bf16x2_t); return __builtin_bit_cast(unsigned, b); }
__device__ __forceinline__ float bflo(unsigned w) { return __builtin_bit_cast(float, w << 16); }
__device__ __forceinline__ float bfhi(unsigned w) { return __builtin_bit_cast(float, w & 0xffff0000u); }
__device__ __forceinline__ float bf1(bf16_t h) { return __builtin_bit_cast(float, (unsigned)h << 16); }
__device__ __forceinline__ void unpack8(const u32x4 w, float* v) { v[0] = bflo(w.x); v[1] = bfhi(w.x); v[2] = bflo(w.y); v[3] = bfhi(w.y); v[4] = bflo(w.z); v[5] = bfhi(w.z); v[6] = bflo(w.w); v[7] = bfhi(w.w); }
__device__ __forceinline__ u32x4 pack8(const float* v) { u32x4 w; w.x = pk2(v[0], v[1]); w.y = pk2(v[2], v[3]); w.z = pk2(v[4], v[5]); w.w = pk2(v[6], v[7]); return w; }
__device__ __forceinline__ float wave_sum(float v) {
#pragma unroll
    for (int o = 1; o < 64; o <<= 1) v += __shfl_xor(v, o);
    return v;
}
__device__ __forceinline__ float wave_max(float v) {
#pragma unroll
    for (int o = 1; o < 64; o <<= 1) v = fmaxf(v, __shfl_xor(v, o));
    return v;
}
__device__ __forceinline__ float siluf(float x) { return x * __builtin_amdgcn_rcpf(1.f + __builtin_amdgcn_exp2f(-LOG2E_ * x)); }
__device__ __forceinline__ float sigmf(float x) { return __builtin_amdgcn_rcpf(1.f + __builtin_amdgcn_exp2f(-LOG2E_ * x)); }
__device__ __forceinline__ int crow(int r, int hi) { return (r & 3) + 8 * (r >> 2) + 4 * hi; }
__device__ __forceinline__ int perm_off(int p) { const int h = p >> 3, j = p & 7; return 8 * (j >> 2) + 4 * h + (j & 3); }
__device__ __forceinline__ int mod_batch(int row) { return row < M_LAT ? (row >> 12) : 4; }

namespace pg8 {
constexpr int BM = 256, BK = 64, HALF = 128, HTB = HALF * BK * 2, STAGE_BYTES = 8 * HTB, NXCD = 8, WGM = 8;
__host__ __device__ __forceinline__ int lds_byte(int r, int c) { const int st = (r >> 4) * 2 + (c >> 5), rr = r & 15, cc = c & 31, ob = rr * 64 + cc * 2; return st * 1024 + (ob ^ (((ob >> 9) & 1) << 5)); }
__host__ __device__ __forceinline__ void stage_rc(int b, int& R, int& C) { const int st = b / 1024, sb = b % 1024, swz = sb ^ (((sb >> 9) & 1) << 5); R = (st >> 1) * 16 + swz / 64; C = (st & 1) * 32 + (swz % 64) / 2; }
__host__ __device__ __forceinline__ int perm32(int rho) { const int n = rho >> 4, i = rho & 15; return 8 * (i >> 2) + 4 * n + (i & 3); }

struct Unit { int pm, pn; };
struct Gemm { const bf16_t* A; const bf16_t* Bt; int M, N, K; };

struct StaticOrder {
    int nM, nN, nwg, G, c;
    __device__ void init(int M, int N, int G_, int c_) { nM = M / BM; nN = N / BM; nwg = nM * nN; G = G_; c = c_; }
    __device__ bool next(int i, Unit& u) const {
        const long L = (long)i * G + c; if (L >= nwg) return false;
        int wgid = (int)L; { const int q = nwg / NXCD, r = nwg % NXCD, xcd = wgid % NXCD, off = wgid / NXCD; wgid = (xcd < r ? xcd * (q + 1) : r * (q + 1) + (xcd - r) * q) + off; }
        const int nig = WGM * nN, gid = wgid / nig, fm = gid * WGM, gsz = (nM - fm) < WGM ? (nM - fm) : WGM;
        u.pm = fm + ((wgid % nig) % gsz); u.pn = (wgid % nig) / gsz; return true;
    }
};

struct EpiBf16 {
    static constexpr bool PERM = true;
    bf16_t* O; int ldc; float* gates; int gate_pn;
    __device__ __forceinline__ void operator()(const f32x4 (&acc)[2][2][4][2], const Unit& u, int wr, int wc, int fr, int fq) const {
        const int row0 = u.pm * BM + wr * 64 + fr; const int col0 = u.pn * BM + wc * 32 + 8 * fq;
        const bool g = gates != nullptr && u.pn == gate_pn && wc == 0 && fq < 2;
#pragma unroll
        for (int ai = 0; ai < 2; ++ai)
#pragma unroll
            for (int m = 0; m < 4; ++m) { const int row = row0 + ai * HALF + m * 16; bf16_t* rowp = O + (size_t)row * ldc + col0;
#pragma unroll
                for (int bj = 0; bj < 2; ++bj) { const f32x4 v0 = acc[ai][bj][m][0], v1 = acc[ai][bj][m][1];
                    u32x4 w; w.x = pk2(v0[0], v0[1]); w.y = pk2(v0[2], v0[3]); w.z = pk2(v1[0], v1[1]); w.w = pk2(v1[2], v1[3]);
                    *(u32x4*)(rowp + bj * HALF) = w;
                    if (bj == 0 && g) { *(f32x4*)(gates + (size_t)row * 16 + 8 * fq) = v0; *(f32x4*)(gates + (size_t)row * 16 + 8 * fq + 4) = v1; } } }
    }
};
struct EpiSwiGLU {
    static constexpr bool PERM = true;
    bf16_t* O; int ldc;
    __device__ __forceinline__ void operator()(const f32x4 (&acc)[2][2][4][2], const Unit& u, int wr, int wc, int fr, int fq) const {
        const int row0 = u.pm * BM + wr * 64 + fr; const int col0 = u.pn * HALF + wc * 32 + 8 * fq;
#pragma unroll
        for (int ai = 0; ai < 2; ++ai)
#pragma unroll
            for (int m = 0; m < 4; ++m) { const int row = row0 + ai * HALF + m * 16;
                float o[8];
#pragma unroll
                for (int n = 0; n < 2; ++n)
#pragma unroll
                    for (int i = 0; i < 4; ++i) { const float gt = acc[ai][0][m][n][i], up = acc[ai][1][m][n][i]; o[4 * n + i] = siluf(gt) * up; }
                *(u32x4*)(O + (size_t)row * ldc + col0) = pack8(o); }
    }
};
struct EpiRes {
    static constexpr bool PERM = false;
    const float* res_lat; const float* res_ctx; float* out_lat; float* out_ctx; const float* gate;
    __device__ __forceinline__ void operator()(const f32x4 (&acc)[2][2][4][2], const Unit& u, int wr, int wc, int fr, int fq) const {
        const int row0 = u.pm * BM + wr * 64 + fr; const int col0 = u.pn * BM + wc * 32 + 4 * fq;
#pragma unroll
        for (int ai = 0; ai < 2; ++ai)
#pragma unroll
            for (int m = 0; m < 4; ++m) { const int row = row0 + ai * HALF + m * 16;
                const float* rp = row < M_LAT ? res_lat + (size_t)row * DM : res_ctx + (size_t)(row - M_LAT) * DM;
                float* op = row < M_LAT ? out_lat + (size_t)row * DM : out_ctx + (size_t)(row - M_LAT) * DM;
                const float* gp = gate + (size_t)mod_batch(row) * 6 * DM;
#pragma unroll
                for (int bj = 0; bj < 2; ++bj)
#pragma unroll
                    for (int n = 0; n < 2; ++n) { const int c = col0 + bj * HALF + n * 16;
                        const f32x4 r = *(const f32x4*)(rp + c), g = *(const f32x4*)(gp + c);
                        *(f32x4*)(op + c) = r + g * acc[ai][bj][m][n]; } }
    }
};

template <class Epi, bool ALIGN_EPI = true>
__device__ __forceinline__ void gemm_phase(LAS unsigned char* lds, const Gemm g, const StaticOrder& S, const Epi& E) {
    int tid = threadIdx.x; asm volatile("" : "+v"(tid)); const int wid = __builtin_amdgcn_readfirstlane(tid >> 6), lane = tid & 63, wr = wid >> 2, wc = wid & 3, fr = lane & 15, fq = lane >> 4;
    int K = g.K; asm volatile("" : "+s"(K)); const int nt = K / BK;
    unsigned voffA[2], voffB[2];
#pragma unroll
    for (int i = 0; i < 2; ++i) { int R, C; stage_rc(tid * 16 + i * 8192, R, C); const int Rb = Epi::PERM ? ((R & ~31) + perm32(R & 31)) : R;
        voffA[i] = (unsigned)(R * K + C) * 2u; voffB[i] = (unsigned)(Rb * K + C) * 2u; }
    const size_t kstep = (size_t)(BK * 2);
    const size_t hstep = (size_t)HALF * K * 2;
    const size_t tstep = 2 * hstep;
    const unsigned ldsw = (unsigned)wid * 1024u;
    const int aoff = lds_byte(wr * 64 + fr, fq * 8), boff = lds_byte(wc * 32 + fr, fq * 8);
#define PG8_SA(b, h) (((b) * 2 + (h)) * HTB)
#define PG8_SB(b, h) ((4 + (b) * 2 + (h)) * HTB)
#define PG8_STAGE(bufoff, gbase, voff) do { _Pragma("unroll") for (int _i = 0; _i < 2; ++_i) \
        __builtin_amdgcn_global_load_lds((const unsigned*)((const char*)(gbase) + (voff)[_i]), (LAS unsigned*)(lds + (bufoff) + ldsw + _i * 8192), 16, 0, 0); } while (0)
#define PG8_LDA(dst, b, h) do { _Pragma("unroll") for (int m = 0; m < 4; ++m) _Pragma("unroll") for (int k = 0; k < 2; ++k) dst[m][k] = *(const LAS bf16x8*)(lds + PG8_SA(b, h) + aoff + m * 2048 + k * 1024); } while (0)
#define PG8_LDB(dst, b, h) do { _Pragma("unroll") for (int n = 0; n < 2; ++n) _Pragma("unroll") for (int k = 0; k < 2; ++k) dst[n][k] = *(const LAS bf16x8*)(lds + PG8_SB(b, h) + boff + n * 2048 + k * 1024); } while (0)
#define PG8_MMA(ai, bj, At, Bt) do { __builtin_amdgcn_s_setprio(1); _Pragma("unroll") for (int m = 0; m < 4; ++m) _Pragma("unroll") for (int n = 0; n < 2; ++n) _Pragma("unroll") for (int k = 0; k < 2; ++k) \
        acc[ai][bj][m][n] = __builtin_amdgcn_mfma_f32_16x16x32_bf16(Bt[n][k], At[m][k], acc[ai][bj][m][n], 0, 0, 0); __builtin_amdgcn_s_setprio(0); } while (0)
#define PG8_WAIT_V(n) asm volatile("s_waitcnt vmcnt(" #n ")" ::: "memory")
#define PG8_WAIT_L(n) asm volatile("s_waitcnt lgkmcnt(" #n ")" ::: "memory")
#define PG8_BAR __builtin_amdgcn_s_barrier()
#define PG8_SCHED __builtin_amdgcn_sched_barrier(0)
    Unit cur, nxt; int ui = 0;
    if (!S.next(0, cur)) return;
    f32x4 acc[2][2][4][2];
#pragma unroll
    for (int a = 0; a < 2; ++a)
#pragma unroll
        for (int b = 0; b < 2; ++b)
#pragma unroll
            for (int m = 0; m < 4; ++m)
#pragma unroll
                for (int n = 0; n < 2; ++n) acc[a][b][m][n] = (f32x4){0.f, 0.f, 0.f, 0.f};
    bf16x8 At[4][2], B0[2][2], B1[2][2];
    const char* cA = (const char*)g.A + (size_t)cur.pm * tstep; const char* cB = (const char*)g.Bt + (size_t)cur.pn * tstep;
    PG8_STAGE(PG8_SB(0, 0), cB, voffB); PG8_STAGE(PG8_SB(0, 1), cB + hstep, voffB); PG8_STAGE(PG8_SA(0, 0), cA, voffA); PG8_STAGE(PG8_SA(0, 1), cA + hstep, voffA);
    if (wr == 1) PG8_BAR;
    PG8_WAIT_V(2); PG8_BAR;
    PG8_STAGE(PG8_SB(1, 0), cB + kstep, voffB); PG8_STAGE(PG8_SA(1, 0), cA + kstep, voffA); PG8_STAGE(PG8_SB(1, 1), cB + hstep + kstep, voffB);
    PG8_WAIT_V(6); PG8_BAR;
    for (;;) {
        const bool has_next = S.next(ui + 1, nxt);
        const char* nA = has_next ? (const char*)g.A + (size_t)nxt.pm * tstep : cA; const char* nB = has_next ? (const char*)g.Bt + (size_t)nxt.pn * tstep : cB;
        for (int t = 0; t < nt; t += 2) {
            const bool last = (t == nt - 2);
            const char* a1 = cA + (size_t)(t + 1) * kstep;
            const char* a2 = last ? nA : cA + (size_t)(t + 2) * kstep; const char* b2 = last ? nB : cB + (size_t)(t + 2) * kstep;
            const char* a3 = a2 + kstep; const char* b3 = b2 + kstep;
            PG8_LDB(B0, 0, 0); PG8_LDB(B1, 0, 1); PG8_SCHED; PG8_LDA(At, 0, 0); PG8_STAGE(PG8_SA(1, 1), a1 + hstep, voffA);
            PG8_WAIT_V(8); PG8_WAIT_L(0); PG8_BAR; PG8_MMA(0, 0, At, B0); PG8_MMA(0, 1, At, B1); PG8_BAR; PG8_SCHED;
            PG8_LDA(At, 0, 1); PG8_STAGE(PG8_SB(0, 0), b2, voffB); PG8_STAGE(PG8_SB(0, 1), b2 + hstep, voffB); PG8_STAGE(PG8_SA(0, 0), a2, voffA);
            PG8_WAIT_V(8); PG8_WAIT_L(0); PG8_BAR; PG8_MMA(1, 0, At, B0); PG8_MMA(1, 1, At, B1); PG8_BAR; PG8_SCHED;
            PG8_LDB(B0, 1, 0); PG8_LDB(B1, 1, 1); PG8_SCHED; PG8_LDA(At, 1, 0); PG8_STAGE(PG8_SA(0, 1), a2 + hstep, voffA);
            PG8_WAIT_V(8); PG8_WAIT_L(0); PG8_BAR; PG8_MMA(0, 0, At, B0); PG8_MMA(0, 1, At, B1); PG8_BAR; PG8_SCHED;
            PG8_LDA(At, 1, 1); PG8_STAGE(PG8_SB(1, 0), b3, voffB); PG8_STAGE(PG8_SB(1, 1), b3 + hstep, voffB); PG8_STAGE(PG8_SA(1, 0), a3, voffA);
            PG8_WAIT_V(8); PG8_WAIT_L(0); PG8_BAR; PG8_MMA(1, 0, At, B0); PG8_MMA(1, 1, At, B1); PG8_BAR; PG8_SCHED;
        }
        if constexpr (ALIGN_EPI) { if (wr == 0) PG8_BAR; }
        E(acc, cur, wr, wc, fr, fq);
        if (!has_next) break;
#pragma unroll
        for (int a = 0; a < 2; ++a)
#pragma unroll
            for (int b = 0; b < 2; ++b)
#pragma unroll
                for (int m = 0; m < 4; ++m)
#pragma unroll
                    for (int n = 0; n < 2; ++n) acc[a][b][m][n] = (f32x4){0.f, 0.f, 0.f, 0.f};
        cur = nxt; cA = nA; cB = nB; ++ui;
        if constexpr (ALIGN_EPI) { if (wr == 1) PG8_BAR; }
    }
    PG8_WAIT_V(0);
    if constexpr (!ALIGN_EPI) { if (wr == 0) PG8_BAR; }
    PG8_BAR;
#undef PG8_SA
#undef PG8_SB
#undef PG8_STAGE
#undef PG8_LDA
#undef PG8_LDB
#undef PG8_MMA
#undef PG8_WAIT_V
#undef PG8_WAIT_L
#undef PG8_BAR
#undef PG8_SCHED
}
}


#define XB_TMO      128
#define XB_XCNT(j)  (256  + 64 * (j))
#define XB_XSUB(j)  (1280 + 64 * (j))
#define XB_XGEN(j)  (2304 + 64 * (j))
#define XB_TOP      3328
#define XB_TOPGEN   3392
#define XCD_BAR_WORDS 3456
#define XB_SPIN_CAP (1u << 22)
__device__ __forceinline__ unsigned xb_ld(unsigned* p)              { return __hip_atomic_load(p, __ATOMIC_RELAXED, __HIP_MEMORY_SCOPE_AGENT); }
__device__ __forceinline__ unsigned xb_add(unsigned* p, unsigned v) { return __hip_atomic_fetch_add(p, v, __ATOMIC_RELAXED, __HIP_MEMORY_SCOPE_AGENT); }
__device__ __forceinline__ unsigned xb_xcc_id() { return (unsigned)__builtin_amdgcn_s_getreg((3 << 11) | 20) & 0xFu; }
#define XB_SPIN(cond, bar) do { unsigned _sp = 0; while (cond) { __builtin_amdgcn_s_sleep(1); \
    if ((++_sp & 255u) == 0u) { if (xb_ld(&(bar)[XB_TMO])) break; if (_sp > XB_SPIN_CAP) { atomicAdd(&(bar)[XB_TMO], 1u); break; } } } } while (0)
struct XcdBarrier { unsigned* bar; unsigned x; volatile LAS unsigned* st; };
__device__ __forceinline__ XcdBarrier xcd_barrier_post(unsigned* bar, volatile LAS unsigned* st) {
    XcdBarrier b; b.bar = bar; b.x = xb_xcc_id(); b.st = st;
    if (threadIdx.x == 0) (void)xb_add(&bar[XB_XCNT(b.x)], 1u);
    return b;
}
__device__ __forceinline__ void xcd_barrier_complete(unsigned* bar, unsigned x, unsigned& nloc, unsigned& nx) {
    const unsigned G = gridDim.x * gridDim.y * gridDim.z;
    unsigned sum, cnt, mine, sp = 0u;
    for (;;) {
        sum = 0u; cnt = 0u; mine = 0u;
#pragma unroll
        for (unsigned j = 0; j < 16; ++j) { const unsigned c = xb_ld(&bar[XB_XCNT(j)]); sum += c; cnt += (c > 0u) ? 1u : 0u; mine = (j == x) ? c : mine; }
        if (sum == G) break;
        __builtin_amdgcn_s_sleep(1);
        if ((++sp & 255u) == 0u) { if (xb_ld(&bar[XB_TMO])) break; if (sp > XB_SPIN_CAP) { atomicAdd(&bar[XB_TMO], 1u); break; } }
    }
    nloc = mine > 0u ? mine : 1u; nx = cnt > 0u ? cnt : 1u;
}
__device__ __forceinline__ void xcd_barrier(unsigned char* wsb) {
    XcdBarrier b; b.bar = (unsigned*)(wsb + WS_BAR); b.x = 0; b.st = (volatile LAS unsigned*)(135168 + 64);
    asm volatile("s_waitcnt vmcnt(0)" ::: "memory");
    __syncthreads();
    if (threadIdx.x == 0) {
        unsigned* bar = b.bar; b.x = xb_xcc_id();
        __builtin_amdgcn_s_waitcnt(0);
        unsigned nloc = b.st[0], nx = b.st[1];
        if (nloc == 0u) { xcd_barrier_complete(bar, b.x, nloc, nx); b.st[0] = nloc; b.st[1] = nx; }
        const unsigned old = xb_add(&bar[XB_XSUB(b.x)], 1u);
        const unsigned gen = old / nloc;
        if (old + 1u == (gen + 1u) * nloc) {
            __builtin_amdgcn_fence(__ATOMIC_RELEASE, "agent");
            asm volatile("s_waitcnt vmcnt(0)" ::: "memory");
            const unsigned og = xb_add(&bar[XB_TOP], 1u);
            const unsigned tg = og / nx;
            if (og + 1u == (tg + 1u) * nx) xb_add(&bar[XB_TOPGEN], 1u);
            else XB_SPIN(xb_ld(&bar[XB_TOPGEN]) == tg, bar);
            __builtin_amdgcn_fence(__ATOMIC_ACQUIRE, "agent");
            xb_add(&bar[XB_XGEN(b.x)], 1u);
            asm volatile("s_waitcnt vmcnt(0)" ::: "memory");
        } else {
            XB_SPIN(xb_ld(&bar[XB_XGEN(b.x)]) == gen, bar);
            __builtin_amdgcn_fence(__ATOMIC_ACQUIRE, "agent");
            asm volatile("s_waitcnt vmcnt(0)" ::: "memory");
        }
    }
    __syncthreads();
}

struct Params { const float* in[24]; float* out; unsigned char* ws; };
struct PRef {
    typedef const __attribute__((address_space(4))) char* kptr_t;
    __device__ __forceinline__ kptr_t base() const { kptr_t ka = (kptr_t)__builtin_amdgcn_kernarg_segment_ptr(); asm volatile("" : "+s"(ka)); return ka; }
    __device__ __forceinline__ const float* in(int i) const { return *(const float* const __attribute__((address_space(4)))*)(base() + 8 * i); }
    __device__ __forceinline__ float* out() const { return *(float* const __attribute__((address_space(4)))*)(base() + 8 * 24); }
    __device__ __forceinline__ unsigned char* ws() const { return *(unsigned char* const __attribute__((address_space(4)))*)(base() + 8 * 25); }
};
enum { I_X = 0, I_C, I_CTX, I_CCTX, I_MODW, I_MODB, I_N1G, I_N2G, I_WIN, I_DAQKG, I_DALAM, I_DAOUTG, I_CONVW, I_CONVB, I_GATEB, I_MLOUTG, I_QNG, I_KVNG, I_WUQ, I_WUKV, I_MLAQKG, I_WOUT, I_WGU, I_WDN };

struct Ctx {
    unsigned char* lds;
    int tid, lane, wave, gw, ngw, nwg, wg; unsigned l3off;
};

__device__ __forceinline__ Ctx fresh(const Ctx& X) {
    Ctx Y = X; int t = X.tid; asm volatile("" : "+v"(t)); Y.tid = t; Y.lane = t & 63; Y.wave = __builtin_amdgcn_readfirstlane(t >> 6); return Y;
}
template <int MODE>
__device__ __forceinline__ void transpose_item(const float* W, int K, int N, bf16_t* WT, float* scr, int item, int nblk, int lane) {
    const int kb = item / nblk, nb = item % nblk, k0 = 64 * kb, n0 = 32 * nb;
    const int ncol = n0 + (lane & 31); const bool ok = ncol < N;
#pragma unroll 8
    for (int i = 0; i < 32; ++i) { const int kk = 2 * i + (lane >> 5); scr[kk * 33 + (lane & 31)] = ok ? W[(size_t)(k0 + kk) * N + ncol] : 0.f; }
    asm volatile("s_waitcnt lgkmcnt(0)" ::: "memory");
    const int c = lane & 7;
#pragma unroll
    for (int j = 0; j < 4; ++j) { const int n = (lane >> 3) + 8 * j; const float* s = scr + (8 * c) * 33 + n;
        u32x4 o; o.x = pk2(s[0 * 33], s[1 * 33]); o.y = pk2(s[2 * 33], s[3 * 33]); o.z = pk2(s[4 * 33], s[5 * 33]); o.w = pk2(s[6 * 33], s[7 * 33]);
        int nn = n0 + n;
        if (MODE == 1) { const int up = nn >= FF ? 1 : 0; const int hcol = nn - up * FF; nn = (hcol >> 7) * 256 + up * 128 + (hcol & 127); }
        *(u32x4*)(WT + (size_t)nn * K + k0 + 8 * c) = o; }
    asm volatile("s_waitcnt lgkmcnt(0)" ::: "memory");
}
__device__ __forceinline__ void convert_weights(const Ctx& X0, const PRef& P, int l, int part, int wg_lo) {
    const Ctx X = fresh(X0);
    const int vwg = X.wg - wg_lo; if (vwg < 0) return;
    const int gwv = vwg * 8 + X.wave, ngwv = (X.nwg - wg_lo) * 8;
    float* scr = (float*)(X.lds + X.wave * 16384);
    unsigned char* ws = P.ws();
    constexpr int I_IN = (DM / 64) * (NPROJ / 32), I_OUT = (DM / 64) * (DM / 32), I_GU = (DM / 64) * (2 * FF / 32), I_DN = (FF / 64) * (DM / 32), I_UQ = (512 / 64) * (1536 / 32), I_UKV = (256 / 64) * (2048 / 32);
    constexpr int NITEMS = I_IN + I_OUT + I_GU + I_DN + I_UQ + I_UKV;
    const int it_lo = part == 2 ? NITEMS - I_DN : 0, it_hi = part == 1 ? NITEMS - I_DN : NITEMS;
    for (int it = it_lo + gwv; it < it_hi; it += ngwv) {
        int r = it;
        if (r < I_IN) { transpose_item<0>(P.in(I_WIN) + (size_t)l * DM * IN_W, DM, IN_W, (bf16_t*)(ws + WS_WIN), scr, r, NPROJ / 32, X.lane); continue; } r -= I_IN;
        if (r < I_OUT) { transpose_item<0>(P.in(I_WOUT) + (size_t)l * DM * DM, DM, DM, (bf16_t*)(ws + WS_WOUT), scr, r, DM / 32, X.lane); continue; } r -= I_OUT;
        if (r < I_GU) { transpose_item<1>(P.in(I_WGU) + (size_t)l * DM * 2 * FF, DM, 2 * FF, (bf16_t*)(ws + WS_WGU), scr, r, 2 * FF / 32, X.lane); continue; } r -= I_GU;
        if (r < I_UQ) { transpose_item<0>(P.in(I_WUQ) + (size_t)l * 512 * 1536, 512, 1536, (bf16_t*)(ws + WS_WUQ), scr, r, 1536 / 32, X.lane); continue; } r -= I_UQ;
        if (r < I_UKV) { transpose_item<0>(P.in(I_WUKV) + (size_t)l * 256 * 2048, 256, 2048, (bf16_t*)(ws + WS_WUKV), scr, r, 2048 / 32, X.lane); continue; } r -= I_UKV;
        transpose_item<0>(P.in(I_WDN) + (size_t)l * FF * DM, FF, DM, (bf16_t*)(ws + WS_WDN), scr, r, DM / 32, X.lane);
    }
}
__device__ __forceinline__ void mod_gemv(const Ctx& X0, const PRef& P, int l_lo, int l_hi, int wg_lo) {
    const Ctx X = fresh(X0);
    const int vwg = X.wg - wg_lo; if (vwg < 0) return;
    float* sc = (float*)X.lds;
    float* red = (float*)(X.lds + 40960);
    for (int i = X.tid; i < 5 * DM; i += 512) { const int mb = i / DM, k = i % DM; const float v = mb < 4 ? P.in(I_C)[mb * DM + k] : P.in(I_CCTX)[k]; sc[i] = siluf(v); }
    __syncthreads();
    float* mod = (float*)(P.ws() + WS_MOD);
    const int kq = X.tid >> 4, c4 = X.tid & 15;
    for (int task = vwg; task < (l_hi - l_lo) * 192; task += X.nwg - wg_lo) {
        const int l = l_lo + task / 192, n0 = (task % 192) * 64;
        const float* W = P.in(I_MODW) + (size_t)l * DM * 6 * DM + n0 + 4 * c4;
        f32x4 a[5];
#pragma unroll
        for (int mb = 0; mb < 5; ++mb) a[mb] = (f32x4){0.f, 0.f, 0.f, 0.f};
#pragma unroll 8
        for (int i = 0; i < 64; ++i) { const int k = kq + 32 * i; const f32x4 w = *(const f32x4*)(W + (size_t)k * 6 * DM);
#pragma unroll
            for (int mb = 0; mb < 5; ++mb) a[mb] += w * sc[mb * DM + k]; }
#pragma unroll
        for (int mb = 0; mb < 5; ++mb) *(f32x4*)(red + (kq * 5 + mb) * 64 + 4 * c4) = a[mb];
        __syncthreads();
        if (X.tid < 320) { const int mb = X.tid >> 6, cc = X.tid & 63; float s = 0.f;
#pragma unroll 8
            for (int q = 0; q < 32; ++q) s += red[(q * 5 + mb) * 64 + cc];
            mod[((size_t)l * 5 + mb) * 6 * DM + n0 + cc] = s + P.in(I_MODB)[(size_t)l * 6 * DM + n0 + cc]; }
        __syncthreads();
    }
}

__device__ __forceinline__ void modulate_phase(const Ctx& X0, const float* src_lat, const float* src_ctx, const float* g, const float* modl, int shift_off, int scale_off, bf16_t* A, int nrows) {
    const Ctx X = fresh(X0);
    const int rpw = (nrows + X.ngw - 1) / X.ngw;
    int row = X.gw * rpw; const int rend = min(row + rpw, nrows);
    f32x4 v[8], nx[8], gm[8], sh[8];
    int cur_mb = -1;
    if (row < rend) { const float* src = row < M_LAT ? src_lat + (size_t)row * DM : src_ctx + (size_t)(row - M_LAT) * DM;
#pragma unroll
        for (int j = 0; j < 8; ++j) v[j] = *(const f32x4*)(src + X.lane * 4 + 256 * j); }
    for (; row < rend; ++row) {
        const int nrow = row + 1;
        if (nrow < rend) { const float* src = nrow < M_LAT ? src_lat + (size_t)nrow * DM : src_ctx + (size_t)(nrow - M_LAT) * DM;
#pragma unroll
            for (int j = 0; j < 8; ++j) nx[j] = *(const f32x4*)(src + X.lane * 4 + 256 * j); }
        const int mb = mod_batch(row);
        if (mb != cur_mb) { cur_mb = mb; const float* mp = modl + (size_t)mb * 6 * DM;
#pragma unroll
            for (int j = 0; j < 8; ++j) { const int col = X.lane * 4 + 256 * j; gm[j] = *(const f32x4*)(g + col) * (*(const f32x4*)(mp + scale_off + col) + 1.0f); sh[j] = *(const f32x4*)(mp + shift_off + col); } }
        float ss = 0.f;
#pragma unroll
        for (int j = 0; j < 8; ++j) ss += (v[j][0] * v[j][0] + v[j][1] * v[j][1]) + (v[j][2] * v[j][2] + v[j][3] * v[j][3]);
        const float rstd = rsqrtf(wave_sum(ss) * (1.f / DM) + EPS);
#pragma unroll
        for (int j = 0; j < 8; ++j) { const int col = X.lane * 4 + 256 * j;
            const f32x4 y = (v[j] * rstd) * gm[j] + sh[j];
            u32x2 w; w.x = pk2(y[0], y[1]); w.y = pk2(y[2], y[3]);
            *(u32x2*)(A + (size_t)row * DM + col) = w; }
#pragma unroll
        for (int j = 0; j < 8; ++j) v[j] = nx[j];
    }
}

struct ChunkId { int b, j, row0, tok0, is_lat, seglen; };
__device__ __forceinline__ ChunkId chunk_of_unit(int u) {
    ChunkId c;
    if (u < 256) { c.b = u >> 6; c.j = u & 63; c.row0 = c.b * SEQ + 64 * c.j; c.tok0 = CTXL + 64 * c.j; c.is_lat = 1; c.seglen = SEQ; }
    else { const int uu = u - 256; c.b = uu >> 2; c.j = uu & 3; c.row0 = M_LAT + c.b * CTXL + 64 * c.j; c.tok0 = 64 * c.j; c.is_lat = 0; c.seglen = CTXL; }
    return c;
}
__device__ __forceinline__ int row_of_tokchunk(int b, int jt) { return jt < 4 ? M_LAT + b * CTXL + 64 * jt : b * SEQ + 64 * (jt - 4); }

constexpr int TSTR = 520;
__device__ __forceinline__ void write_vt(const Ctx& X, const bf16_t* tile, bf16_t* img, size_t img_row0, int tok0) {
#pragma unroll 2
    for (int it = 0; it < 8; ++it) { const int task = it * 512 + X.tid; const int k = task & 7, c = task >> 3;
        float v[8];
#pragma unroll
        for (int jj = 0; jj < 8; ++jj) { const int i = 16 * (k >> 1) + 8 * (jj >> 2) + 4 * (k & 1) + (jj & 3); v[jj] = bf1(tile[i * TSTR + c]); }
        *(u32x4*)(img + (img_row0 + c) * TK + tok0 + 8 * k) = pack8(v); }
}
template <class F>
__device__ __forceinline__ void load_tile(const Ctx& X, bf16_t* tile, const bf16_t* src, size_t rstride, F colmap) {
#pragma unroll 4
    for (int it = 0; it < 8; ++it) { const int ch = it * 512 + X.tid; const int i = ch >> 6, cc = ch & 63;
        const u32x4 w = *(const u32x4*)(src + (size_t)i * rstride + colmap(cc));
        *(u32x4*)(tile + i * TSTR + 8 * cc) = w; }
}

__device__ __forceinline__ void rope_cs(int sub, int prow, int pcol, float* cs, float* sn) {
    const float pos = (float)((sub < 4) ? prow : pcol);
#pragma unroll
    for (int e = 0; e < 8; ++e) { const int fi = (sub & 1) * 8 + e; const float inv = exp2f(-(float)fi * (13.287712379549449f / 16.0f)); const float a = pos * inv; cs[e] = __cosf(a); sn[e] = __sinf(a); }
}
__device__ __forceinline__ void rope_apply(int sub, float* y, const float* cs, const float* sn) {
#pragma unroll
    for (int e = 0; e < 8; ++e) { const float p = __shfl_xor(y[e], 2); y[e] = (sub & 2) ? (y[e] * cs[e] + p * sn[e]) : (y[e] * cs[e] - p * sn[e]); }
}

__device__ __forceinline__ void prep_phase(const Ctx& X0, const PRef& P, int l) {
    const Ctx X = fresh(X0);
    unsigned char* ws = P.ws();
    const bf16_t* proj = (const bf16_t*)(ws + WS_PROJ);
    bf16_t* tile = (bf16_t*)X.lds;
    const float* qkg = P.in(I_DAQKG) + l * 128;
    const float* convw = P.in(I_CONVW) + (size_t)l * 3 * 1024; const float* convb = P.in(I_CONVB) + l * 1024;
    const float* qng = P.in(I_QNG) + l * 512; const float* kvng = P.in(I_KVNG) + l * 256;
    const int lane = X.lane, sub = lane & 7;
    const float qscale = 0.125f * LOG2E;
    for (int uu = X.wg; uu < 4 * 272; uu += X.nwg) {
        const int part = uu / 272, u = uu % 272;
        const ChunkId c = chunk_of_unit(u);
        if (part == 0) {
        for (int i = X.wave; i < 64; i += 8) {
            const int row = c.row0 + i, tok = c.tok0 + i;
            const bf16_t* pr = proj + (size_t)row * NPROJ;
            float cs[8], sn[8];
            if (c.is_lat) rope_cs(sub, c.j, i, cs, sn);
#pragma unroll
            for (int qk = 0; qk < 2; ++qk) {
                float y[8]; unpack8(*(const u32x4*)(pr + (qk ? C_DAK : C_DAQ) + 8 * lane), y);
                float ss = 0.f;
#pragma unroll
                for (int e = 0; e < 8; ++e) ss += y[e] * y[e];
                ss += __shfl_xor(ss, 1); ss += __shfl_xor(ss, 2); ss += __shfl_xor(ss, 4);
                const float rstd = rsqrtf(ss * (1.f / 64.f) + EPS);
#pragma unroll
                for (int e = 0; e < 8; ++e) y[e] = y[e] * rstd * qkg[qk * 64 + 8 * sub + e];
                if (c.is_lat) rope_apply(sub, y, cs, sn);
                const int head = lane >> 4, comp = (lane >> 3) & 1;
                if (qk == 0) {
#pragma unroll
                    for (int e = 0; e < 8; ++e) y[e] *= qscale;
                    *(u32x4*)((bf16_t*)(ws + WS_QDA) + ((size_t)head * M_ALL + row) * 128 + comp * 64 + 8 * sub) = pack8(y);
                } else {
                    *(u32x4*)((bf16_t*)(ws + WS_KDA) + ((size_t)(c.b * 4 + head) * TK + tok) * 128 + comp * 64 + 8 * sub) = pack8(y);
                }
            }
            {
                float y[8]; unpack8(*(const u32x4*)(pr + C_CQ + 8 * lane), y);
                float ss = 0.f;
#pragma unroll
                for (int e = 0; e < 8; ++e) ss += y[e] * y[e];
                const float rstd = rsqrtf(wave_sum(ss) * (1.f / 512.f) + EPS);
#pragma unroll
                for (int e = 0; e < 8; ++e) y[e] = y[e] * rstd * qng[8 * lane + e];
                *(u32x4*)((bf16_t*)(ws + WS_CQN) + (size_t)row * 512 + 8 * lane) = pack8(y);
            }
            {
                float y[8];
                if (lane < 32) unpack8(*(const u32x4*)(pr + C_CKV + 8 * lane), y);
                else {
#pragma unroll
                    for (int e = 0; e < 8; ++e) y[e] = 0.f;
                }
                float ss = 0.f;
#pragma unroll
                for (int e = 0; e < 8; ++e) ss += y[e] * y[e];
                const float rstd = rsqrtf(wave_sum(ss) * (1.f / 256.f) + EPS);
                if (lane < 32) {
#pragma unroll
                    for (int e = 0; e < 8; ++e) y[e] = y[e] * rstd * kvng[8 * lane + e];
                    *(u32x4*)((bf16_t*)(ws + WS_CKVN) + (size_t)row * 256 + 8 * lane) = pack8(y);
                }
            }
            if (lane < 8) *(u32x4*)((bf16_t*)(ws + WS_KPE) + (size_t)row * 64 + 8 * lane) = *(const u32x4*)(pr + C_KPE + 8 * lane);
            *(u32x4*)((bf16_t*)(ws + WS_OCOPY) + (size_t)row * 512 + 8 * lane) = *(const u32x4*)(pr + C_MLO + 8 * lane);
        }
        } else if (part == 1) {
        for (int i = X.wave; i < 64; i += 8) {
            const int row = c.row0 + i, tseg = 64 * c.j + i, tok = c.tok0 + i;
            const bf16_t* pr = proj + (size_t)row * NPROJ;
#pragma unroll
            for (int qk = 0; qk < 2; ++qk) {
                const int ch0 = qk * 512 + 8 * lane;
                float xm[8], x0[8], xp[8];
                unpack8(*(const u32x4*)(pr + C_MLQ + ch0), x0);
                if (tseg > 0) unpack8(*(const u32x4*)(pr - NPROJ + C_MLQ + ch0), xm);
                else {
#pragma unroll
                    for (int e = 0; e < 8; ++e) xm[e] = 0.f;
                }
                if (tseg < c.seglen - 1) unpack8(*(const u32x4*)(pr + NPROJ + C_MLQ + ch0), xp);
                else {
#pragma unroll
                    for (int e = 0; e < 8; ++e) xp[e] = 0.f;
                }
                float y[8];
#pragma unroll
                for (int e = 0; e < 8; ++e) { const float v = convb[ch0 + e] + convw[ch0 + e] * xm[e] + convw[1024 + ch0 + e] * x0[e] + convw[2048 + ch0 + e] * xp[e]; y[e] = siluf(v) * (qk ? 0.08838834764831845f : 1.0f); }
                const int head = lane >> 4, d = 8 * (lane & 15);
                const u32x4 w = pack8(y);
                *(u32x4*)((bf16_t*)(ws + (qk ? WS_KML : WS_QML)) + ((size_t)(c.b * 4 + head) * TK + tok) * 128 + d) = w;
                if (qk) *(u32x4*)(tile + i * TSTR + 8 * lane) = w;
            }
        }
        __syncthreads();
        write_vt(X, tile, (bf16_t*)(ws + WS_KTML), (size_t)c.b * 512, c.tok0);
        __syncthreads();
        } else if (part == 2) {
        load_tile(X, tile, proj + (size_t)c.row0 * NPROJ, NPROJ, [](int cc) { return C_DAV + 8 * cc; });
        __syncthreads();
        write_vt(X, tile, (bf16_t*)(ws + WS_VTDA), (size_t)c.b * 512, c.tok0);
        __syncthreads();
        } else {
        load_tile(X, tile, proj + (size_t)c.row0 * NPROJ, NPROJ, [](int cc) { return C_MLV + 8 * cc; });
        __syncthreads();
        write_vt(X, tile, (bf16_t*)(ws + WS_VTML), (size_t)c.b * 512, c.tok0);
        __syncthreads();
        }
    }
}

__device__ __forceinline__ void mla_prep_phase(const Ctx& X0, const PRef& P, int l) {
    const Ctx X = fresh(X0);
    unsigned char* ws = P.ws();
    const bf16_t* qup = (const bf16_t*)(ws + WS_QUP); const bf16_t* kvup = (const bf16_t*)(ws + WS_KVUP); const bf16_t* kpe = (const bf16_t*)(ws + WS_KPE);
    bf16_t* tile = (bf16_t*)X.lds;
    const float* g = P.in(I_MLAQKG) + l * 2 * 192;
    const int lane = X.lane, sub = lane & 7, head = lane >> 3;
    const float qscale = 0.07216878364870322f * LOG2E;
    for (int uu = X.wg; uu < 3 * 272; uu += X.nwg) {
        const int part = uu / 272, u = uu % 272;
        const ChunkId c = chunk_of_unit(u);
        if (part == 0) {
        for (int i = X.wave; i < 64; i += 8) {
            const int row = c.row0 + i, tok = c.tok0 + i;
            float cs[8], sn[8];
            if (c.is_lat) rope_cs(sub, c.j, i, cs, sn);
#pragma unroll
            for (int qk = 0; qk < 2; ++qk) {
                float y[3][8];
                if (qk == 0) {
#pragma unroll
                    for (int cc = 0; cc < 3; ++cc) unpack8(*(const u32x4*)(qup + (size_t)row * 1536 + head * 192 + 64 * cc + 8 * sub), y[cc]);
                } else {
#pragma unroll
                    for (int cc = 0; cc < 2; ++cc) unpack8(*(const u32x4*)(kvup + (size_t)row * 2048 + head * 256 + 64 * cc + 8 * sub), y[cc]);
                    unpack8(*(const u32x4*)(kpe + (size_t)row * 64 + 8 * sub), y[2]);
                }
                float ss = 0.f;
#pragma unroll
                for (int cc = 0; cc < 3; ++cc)
#pragma unroll
                    for (int e = 0; e < 8; ++e) ss += y[cc][e] * y[cc][e];
                ss += __shfl_xor(ss, 1); ss += __shfl_xor(ss, 2); ss += __shfl_xor(ss, 4);
                const float rstd = rsqrtf(ss * (1.f / 192.f) + EPS);
#pragma unroll
                for (int cc = 0; cc < 3; ++cc)
#pragma unroll
                    for (int e = 0; e < 8; ++e) y[cc][e] = y[cc][e] * rstd * g[qk * 192 + 64 * cc + 8 * sub + e];
                if (c.is_lat) rope_apply(sub, y[2], cs, sn);
                bf16_t* dst;
                if (qk == 0) {
#pragma unroll
                    for (int cc = 0; cc < 3; ++cc)
#pragma unroll
                        for (int e = 0; e < 8; ++e) y[cc][e] *= qscale;
                    dst = (bf16_t*)(ws + WS_QM) + ((size_t)head * M_ALL + row) * 192;
                } else dst = (bf16_t*)(ws + WS_KM) + ((size_t)(c.b * 8 + head) * TK + tok) * 192;
#pragma unroll
                for (int cc = 0; cc < 3; ++cc) *(u32x4*)(dst + 64 * cc + 8 * sub) = pack8(y[cc]);
            }
        }
        } else {
            const int p = part - 1;
            load_tile(X, tile, kvup + (size_t)c.row0 * 2048, 2048, [p](int cc) { return (4 * p + (cc >> 4)) * 256 + 128 + 8 * (cc & 15); });
            __syncthreads();
            write_vt(X, tile, (bf16_t*)(ws + WS_VTM), (size_t)(c.b * 8 + 4 * p) * 128, c.tok0);
            __syncthreads();
        }
    }
}

__device__ __forceinline__ void ml_gates(const float* gates, const float* gb, int b, int jt, int dir, int h, int lane, float& ig, float& lf, float& pre, float& total) {
    const int row = row_of_tokchunk(b, jt) + lane;
    ig = gates[(size_t)row * 16 + dir * 8 + h] + gb[dir * 8 + h];
    const float fg = gates[(size_t)row * 16 + dir * 8 + 4 + h] + gb[dir * 8 + 4 + h];
    lf = fminf(fg, 0.f) - log1pf(__expf(-fabsf(fg)));
    float s = lf;
#pragma unroll
    for (int o = 1; o < 64; o <<= 1) { const float t = __shfl_up(s, o); if (lane >= o) s += t; }
    pre = s; total = __shfl(s, 63);
}
constexpr int KSTR = 72;
constexpr int QSTR = 136;
__device__ __forceinline__ void mlstm_a_phase(const Ctx& X0, const PRef& P, int l) {
    const Ctx X = fresh(X0);
    unsigned char* ws = P.ws();
    const float* gates = (const float*)(ws + WS_GATES); const float* gb = P.in(I_GATEB) + l * 16;
    bf16_t* Kt = (bf16_t*)X.lds;
    bf16_t* Vw = (bf16_t*)(X.lds + 128 * KSTR * 2);
    float* wtab = (float*)(X.lds + 3 * 128 * KSTR * 2);
    const int lane = X.lane, r32 = lane & 31, hi = lane >> 5;
    for (int u = (X.wg + X.nwg - 152 % X.nwg) % X.nwg; u < 16 * NCH; u += X.nwg) {
        const int bh = u / NCH, jt = u % NCH, b = bh >> 2, h = bh & 3, tok0 = 64 * jt;
        if (X.wave < 2) {
            const int dir = X.wave; float ig, lf, pre, total; ml_gates(gates, gb, b, jt, dir, h, lane, ig, lf, pre, total);
            const float cum = dir == 0 ? pre : total - pre + lf;
            const float wlog = total - cum + ig; const float mloc = wave_max(wlog);
            wtab[dir * 64 + lane] = __expf(wlog - mloc);
            if (lane == 0) { float* cs = (float*)(ws + WS_CSTAT) + ((size_t)(bh * 2 + dir) * NCH + jt) * 4; cs[0] = total; cs[1] = mloc; }
        }
        u32x4 vr[2];
#pragma unroll
        for (int it = 0; it < 2; ++it) { const int ch = it * 512 + X.tid; const int rr = ch >> 3, k = ch & 7;
            *(u32x4*)(Kt + rr * KSTR + 8 * k) = *(const u32x4*)((const bf16_t*)(ws + WS_KTML) + ((size_t)bh * 128 + rr) * TK + tok0 + 8 * k);
            vr[it] = *(const u32x4*)((const bf16_t*)(ws + WS_VTML) + ((size_t)bh * 128 + rr) * TK + tok0 + 8 * k); }
        __syncthreads();
#pragma unroll
        for (int it = 0; it < 2; ++it) { const int ch = it * 512 + X.tid; const int rr = ch >> 3, k = ch & 7;
            float v[8]; unpack8(vr[it], v);
#pragma unroll
            for (int dir = 0; dir < 2; ++dir) { float o[8];
#pragma unroll
                for (int jj = 0; jj < 8; ++jj) { const int i = 16 * (k >> 1) + 8 * (jj >> 2) + 4 * (k & 1) + (jj & 3); o[jj] = v[jj] * wtab[dir * 64 + i]; }
                *(u32x4*)(Vw + (dir * 128 + rr) * KSTR + 8 * k) = pack8(o); } }
        __syncthreads();
        {
            const int dir = X.wave >> 2, dvb = X.wave & 3;
            bf16_t* U = (bf16_t*)(ws + WS_AB) + ((size_t)(bh * 2 + dir) * NCH + jt) * 16384;
            bf16x8 a[4];
#pragma unroll
            for (int ks = 0; ks < 4; ++ks) a[ks] = *(const bf16x8*)(Vw + (dir * 128 + 32 * dvb + r32) * KSTR + 16 * ks + 8 * hi);
            for (int dkb = 0; dkb < 4; ++dkb) {
                f32x16 acc;
#pragma unroll
                for (int r = 0; r < 16; ++r) acc[r] = 0.f;
#pragma unroll
                for (int ks = 0; ks < 4; ++ks) { const bf16x8 bb = *(const bf16x8*)(Kt + (32 * dkb + r32) * KSTR + 16 * ks + 8 * hi); acc = __builtin_amdgcn_mfma_f32_32x32x16_bf16(a[ks], bb, acc, 0, 0, 0); }
#pragma unroll
                for (int r = 0; r < 16; ++r) U[(32 * dvb + crow(r, hi)) * 128 + 32 * dkb + r32] = (bf16_t)(pk2(acc[r], 0.f) & 0xffffu);
            }
        }
        if (X.tid < 256) { const int dir = X.tid >> 7, dk = X.tid & 127; float s = 0.f;
#pragma unroll 8
            for (int p = 0; p < 64; ++p) { const int i = (p & ~15) + perm_off(p & 15); s += wtab[dir * 64 + i] * bf1(Kt[dk * KSTR + p]); }
            ((float*)(ws + WS_NU))[((size_t)(bh * 2 + dir) * NCH + jt) * 128 + dk] = s; }
        __syncthreads();
    }
}
__device__ __forceinline__ int ml_jmap(int dir, int c) { return dir == 0 ? c : (c < 4 ? 3 - c : 71 - c); }
__device__ __forceinline__ void mlstm_scan_phase(const Ctx& X0, const PRef& P) {
    const Ctx X = fresh(X0);
    unsigned char* ws = P.ws();
    float* cstat = (float*)(ws + WS_CSTAT);
    const int gtid = (X.nwg - 1 - X.wg) * 512 + X.tid, nthr = X.nwg * 512;
    for (int task = gtid; task < 65536 + 1024; task += nthr) {
        float m = 0.f;
        if (task < 65536) {
            const int seq = task >> 11, e = task & 2047, dir = seq & 1;
            const bf16_t* __restrict__ U = (const bf16_t*)(ws + WS_AB); bf16_t* __restrict__ S = (bf16_t*)(ws + WS_CSNAP);
            float C[8];
#pragma unroll
            for (int i = 0; i < 8; ++i) C[i] = 0.f;
            for (int cb = 0; cb < 4; ++cb) {
                u32x4 uu[17]; float tot[17], mlc[17];
#pragma unroll
                for (int i = 0; i < 17; ++i) { const size_t base = (size_t)seq * NCH + ml_jmap(dir, cb * 17 + i);
                    uu[i] = *(const u32x4*)(U + base * 16384 + 8 * e); tot[i] = cstat[base * 4]; mlc[i] = cstat[base * 4 + 1]; }
#pragma unroll
                for (int i = 0; i < 17; ++i) { const size_t base = (size_t)seq * NCH + ml_jmap(dir, cb * 17 + i);
                    *(u32x4*)(S + base * 16384 + 8 * e) = pack8(C);
                    if (e == 0) cstat[base * 4 + 2] = m;
                    const float mn = fmaxf(tot[i] + m, mlc[i]); const float dec = __expf(tot[i] + m - mn), sc = __expf(mlc[i] - mn);
                    float u8[8]; unpack8(uu[i], u8);
#pragma unroll
                    for (int q = 0; q < 8; ++q) C[q] = C[q] * dec + u8[q] * sc;
                    m = mn; }
            }
        } else {
            const int t2 = task - 65536, seq = t2 >> 5, e4 = t2 & 31, dir = seq & 1;
            const float* __restrict__ NU = (const float*)(ws + WS_NU); float* __restrict__ NS = (float*)(ws + WS_NSNAP);
            f32x4 C = (f32x4){0.f, 0.f, 0.f, 0.f};
            for (int cb = 0; cb < 4; ++cb) {
                f32x4 uu[17]; float tot[17], mlc[17];
#pragma unroll
                for (int i = 0; i < 17; ++i) { const size_t base = (size_t)seq * NCH + ml_jmap(dir, cb * 17 + i);
                    uu[i] = *(const f32x4*)(NU + base * 128 + 4 * e4); tot[i] = cstat[base * 4]; mlc[i] = cstat[base * 4 + 1]; }
#pragma unroll
                for (int i = 0; i < 17; ++i) { const size_t base = (size_t)seq * NCH + ml_jmap(dir, cb * 17 + i);
                    *(f32x4*)(NS + base * 128 + 4 * e4) = C;
                    const float mn = fmaxf(tot[i] + m, mlc[i]); const float dec = __expf(tot[i] + m - mn), sc = __expf(mlc[i] - mn);
                    C = C * dec + uu[i] * sc; m = mn; }
            }
        }
    }
}
__device__ __forceinline__ void mlstm_c_unit(const Ctx& X0, const PRef& P, int l, int u) {
    const Ctx X = fresh(X0);
    unsigned char* ws = P.ws();
    const float* gates = (const float*)(ws + WS_GATES); const float* gb = P.in(I_GATEB) + l * 16;
    const float* cstat = (const float*)(ws + WS_CSTAT);
    bf16_t* Qt = (bf16_t*)X.lds;
    bf16_t* Kn = (bf16_t*)(X.lds + 64 * QSTR * 2);
    bf16_t* Vt = (bf16_t*)(X.lds + 2 * 64 * QSTR * 2);
    float* tab = (float*)(X.lds + 2 * 64 * QSTR * 2 + 128 * KSTR * 2);
    float* t_a = tab, *t_c1 = tab + 128, *t_wp = tab + 256, *t_em = tab + 384, *t_n = tab + 512, *t_red = tab + 768;
    const int lane = X.lane, r32 = lane & 31, hi = lane >> 5;
    const int bh = u / NCH, jt = u % NCH, b = bh >> 2, h = bh & 3, tok0 = 64 * jt;
    if (X.wave < 2) {
        const int dir = X.wave; float ig, lf, pre, total; ml_gates(gates, gb, b, jt, dir, h, lane, ig, lf, pre, total);
        const float cum = dir == 0 ? pre : total - pre + lf;
        const float a = ig - cum; float pm = a;
#pragma unroll
        for (int o = 1; o < 64; o <<= 1) { const float t = dir == 0 ? __shfl_up(pm, o) : __shfl_down(pm, o); const bool ok = dir == 0 ? (lane >= o) : (lane + o < 64); if (ok) pm = fmaxf(pm, t); }
        const float mc = cstat[((size_t)(bh * 2 + dir) * NCH + jt) * 4 + 2];
        const float mt = cum + fmaxf(mc, pm);
        t_a[dir * 64 + lane] = a; t_c1[dir * 64 + lane] = cum - mt; t_wp[dir * 64 + lane] = __expf(cum + mc - mt); t_em[dir * 64 + lane] = __expf(-mt);
    }
#pragma unroll
    for (int it = 0; it < 2; ++it) { const int ch = it * 512 + X.tid;
        { const int i = ch >> 4, k = ch & 15;
          *(u32x4*)(Qt + i * QSTR + 8 * k) = *(const u32x4*)((const bf16_t*)(ws + WS_QML) + ((size_t)bh * TK + tok0 + i) * 128 + 8 * k);
          *(u32x4*)(Kn + i * QSTR + 8 * k) = *(const u32x4*)((const bf16_t*)(ws + WS_KML) + ((size_t)bh * TK + tok0 + i) * 128 + 8 * k); }
        { const int rr = ch >> 3, k = ch & 7;
          *(u32x4*)(Vt + rr * KSTR + 8 * k) = *(const u32x4*)((const bf16_t*)(ws + WS_VTML) + ((size_t)bh * 128 + rr) * TK + tok0 + 8 * k); } }
    if (X.tid < 256) t_n[X.tid] = ((const float*)(ws + WS_NSNAP))[((size_t)(bh * 2 + (X.tid >> 7)) * NCH + jt) * 128 + (X.tid & 127)];
    __syncthreads();
    const int tb = X.wave & 1, db = X.wave >> 1, t = 32 * tb + r32;
    bf16x8 qf[8];
#pragma unroll
    for (int ks = 0; ks < 8; ++ks) qf[ks] = *(const bf16x8*)(Qt + t * QSTR + 16 * ks + 8 * hi);
    f32x16 st[2];
#pragma unroll
    for (int sb = 0; sb < 2; ++sb) {
#pragma unroll
        for (int r = 0; r < 16; ++r) st[sb][r] = 0.f;
#pragma unroll
        for (int ks = 0; ks < 8; ++ks) { const bf16x8 kf = *(const bf16x8*)(Kn + (32 * sb + r32) * QSTR + 16 * ks + 8 * hi); st[sb] = __builtin_amdgcn_mfma_f32_32x32x16_bf16(kf, qf[ks], st[sb], 0, 0, 0); }
    }
    f32x16 hsum;
#pragma unroll
    for (int r = 0; r < 16; ++r) hsum[r] = 0.f;
#pragma unroll
    for (int dir = 0; dir < 2; ++dir) {
        const float c1 = t_c1[dir * 64 + t], wp = t_wp[dir * 64 + t], em = t_em[dir * 64 + t];
        float rs = 0.f; u32x4 pw[2][2];
#pragma unroll
        for (int sb = 0; sb < 2; ++sb) { float p[16];
#pragma unroll
            for (int r = 0; r < 16; ++r) { const int s = 32 * sb + crow(r, hi); const bool ok = dir == 0 ? (s <= t) : (s >= t);
                const float dm = ok ? __expf(t_a[dir * 64 + s] + c1) : 0.f; p[r] = st[sb][r] * dm; rs += p[r]; }
            pw[sb][0] = pack8(p); pw[sb][1] = pack8(p + 8); }
        rs += __shfl_xor(rs, 32);
        float qn = 0.f;
#pragma unroll
        for (int ks = 0; ks < 8; ++ks) { float q8[8]; unpack8(__builtin_bit_cast(u32x4, qf[ks]), q8);
#pragma unroll
            for (int e = 0; e < 8; ++e) qn += q8[e] * t_n[dir * 128 + 16 * ks + 8 * hi + e]; }
        qn += __shfl_xor(qn, 32);
        const float den = rs + wp * qn; const float rden = 1.f / fmaxf(fabsf(den), em);
        f32x16 acc;
#pragma unroll
        for (int r = 0; r < 16; ++r) acc[r] = 0.f;
        const bf16_t* Cs = (const bf16_t*)(ws + WS_CSNAP) + ((size_t)(bh * 2 + dir) * NCH + jt) * 16384 + (size_t)(32 * db + r32) * 128;
#pragma unroll
        for (int ks = 0; ks < 8; ++ks) { const bf16x8 cf = *(const bf16x8*)(Cs + 16 * ks + 8 * hi); acc = __builtin_amdgcn_mfma_f32_32x32x16_bf16(cf, qf[ks], acc, 0, 0, 0); }
#pragma unroll
        for (int r = 0; r < 16; ++r) acc[r] *= wp;
#pragma unroll
        for (int sb = 0; sb < 2; ++sb)
#pragma unroll
            for (int s2 = 0; s2 < 2; ++s2) { const bf16x8 vf = *(const bf16x8*)(Vt + (32 * db + r32) * KSTR + 32 * sb + 16 * s2 + 8 * hi);
                acc = __builtin_amdgcn_mfma_f32_32x32x16_bf16(vf, __builtin_bit_cast(bf16x8, pw[sb][s2]), acc, 0, 0, 0); }
#pragma unroll
        for (int r = 0; r < 16; ++r) hsum[r] += acc[r] * rden;
    }
    float ss = 0.f;
#pragma unroll
    for (int r = 0; r < 16; ++r) ss += hsum[r] * hsum[r];
    ss += __shfl_xor(ss, 32);
    if (hi == 0) t_red[(tb * 4 + db) * 32 + r32] = ss;
    __syncthreads();
    const float tot = t_red[(tb * 4 + 0) * 32 + r32] + t_red[(tb * 4 + 1) * 32 + r32] + t_red[(tb * 4 + 2) * 32 + r32] + t_red[(tb * 4 + 3) * 32 + r32];
    const float rstd = rsqrtf(tot * (1.f / 128.f) + EPS);
    const int row = row_of_tokchunk(b, jt) + t;
    const float* og = P.in(I_MLOUTG) + l * 512 + h * 128;
    const bf16_t* oc = (const bf16_t*)(ws + WS_OCOPY) + (size_t)row * 512 + h * 128;
    bf16_t* mix = (bf16_t*)(ws + WS_AB) + (size_t)row * DM + 512 + h * 128;
#pragma unroll
    for (int q = 0; q < 4; ++q) { const int dv = 32 * db + 8 * q + 4 * hi;
        const u32x2 ow = *(const u32x2*)(oc + dv); const f32x4 gg = *(const f32x4*)(og + dv);
        const float o0 = hsum[4 * q + 0] * rstd * gg[0] * sigmf(bflo(ow.x)), o1 = hsum[4 * q + 1] * rstd * gg[1] * sigmf(bfhi(ow.x));
        const float o2 = hsum[4 * q + 2] * rstd * gg[2] * sigmf(bflo(ow.y)), o3 = hsum[4 * q + 3] * rstd * gg[3] * sigmf(bfhi(ow.y));
        u32x2 w; w.x = pk2(o0, o1); w.y = pk2(o2, o3); *(u32x2*)(mix + dv) = w; }
    __syncthreads();
}

template <int DQK, int KROW>
struct AttnCore {
    static constexpr int NKS = DQK / 16, NKC1 = KROW / 8 + 1, KS = NKC1 * 8, KT_B = 64 * NKC1 * 16, VT_B = 128 * 9 * 16, SLOT_B = KT_B + VT_B;
    static constexpr int NBK = KT_B / 1024, NBV = VT_B / 1024, NB = NBK + NBV, NI = (NB + 7) / 8;
    static_assert(KT_B % 1024 == 0 && VT_B % 1024 == 0 && 8 * NI - NB <= 8 && 3 * SLOT_B <= 135168, "attention LDS geometry");
    static __device__ __forceinline__ void run(const Ctx& X, const bf16_t* Qrow, int kcol, const bf16_t* K, const bf16_t* Vt, int nt, f32x16 (&o)[4]) {
        const int lane = X.lane, r32 = lane & 31, hi = lane >> 5;
        LAS unsigned char* l3 = (LAS unsigned char*)0 + X.l3off;
        bf16x8 qf[NKS];
#pragma unroll
        for (int ks = 0; ks < NKS; ++ks) qf[ks] = *(const bf16x8*)(Qrow + 16 * ks + 8 * hi);
        unsigned goff[NI]; int bsel[NI];
#pragma unroll
        for (int i = 0; i < NI; ++i) {
            int bidx = X.wave + 8 * i; if (bidx >= NB) bidx -= NB;
            bsel[i] = bidx;
            if (bidx < NBK) { const int c = bidx * 64 + lane; const int row = c / NKC1; int col = c % NKC1; if (col > NKC1 - 2) col = NKC1 - 2; goff[i] = (unsigned)(row * KROW + 8 * col) * 2u; }
            else { const int c = (bidx - NBK) * 64 + lane; const int row = c / 9; int col = c % 9; if (col > 7) col = 7; goff[i] = (unsigned)(row * TK + 8 * col) * 2u; }
        }
        asm volatile("s_waitcnt vmcnt(0)" ::: "memory");
#pragma unroll
        for (int ks = 0; ks < NKS; ++ks) asm volatile("" : "+v"(qf[ks]));
        auto issue = [&](int t, int slotoff) {
#pragma unroll
            for (int i = 0; i < NI; ++i) {
                const char* base = bsel[i] < NBK ? (const char*)K + (size_t)t * (64 * KROW * 2) : (const char*)Vt + (size_t)t * 128;
                __builtin_amdgcn_global_load_lds((const unsigned*)(base + goff[i]), (LAS unsigned*)(l3 + slotoff + bsel[i] * 1024), 16, 0, 0);
            }
        };
#pragma unroll
        for (int d = 0; d < 4; ++d)
#pragma unroll
            for (int r = 0; r < 16; ++r) o[d][r] = 0.f;
        float mrun = -1e30f, lrun = 0.f;
        issue(0, 0); issue(1, SLOT_B);
        asm volatile("s_waitcnt vmcnt(%0)" :: "i"(NI) : "memory");
        __builtin_amdgcn_s_barrier(); asm volatile("" ::: "memory");
        int s_cur = 0, s_nn = 2 * SLOT_B;
        for (int t = 0; t < nt; ++t) {
            if (t + 2 < nt) issue(t + 2, s_nn);
            const LAS bf16_t* kt = (const LAS bf16_t*)(l3 + s_cur) + r32 * KS + kcol + 8 * hi; const LAS bf16_t* vt = (const LAS bf16_t*)(l3 + s_cur + KT_B) + r32 * KSTR + 8 * hi;
            f32x16 s0, s1;
#pragma unroll
            for (int r = 0; r < 16; ++r) { s0[r] = 0.f; s1[r] = 0.f; }
            {
                bf16x8 a0 = *(const LAS bf16x8*)(kt), a1 = *(const LAS bf16x8*)(kt + 32 * KS);
                __builtin_amdgcn_sched_group_barrier(0x100, 2, 0);
#pragma unroll
                for (int ks = 0; ks < NKS; ++ks) {
                    bf16x8 b0 = a0, b1 = a1;
                    if (ks + 1 < NKS) { b0 = *(const LAS bf16x8*)(kt + 16 * (ks + 1)); b1 = *(const LAS bf16x8*)(kt + 32 * KS + 16 * (ks + 1)); }
                    s0 = __builtin_amdgcn_mfma_f32_32x32x16_bf16(a0, qf[ks], s0, 0, 0, 0);
                    s1 = __builtin_amdgcn_mfma_f32_32x32x16_bf16(a1, qf[ks], s1, 0, 0, 0);
                    if (ks + 1 < NKS) __builtin_amdgcn_sched_group_barrier(0x100, 2, 0);
                    __builtin_amdgcn_sched_group_barrier(0x008, 2, 0);
                    a0 = b0; a1 = b1;
                }
            }
            bf16x8 vf[4];
#pragma unroll
            for (int d = 0; d < 4; ++d) vf[d] = *(const LAS bf16x8*)(vt + 32 * d * KSTR);
            float mx = fmaxf(s0[0], s1[0]);
#pragma unroll
            for (int r = 1; r < 16; ++r) mx = fmaxf(fmaxf(mx, s0[r]), s1[r]);
            mx = fmaxf(mx, __shfl_xor(mx, 32));
            if (__any(mx - mrun > RESC_THR)) {
                const float mnew = fmaxf(mrun, mx); const float alpha = __builtin_amdgcn_exp2f(mrun - mnew); mrun = mnew; lrun *= alpha;
#pragma unroll
                for (int d = 0; d < 4; ++d) o[d] = o[d] * alpha;
            }
            s0 = s0 - mrun; s1 = s1 - mrun;
#pragma unroll
            for (int r = 0; r < 16; ++r) { s0[r] = __builtin_amdgcn_exp2f(s0[r]); s1[r] = __builtin_amdgcn_exp2f(s1[r]); }
            { const f32x16 sm = s0 + s1;
              lrun += ((sm[0] + sm[1]) + (sm[2] + sm[3])) + ((sm[4] + sm[5]) + (sm[6] + sm[7])) + (((sm[8] + sm[9]) + (sm[10] + sm[11])) + ((sm[12] + sm[13]) + (sm[14] + sm[15]))); }
            bf16x8 pf[4];
            { float p[16];
#pragma unroll
              for (int r = 0; r < 16; ++r) p[r] = s0[r];
              pf[0] = __builtin_bit_cast(bf16x8, pack8(p)); pf[1] = __builtin_bit_cast(bf16x8, pack8(p + 8));
#pragma unroll
              for (int r = 0; r < 16; ++r) p[r] = s1[r];
              pf[2] = __builtin_bit_cast(bf16x8, pack8(p)); pf[3] = __builtin_bit_cast(bf16x8, pack8(p + 8)); }
#pragma unroll
            for (int g = 0; g < 4; ++g) {
                bf16x8 vn[4];
                if (g + 1 < 4) {
#pragma unroll
                    for (int d = 0; d < 4; ++d) vn[d] = *(const LAS bf16x8*)(vt + 32 * d * KSTR + 16 * (g + 1));
                }
#pragma unroll
                for (int d = 0; d < 4; ++d) o[d] = __builtin_amdgcn_mfma_f32_32x32x16_bf16(vf[d], pf[g], o[d], 0, 0, 0);
                if (g + 1 < 4) {
                    __builtin_amdgcn_sched_group_barrier(0x100, 4, 0);
#pragma unroll
                    for (int d = 0; d < 4; ++d) vf[d] = vn[d];
                }
                __builtin_amdgcn_sched_group_barrier(0x008, 4, 0);
            }
            if (t + 2 < nt) asm volatile("s_waitcnt vmcnt(%0)" :: "i"(NI) : "memory");
            else asm volatile("s_waitcnt vmcnt(0)" ::: "memory");
            asm volatile("s_waitcnt lgkmcnt(0)" ::: "memory");
            __builtin_amdgcn_s_barrier(); asm volatile("" ::: "memory");
            s_cur = (s_cur == 2 * SLOT_B) ? 0 : s_cur + SLOT_B; s_nn = (s_nn == 2 * SLOT_B) ? 0 : s_nn + SLOT_B;
        }
        lrun += __shfl_xor(lrun, 32);
        const float rl = 1.f / lrun;
#pragma unroll
        for (int d = 0; d < 4; ++d) o[d] = o[d] * rl;
    }
};

template <int DQK, int KROW>
struct AttnCoreP {
    static constexpr int NKS = DQK / 16, NKC1 = KROW / 8 + 1, KS = NKC1 * 8, KT_B = 64 * NKC1 * 16, VT_B = 128 * 9 * 16, SLOT_B = KT_B + VT_B;
    static constexpr int NBK = KT_B / 1024, NBV = VT_B / 1024, NB = NBK + NBV, NI = (NB + 7) / 8;
    static_assert(KT_B % 1024 == 0 && VT_B % 1024 == 0 && 8 * NI - NB <= 8 && 3 * SLOT_B <= 135168, "attention LDS geometry");
    static __device__ __forceinline__ void run(const Ctx& X, const bf16_t* Qrow, int kcol, const bf16_t* K, const bf16_t* Vt, int nt, f32x16 (&o)[4]) {
        const int lane = X.lane, r32 = lane & 31, hi = lane >> 5, role = X.wave >> 2;
        LAS unsigned char* l3 = (LAS unsigned char*)0 + X.l3off;
        bf16x8 qf[NKS];
#pragma unroll
        for (int ks = 0; ks < NKS; ++ks) qf[ks] = *(const bf16x8*)(Qrow + 16 * ks + 8 * hi);
        unsigned goff[NI]; int bsel[NI];
#pragma unroll
        for (int i = 0; i < NI; ++i) {
            int bidx = X.wave + 8 * i; if (bidx >= NB) bidx -= NB;
            bsel[i] = bidx;
            if (bidx < NBK) { const int c = bidx * 64 + lane; const int row = c / NKC1; int col = c % NKC1; if (col > NKC1 - 2) col = NKC1 - 2; goff[i] = (unsigned)(row * KROW + 8 * col) * 2u; }
            else { const int c = (bidx - NBK) * 64 + lane; const int row = c / 9; int col = c % 9; if (col > 7) col = 7; goff[i] = (unsigned)(row * TK + 8 * col) * 2u; }
        }
        asm volatile("s_waitcnt vmcnt(0)" ::: "memory");
#pragma unroll
        for (int ks = 0; ks < NKS; ++ks) asm volatile("" : "+v"(qf[ks]));
        auto issue = [&](int tk, int ks_off, bool doK, int tv, int vs_off, bool doV) {
#pragma unroll
            for (int i = 0; i < NI; ++i) {
                const bool isK = bsel[i] < NBK;
                if (isK ? doK : doV) {
                    const char* base = isK ? (const char*)K + (size_t)tk * (64 * KROW * 2) : (const char*)Vt + (size_t)tv * 128;
                    __builtin_amdgcn_global_load_lds((const unsigned*)(base + goff[i]), (LAS unsigned*)(l3 + (isK ? ks_off : vs_off) + bsel[i] * 1024), 16, 0, 0);
                }
            }
        };
#pragma unroll
        for (int d = 0; d < 4; ++d)
#pragma unroll
            for (int r = 0; r < 16; ++r) o[d][r] = 0.f;
        float mrun = -1e30f, lrun = 0.f;
        issue(0, 0, true, 0, 0, true); issue(1, SLOT_B, true, 1, SLOT_B, true); issue(2, 2 * SLOT_B, nt > 2, 0, 0, false);
        asm volatile("s_waitcnt vmcnt(0)" ::: "memory");
        __builtin_amdgcn_s_barrier(); asm volatile("" ::: "memory");
        f32x16 sc0, sc1;
        {
            const LAS bf16_t* kt = (const LAS bf16_t*)(l3) + r32 * KS + kcol + 8 * hi;
#pragma unroll
            for (int r = 0; r < 16; ++r) { sc0[r] = 0.f; sc1[r] = 0.f; }
#pragma unroll
            for (int ks = 0; ks < NKS; ++ks) {
                const bf16x8 a0 = *(const LAS bf16x8*)(kt + 16 * ks), a1 = *(const LAS bf16x8*)(kt + 32 * KS + 16 * ks);
                sc0 = __builtin_amdgcn_mfma_f32_32x32x16_bf16(a0, qf[ks], sc0, 0, 0, 0);
                sc1 = __builtin_amdgcn_mfma_f32_32x32x16_bf16(a1, qf[ks], sc1, 0, 0, 0);
            }
        }
        int s0off = 0, s1off = SLOT_B, s2off = 2 * SLOT_B;
        for (int t = 0; t < nt; ++t) {
            issue(t + 3, s0off, t + 3 < nt, t + 2, s2off, t + 2 < nt);
            const bool hasN = t + 1 < nt;
            const LAS bf16_t* kt = (const LAS bf16_t*)(l3 + s1off) + r32 * KS + kcol + 8 * hi;
            const LAS bf16_t* vt = (const LAS bf16_t*)(l3 + s0off + KT_B) + r32 * KSTR + 8 * hi;
            f32x16 sn0, sn1;
            auto qk_next = [&]() {
#pragma unroll
                for (int r = 0; r < 16; ++r) { sn0[r] = 0.f; sn1[r] = 0.f; }
                bf16x8 a0 = *(const LAS bf16x8*)(kt), a1 = *(const LAS bf16x8*)(kt + 32 * KS);
                __builtin_amdgcn_sched_group_barrier(0x100, 2, 0);
#pragma unroll
                for (int ks = 0; ks < NKS; ++ks) {
                    bf16x8 b0 = a0, b1 = a1;
                    if (ks + 1 < NKS) { b0 = *(const LAS bf16x8*)(kt + 16 * (ks + 1)); b1 = *(const LAS bf16x8*)(kt + 32 * KS + 16 * (ks + 1)); }
                    sn0 = __builtin_amdgcn_mfma_f32_32x32x16_bf16(a0, qf[ks], sn0, 0, 0, 0);
                    sn1 = __builtin_amdgcn_mfma_f32_32x32x16_bf16(a1, qf[ks], sn1, 0, 0, 0);
                    if (ks + 1 < NKS) __builtin_amdgcn_sched_group_barrier(0x100, 2, 0);
                    __builtin_amdgcn_sched_group_barrier(0x008, 2, 0);
                    a0 = b0; a1 = b1;
                }
            };
            if (role == 0 && hasN) qk_next();
            float mx = fmaxf(sc0[0], sc1[0]);
#pragma unroll
            for (int r = 1; r < 16; ++r) mx = fmaxf(fmaxf(mx, sc0[r]), sc1[r]);
            mx = fmaxf(mx, __shfl_xor(mx, 32));
            if (__any(mx - mrun > RESC_THR)) {
                const float mnew = fmaxf(mrun, mx); const float alpha = __builtin_amdgcn_exp2f(mrun - mnew); mrun = mnew; lrun *= alpha;
#pragma unroll
                for (int d = 0; d < 4; ++d) o[d] = o[d] * alpha;
            }
            sc0 = sc0 - mrun; sc1 = sc1 - mrun;
#pragma unroll
            for (int r = 0; r < 16; ++r) { sc0[r] = __builtin_amdgcn_exp2f(sc0[r]); sc1[r] = __builtin_amdgcn_exp2f(sc1[r]); }
            { const f32x16 sm = sc0 + sc1;
              lrun += ((sm[0] + sm[1]) + (sm[2] + sm[3])) + ((sm[4] + sm[5]) + (sm[6] + sm[7])) + (((sm[8] + sm[9]) + (sm[10] + sm[11])) + ((sm[12] + sm[13]) + (sm[14] + sm[15]))); }
            bf16x8 pf[4];
            { float p[16];
#pragma unroll
              for (int r = 0; r < 16; ++r) p[r] = sc0[r];
              pf[0] = __builtin_bit_cast(bf16x8, pack8(p)); pf[1] = __builtin_bit_cast(bf16x8, pack8(p + 8));
#pragma unroll
              for (int r = 0; r < 16; ++r) p[r] = sc1[r];
              pf[2] = __builtin_bit_cast(bf16x8, pack8(p)); pf[3] = __builtin_bit_cast(bf16x8, pack8(p + 8)); }
            bf16x8 vf[4];
#pragma unroll
            for (int d = 0; d < 4; ++d) vf[d] = *(const LAS bf16x8*)(vt + 32 * d * KSTR);
#pragma unroll
            for (int g = 0; g < 4; ++g) {
                bf16x8 vn[4];
                if (g + 1 < 4) {
#pragma unroll
                    for (int d = 0; d < 4; ++d) vn[d] = *(const LAS bf16x8*)(vt + 32 * d * KSTR + 16 * (g + 1));
                }
#pragma unroll
                for (int d = 0; d < 4; ++d) o[d] = __builtin_amdgcn_mfma_f32_32x32x16_bf16(vf[d], pf[g], o[d], 0, 0, 0);
                if (g + 1 < 4) {
#pragma unroll
                    for (int d = 0; d < 4; ++d) vf[d] = vn[d];
                }
            }
            if (role != 0 && hasN) qk_next();
            if (t + 3 < nt) asm volatile("s_waitcnt vmcnt(%0)" :: "i"(NI) : "memory");
            else asm volatile("s_waitcnt vmcnt(0)" ::: "memory");
            asm volatile("s_waitcnt lgkmcnt(0)" ::: "memory");
            __builtin_amdgcn_s_barrier(); asm volatile("" ::: "memory");
            sc0 = sn0; sc1 = sn1;
            const int tmp = s0off; s0off = s1off; s1off = s2off; s2off = tmp;
        }
        lrun += __shfl_xor(lrun, 32);
        const float rl = 1.f / lrun;
#pragma unroll
        for (int d = 0; d < 4; ++d) o[d] = o[d] * rl;
    }
};

__device__ __forceinline__ void mla_attn_unit(const Ctx& X0, const PRef& P, int b, int h, int q0, int is_ctx) {
    const Ctx X = fresh(X0);
    unsigned char* ws = P.ws();
    const int lane = X.lane, r32 = lane & 31, hi = lane >> 5;
    const int row = (is_ctx ? M_LAT + b * CTXL : b * SEQ) + q0 + 32 * X.wave + r32;
    const bf16_t* Q = (const bf16_t*)(ws + WS_QM) + ((size_t)h * M_ALL + row) * 192;
    const bf16_t* K = (const bf16_t*)(ws + WS_KM) + (size_t)(b * 8 + h) * TK * 192;
    const bf16_t* Vt = (const bf16_t*)(ws + WS_VTM) + (size_t)(b * 8 + h) * 128 * TK;
    f32x16 o[4];
    AttnCore<192, 192>::run(X, Q, 0, K, Vt, is_ctx ? 4 : NCH, o);
    bf16_t* mix = (bf16_t*)(ws + WS_AB) + (size_t)row * DM + 1024 + h * 128;
#pragma unroll
    for (int d = 0; d < 4; ++d)
#pragma unroll
        for (int q = 0; q < 4; ++q) { u32x2 w; w.x = pk2(o[d][4 * q], o[d][4 * q + 1]); w.y = pk2(o[d][4 * q + 2], o[d][4 * q + 3]); *(u32x2*)(mix + 32 * d + 8 * q + 4 * hi) = w; }
}
__device__ __forceinline__ void da_attn_unit(const Ctx& X0, const PRef& P, int l, int b, int h, int q0, int is_ctx, float lam, float lam_init) {
    const Ctx X = fresh(X0);
    unsigned char* ws = P.ws();
    const int lane = X.lane, r32 = lane & 31, hi = lane >> 5;
    const int comp = X.wave >> 2, qs = X.wave & 3;
    const int row = (is_ctx ? M_LAT + b * CTXL : b * SEQ) + q0 + 32 * qs + r32;
    const bf16_t* Q = (const bf16_t*)(ws + WS_QDA) + ((size_t)h * M_ALL + row) * 128 + comp * 64;
    const bf16_t* K = (const bf16_t*)(ws + WS_KDA) + (size_t)(b * 4 + h) * TK * 128;
    const bf16_t* Vt = (const bf16_t*)(ws + WS_VTDA) + (size_t)(b * 4 + h) * 128 * TK;
    f32x16 o[4];
    AttnCoreP<64, 128>::run(X, Q, comp * 64, K, Vt, is_ctx ? 4 : NCH, o);
    float* xch = (float*)X.lds;
    if (comp == 1) {
#pragma unroll
        for (int d = 0; d < 4; ++d)
#pragma unroll
            for (int r = 0; r < 16; ++r) xch[(qs * 64 + d * 16 + r) * 64 + lane] = o[d][r];
    }
    __syncthreads();
    if (comp == 0) {
        float ss = 0.f;
#pragma unroll
        for (int d = 0; d < 4; ++d)
#pragma unroll
            for (int r = 0; r < 16; ++r) { o[d][r] -= lam * xch[(qs * 64 + d * 16 + r) * 64 + lane]; ss += o[d][r] * o[d][r]; }
        ss += __shfl_xor(ss, 32);
        float li_ = lam_init; asm volatile("" : "+s"(li_));
        const float rstd = rsqrtf(ss * (1.f / 128.f) + EPS) * (1.f - li_);
        const float* og = P.in(I_DAOUTG) + l * 128;
        bf16_t* mix = (bf16_t*)(ws + WS_AB) + (size_t)row * DM + h * 128;
#pragma unroll
        for (int d = 0; d < 4; ++d)
#pragma unroll
            for (int q = 0; q < 4; ++q) { const int dv = 32 * d + 8 * q + 4 * hi; const f32x4 gg = *(const f32x4*)(og + dv);
                u32x2 w; w.x = pk2(o[d][4 * q] * rstd * gg[0], o[d][4 * q + 1] * rstd * gg[1]); w.y = pk2(o[d][4 * q + 2] * rstd * gg[2], o[d][4 * q + 3] * rstd * gg[3]);
                *(u32x2*)(mix + dv) = w; }
    }
    __syncthreads();
}

__device__ __forceinline__ void mixer_phase(const Ctx& X, const PRef& P, int l) {
    const bool need_ctx = l < DEPTH - 1;
    STAMPN(20);
    const int vcu = (X.nwg % 8 == 0) ? (X.wg % 8) * (X.nwg / 8) + X.wg / 8 : X.wg;
    if (EN(13)) for (int u = vcu; u < 512; u += X.nwg) mla_attn_unit(X, P, u >> 7, (u >> 4) & 7, (u & 15) * 256, 0);
    STAMPN(11);
    float lam, lam_init;
    { const float* lp = P.in(I_DALAM) + l * 256;
      float s1 = 0.f, s2 = 0.f;
      for (int i = 0; i < 64; ++i) { s1 += lp[i] * lp[64 + i]; s2 += lp[128 + i] * lp[192 + i]; }
      const float li = 0.8f - 0.6f * expf(-0.3f * (float)l);
      const float la = expf(s1) - expf(s2) + li;
      lam = __builtin_bit_cast(float, __builtin_amdgcn_readfirstlane(__builtin_bit_cast(int, la)));
      lam_init = __builtin_bit_cast(float, __builtin_amdgcn_readfirstlane(__builtin_bit_cast(int, li))); }
    if (EN(14)) for (int v = vcu; v < 512; v += X.nwg) da_attn_unit(X, P, l, v >> 7, (v >> 5) & 3, (v & 31) * 128, 0, lam, lam_init);
    STAMPN(12);
    if (EN(15)) for (int u = (X.wg + X.nwg / 2) % X.nwg; u < 16 * NCH; u += X.nwg) mlstm_c_unit(X, P, l, u);
    STAMPN(13);
    if (need_ctx) {
        if (EN(13)) for (int v = X.wg; v < 32; v += X.nwg) mla_attn_unit(X, P, v >> 3, v & 7, 0, 1);
        if (EN(14)) for (int v = X.nwg - 1 - X.wg; v < 32; v += X.nwg) da_attn_unit(X, P, l, v >> 3, (v >> 1) & 3, (v & 1) * 128, 1, lam, lam_init);
    }
}

__global__ void __launch_bounds__(512, 2) fwd_megakernel(Params Pk) {
    const PRef P;
    extern __shared__ __attribute__((aligned(16))) unsigned char lds[];
    cg::grid_group grid = cg::this_grid();
    Ctx X; X.lds = lds; X.tid = threadIdx.x; X.lane = X.tid & 63; X.wave = __builtin_amdgcn_readfirstlane(X.tid >> 6);
    X.nwg = gridDim.x; X.wg = blockIdx.x; X.gw = X.wg * 8 + X.wave; X.ngw = X.nwg * 8;
    LAS unsigned char* lds3 = (LAS unsigned char*)lds; X.l3off = (unsigned)(uintptr_t)lds3;
    unsigned char* ws = P.ws();
    if (threadIdx.x < 16) ((LAS unsigned*)(lds3 + 135168 + 64))[threadIdx.x] = 0u;
    __syncthreads();
    (void)xcd_barrier_post((unsigned*)(ws + WS_BAR), (volatile LAS unsigned*)(lds3 + 135168 + 64));
    float* R_lat = P.out(); float* R_ctx = (float*)(ws + WS_RCTX);
    bf16_t* AB = (bf16_t*)(ws + WS_AB);

#ifdef PROBE_CAT
    if (blockIdx.x == 0 && threadIdx.x == 0) { volatile unsigned long long* tp_ = (volatile unsigned long long*)(P.ws() + WS_END); tp_[0] = __builtin_amdgcn_s_memrealtime(); tp_[1] = 0; tp_[2] = 0; }
#endif
    const int tail_lo = X.nwg > 64 ? 32 : 0;
    if (EN(0)) mod_gemv(X, P, 0, 1, 0);
    if (EN(1)) convert_weights(X, P, 0, 0, 0);
    grid.sync();
#ifdef PROBE_CAT
    STAMP(0);
#endif
    for (int l = 0; l < DEPTH; ++l) {
        const float* modl = (const float*)(ws + WS_MOD) + (size_t)l * 5 * 6 * DM;
        const float* xin_lat = l == 0 ? P.in(I_X) : R_lat; const float* xin_ctx = l == 0 ? P.in(I_CTX) : R_ctx;
        const int Mfin = l < DEPTH - 1 ? M_ALL : M_LAT;
        if (EN(2)) modulate_phase(X, xin_lat, xin_ctx, P.in(I_N1G) + l * DM, modl, 0 * DM, 1 * DM, AB, M_ALL);
        if (EN(1)) if (l > 0) convert_weights(X, P, l, 2, 0);
        STAMP(1);
        if (EN(3)) { pg8::Gemm g{AB, (const bf16_t*)(ws + WS_WIN), M_ALL, NPROJ, DM}; pg8::StaticOrder S; S.init(M_ALL, NPROJ, X.nwg, X.wg);
          pg8::EpiBf16 E{(bf16_t*)(ws + WS_PROJ), NPROJ, (float*)(ws + WS_GATES), C_GATE / 256};
          pg8::gemm_phase<pg8::EpiBf16>(lds3, g, S, E); }
        STAMP(2);
        if (EN(4)) prep_phase(X, P, l);
        STAMP(3);
        if (EN(5)) { pg8::Gemm g{(const bf16_t*)(ws + WS_CQN), (const bf16_t*)(ws + WS_WUQ), M_ALL, 1536, 512}; pg8::StaticOrder S; S.init(M_ALL, 1536, X.nwg, X.wg);
          pg8::EpiBf16 E{(bf16_t*)(ws + WS_QUP), 1536, nullptr, 0};
          pg8::gemm_phase<pg8::EpiBf16>(lds3, g, S, E); }
        if (EN(5)) { pg8::Gemm g{(const bf16_t*)(ws + WS_CKVN), (const bf16_t*)(ws + WS_WUKV), M_ALL, 2048, 256}; pg8::StaticOrder S; S.init(M_ALL, 2048, X.nwg, X.nwg - 1 - X.wg);
          pg8::EpiBf16 E{(bf16_t*)(ws + WS_KVUP), 2048, nullptr, 0};
          pg8::gemm_phase<pg8::EpiBf16>(lds3, g, S, E); }
        __syncthreads();
        if (EN(6)) mlstm_a_phase(X, P, l);
        STAMP(4);
        if (EN(7)) mla_prep_phase(X, P, l);
        if (EN(8)) mlstm_scan_phase(X, P);
        STAMP(5);
        if (EN(9)) mixer_phase(X, P, l);
        STAMP(6);
        if (EN(10)) { pg8::Gemm g{AB, (const bf16_t*)(ws + WS_WOUT), Mfin, DM, DM}; pg8::StaticOrder S; S.init(Mfin, DM, X.nwg, X.wg);
          pg8::EpiRes E{xin_lat, xin_ctx, R_lat, R_ctx, modl + 2 * DM};
          pg8::gemm_phase<pg8::EpiRes>(lds3, g, S, E); }
        if (EN(0)) if (l + 1 < DEPTH) { __syncthreads(); mod_gemv(X, P, l + 1, l + 2, tail_lo); }
        STAMP(7);
        if (EN(2)) modulate_phase(X, R_lat, R_ctx, P.in(I_N2G) + l * DM, modl, 3 * DM, 4 * DM, AB, Mfin);
        STAMP(1);
        if (EN(11)) { pg8::Gemm g{AB, (const bf16_t*)(ws + WS_WGU), Mfin, 2 * FF, DM}; pg8::StaticOrder S; S.init(Mfin, 2 * FF, X.nwg, X.wg);
          pg8::EpiSwiGLU E{(bf16_t*)(ws + WS_HID), FF};
          pg8::gemm_phase<pg8::EpiSwiGLU>(lds3, g, S, E); }
        STAMP(9);
        if (EN(12)) { pg8::Gemm g{(const bf16_t*)(ws + WS_HID), (const bf16_t*)(ws + WS_WDN), Mfin, DM, FF}; pg8::StaticOrder S; S.init(Mfin, DM, X.nwg, X.wg);
          pg8::EpiRes E{R_lat, R_ctx, R_lat, R_ctx, modl + 5 * DM};
          pg8::gemm_phase<pg8::EpiRes>(lds3, g, S, E); }
        if (EN(1)) if (l + 1 < DEPTH) { __syncthreads(); convert_weights(X, P, l + 1, 1, tail_lo); }
#ifdef PROBE_CAT
        STAMP(10);
#else
        if (l + 1 < DEPTH) xcd_barrier(P.ws());
#endif
    }
#ifdef PROBE_CAT
    if (blockIdx.x == 0 && threadIdx.x == 0) P.out()[0] += (float)(((volatile unsigned long long*)(P.ws() + WS_END))[1]) * (0.01f / PROBE_SCALE);
#endif
}

extern "C" void kernel_launch(void* const* d_in, const int* in_sizes, int n_in, void* d_out, int out_size, void* d_ws, size_t ws_size, hipStream_t stream) {
    static int grid = 0;
    if (grid == 0) {
        if (n_in != 24 || ws_size < WS_END) { fprintf(stderr, "kernel_launch: unexpected inputs (n_in %d, ws %zu)\n", n_in, ws_size); grid = -1; return; }
        int dev = 0, cus = 0, per_cu = 0;
        (void)hipGetDevice(&dev); (void)hipDeviceGetAttribute(&cus, hipDeviceAttributeMultiprocessorCount, dev);
        if (hipFuncSetAttribute((const void*)fwd_megakernel, hipFuncAttributeMaxDynamicSharedMemorySize, LDS_BYTES) != hipSuccess) { fprintf(stderr, "kernel_launch: hipFuncSetAttribute failed\n"); grid = -1; return; }
        (void)hipOccupancyMaxActiveBlocksPerMultiprocessor(&per_cu, (const void*)fwd_megakernel, 512, LDS_BYTES);
        (void)hipGetLastError();
        if (per_cu < 1) { fprintf(stderr, "kernel_launch: occupancy query says %d\n", per_cu); per_cu = 1; }
        grid = cus;
    }
    if (grid < 0) return;
    if (hipMemsetAsync((char*)d_ws + WS_BAR, 0, XCD_BAR_WORDS * 4, stream) != hipSuccess) { fprintf(stderr, "kernel_launch: memset failed\n"); return; }
    Params p{};
    for (int i = 0; i < 24; ++i) p.in[i] = (const float*)d_in[i];
    p.out = (float*)d_out; p.ws = (unsigned char*)d_ws;
    void* args[] = {&p};
    hipError_t e = hipLaunchCooperativeKernel((const void*)fwd_megakernel, dim3(grid), dim3(512), args, LDS_BYTES, stream);
    if (e != hipSuccess) fprintf(stderr, "cooperative launch failed: %s (grid %d)\n", hipGetErrorString(e), grid);
}
```

```cpp
#include <hip/hip_runtime.h>
#include <hip/hip_cooperative_groups.h>
#include <cstdio>
#include <cstdint>
namespace cg = cooperative_groups;

#define LAS __attribute__((address_space(3)))
typedef unsigned short bf16_t;
typedef short bf16x8 __attribute__((ext_vector_type(8)));
typedef float f32x4 __attribute__((ext_vector_type(4)));
typedef float f32x16 __attribute__((ext_vector_type(16)));
typedef unsigned u32x4 __attribute__((ext_vector_type(4)));
typedef unsigned u32x2 __attribute__((ext_vector_type(2)));

constexpr int DM = 2048, BATCH = 4, SEQ = 4096, CTXL = 256, DEPTH = 2;
constexpr int M_LAT = BATCH * SEQ, M_CTX = BATCH * CTXL, M_ALL = M_LAT + M_CTX;
constexpr int TK = CTXL + SEQ;
constexpr int NCH = TK / 64;
constexpr int IN_W = 4432, NPROJ = 4608, FF = 5632;
constexpr int C_DAQ = 0, C_DAK = 512, C_DAV = 1024, C_MLQ = 1536, C_MLK = 2048, C_MLV = 2560, C_MLO = 3072, C_GATE = 3584, C_CQ = 3600, C_CKV = 4112, C_KPE = 4368;
constexpr float EPS = 1e-6f;
constexpr float LOG2E = 1.4426950408889634f;
constexpr float RESC_THR = 8.0f;

constexpr size_t MiB = 1u << 20;
constexpr size_t WS_WIN = 0, WS_WOUT = 18 * MiB, WS_WGU = 26 * MiB, WS_WDN = 70 * MiB, WS_WUQ = 92 * MiB, WS_WUKV = 94 * MiB, WS_MOD = 95 * MiB, WS_RCTX = 96 * MiB;
constexpr size_t WS_AB = 104 * MiB;
constexpr size_t WS_PROJ = 172 * MiB;
constexpr size_t WS_QUP = 172 * MiB, WS_KVUP = 223 * MiB, WS_HID = 172 * MiB;
constexpr size_t WS_GATES = 325 * MiB, WS_CQN = 327 * MiB, WS_CKVN = 344 * MiB, WS_KPE = 353 * MiB, WS_OCOPY = 356 * MiB;
constexpr size_t WS_QDA = 373 * MiB, WS_KDA = 390 * MiB, WS_VTDA = 407 * MiB, WS_QML = 424 * MiB, WS_KML = 441 * MiB, WS_KTML = 458 * MiB, WS_VTML = 475 * MiB;
constexpr size_t WS_QM = 492 * MiB, WS_KM = 543 * MiB, WS_VTM = 594 * MiB, WS_CSNAP = 628 * MiB, WS_NSNAP = 696 * MiB, WS_NU = 698 * MiB, WS_CSTAT = 700 * MiB, WS_BAR = 701 * MiB, WS_WDN2 = 702 * MiB, WS_END = 724 * MiB;
static_assert((size_t)NPROJ * DM * 2 <= 18 * MiB && (size_t)2 * FF * DM * 2 <= 44 * MiB && (size_t)M_ALL * NPROJ * 2 <= 153 * MiB, "ws map");
static_assert(WS_HID + (size_t)M_ALL * FF * 2 <= WS_QDA, "hid overlay");
static_assert(WS_END <= 768 * MiB, "ws fits the guaranteed minimum");

constexpr int LDS_BYTES = 140 * 1024;
#ifndef PH_EN
#define PH_EN 0xFFFF
#endif
#define EN(k) ((PH_EN >> (k)) & 1)
#ifdef PROBE_CAT
#define STAMP(cat) do { xcd_barrier(P.ws()); if (blockIdx.x == 0 && threadIdx.x == 0) { volatile unsigned long long* tp_ = (volatile unsigned long long*)(P.ws() + WS_END); const unsigned long long t1_ = __builtin_amdgcn_s_memrealtime(); if ((1 << (cat)) & PROBE_CAT) tp_[1] += t1_ - tp_[0]; if ((1 << (cat)) & PROBE_CAT2) tp_[2] += t1_ - tp_[0]; tp_[0] = t1_; } } while (0)
#define STAMPN(cat) do { __syncthreads(); if (blockIdx.x == 0 && threadIdx.x == 0) { volatile unsigned long long* tp_ = (volatile unsigned long long*)(P.ws() + WS_END); const unsigned long long t1_ = __builtin_amdgcn_s_memrealtime(); if ((1 << (cat)) & PROBE_CAT) tp_[1] += t1_ - tp_[0]; tp_[0] = t1_; } } while (0)
#else
#define STAMPN(cat) do {} while (0)
#define STAMP(cat) xcd_barrier(P.ws())
#endif

#define LOG2E_ 1.4426950408889634f
__device__ __forceinline__ unsigned f2bf(float f) { unsigned u = __builtin_bit_cast(unsigned, f); return (u + 0x7fffu + ((u >> 16) & 1u)) >> 16; }
typedef float f32x2_t __attribute__((ext_vector_type(2))); typedef __bf16 bf16x2_t __attribute__((ext_vector_type(2)));
__device__ __forceinline__ unsigned pk2(float lo, float hi) { f32x2_t v = {lo, hi}; bf16x2_t b = __builtin_convertvector(v, bf16x2_t); return __builtin_bit_cast(unsigned, b); }
__device__ __forceinline__ float bflo(unsigned w) { return __builtin_bit_cast(float, w << 16); }
__device__ __forceinline__ float bfhi(unsigned w) { return __builtin_bit_cast(float, w & 0xffff0000u); }
__device__ __forceinline__ float bf1(bf16_t h) { return __builtin_bit_cast(float, (unsigned)h << 16); }
__device__ __forceinline__ void unpack8(const u32x4 w, float* v) { v[0] = bflo(w.x); v[1] = bfhi(w.x); v[2] = bflo(w.y); v[3] = bfhi(w.y); v[4] = bflo(w.z); v[5] = bfhi(w.z); v[6] = bflo(w.w); v[7] = bfhi(w.w); }
__device__ __forceinline__ u32x4 pack8(const float* v) { u32x4 w; w.x = pk2(v[0], v[1]); w.y = pk2(v[2], v[3]); w.z = pk2(v[4], v[5]); w.w = pk2(v[6], v[7]); return w; }
__device__ __forceinline__ float wave_sum(float v) {
#pragma unroll
    for (int o = 1; o < 64; o <<= 1) v += __shfl_xor(v, o);
    return v;
}
__device__ __forceinline__ float wave_max(float v) {
#pragma unroll
    for (int o = 1; o < 64; o <<= 1) v = fmaxf(v, __shfl_xor(v, o));
    return v;
}
__device__ __forceinline__ float siluf(float x) { return x * __builtin_amdgcn_rcpf(1.f + __builtin_amdgcn_exp2f(-LOG2E_ * x)); }
__device__ __forceinline__ float sigmf(float x) { return __builtin_amdgcn_rcpf(1.f + __builtin_amdgcn_exp2f(-LOG2E_ * x)); }
__device__ __forceinline__ int crow(int r, int hi) { return (r & 3) + 8 * (r >> 2) + 4 * hi; }
__device__ __forceinline__ int perm_off(int p) { const int h = p >> 3, j = p & 7; return 8 * (j >> 2) + 4 * h + (j & 3); }
__device__ __forceinline__ int mod_batch(int row) { return row < M_LAT ? (row >> 12) : 4; }

namespace pg8 {
constexpr int BM = 256, BK = 64, HALF = 128, HTB = HALF * BK * 2, STAGE_BYTES = 8 * HTB, NXCD = 8, WGM = 8;
__host__ __device__ __forceinline__ int lds_byte(int r, int c) { const int st = (r >> 4) * 2 + (c >> 5), rr = r & 15, cc = c & 31, ob = rr * 64 + cc * 2; return st * 1024 + (ob ^ (((ob >> 9) & 1) << 5)); }
__host__ __device__ __forceinline__ void stage_rc(int b, int& R, int& C) { const int st = b / 1024, sb = b % 1024, swz = sb ^ (((sb >> 9) & 1) << 5); R = (st >> 1) * 16 + swz / 64; C = (st & 1) * 32 + (swz % 64) / 2; }
__host__ __device__ __forceinline__ int perm32(int rho) { const int n = rho >> 4, i = rho & 15; return 8 * (i >> 2) + 4 * n + (i & 3); }

struct Unit { int pm, pn; };
struct Gemm { const bf16_t* A; const bf16_t* Bt; int M, N, K; };

struct StaticOrder {
    int nM, nN, nwg, G, c;
    __device__ void init(int M, int N, int G_, int c_) { nM = M / BM; nN = N / BM; nwg = nM * nN; G = G_; c = c_; }
    __device__ bool next(int i, Unit& u) const {
        const long L = (long)i * G + c; if (L >= nwg) return false;
        int wgid = (int)L; { const int q = nwg / NXCD, r = nwg % NXCD, xcd = wgid % NXCD, off = wgid / NXCD; wgid = (xcd < r ? xcd * (q + 1) : r * (q + 1) + (xcd - r) * q) + off; }
        const int nig = WGM * nN, gid = wgid / nig, fm = gid * WGM, gsz = (nM - fm) < WGM ? (nM - fm) : WGM;
        u.pm = fm + ((wgid % nig) % gsz); u.pn = (wgid % nig) / gsz; return true;
    }
};

struct EpiBf16 {
    static constexpr bool PERM = true;
    bf16_t* O; int ldc; float* gates; int gate_pn;
    __device__ __forceinline__ void operator()(const f32x4 (&acc)[2][2][4][2], const Unit& u, int wr, int wc, int fr, int fq) const {
        const int row0 = u.pm * BM + wr * 64 + fr; const int col0 = u.pn * BM + wc * 32 + 8 * fq;
        const bool g = gates != nullptr && u.pn == gate_pn && wc == 0 && fq < 2;
#pragma unroll
        for (int ai = 0; ai < 2; ++ai)
#pragma unroll
            for (int m = 0; m < 4; ++m) { const int row = row0 + ai * HALF + m * 16; bf16_t* rowp = O + (size_t)row * ldc + col0;
#pragma unroll
                for (int bj = 0; bj < 2; ++bj) { const f32x4 v0 = acc[ai][bj][m][0], v1 = acc[ai][bj][m][1];
                    u32x4 w; w.x = pk2(v0[0], v0[1]); w.y = pk2(v0[2], v0[3]); w.z = pk2(v1[0], v1[1]); w.w = pk2(v1[2], v1[3]);
                    *(u32x4*)(rowp + bj * HALF) = w;
                    if (bj == 0 && g) { *(f32x4*)(gates + (size_t)row * 16 + 8 * fq) = v0; *(f32x4*)(gates + (size_t)row * 16 + 8 * fq + 4) = v1; } } }
    }
};
struct EpiSwiGLU {
    static constexpr bool PERM = true;
    bf16_t* O; int ldc;
    __device__ __forceinline__ void operator()(const f32x4 (&acc)[2][2][4][2], const Unit& u, int wr, int wc, int fr, int fq) const {
        const int row0 = u.pm * BM + wr * 64 + fr; const int col0 = u.pn * HALF + wc * 32 + 8 * fq;
#pragma unroll
        for (int ai = 0; ai < 2; ++ai)
#pragma unroll
            for (int m = 0; m < 4; ++m) { const int row = row0 + ai * HALF + m * 16;
                float o[8];
#pragma unroll
                for (int n = 0; n < 2; ++n)
#pragma unroll
                    for (int i = 0; i < 4; ++i) { const float gt = acc[ai][0][m][n][i], up = acc[ai][1][m][n][i]; o[4 * n + i] = siluf(gt) * up; }
                *(u32x4*)(O + (size_t)row * ldc + col0) = pack8(o); }
    }
};
struct EpiRes {
    static constexpr bool PERM = false;
    const float* res_lat; const float* res_ctx; float* out_lat; float* out_ctx; const float* gate;
    __device__ __forceinline__ void operator()(const f32x4 (&acc)[2][2][4][2], const Unit& u, int wr, int wc, int fr, int fq) const {
        const int row0 = u.pm * BM + wr * 64 + fr; const int col0 = u.pn * BM + wc * 32 + 4 * fq;
#pragma unroll
        for (int ai = 0; ai < 2; ++ai)
#pragma unroll
            for (int m = 0; m < 4; ++m) { const int row = row0 + ai * HALF + m * 16;
                const float* rp = row < M_LAT ? res_lat + (size_t)row * DM : res_ctx + (size_t)(row - M_LAT) * DM;
                float* op = row < M_LAT ? out_lat + (size_t)row * DM : out_ctx + (size_t)(row - M_LAT) * DM;
                const float* gp = gate + (size_t)mod_batch(row) * 6 * DM;
#pragma unroll
                for (int bj = 0; bj < 2; ++bj)
#pragma unroll
                    for (int n = 0; n < 2; ++n) { const int c = col0 + bj * HALF + n * 16;
                        const f32x4 r = *(const f32x4*)(rp + c), g = *(const f32x4*)(gp + c);
                        *(f32x4*)(op + c) = r + g * acc[ai][bj][m][n]; } }
    }
};

template <class Epi, bool ALIGN_EPI = true>
__device__ __forceinline__ void gemm_phase(LAS unsigned char* lds, const Gemm g, const StaticOrder& S, const Epi& E) {
    int tid = threadIdx.x; asm volatile("" : "+v"(tid)); const int wid = __builtin_amdgcn_readfirstlane(tid >> 6), lane = tid & 63, wr = wid >> 2, wc = wid & 3, fr = lane & 15, fq = lane >> 4;
    int K = g.K; asm volatile("" : "+s"(K)); const int nt = K / BK;
    unsigned voffA[2], voffB[2];
#pragma unroll
    for (int i = 0; i < 2; ++i) { int R, C; stage_rc(tid * 16 + i * 8192, R, C); const int Rb = Epi::PERM ? ((R & ~31) + perm32(R & 31)) : R;
        voffA[i] = (unsigned)(R * K + C) * 2u; voffB[i] = (unsigned)(Rb * K + C) * 2u; }
    const size_t kstep = (size_t)(BK * 2);
    const size_t hstep = (size_t)HALF * K * 2;
    const size_t tstep = 2 * hstep;
    const unsigned ldsw = (unsigned)wid * 1024u;
    const int aoff = lds_byte(wr * 64 + fr, fq * 8), boff = lds_byte(wc * 32 + fr, fq * 8);
#define PG8_SA(b, h) (((b) * 2 + (h)) * HTB)
#define PG8_SB(b, h) ((4 + (b) * 2 + (h)) * HTB)
#define PG8_STAGE(bufoff, gbase, voff) do { _Pragma("unroll") for (int _i = 0; _i < 2; ++_i) \
        __builtin_amdgcn_global_load_lds((const unsigned*)((const char*)(gbase) + (voff)[_i]), (LAS unsigned*)(lds + (bufoff) + ldsw + _i * 8192), 16, 0, 0); } while (0)
#define PG8_LDA(dst, b, h) do { _Pragma("unroll") for (int m = 0; m < 4; ++m) _Pragma("unroll") for (int k = 0; k < 2; ++k) dst[m][k] = *(const LAS bf16x8*)(lds + PG8_SA(b, h) + aoff + m * 2048 + k * 1024); } while (0)
#define PG8_LDB(dst, b, h) do { _Pragma("unroll") for (int n = 0; n < 2; ++n) _Pragma("unroll") for (int k = 0; k < 2; ++k) dst[n][k] = *(const LAS bf16x8*)(lds + PG8_SB(b, h) + boff + n * 2048 + k * 1024); } while (0)
#define PG8_MMA(ai, bj, At, Bt) do { __builtin_amdgcn_s_setprio(1); _Pragma("unroll") for (int m = 0; m < 4; ++m) _Pragma("unroll") for (int n = 0; n < 2; ++n) _Pragma("unroll") for (int k = 0; k < 2; ++k) \
        acc[ai][bj][m][n] = __builtin_amdgcn_mfma_f32_16x16x32_bf16(Bt[n][k], At[m][k], acc[ai][bj][m][n], 0, 0, 0); __builtin_amdgcn_s_setprio(0); } while (0)
#define PG8_WAIT_V(n) asm volatile("s_waitcnt vmcnt(" #n ")" ::: "memory")
#define PG8_WAIT_L(n) asm volatile("s_waitcnt lgkmcnt(" #n ")" ::: "memory")
#define PG8_BAR __builtin_amdgcn_s_barrier()
#define PG8_SCHED __builtin_amdgcn_sched_barrier(0)
    Unit cur, nxt; int ui = 0;
    if (!S.next(0, cur)) return;
    f32x4 acc[2][2][4][2];
#pragma unroll
    for (int a = 0; a < 2; ++a)
#pragma unroll
        for (int b = 0; b < 2; ++b)
#pragma unroll
            for (int m = 0; m < 4; ++m)
#pragma unroll
                for (int n = 0; n < 2; ++n) acc[a][b][m][n] = (f32x4){0.f, 0.f, 0.f, 0.f};
    bf16x8 At[4][2], B0[2][2], B1[2][2];
    const char* cA = (const char*)g.A + (size_t)cur.pm * tstep; const char* cB = (const char*)g.Bt + (size_t)cur.pn * tstep;
    PG8_STAGE(PG8_SB(0, 0), cB, voffB); PG8_STAGE(PG8_SB(0, 1), cB + hstep, voffB); PG8_STAGE(PG8_SA(0, 0), cA, voffA); PG8_STAGE(PG8_SA(0, 1), cA + hstep, voffA);
    if (wr == 1) PG8_BAR;
    PG8_WAIT_V(2); PG8_BAR;
    PG8_STAGE(PG8_SB(1, 0), cB + kstep, voffB); PG8_STAGE(PG8_SA(1, 0), cA + kstep, voffA); PG8_STAGE(PG8_SB(1, 1), cB + hstep + kstep, voffB);
    PG8_WAIT_V(6); PG8_BAR;
    for (;;) {
        const bool has_next = S.next(ui + 1, nxt);
        const char* nA = has_next ? (const char*)g.A + (size_t)nxt.pm * tstep : cA; const char* nB = has_next ? (const char*)g.Bt + (size_t)nxt.pn * tstep : cB;
        for (int t = 0; t < nt; t += 2) {
            const bool last = (t == nt - 2);
            const char* a1 = cA + (size_t)(t + 1) * kstep;
            const char* a2 = last ? nA : cA + (size_t)(t + 2) * kstep; const char* b2 = last ? nB : cB + (size_t)(t + 2) * kstep;
            const char* a3 = a2 + kstep; const char* b3 = b2 + kstep;
            PG8_LDB(B0, 0, 0); PG8_LDB(B1, 0, 1); PG8_SCHED; PG8_LDA(At, 0, 0); PG8_STAGE(PG8_SA(1, 1), a1 + hstep, voffA);
            PG8_WAIT_V(8); PG8_WAIT_L(0); PG8_BAR; PG8_MMA(0, 0, At, B0); PG8_MMA(0, 1, At, B1); PG8_BAR; PG8_SCHED;
            PG8_LDA(At, 0, 1); PG8_STAGE(PG8_SB(0, 0), b2, voffB); PG8_STAGE(PG8_SB(0, 1), b2 + hstep, voffB); PG8_STAGE(PG8_SA(0, 0), a2, voffA);
            PG8_WAIT_V(8); PG8_WAIT_L(0); PG8_BAR; PG8_MMA(1, 0, At, B0); PG8_MMA(1, 1, At, B1); PG8_BAR; PG8_SCHED;
            PG8_LDB(B0, 1, 0); PG8_LDB(B1, 1, 1); PG8_SCHED; PG8_LDA(At, 1, 0); PG8_STAGE(PG8_SA(0, 1), a2 + hstep, voffA);
            PG8_WAIT_V(8); PG8_WAIT_L(0); PG8_BAR; PG8_MMA(0, 0, At, B0); PG8_MMA(0, 1, At, B1); PG8_BAR; PG8_SCHED;
            PG8_LDA(At, 1, 1); PG8_STAGE(PG8_SB(1, 0), b3, voffB); PG8_STAGE(PG8_SB(1, 1), b3 + hstep, voffB); PG8_STAGE(PG8_SA(1, 0), a3, voffA);
            PG8_WAIT_V(8); PG8_WAIT_L(0); PG8_BAR; PG8_MMA(1, 0, At, B0); PG8_MMA(1, 1, At, B1); PG8_BAR; PG8_SCHED;
        }
        if constexpr (ALIGN_EPI) { if (wr == 0) PG8_BAR; }
        E(acc, cur, wr, wc, fr, fq);
        if (!has_next) break;
#pragma unroll
        for (int a = 0; a < 2; ++a)
#pragma unroll
            for (int b = 0; b < 2; ++b)
#pragma unroll
                for (int m = 0; m < 4; ++m)
#pragma unroll
                    for (int n = 0; n < 2; ++n) acc[a][b][m][n] = (f32x4){0.f, 0.f, 0.f, 0.f};
        cur = nxt; cA = nA; cB = nB; ++ui;
        if constexpr (ALIGN_EPI) { if (wr == 1) PG8_BAR; }
    }
    PG8_WAIT_V(0);
    if constexpr (!ALIGN_EPI) { if (wr == 0) PG8_BAR; }
    PG8_BAR;
#undef PG8_SA
#undef PG8_SB
#undef PG8_STAGE
#undef PG8_LDA
#undef PG8_LDB
#undef PG8_MMA
#undef PG8_WAIT_V
#undef PG8_WAIT_L
#undef PG8_BAR
#undef PG8_SCHED
}
}


#define XB_TMO      128
#define XB_XCNT(j)  (256  + 64 * (j))
#define XB_XSUB(j)  (1280 + 64 * (j))
#define XB_XGEN(j)  (2304 + 64 * (j))
#define XB_TOP      3328
#define XB_TOPGEN   3392
#define XCD_BAR_WORDS 3456
#define XB_SPIN_CAP (1u << 22)
__device__ __forceinline__ unsigned xb_ld(unsigned* p)              { return __hip_atomic_load(p, __ATOMIC_RELAXED, __HIP_MEMORY_SCOPE_AGENT); }
__device__ __forceinline__ unsigned xb_add(unsigned* p, unsigned v) { return __hip_atomic_fetch_add(p, v, __ATOMIC_RELAXED, __HIP_MEMORY_SCOPE_AGENT); }
__device__ __forceinline__ unsigned xb_xcc_id() { return (unsigned)__builtin_amdgcn_s_getreg((3 << 11) | 20) & 0xFu; }
#define XB_SPIN(cond, bar) do { unsigned _sp = 0; while (cond) { __builtin_amdgcn_s_sleep(1); \
    if ((++_sp & 255u) == 0u) { if (xb_ld(&(bar)[XB_TMO])) break; if (_sp > XB_SPIN_CAP) { atomicAdd(&(bar)[XB_TMO], 1u); break; } } } } while (0)
struct XcdBarrier { unsigned* bar; unsigned x; volatile LAS unsigned* st; };
__device__ __forceinline__ XcdBarrier xcd_barrier_post(unsigned* bar, volatile LAS unsigned* st) {
    XcdBarrier b; b.bar = bar; b.x = xb_xcc_id(); b.st = st;
    if (threadIdx.x == 0) (void)xb_add(&bar[XB_XCNT(b.x)], 1u);
    return b;
}
__device__ __forceinline__ void xcd_barrier_complete(unsigned* bar, unsigned x, unsigned& nloc, unsigned& nx) {
    const unsigned G = gridDim.x * gridDim.y * gridDim.z;
    unsigned sum, cnt, mine, sp = 0u;
    for (;;) {
        sum = 0u; cnt = 0u; mine = 0u;
#pragma unroll
        for (unsigned j = 0; j < 16; ++j) { const unsigned c = xb_ld(&bar[XB_XCNT(j)]); sum += c; cnt += (c > 0u) ? 1u : 0u; mine = (j == x) ? c : mine; }
        if (sum == G) break;
        __builtin_amdgcn_s_sleep(1);
        if ((++sp & 255u) == 0u) { if (xb_ld(&bar[XB_TMO])) break; if (sp > XB_SPIN_CAP) { atomicAdd(&bar[XB_TMO], 1u); break; } }
    }
    nloc = mine > 0u ? mine : 1u; nx = cnt > 0u ? cnt : 1u;
}
__device__ __forceinline__ void xcd_barrier(unsigned char* wsb) {
    XcdBarrier b; b.bar = (unsigned*)(wsb + WS_BAR); b.x = 0; b.st = (volatile LAS unsigned*)(135168 + 64);
    asm volatile("s_waitcnt vmcnt(0)" ::: "memory");
    __syncthreads();
    if (threadIdx.x == 0) {
        unsigned* bar = b.bar; b.x = xb_xcc_id();
        __builtin_amdgcn_s_waitcnt(0);
        unsigned nloc = b.st[0], nx = b.st[1];
        if (nloc == 0u) { xcd_barrier_complete(bar, b.x, nloc, nx); b.st[0] = nloc; b.st[1] = nx; }
        const unsigned old = xb_add(&bar[XB_XSUB(b.x)], 1u);
        const unsigned gen = old / nloc;
        if (old + 1u == (gen + 1u) * nloc) {
            __builtin_amdgcn_fence(__ATOMIC_RELEASE, "agent");
            asm volatile("s_waitcnt vmcnt(0)" ::: "memory");
            const unsigned og = xb_add(&bar[XB_TOP], 1u);
            const unsigned tg = og / nx;
            if (og + 1u == (tg + 1u) * nx) xb_add(&bar[XB_TOPGEN], 1u);
            else XB_SPIN(xb_ld(&bar[XB_TOPGEN]) == tg, bar);
            __builtin_amdgcn_fence(__ATOMIC_ACQUIRE, "agent");
            xb_add(&bar[XB_XGEN(b.x)], 1u);
            asm volatile("s_waitcnt vmcnt(0)" ::: "memory");
        } else {
            XB_SPIN(xb_ld(&bar[XB_XGEN(b.x)]) == gen, bar);
            __builtin_amdgcn_fence(__ATOMIC_ACQUIRE, "agent");
            asm volatile("s_waitcnt vmcnt(0)" ::: "memory");
        }
    }
    __syncthreads();
}

struct Params { const float* in[24]; float* out; unsigned char* ws; };
struct PRef {
    typedef const __attribute__((address_space(4))) char* kptr_t;
    __device__ __forceinline__ kptr_t base() const { kptr_t ka = (kptr_t)__builtin_amdgcn_kernarg_segment_ptr(); asm volatile("" : "+s"(ka)); return ka; }
    __device__ __forceinline__ const float* in(int i) const { return *(const float* const __attribute__((address_space(4)))*)(base() + 8 * i); }
    __device__ __forceinline__ float* out() const { return *(float* const __attribute__((address_space(4)))*)(base() + 8 * 24); }
    __device__ __forceinline__ unsigned char* ws() const { return *(unsigned char* const __attribute__((address_space(4)))*)(base() + 8 * 25); }
};
enum { I_X = 0, I_C, I_CTX, I_CCTX, I_MODW, I_MODB, I_N1G, I_N2G, I_WIN, I_DAQKG, I_DALAM, I_DAOUTG, I_CONVW, I_CONVB, I_GATEB, I_MLOUTG, I_QNG, I_KVNG, I_WUQ, I_WUKV, I_MLAQKG, I_WOUT, I_WGU, I_WDN };

struct Ctx {
    unsigned char* lds;
    int tid, lane, wave, gw, ngw, nwg, wg; unsigned l3off;
};

__device__ __forceinline__ Ctx fresh(const Ctx& X) {
    Ctx Y = X; int t = X.tid; asm volatile("" : "+v"(t)); Y.tid = t; Y.lane = t & 63; Y.wave = __builtin_amdgcn_readfirstlane(t >> 6); return Y;
}
template <int MODE>
__device__ __forceinline__ void transpose_item(const float* W, int K, int N, bf16_t* WT, float* scr, int item, int nblk, int lane) {
    const int kb = item / nblk, nb = item % nblk, k0 = 64 * kb, n0 = 32 * nb;
    const int ncol = n0 + (lane & 31); const bool ok = ncol < N;
#pragma unroll 8
    for (int i = 0; i < 32; ++i) { const int kk = 2 * i + (lane >> 5); scr[kk * 33 + (lane & 31)] = ok ? W[(size_t)(k0 + kk) * N + ncol] : 0.f; }
    asm volatile("s_waitcnt lgkmcnt(0)" ::: "memory");
    const int c = lane & 7;
#pragma unroll
    for (int j = 0; j < 4; ++j) { const int n = (lane >> 3) + 8 * j; const float* s = scr + (8 * c) * 33 + n;
        u32x4 o; o.x = pk2(s[0 * 33], s[1 * 33]); o.y = pk2(s[2 * 33], s[3 * 33]); o.z = pk2(s[4 * 33], s[5 * 33]); o.w = pk2(s[6 * 33], s[7 * 33]);
        int nn = n0 + n;
        if (MODE == 1) { const int up = nn >= FF ? 1 : 0; const int hcol = nn - up * FF; nn = (hcol >> 7) * 256 + up * 128 + (hcol & 127); }
        *(u32x4*)(WT + (size_t)nn * K + k0 + 8 * c) = o; }
    asm volatile("s_waitcnt lgkmcnt(0)" ::: "memory");
}
__device__ __forceinline__ void convert_weights(const Ctx& X0, const PRef& P, int l, int part, int wg_lo) {
    const Ctx X = fresh(X0);
    const int vwg = X.wg - wg_lo; if (vwg < 0) return;
    const int gwv = vwg * 8 + X.wave, ngwv = (X.nwg - wg_lo) * 8;
    float* scr = (float*)(X.lds + X.wave * 16384);
    unsigned char* ws = P.ws();
    constexpr int I_IN = (DM / 64) * (NPROJ / 32), I_OUT = (DM / 64) * (DM / 32), I_GU = (DM / 64) * (2 * FF / 32), I_DN = (FF / 64) * (DM / 32), I_UQ = (512 / 64) * (1536 / 32), I_UKV = (256 / 64) * (2048 / 32);
    constexpr int NITEMS = I_IN + I_OUT + I_GU + I_DN + I_UQ + I_UKV;
    const int it_lo = part == 2 ? NITEMS - I_DN : 0, it_hi = part == 1 ? NITEMS - I_DN : NITEMS;
    for (int it = it_lo + gwv; it < it_hi; it += ngwv) {
        int r = it;
        if (r < I_IN) { transpose_item<0>(P.in(I_WIN) + (size_t)l * DM * IN_W, DM, IN_W, (bf16_t*)(ws + WS_WIN), scr, r, NPROJ / 32, X.lane); continue; } r -= I_IN;
        if (r < I_OUT) { transpose_item<0>(P.in(I_WOUT) + (size_t)l * DM * DM, DM, DM, (bf16_t*)(ws + WS_WOUT), scr, r, DM / 32, X.lane); continue; } r -= I_OUT;
        if (r < I_GU) { transpose_item<1>(P.in(I_WGU) + (size_t)l * DM * 2 * FF, DM, 2 * FF, (bf16_t*)(ws + WS_WGU), scr, r, 2 * FF / 32, X.lane); continue; } r -= I_GU;
        if (r < I_UQ) { transpose_item<0>(P.in(I_WUQ) + (size_t)l * 512 * 1536, 512, 1536, (bf16_t*)(ws + WS_WUQ), scr, r, 1536 / 32, X.lane); continue; } r -= I_UQ;
        if (r < I_UKV) { transpose_item<0>(P.in(I_WUKV) + (size_t)l * 256 * 2048, 256, 2048, (bf16_t*)(ws + WS_WUKV), scr, r, 2048 / 32, X.lane); continue; } r -= I_UKV;
        transpose_item<0>(P.in(I_WDN) + (size_t)l * FF * DM, FF, DM, (bf16_t*)(ws + ((l & 1) ? WS_WDN2 : WS_WDN)), scr, r, DM / 32, X.lane);
    }
}
__device__ __forceinline__ void mod_gemv(const Ctx& X0, const PRef& P, int l_lo, int l_hi, int wg_lo) {
    const Ctx X = fresh(X0);
    const int vwg = X.wg - wg_lo; if (vwg < 0) return;
    float* sc = (float*)X.lds;
    float* red = (float*)(X.lds + 40960);
    for (int i = X.tid; i < 5 * DM; i += 512) { const int mb = i / DM, k = i % DM; const float v = mb < 4 ? P.in(I_C)[mb * DM + k] : P.in(I_CCTX)[k]; sc[i] = siluf(v); }
    __syncthreads();
    float* mod = (float*)(P.ws() + WS_MOD);
    const int kq = X.tid >> 4, c4 = X.tid & 15;
    for (int task = vwg; task < (l_hi - l_lo) * 192; task += X.nwg - wg_lo) {
        const int l = l_lo + task / 192, n0 = (task % 192) * 64;
        const float* W = P.in(I_MODW) + (size_t)l * DM * 6 * DM + n0 + 4 * c4;
        f32x4 a[5];
#pragma unroll
        for (int mb = 0; mb < 5; ++mb) a[mb] = (f32x4){0.f, 0.f, 0.f, 0.f};
#pragma unroll 8
        for (int i = 0; i < 64; ++i) { const int k = kq + 32 * i; const f32x4 w = *(const f32x4*)(W + (size_t)k * 6 * DM);
#pragma unroll
            for (int mb = 0; mb < 5; ++mb) a[mb] += w * sc[mb * DM + k]; }
#pragma unroll
        for (int mb = 0; mb < 5; ++mb) *(f32x4*)(red + (kq * 5 + mb) * 64 + 4 * c4) = a[mb];
        __syncthreads();
        if (X.tid < 320) { const int mb = X.tid >> 6, cc = X.tid & 63; float s = 0.f;
#pragma unroll 8
            for (int q = 0; q < 32; ++q) s += red[(q * 5 + mb) * 64 + cc];
            mod[((size_t)l * 5 + mb) * 6 * DM + n0 + cc] = s + P.in(I_MODB)[(size_t)l * 6 * DM + n0 + cc]; }
        __syncthreads();
    }
}

__device__ __forceinline__ void modulate_phase(const Ctx& X0, const float* src_lat, const float* src_ctx, const float* g, const float* modl, int shift_off, int scale_off, bf16_t* A, int nrows) {
    const Ctx X = fresh(X0);
    const int rpw = (nrows + X.ngw - 1) / X.ngw;
    int row = X.gw * rpw; const int rend = min(row + rpw, nrows);
    f32x4 v[8], nx[8], gm[8], sh[8];
    int cur_mb = -1;
    if (row < rend) { const float* src = row < M_LAT ? src_lat + (size_t)row * DM : src_ctx + (size_t)(row - M_LAT) * DM;
#pragma unroll
        for (int j = 0; j < 8; ++j) v[j] = *(const f32x4*)(src + X.lane * 4 + 256 * j); }
    for (; row < rend; ++row) {
        const int nrow = row + 1;
        if (nrow < rend) { const float* src = nrow < M_LAT ? src_lat + (size_t)nrow * DM : src_ctx + (size_t)(nrow - M_LAT) * DM;
#pragma unroll
            for (int j = 0; j < 8; ++j) nx[j] = *(const f32x4*)(src + X.lane * 4 + 256 * j); }
        const int mb = mod_batch(row);
        if (mb != cur_mb) { cur_mb = mb; const float* mp = modl + (size_t)mb * 6 * DM;
#pragma unroll
            for (int j = 0; j < 8; ++j) { const int col = X.lane * 4 + 256 * j; gm[j] = *(const f32x4*)(g + col) * (*(const f32x4*)(mp + scale_off + col) + 1.0f); sh[j] = *(const f32x4*)(mp + shift_off + col); } }
        float ss = 0.f;
#pragma unroll
        for (int j = 0; j < 8; ++j) ss += (v[j][0] * v[j][0] + v[j][1] * v[j][1]) + (v[j][2] * v[j][2] + v[j][3] * v[j][3]);
        const float rstd = rsqrtf(wave_sum(ss) * (1.f / DM) + EPS);
#pragma unroll
        for (int j = 0; j < 8; ++j) { const int col = X.lane * 4 + 256 * j;
            const f32x4 y = (v[j] * rstd) * gm[j] + sh[j];
            u32x2 w; w.x = pk2(y[0], y[1]); w.y = pk2(y[2], y[3]);
            *(u32x2*)(A + (size_t)row * DM + col) = w; }
#pragma unroll
        for (int j = 0; j < 8; ++j) v[j] = nx[j];
    }
}

struct ChunkId { int b, j, row0, tok0, is_lat, seglen; };
__device__ __forceinline__ ChunkId chunk_of_unit(int u) {
    ChunkId c;
    if (u < 256) { c.b = u >> 6; c.j = u & 63; c.row0 = c.b * SEQ + 64 * c.j; c.tok0 = CTXL + 64 * c.j; c.is_lat = 1; c.seglen = SEQ; }
    else { const int uu = u - 256; c.b = uu >> 2; c.j = uu & 3; c.row0 = M_LAT + c.b * CTXL + 64 * c.j; c.tok0 = 64 * c.j; c.is_lat = 0; c.seglen = CTXL; }
    return c;
}
__device__ __forceinline__ int row_of_tokchunk(int b, int jt) { return jt < 4 ? M_LAT + b * CTXL + 64 * jt : b * SEQ + 64 * (jt - 4); }

constexpr int TSTR = 520;
__device__ __forceinline__ void write_vt(const Ctx& X, const bf16_t* tile, bf16_t* img, size_t img_row0, int tok0) {
#pragma unroll 2
    for (int it = 0; it < 8; ++it) { const int task = it * 512 + X.tid; const int k = task & 7, c = task >> 3;
        float v[8];
#pragma unroll
        for (int jj = 0; jj < 8; ++jj) { const int i = 16 * (k >> 1) + 8 * (jj >> 2) + 4 * (k & 1) + (jj & 3); v[jj] = bf1(tile[i * TSTR + c]); }
        *(u32x4*)(img + (img_row0 + c) * TK + tok0 + 8 * k) = pack8(v); }
}
template <class F>
__device__ __forceinline__ void load_tile(const Ctx& X, bf16_t* tile, const bf16_t* src, size_t rstride, F colmap) {
#pragma unroll 4
    for (int it = 0; it < 8; ++it) { const int ch = it * 512 + X.tid; const int i = ch >> 6, cc = ch & 63;
        const u32x4 w = *(const u32x4*)(src + (size_t)i * rstride + colmap(cc));
        *(u32x4*)(tile + i * TSTR + 8 * cc) = w; }
}

__device__ __forceinline__ void rope_cs(int sub, int prow, int pcol, float* cs, float* sn) {
    const float pos = (float)((sub < 4) ? prow : pcol);
#pragma unroll
    for (int e = 0; e < 8; ++e) { const int fi = (sub & 1) * 8 + e; const float inv = exp2f(-(float)fi * (13.287712379549449f / 16.0f)); const float a = pos * inv; cs[e] = __cosf(a); sn[e] = __sinf(a); }
}
__device__ __forceinline__ void rope_apply(int sub, float* y, const float* cs, const float* sn) {
#pragma unroll
    for (int e = 0; e < 8; ++e) { const float p = __shfl_xor(y[e], 2); y[e] = (sub & 2) ? (y[e] * cs[e] + p * sn[e]) : (y[e] * cs[e] - p * sn[e]); }
}

__device__ __forceinline__ void prep_phase(const Ctx& X0, const PRef& P, int l) {
    const Ctx X = fresh(X0);
    unsigned char* ws = P.ws();
    const bf16_t* proj = (const bf16_t*)(ws + WS_PROJ);
    bf16_t* tile = (bf16_t*)X.lds;
    const float* qkg = P.in(I_DAQKG) + l * 128;
    const float* convw = P.in(I_CONVW) + (size_t)l * 3 * 1024; const float* convb = P.in(I_CONVB) + l * 1024;
    const float* qng = P.in(I_QNG) + l * 512; const float* kvng = P.in(I_KVNG) + l * 256;
    const int lane = X.lane, sub = lane & 7;
    const float qscale = 0.125f * LOG2E;
    for (int uu = X.wg; uu < 4 * 272; uu += X.nwg) {
        const int part = uu / 272, u = uu % 272;
        const ChunkId c = chunk_of_unit(u);
        if (part == 0) {
        for (int i = X.wave; i < 64; i += 8) {
            const int row = c.row0 + i, tok = c.tok0 + i;
            const bf16_t* pr = proj + (size_t)row * NPROJ;
            float cs[8], sn[8];
            if (c.is_lat) rope_cs(sub, c.j, i, cs, sn);
#pragma unroll
            for (int qk = 0; qk < 2; ++qk) {
                float y[8]; unpack8(*(const u32x4*)(pr + (qk ? C_DAK : C_DAQ) + 8 * lane), y);
                float ss = 0.f;
#pragma unroll
                for (int e = 0; e < 8; ++e) ss += y[e] * y[e];
                ss += __shfl_xor(ss, 1); ss += __shfl_xor(ss, 2); ss += __shfl_xor(ss, 4);
                const float rstd = rsqrtf(ss * (1.f / 64.f) + EPS);
#pragma unroll
                for (int e = 0; e < 8; ++e) y[e] = y[e] * rstd * qkg[qk * 64 + 8 * sub + e];
                if (c.is_lat) rope_apply(sub, y, cs, sn);
                const int head = lane >> 4, comp = (lane >> 3) & 1;
                if (qk == 0) {
#pragma unroll
                    for (int e = 0; e < 8; ++e) y[e] *= qscale;
                    *(u32x4*)((bf16_t*)(ws + WS_QDA) + ((size_t)head * M_ALL + row) * 128 + comp * 64 + 8 * sub) = pack8(y);
                } else {
                    *(u32x4*)((bf16_t*)(ws + WS_KDA) + ((size_t)(c.b * 4 + head) * TK + tok) * 128 + comp * 64 + 8 * sub) = pack8(y);
                }
            }
            {
                float y[8]; unpack8(*(const u32x4*)(pr + C_CQ + 8 * lane), y);
                float ss = 0.f;
#pragma unroll
                for (int e = 0; e < 8; ++e) ss += y[e] * y[e];
                const float rstd = rsqrtf(wave_sum(ss) * (1.f / 512.f) + EPS);
#pragma unroll
                for (int e = 0; e < 8; ++e) y[e] = y[e] * rstd * qng[8 * lane + e];
                *(u32x4*)((bf16_t*)(ws + WS_CQN) + (size_t)row * 512 + 8 * lane) = pack8(y);
            }
            {
                float y[8];
                if (lane < 32) unpack8(*(const u32x4*)(pr + C_CKV + 8 * lane), y);
                else {
#pragma unroll
                    for (int e = 0; e < 8; ++e) y[e] = 0.f;
                }
                float ss = 0.f;
#pragma unroll
                for (int e = 0; e < 8; ++e) ss += y[e] * y[e];
                const float rstd = rsqrtf(wave_sum(ss) * (1.f / 256.f) + EPS);
                if (lane < 32) {
#pragma unroll
                    for (int e = 0; e < 8; ++e) y[e] = y[e] * rstd * kvng[8 * lane + e];
                    *(u32x4*)((bf16_t*)(ws + WS_CKVN) + (size_t)row * 256 + 8 * lane) = pack8(y);
                }
            }
            if (lane < 8) *(u32x4*)((bf16_t*)(ws + WS_KPE) + (size_t)row * 64 + 8 * lane) = *(const u32x4*)(pr + C_KPE + 8 * lane);
            *(u32x4*)((bf16_t*)(ws + WS_OCOPY) + (size_t)row * 512 + 8 * lane) = *(const u32x4*)(pr + C_MLO + 8 * lane);
        }
        } else if (part == 1) {
        for (int i = X.wave; i < 64; i += 8) {
            const int row = c.row0 + i, tseg = 64 * c.j + i, tok = c.tok0 + i;
            const bf16_t* pr = proj + (size_t)row * NPROJ;
#pragma unroll
            for (int qk = 0; qk < 2; ++qk) {
                const int ch0 = qk * 512 + 8 * lane;
                float xm[8], x0[8], xp[8];
                unpack8(*(const u32x4*)(pr + C_MLQ + ch0), x0);
                if (tseg > 0) unpack8(*(const u32x4*)(pr - NPROJ + C_MLQ + ch0), xm);
                else {
#pragma unroll
                    for (int e = 0; e < 8; ++e) xm[e] = 0.f;
                }
                if (tseg < c.seglen - 1) unpack8(*(const u32x4*)(pr + NPROJ + C_MLQ + ch0), xp);
                else {
#pragma unroll
                    for (int e = 0; e < 8; ++e) xp[e] = 0.f;
                }
                float y[8];
#pragma unroll
                for (int e = 0; e < 8; ++e) { const float v = convb[ch0 + e] + convw[ch0 + e] * xm[e] + convw[1024 + ch0 + e] * x0[e] + convw[2048 + ch0 + e] * xp[e]; y[e] = siluf(v) * (qk ? 0.08838834764831845f : 1.0f); }
                const int head = lane >> 4, d = 8 * (lane & 15);
                const u32x4 w = pack8(y);
                *(u32x4*)((bf16_t*)(ws + (qk ? WS_KML : WS_QML)) + ((size_t)(c.b * 4 + head) * TK + tok) * 128 + d) = w;
                if (qk) *(u32x4*)(tile + i * TSTR + 8 * lane) = w;
            }
        }
        __syncthreads();
        write_vt(X, tile, (bf16_t*)(ws + WS_KTML), (size_t)c.b * 512, c.tok0);
        __syncthreads();
        } else if (part == 2) {
        load_tile(X, tile, proj + (size_t)c.row0 * NPROJ, NPROJ, [](int cc) { return C_DAV + 8 * cc; });
        __syncthreads();
        write_vt(X, tile, (bf16_t*)(ws + WS_VTDA), (size_t)c.b * 512, c.tok0);
        __syncthreads();
        } else {
        load_tile(X, tile, proj + (size_t)c.row0 * NPROJ, NPROJ, [](int cc) { return C_MLV + 8 * cc; });
        __syncthreads();
        write_vt(X, tile, (bf16_t*)(ws + WS_VTML), (size_t)c.b * 512, c.tok0);
        __syncthreads();
        }
    }
}

__device__ __forceinline__ void mla_prep_phase(const Ctx& X0, const PRef& P, int l) {
    const Ctx X = fresh(X0);
    unsigned char* ws = P.ws();
    const bf16_t* qup = (const bf16_t*)(ws + WS_QUP); const bf16_t* kvup = (const bf16_t*)(ws + WS_KVUP); const bf16_t* kpe = (const bf16_t*)(ws + WS_KPE);
    bf16_t* tile = (bf16_t*)X.lds;
    const float* g = P.in(I_MLAQKG) + l * 2 * 192;
    const int lane = X.lane, sub = lane & 7, head = lane >> 3;
    const float qscale = 0.07216878364870322f * LOG2E;
    for (int uu = X.wg; uu < 3 * 272; uu += X.nwg) {
        const int part = uu / 272, u = uu % 272;
        const ChunkId c = chunk_of_unit(u);
        if (part == 0) {
        for (int i = X.wave; i < 64; i += 8) {
            const int row = c.row0 + i, tok = c.tok0 + i;
            float cs[8], sn[8];
            if (c.is_lat) rope_cs(sub, c.j, i, cs, sn);
#pragma unroll
            for (int qk = 0; qk < 2; ++qk) {
                float y[3][8];
                if (qk == 0) {
#pragma unroll
                    for (int cc = 0; cc < 3; ++cc) unpack8(*(const u32x4*)(qup + (size_t)row * 1536 + head * 192 + 64 * cc + 8 * sub), y[cc]);
                } else {
#pragma unroll
                    for (int cc = 0; cc < 2; ++cc) unpack8(*(const u32x4*)(kvup + (size_t)row * 2048 + head * 256 + 64 * cc + 8 * sub), y[cc]);
                    unpack8(*(const u32x4*)(kpe + (size_t)row * 64 + 8 * sub), y[2]);
                }
                float ss = 0.f;
#pragma unroll
                for (int cc = 0; cc < 3; ++cc)
#pragma unroll
                    for (int e = 0; e < 8; ++e) ss += y[cc][e] * y[cc][e];
                ss += __shfl_xor(ss, 1); ss += __shfl_xor(ss, 2); ss += __shfl_xor(ss, 4);
                const float rstd = rsqrtf(ss * (1.f / 192.f) + EPS);
#pragma unroll
                for (int cc = 0; cc < 3; ++cc)
#pragma unroll
                    for (int e = 0; e < 8; ++e) y[cc][e] = y[cc][e] * rstd * g[qk * 192 + 64 * cc + 8 * sub + e];
                if (c.is_lat) rope_apply(sub, y[2], cs, sn);
                bf16_t* dst;
                if (qk == 0) {
#pragma unroll
                    for (int cc = 0; cc < 3; ++cc)
#pragma unroll
                        for (int e = 0; e < 8; ++e) y[cc][e] *= qscale;
                    dst = (bf16_t*)(ws + WS_QM) + ((size_t)head * M_ALL + row) * 192;
                } else dst = (bf16_t*)(ws + WS_KM) + ((size_t)(c.b * 8 + head) * TK + tok) * 192;
#pragma unroll
                for (int cc = 0; cc < 3; ++cc) *(u32x4*)(dst + 64 * cc + 8 * sub) = pack8(y[cc]);
            }
        }
        } else {
            const int p = part - 1;
            load_tile(X, tile, kvup + (size_t)c.row0 * 2048, 2048, [p](int cc) { return (4 * p + (cc >> 4)) * 256 + 128 + 8 * (cc & 15); });
            __syncthreads();
            write_vt(X, tile, (bf16_t*)(ws + WS_VTM), (size_t)(c.b * 8 + 4 * p) * 128, c.tok0);
            __syncthreads();
        }
    }
}

__device__ __forceinline__ void ml_gates(const float* gates, const float* gb, int b, int jt, int dir, int h, int lane, float& ig, float& lf, float& pre, float& total) {
    const int row = row_of_tokchunk(b, jt) + lane;
    ig = gates[(size_t)row * 16 + dir * 8 + h] + gb[dir * 8 + h];
    const float fg = gates[(size_t)row * 16 + dir * 8 + 4 + h] + gb[dir * 8 + 4 + h];
    lf = fminf(fg, 0.f) - log1pf(__expf(-fabsf(fg)));
    float s = lf;
#pragma unroll
    for (int o = 1; o < 64; o <<= 1) { const float t = __shfl_up(s, o); if (lane >= o) s += t; }
    pre = s; total = __shfl(s, 63);
}
constexpr int KSTR = 72;
constexpr int QSTR = 136;
__device__ __forceinline__ void mlstm_a_phase(const Ctx& X0, const PRef& P, int l) {
    const Ctx X = fresh(X0);
    unsigned char* ws = P.ws();
    const float* gates = (const float*)(ws + WS_GATES); const float* gb = P.in(I_GATEB) + l * 16;
    bf16_t* Kt = (bf16_t*)X.lds;
    bf16_t* Vw = (bf16_t*)(X.lds + 128 * KSTR * 2);
    float* wtab = (float*)(X.lds + 3 * 128 * KSTR * 2);
    const int lane = X.lane, r32 = lane & 31, hi = lane >> 5;
    for (int u = (X.wg + X.nwg - 152 % X.nwg) % X.nwg; u < 16 * NCH; u += X.nwg) {
        const int bh = u / NCH, jt = u % NCH, b = bh >> 2, h = bh & 3, tok0 = 64 * jt;
        if (X.wave < 2) {
            const int dir = X.wave; float ig, lf, pre, total; ml_gates(gates, gb, b, jt, dir, h, lane, ig, lf, pre, total);
            const float cum = dir == 0 ? pre : total - pre + lf;
            const float wlog = total - cum + ig; const float mloc = wave_max(wlog);
            wtab[dir * 64 + lane] = __expf(wlog - mloc);
            if (lane == 0) { float* cs = (float*)(ws + WS_CSTAT) + ((size_t)(bh * 2 + dir) * NCH + jt) * 4; cs[0] = total; cs[1] = mloc; }
        }
        u32x4 vr[2];
#pragma unroll
        for (int it = 0; it < 2; ++it) { const int ch = it * 512 + X.tid; const int rr = ch >> 3, k = ch & 7;
            *(u32x4*)(Kt + rr * KSTR + 8 * k) = *(const u32x4*)((const bf16_t*)(ws + WS_KTML) + ((size_t)bh * 128 + rr) * TK + tok0 + 8 * k);
            vr[it] = *(const u32x4*)((const bf16_t*)(ws + WS_VTML) + ((size_t)bh * 128 + rr) * TK + tok0 + 8 * k); }
        __syncthreads();
#pragma unroll
        for (int it = 0; it < 2; ++it) { const int ch = it * 512 + X.tid; const int rr = ch >> 3, k = ch & 7;
            float v[8]; unpack8(vr[it], v);
#pragma unroll
            for (int dir = 0; dir < 2; ++dir) { float o[8];
#pragma unroll
                for (int jj = 0; jj < 8; ++jj) { const int i = 16 * (k >> 1) + 8 * (jj >> 2) + 4 * (k & 1) + (jj & 3); o[jj] = v[jj] * wtab[dir * 64 + i]; }
                *(u32x4*)(Vw + (dir * 128 + rr) * KSTR + 8 * k) = pack8(o); } }
        __syncthreads();
        {
            const int dir = X.wave >> 2, dvb = X.wave & 3;
            bf16_t* U = (bf16_t*)(ws + WS_AB) + ((size_t)(bh * 2 + dir) * NCH + jt) * 16384;
            bf16x8 a[4];
#pragma unroll
            for (int ks = 0; ks < 4; ++ks) a[ks] = *(const bf16x8*)(Vw + (dir * 128 + 32 * dvb + r32) * KSTR + 16 * ks + 8 * hi);
            for (int dkb = 0; dkb < 4; ++dkb) {
                f32x16 acc;
#pragma unroll
                for (int r = 0; r < 16; ++r) acc[r] = 0.f;
#pragma unroll
                for (int ks = 0; ks < 4; ++ks) { const bf16x8 bb = *(const bf16x8*)(Kt + (32 * dkb + r32) * KSTR + 16 * ks + 8 * hi); acc = __builtin_amdgcn_mfma_f32_32x32x16_bf16(a[ks], bb, acc, 0, 0, 0); }
#pragma unroll
                for (int r = 0; r < 16; ++r) U[(32 * dvb + crow(r, hi)) * 128 + 32 * dkb + r32] = (bf16_t)(pk2(acc[r], 0.f) & 0xffffu);
            }
        }
        if (X.tid < 256) { const int dir = X.tid >> 7, dk = X.tid & 127; float s = 0.f;
#pragma unroll 8
            for (int p = 0; p < 64; ++p) { const int i = (p & ~15) + perm_off(p & 15); s += wtab[dir * 64 + i] * bf1(Kt[dk * KSTR + p]); }
            ((float*)(ws + WS_NU))[((size_t)(bh * 2 + dir) * NCH + jt) * 128 + dk] = s; }
        __syncthreads();
    }
}
__device__ __forceinline__ int ml_jmap(int dir, int c) { return dir == 0 ? c : (c < 4 ? 3 - c : 71 - c); }
__device__ __forceinline__ void mlstm_scan_phase(const Ctx& X0, const PRef& P) {
    const Ctx X = fresh(X0);
    unsigned char* ws = P.ws();
    float* cstat = (float*)(ws + WS_CSTAT);
    const int gtid = (X.nwg - 1 - X.wg) * 512 + X.tid, nthr = X.nwg * 512;
    for (int task = gtid; task < 65536 + 1024; task += nthr) {
        float m = 0.f;
        if (task < 65536) {
            const int seq = task >> 11, e = task & 2047, dir = seq & 1;
            const bf16_t* __restrict__ U = (const bf16_t*)(ws + WS_AB); bf16_t* __restrict__ S = (bf16_t*)(ws + WS_CSNAP);
            float C[8];
#pragma unroll
            for (int i = 0; i < 8; ++i) C[i] = 0.f;
            for (int cb = 0; cb < 4; ++cb) {
                u32x4 uu[17]; float tot[17], mlc[17];
#pragma unroll
                for (int i = 0; i < 17; ++i) { const size_t base = (size_t)seq * NCH + ml_jmap(dir, cb * 17 + i);
                    uu[i] = *(const u32x4*)(U + base * 16384 + 8 * e); tot[i] = cstat[base * 4]; mlc[i] = cstat[base * 4 + 1]; }
#pragma unroll
                for (int i = 0; i < 17; ++i) { const size_t base = (size_t)seq * NCH + ml_jmap(dir, cb * 17 + i);
                    *(u32x4*)(S + base * 16384 + 8 * e) = pack8(C);
                    if (e == 0) cstat[base * 4 + 2] = m;
                    const float mn = fmaxf(tot[i] + m, mlc[i]); const float dec = __expf(tot[i] + m - mn), sc = __expf(mlc[i] - mn);
                    float u8[8]; unpack8(uu[i], u8);
#pragma unroll
                    for (int q = 0; q < 8; ++q) C[q] = C[q] * dec + u8[q] * sc;
                    m = mn; }
            }
        } else {
            const int t2 = task - 65536, seq = t2 >> 5, e4 = t2 & 31, dir = seq & 1;
            const float* __restrict__ NU = (const float*)(ws + WS_NU); float* __restrict__ NS = (float*)(ws + WS_NSNAP);
            f32x4 C = (f32x4){0.f, 0.f, 0.f, 0.f};
            for (int cb = 0; cb < 4; ++cb) {
                f32x4 uu[17]; float tot[17], mlc[17];
#pragma unroll
                for (int i = 0; i < 17; ++i) { const size_t base = (size_t)seq * NCH + ml_jmap(dir, cb * 17 + i);
                    uu[i] = *(const f32x4*)(NU + base * 128 + 4 * e4); tot[i] = cstat[base * 4]; mlc[i] = cstat[base * 4 + 1]; }
#pragma unroll
                for (int i = 0; i < 17; ++i) { const size_t base = (size_t)seq * NCH + ml_jmap(dir, cb * 17 + i);
                    *(f32x4*)(NS + base * 128 + 4 * e4) = C;
                    const float mn = fmaxf(tot[i] + m, mlc[i]); const float dec = __expf(tot[i] + m - mn), sc = __expf(mlc[i] - mn);
                    C = C * dec + uu[i] * sc; m = mn; }
            }
        }
    }
}
__device__ __forceinline__ void mlstm_c_unit(const Ctx& X0, const PRef& P, int l, int u) {
    const Ctx X = fresh(X0);
    unsigned char* ws = P.ws();
    const float* gates = (const float*)(ws + WS_GATES); const float* gb = P.in(I_GATEB) + l * 16;
    const float* cstat = (const float*)(ws + WS_CSTAT);
    bf16_t* Qt = (bf16_t*)X.lds;
    bf16_t* Kn = (bf16_t*)(X.lds + 64 * QSTR * 2);
    bf16_t* Vt = (bf16_t*)(X.lds + 2 * 64 * QSTR * 2);
    float* tab = (float*)(X.lds + 2 * 64 * QSTR * 2 + 128 * KSTR * 2);
    float* t_a = tab, *t_c1 = tab + 128, *t_wp = tab + 256, *t_em = tab + 384, *t_n = tab + 512, *t_red = tab + 768;
    const int lane = X.lane, r32 = lane & 31, hi = lane >> 5;
    const int bh = u / NCH, jt = u % NCH, b = bh >> 2, h = bh & 3, tok0 = 64 * jt;
    if (X.wave < 2) {
        const int dir = X.wave; float ig, lf, pre, total; ml_gates(gates, gb, b, jt, dir, h, lane, ig, lf, pre, total);
        const float cum = dir == 0 ? pre : total - pre + lf;
        const float a = ig - cum; float pm = a;
#pragma unroll
        for (int o = 1; o < 64; o <<= 1) { const float t = dir == 0 ? __shfl_up(pm, o) : __shfl_down(pm, o); const bool ok = dir == 0 ? (lane >= o) : (lane + o < 64); if (ok) pm = fmaxf(pm, t); }
        const float mc = cstat[((size_t)(bh * 2 + dir) * NCH + jt) * 4 + 2];
        const float mt = cum + fmaxf(mc, pm);
        t_a[dir * 64 + lane] = a; t_c1[dir * 64 + lane] = cum - mt; t_wp[dir * 64 + lane] = __expf(cum + mc - mt); t_em[dir * 64 + lane] = __expf(-mt);
    }
#pragma unroll
    for (int it = 0; it < 2; ++it) { const int ch = it * 512 + X.tid;
        { const int i = ch >> 4, k = ch & 15;
          *(u32x4*)(Qt + i * QSTR + 8 * k) = *(const u32x4*)((const bf16_t*)(ws + WS_QML) + ((size_t)bh * TK + tok0 + i) * 128 + 8 * k);
          *(u32x4*)(Kn + i * QSTR + 8 * k) = *(const u32x4*)((const bf16_t*)(ws + WS_KML) + ((size_t)bh * TK + tok0 + i) * 128 + 8 * k); }
        { const int rr = ch >> 3, k = ch & 7;
          *(u32x4*)(Vt + rr * KSTR + 8 * k) = *(const u32x4*)((const bf16_t*)(ws + WS_VTML) + ((size_t)bh * 128 + rr) * TK + tok0 + 8 * k); } }
    if (X.tid < 256) t_n[X.tid] = ((const float*)(ws + WS_NSNAP))[((size_t)(bh * 2 + (X.tid >> 7)) * NCH + jt) * 128 + (X.tid & 127)];
    __syncthreads();
    const int tb = X.wave & 1, db = X.wave >> 1, t = 32 * tb + r32;
    bf16x8 qf[8];
#pragma unroll
    for (int ks = 0; ks < 8; ++ks) qf[ks] = *(const bf16x8*)(Qt + t * QSTR + 16 * ks + 8 * hi);
    f32x16 st[2];
#pragma unroll
    for (int sb = 0; sb < 2; ++sb) {
#pragma unroll
        for (int r = 0; r < 16; ++r) st[sb][r] = 0.f;
#pragma unroll
        for (int ks = 0; ks < 8; ++ks) { const bf16x8 kf = *(const bf16x8*)(Kn + (32 * sb + r32) * QSTR + 16 * ks + 8 * hi); st[sb] = __builtin_amdgcn_mfma_f32_32x32x16_bf16(kf, qf[ks], st[sb], 0, 0, 0); }
    }
    f32x16 hsum;
#pragma unroll
    for (int r = 0; r < 16; ++r) hsum[r] = 0.f;
#pragma unroll
    for (int dir = 0; dir < 2; ++dir) {
        const float c1 = t_c1[dir * 64 + t], wp = t_wp[dir * 64 + t], em = t_em[dir * 64 + t];
        float rs = 0.f; u32x4 pw[2][2];
#pragma unroll
        for (int sb = 0; sb < 2; ++sb) { float p[16];
#pragma unroll
            for (int r = 0; r < 16; ++r) { const int s = 32 * sb + crow(r, hi); const bool ok = dir == 0 ? (s <= t) : (s >= t);
                const float dm = ok ? __expf(t_a[dir * 64 + s] + c1) : 0.f; p[r] = st[sb][r] * dm; rs += p[r]; }
            pw[sb][0] = pack8(p); pw[sb][1] = pack8(p + 8); }
        rs += __shfl_xor(rs, 32);
        float qn = 0.f;
#pragma unroll
        for (int ks = 0; ks < 8; ++ks) { float q8[8]; unpack8(__builtin_bit_cast(u32x4, qf[ks]), q8);
#pragma unroll
            for (int e = 0; e < 8; ++e) qn += q8[e] * t_n[dir * 128 + 16 * ks + 8 * hi + e]; }
        qn += __shfl_xor(qn, 32);
        const float den = rs + wp * qn; const float rden = 1.f / fmaxf(fabsf(den), em);
        f32x16 acc;
#pragma unroll
        for (int r = 0; r < 16; ++r) acc[r] = 0.f;
        const bf16_t* Cs = (const bf16_t*)(ws + WS_CSNAP) + ((size_t)(bh * 2 + dir) * NCH + jt) * 16384 + (size_t)(32 * db + r32) * 128;
#pragma unroll
        for (int ks = 0; ks < 8; ++ks) { const bf16x8 cf = *(const bf16x8*)(Cs + 16 * ks + 8 * hi); acc = __builtin_amdgcn_mfma_f32_32x32x16_bf16(cf, qf[ks], acc, 0, 0, 0); }
#pragma unroll
        for (int r = 0; r < 16; ++r) acc[r] *= wp;
#pragma unroll
        for (int sb = 0; sb < 2; ++sb)
#pragma unroll
            for (int s2 = 0; s2 < 2; ++s2) { const bf16x8 vf = *(const bf16x8*)(Vt + (32 * db + r32) * KSTR + 32 * sb + 16 * s2 + 8 * hi);
                acc = __builtin_amdgcn_mfma_f32_32x32x16_bf16(vf, __builtin_bit_cast(bf16x8, pw[sb][s2]), acc, 0, 0, 0); }
#pragma unroll
        for (int r = 0; r < 16; ++r) hsum[r] += acc[r] * rden;
    }
    float ss = 0.f;
#pragma unroll
    for (int r = 0; r < 16; ++r) ss += hsum[r] * hsum[r];
    ss += __shfl_xor(ss, 32);
    if (hi == 0) t_red[(tb * 4 + db) * 32 + r32] = ss;
    __syncthreads();
    const float tot = t_red[(tb * 4 + 0) * 32 + r32] + t_red[(tb * 4 + 1) * 32 + r32] + t_red[(tb * 4 + 2) * 32 + r32] + t_red[(tb * 4 + 3) * 32 + r32];
    const float rstd = rsqrtf(tot * (1.f / 128.f) + EPS);
    const int row = row_of_tokchunk(b, jt) + t;
    const float* og = P.in(I_MLOUTG) + l * 512 + h * 128;
    const bf16_t* oc = (const bf16_t*)(ws + WS_OCOPY) + (size_t)row * 512 + h * 128;
    bf16_t* mix = (bf16_t*)(ws + WS_AB) + (size_t)row * DM + 512 + h * 128;
#pragma unroll
    for (int q = 0; q < 4; ++q) { const int dv = 32 * db + 8 * q + 4 * hi;
        const u32x2 ow = *(const u32x2*)(oc + dv); const f32x4 gg = *(const f32x4*)(og + dv);
        const float o0 = hsum[4 * q + 0] * rstd * gg[0] * sigmf(bflo(ow.x)), o1 = hsum[4 * q + 1] * rstd * gg[1] * sigmf(bfhi(ow.x));
        const float o2 = hsum[4 * q + 2] * rstd * gg[2] * sigmf(bflo(ow.y)), o3 = hsum[4 * q + 3] * rstd * gg[3] * sigmf(bfhi(ow.y));
        u32x2 w; w.x = pk2(o0, o1); w.y = pk2(o2, o3); *(u32x2*)(mix + dv) = w; }
    __syncthreads();
}

template <int DQK, int KROW>
struct AttnCore {
    static constexpr int NKS = DQK / 16, NKC1 = KROW / 8 + 1, KS = NKC1 * 8, KT_B = 64 * NKC1 * 16, VT_B = 128 * 9 * 16, SLOT_B = KT_B + VT_B;
    static constexpr int NBK = KT_B / 1024, NBV = VT_B / 1024, NB = NBK + NBV, NI = (NB + 7) / 8;
    static_assert(KT_B % 1024 == 0 && VT_B % 1024 == 0 && 8 * NI - NB <= 8 && 3 * SLOT_B <= 135168, "attention LDS geometry");
    static __device__ __forceinline__ void run(const Ctx& X, const bf16_t* Qrow, int kcol, const bf16_t* K, const bf16_t* Vt, int nt, f32x16 (&o)[4]) {
        const int lane = X.lane, r32 = lane & 31, hi = lane >> 5;
        LAS unsigned char* l3 = (LAS unsigned char*)0 + X.l3off;
        bf16x8 qf[NKS];
#pragma unroll
        for (int ks = 0; ks < NKS; ++ks) qf[ks] = *(const bf16x8*)(Qrow + 16 * ks + 8 * hi);
        unsigned goff[NI]; int bsel[NI];
#pragma unroll
        for (int i = 0; i < NI; ++i) {
            int bidx = X.wave + 8 * i; if (bidx >= NB) bidx -= NB;
            bsel[i] = bidx;
            if (bidx < NBK) { const int c = bidx * 64 + lane; const int row = c / NKC1; int col = c % NKC1; if (col > NKC1 - 2) col = NKC1 - 2; goff[i] = (unsigned)(row * KROW + 8 * col) * 2u; }
            else { const int c = (bidx - NBK) * 64 + lane; const int row = c / 9; int col = c % 9; if (col > 7) col = 7; goff[i] = (unsigned)(row * TK + 8 * col) * 2u; }
        }
        asm volatile("s_waitcnt vmcnt(0)" ::: "memory");
#pragma unroll
        for (int ks = 0; ks < NKS; ++ks) asm volatile("" : "+v"(qf[ks]));
        auto issue = [&](int t, int slotoff) {
#pragma unroll
            for (int i = 0; i < NI; ++i) {
                const char* base = bsel[i] < NBK ? (const char*)K + (size_t)t * (64 * KROW * 2) : (const char*)Vt + (size_t)t * 128;
                __builtin_amdgcn_global_load_lds((const unsigned*)(base + goff[i]), (LAS unsigned*)(l3 + slotoff + bsel[i] * 1024), 16, 0, 0);
            }
        };
#pragma unroll
        for (int d = 0; d < 4; ++d)
#pragma unroll
            for (int r = 0; r < 16; ++r) o[d][r] = 0.f;
        float mrun = -1e30f, lrun = 0.f;
        issue(0, 0); issue(1, SLOT_B);
        asm volatile("s_waitcnt vmcnt(%0)" :: "i"(NI) : "memory");
        __builtin_amdgcn_s_barrier(); asm volatile("" ::: "memory");
        int s_cur = 0, s_nn = 2 * SLOT_B;
        for (int t = 0; t < nt; ++t) {
            if (t + 2 < nt) issue(t + 2, s_nn);
            const LAS bf16_t* kt = (const LAS bf16_t*)(l3 + s_cur) + r32 * KS + kcol + 8 * hi; const LAS bf16_t* vt = (const LAS bf16_t*)(l3 + s_cur + KT_B) + r32 * KSTR + 8 * hi;
            f32x16 s0, s1;
#pragma unroll
            for (int r = 0; r < 16; ++r) { s0[r] = 0.f; s1[r] = 0.f; }
            {
                bf16x8 a0 = *(const LAS bf16x8*)(kt), a1 = *(const LAS bf16x8*)(kt + 32 * KS);
                __builtin_amdgcn_sched_group_barrier(0x100, 2, 0);
#pragma unroll
                for (int ks = 0; ks < NKS; ++ks) {
                    bf16x8 b0 = a0, b1 = a1;
                    if (ks + 1 < NKS) { b0 = *(const LAS bf16x8*)(kt + 16 * (ks + 1)); b1 = *(const LAS bf16x8*)(kt + 32 * KS + 16 * (ks + 1)); }
                    s0 = __builtin_amdgcn_mfma_f32_32x32x16_bf16(a0, qf[ks], s0, 0, 0, 0);
                    s1 = __builtin_amdgcn_mfma_f32_32x32x16_bf16(a1, qf[ks], s1, 0, 0, 0);
                    if (ks + 1 < NKS) __builtin_amdgcn_sched_group_barrier(0x100, 2, 0);
                    __builtin_amdgcn_sched_group_barrier(0x008, 2, 0);
                    a0 = b0; a1 = b1;
                }
            }
            bf16x8 vf[4];
#pragma unroll
            for (int d = 0; d < 4; ++d) vf[d] = *(const LAS bf16x8*)(vt + 32 * d * KSTR);
            float mx = fmaxf(s0[0], s1[0]);
#pragma unroll
            for (int r = 1; r < 16; ++r) mx = fmaxf(fmaxf(mx, s0[r]), s1[r]);
            mx = fmaxf(mx, __shfl_xor(mx, 32));
            if (__any(mx - mrun > RESC_THR)) {
                const float mnew = fmaxf(mrun, mx); const float alpha = __builtin_amdgcn_exp2f(mrun - mnew); mrun = mnew; lrun *= alpha;
#pragma unroll
                for (int d = 0; d < 4; ++d) o[d] = o[d] * alpha;
            }
            s0 = s0 - mrun; s1 = s1 - mrun;
#pragma unroll
            for (int r = 0; r < 16; ++r) { s0[r] = __builtin_amdgcn_exp2f(s0[r]); s1[r] = __builtin_amdgcn_exp2f(s1[r]); }
            { const f32x16 sm = s0 + s1;
              lrun += ((sm[0] + sm[1]) + (sm[2] + sm[3])) + ((sm[4] + sm[5]) + (sm[6] + sm[7])) + (((sm[8] + sm[9]) + (sm[10] + sm[11])) + ((sm[12] + sm[13]) + (sm[14] + sm[15]))); }
            bf16x8 pf[4];
            { float p[16];
#pragma unroll
              for (int r = 0; r < 16; ++r) p[r] = s0[r];
              pf[0] = __builtin_bit_cast(bf16x8, pack8(p)); pf[1] = __builtin_bit_cast(bf16x8, pack8(p + 8));
#pragma unroll
              for (int r = 0; r < 16; ++r) p[r] = s1[r];
              pf[2] = __builtin_bit_cast(bf16x8, pack8(p)); pf[3] = __builtin_bit_cast(bf16x8, pack8(p + 8)); }
#pragma unroll
            for (int g = 0; g < 4; ++g) {
                bf16x8 vn[4];
                if (g + 1 < 4) {
#pragma unroll
                    for (int d = 0; d < 4; ++d) vn[d] = *(const LAS bf16x8*)(vt + 32 * d * KSTR + 16 * (g + 1));
                }
#pragma unroll
                for (int d = 0; d < 4; ++d) o[d] = __builtin_amdgcn_mfma_f32_32x32x16_bf16(vf[d], pf[g], o[d], 0, 0, 0);
                if (g + 1 < 4) {
                    __builtin_amdgcn_sched_group_barrier(0x100, 4, 0);
#pragma unroll
                    for (int d = 0; d < 4; ++d) vf[d] = vn[d];
                }
                __builtin_amdgcn_sched_group_barrier(0x008, 4, 0);
            }
            if (t + 2 < nt) asm volatile("s_waitcnt vmcnt(%0)" :: "i"(NI) : "memory");
            else asm volatile("s_waitcnt vmcnt(0)" ::: "memory");
            asm volatile("s_waitcnt lgkmcnt(0)" ::: "memory");
            __builtin_amdgcn_s_barrier(); asm volatile("" ::: "memory");
            s_cur = (s_cur == 2 * SLOT_B) ? 0 : s_cur + SLOT_B; s_nn = (s_nn == 2 * SLOT_B) ? 0 : s_nn + SLOT_B;
        }
        lrun += __shfl_xor(lrun, 32);
        const float rl = 1.f / lrun;
#pragma unroll
        for (int d = 0; d < 4; ++d) o[d] = o[d] * rl;
    }
};

template <int DQK, int KROW>
struct AttnCoreP {
    static constexpr int NKS = DQK / 16, NKC1 = KROW / 8 + 1, KS = NKC1 * 8, KT_B = 64 * NKC1 * 16, VT_B = 128 * 9 * 16, SLOT_B = KT_B + VT_B;
    static constexpr int NBK = KT_B / 1024, NBV = VT_B / 1024, NB = NBK + NBV, NI = (NB + 7) / 8;
    static_assert(KT_B % 1024 == 0 && VT_B % 1024 == 0 && 8 * NI - NB <= 8 && 3 * SLOT_B <= 135168, "attention LDS geometry");
    static __device__ __forceinline__ void run(const Ctx& X, const bf16_t* Qrow, int kcol, const bf16_t* K, const bf16_t* Vt, int nt, f32x16 (&o)[4]) {
        const int lane = X.lane, r32 = lane & 31, hi = lane >> 5, role = X.wave >> 2;
        LAS unsigned char* l3 = (LAS unsigned char*)0 + X.l3off;
        bf16x8 qf[NKS];
#pragma unroll
        for (int ks = 0; ks < NKS; ++ks) qf[ks] = *(const bf16x8*)(Qrow + 16 * ks + 8 * hi);
        unsigned goff[NI]; int bsel[NI];
#pragma unroll
        for (int i = 0; i < NI; ++i) {
            int bidx = X.wave + 8 * i; if (bidx >= NB) bidx -= NB;
            bsel[i] = bidx;
            if (bidx < NBK) { const int c = bidx * 64 + lane; const int row = c / NKC1; int col = c % NKC1; if (col > NKC1 - 2) col = NKC1 - 2; goff[i] = (unsigned)(row * KROW + 8 * col) * 2u; }
            else { const int c = (bidx - NBK) * 64 + lane; const int row = c / 9; int col = c % 9; if (col > 7) col = 7; goff[i] = (unsigned)(row * TK + 8 * col) * 2u; }
        }
        asm volatile("s_waitcnt vmcnt(0)" ::: "memory");
#pragma unroll
        for (int ks = 0; ks < NKS; ++ks) asm volatile("" : "+v"(qf[ks]));
        auto issue = [&](int tk, int ks_off, bool doK, int tv, int vs_off, bool doV) {
#pragma unroll
            for (int i = 0; i < NI; ++i) {
                const bool isK = bsel[i] < NBK;
                if (isK ? doK : doV) {
                    const char* base = isK ? (const char*)K + (size_t)tk * (64 * KROW * 2) : (const char*)Vt + (size_t)tv * 128;
                    __builtin_amdgcn_global_load_lds((const unsigned*)(base + goff[i]), (LAS unsigned*)(l3 + (isK ? ks_off : vs_off) + bsel[i] * 1024), 16, 0, 0);
                }
            }
        };
#pragma unroll
        for (int d = 0; d < 4; ++d)
#pragma unroll
            for (int r = 0; r < 16; ++r) o[d][r] = 0.f;
        float mrun = -1e30f, lrun = 0.f;
        issue(0, 0, true, 0, 0, true); issue(1, SLOT_B, true, 1, SLOT_B, true); issue(2, 2 * SLOT_B, nt > 2, 0, 0, false);
        asm volatile("s_waitcnt vmcnt(0)" ::: "memory");
        __builtin_amdgcn_s_barrier(); asm volatile("" ::: "memory");
        f32x16 sc0, sc1;
        {
            const LAS bf16_t* kt = (const LAS bf16_t*)(l3) + r32 * KS + kcol + 8 * hi;
#pragma unroll
            for (int r = 0; r < 16; ++r) { sc0[r] = 0.f; sc1[r] = 0.f; }
#pragma unroll
            for (int ks = 0; ks < NKS; ++ks) {
                const bf16x8 a0 = *(const LAS bf16x8*)(kt + 16 * ks), a1 = *(const LAS bf16x8*)(kt + 32 * KS + 16 * ks);
                sc0 = __builtin_amdgcn_mfma_f32_32x32x16_bf16(a0, qf[ks], sc0, 0, 0, 0);
                sc1 = __builtin_amdgcn_mfma_f32_32x32x16_bf16(a1, qf[ks], sc1, 0, 0, 0);
            }
        }
        int s0off = 0, s1off = SLOT_B, s2off = 2 * SLOT_B;
        for (int t = 0; t < nt; ++t) {
            issue(t + 3, s0off, t + 3 < nt, t + 2, s2off, t + 2 < nt);
            const bool hasN = t + 1 < nt;
            const LAS bf16_t* kt = (const LAS bf16_t*)(l3 + s1off) + r32 * KS + kcol + 8 * hi;
            const LAS bf16_t* vt = (const LAS bf16_t*)(l3 + s0off + KT_B) + r32 * KSTR + 8 * hi;
            f32x16 sn0, sn1;
            auto qk_next = [&]() {
#pragma unroll
                for (int r = 0; r < 16; ++r) { sn0[r] = 0.f; sn1[r] = 0.f; }
                bf16x8 a0 = *(const LAS bf16x8*)(kt), a1 = *(const LAS bf16x8*)(kt + 32 * KS);
                __builtin_amdgcn_sched_group_barrier(0x100, 2, 0);
#pragma unroll
                for (int ks = 0; ks < NKS; ++ks) {
                    bf16x8 b0 = a0, b1 = a1;
                    if (ks + 1 < NKS) { b0 = *(const LAS bf16x8*)(kt + 16 * (ks + 1)); b1 = *(const LAS bf16x8*)(kt + 32 * KS + 16 * (ks + 1)); }
                    sn0 = __builtin_amdgcn_mfma_f32_32x32x16_bf16(a0, qf[ks], sn0, 0, 0, 0);
                    sn1 = __builtin_amdgcn_mfma_f32_32x32x16_bf16(a1, qf[ks], sn1, 0, 0, 0);
                    if (ks + 1 < NKS) __builtin_amdgcn_sched_group_barrier(0x100, 2, 0);
                    __builtin_amdgcn_sched_group_barrier(0x008, 2, 0);
                    a0 = b0; a1 = b1;
                }
            };
            if (role == 0 && hasN) qk_next();
            float mx = fmaxf(sc0[0], sc1[0]);
#pragma unroll
            for (int r = 1; r < 16; ++r) mx = fmaxf(fmaxf(mx, sc0[r]), sc1[r]);
            mx = fmaxf(mx, __shfl_xor(mx, 32));
            if (__any(mx - mrun > RESC_THR)) {
                const float mnew = fmaxf(mrun, mx); const float alpha = __builtin_amdgcn_exp2f(mrun - mnew); mrun = mnew; lrun *= alpha;
#pragma unroll
                for (int d = 0; d < 4; ++d) o[d] = o[d] * alpha;
            }
            sc0 = sc0 - mrun; sc1 = sc1 - mrun;
#pragma unroll
            for (int r = 0; r < 16; ++r) { sc0[r] = __builtin_amdgcn_exp2f(sc0[r]); sc1[r] = __builtin_amdgcn_exp2f(sc1[r]); }
            { const f32x16 sm = sc0 + sc1;
              lrun += ((sm[0] + sm[1]) + (sm[2] + sm[3])) + ((sm[4] + sm[5]) + (sm[6] + sm[7])) + (((sm[8] + sm[9]) + (sm[10] + sm[11])) + ((sm[12] + sm[13]) + (sm[14] + sm[15]))); }
            bf16x8 pf[4];
            { float p[16];
#pragma unroll
              for (int r = 0; r < 16; ++r) p[r] = sc0[r];
              pf[0] = __builtin_bit_cast(bf16x8, pack8(p)); pf[1] = __builtin_bit_cast(bf16x8, pack8(p + 8));
#pragma unroll
              for (int r = 0; r < 16; ++r) p[r] = sc1[r];
              pf[2] = __builtin_bit_cast(bf16x8, pack8(p)); pf[3] = __builtin_bit_cast(bf16x8, pack8(p + 8)); }
            bf16x8 vf[4];
#pragma unroll
            for (int d = 0; d < 4; ++d) vf[d] = *(const LAS bf16x8*)(vt + 32 * d * KSTR);
#pragma unroll
            for (int g = 0; g < 4; ++g) {
                bf16x8 vn[4];
                if (g + 1 < 4) {
#pragma unroll
                    for (int d = 0; d < 4; ++d) vn[d] = *(const LAS bf16x8*)(vt + 32 * d * KSTR + 16 * (g + 1));
                }
#pragma unroll
                for (int d = 0; d < 4; ++d) o[d] = __builtin_amdgcn_mfma_f32_32x32x16_bf16(vf[d], pf[g], o[d], 0, 0, 0);
                if (g + 1 < 4) {
#pragma unroll
                    for (int d = 0; d < 4; ++d) vf[d] = vn[d];
                }
            }
            if (role != 0 && hasN) qk_next();
            if (t + 3 < nt) asm volatile("s_waitcnt vmcnt(%0)" :: "i"(NI) : "memory");
            else asm volatile("s_waitcnt vmcnt(0)" ::: "memory");
            asm volatile("s_waitcnt lgkmcnt(0)" ::: "memory");
            __builtin_amdgcn_s_barrier(); asm volatile("" ::: "memory");
            sc0 = sn0; sc1 = sn1;
            const int tmp = s0off; s0off = s1off; s1off = s2off; s2off = tmp;
        }
        lrun += __shfl_xor(lrun, 32);
        const float rl = 1.f / lrun;
#pragma unroll
        for (int d = 0; d < 4; ++d) o[d] = o[d] * rl;
    }
};

__device__ __forceinline__ void mla_attn_unit(const Ctx& X0, const PRef& P, int b, int h, int q0, int is_ctx) {
    const Ctx X = fresh(X0);
    unsigned char* ws = P.ws();
    const int lane = X.lane, r32 = lane & 31, hi = lane >> 5;
    const int row = (is_ctx ? M_LAT + b * CTXL : b * SEQ) + q0 + 32 * X.wave + r32;
    const bf16_t* Q = (const bf16_t*)(ws + WS_QM) + ((size_t)h * M_ALL + row) * 192;
    const bf16_t* K = (const bf16_t*)(ws + WS_KM) + (size_t)(b * 8 + h) * TK * 192;
    const bf16_t* Vt = (const bf16_t*)(ws + WS_VTM) + (size_t)(b * 8 + h) * 128 * TK;
    f32x16 o[4];
    AttnCore<192, 192>::run(X, Q, 0, K, Vt, is_ctx ? 4 : NCH, o);
    bf16_t* mix = (bf16_t*)(ws + WS_AB) + (size_t)row * DM + 1024 + h * 128;
#pragma unroll
    for (int d = 0; d < 4; ++d)
#pragma unroll
        for (int q = 0; q < 4; ++q) { u32x2 w; w.x = pk2(o[d][4 * q], o[d][4 * q + 1]); w.y = pk2(o[d][4 * q + 2], o[d][4 * q + 3]); *(u32x2*)(mix + 32 * d + 8 * q + 4 * hi) = w; }
}
__device__ __forceinline__ void da_attn_unit(const Ctx& X0, const PRef& P, int l, int b, int h, int q0, int is_ctx, float lam, float lam_init) {
    const Ctx X = fresh(X0);
    unsigned char* ws = P.ws();
    const int lane = X.lane, r32 = lane & 31, hi = lane >> 5;
    const int comp = X.wave >> 2, qs = X.wave & 3;
    const int row = (is_ctx ? M_LAT + b * CTXL : b * SEQ) + q0 + 32 * qs + r32;
    const bf16_t* Q = (const bf16_t*)(ws + WS_QDA) + ((size_t)h * M_ALL + row) * 128 + comp * 64;
    const bf16_t* K = (const bf16_t*)(ws + WS_KDA) + (size_t)(b * 4 + h) * TK * 128;
    const bf16_t* Vt = (const bf16_t*)(ws + WS_VTDA) + (size_t)(b * 4 + h) * 128 * TK;
    f32x16 o[4];
    AttnCoreP<64, 128>::run(X, Q, comp * 64, K, Vt, is_ctx ? 4 : NCH, o);
    float* xch = (float*)X.lds;
    if (comp == 1) {
#pragma unroll
        for (int d = 0; d < 4; ++d)
#pragma unroll
            for (int r = 0; r < 16; ++r) xch[(qs * 64 + d * 16 + r) * 64 + lane] = o[d][r];
    }
    __syncthreads();
    if (comp == 0) {
        float ss = 0.f;
#pragma unroll
        for (int d = 0; d < 4; ++d)
#pragma unroll
            for (int r = 0; r < 16; ++r) { o[d][r] -= lam * xch[(qs * 64 + d * 16 + r) * 64 + lane]; ss += o[d][r] * o[d][r]; }
        ss += __shfl_xor(ss, 32);
        float li_ = lam_init; asm volatile("" : "+s"(li_));
        const float rstd = rsqrtf(ss * (1.f / 128.f) + EPS) * (1.f - li_);
        const float* og = P.in(I_DAOUTG) + l * 128;
        bf16_t* mix = (bf16_t*)(ws + WS_AB) + (size_t)row * DM + h * 128;
#pragma unroll
        for (int d = 0; d < 4; ++d)
#pragma unroll
            for (int q = 0; q < 4; ++q) { const int dv = 32 * d + 8 * q + 4 * hi; const f32x4 gg = *(const f32x4*)(og + dv);
                u32x2 w; w.x = pk2(o[d][4 * q] * rstd * gg[0], o[d][4 * q + 1] * rstd * gg[1]); w.y = pk2(o[d][4 * q + 2] * rstd * gg[2], o[d][4 * q + 3] * rstd * gg[3]);
                *(u32x2*)(mix + dv) = w; }
    }
    __syncthreads();
}

__device__ __forceinline__ void mixer_phase(const Ctx& X, const PRef& P, int l) {
    const bool need_ctx = l < DEPTH - 1;
    STAMPN(20);
    const int vcu = (X.nwg % 8 == 0) ? (X.wg % 8) * (X.nwg / 8) + X.wg / 8 : X.wg;
    if (EN(13)) for (int u = vcu; u < 512; u += X.nwg) mla_attn_unit(X, P, u >> 7, (u >> 4) & 7, (u & 15) * 256, 0);
    STAMPN(11);
    float lam, lam_init;
    { const float* lp = P.in(I_DALAM) + l * 256;
      float s1 = 0.f, s2 = 0.f;
      for (int i = 0; i < 64; ++i) { s1 += lp[i] * lp[64 + i]; s2 += lp[128 + i] * lp[192 + i]; }
      const float li = 0.8f - 0.6f * expf(-0.3f * (float)l);
      const float la = expf(s1) - expf(s2) + li;
      lam = __builtin_bit_cast(float, __builtin_amdgcn_readfirstlane(__builtin_bit_cast(int, la)));
      lam_init = __builtin_bit_cast(float, __builtin_amdgcn_readfirstlane(__builtin_bit_cast(int, li))); }
    if (EN(14)) for (int v = vcu; v < 512; v += X.nwg) da_attn_unit(X, P, l, v >> 7, (v >> 5) & 3, (v & 31) * 128, 0, lam, lam_init);
    STAMPN(12);
    if (EN(15)) for (int u = (X.wg + X.nwg / 2) % X.nwg; u < 16 * NCH; u += X.nwg) mlstm_c_unit(X, P, l, u);
    STAMPN(13);
    if (need_ctx) {
        if (EN(13)) for (int v = X.wg; v < 32; v += X.nwg) mla_attn_unit(X, P, v >> 3, v & 7, 0, 1);
        if (EN(14)) for (int v = X.nwg - 1 - X.wg; v < 32; v += X.nwg) da_attn_unit(X, P, l, v >> 3, (v >> 1) & 3, (v & 1) * 128, 1, lam, lam_init);
    }
}

__global__ void __launch_bounds__(512, 2) fwd_megakernel(Params Pk) {
    const PRef P;
    extern __shared__ __attribute__((aligned(16))) unsigned char lds[];
    cg::grid_group grid = cg::this_grid();
    Ctx X; X.lds = lds; X.tid = threadIdx.x; X.lane = X.tid & 63; X.wave = __builtin_amdgcn_readfirstlane(X.tid >> 6);
    X.nwg = gridDim.x; X.wg = blockIdx.x; X.gw = X.wg * 8 + X.wave; X.ngw = X.nwg * 8;
    LAS unsigned char* lds3 = (LAS unsigned char*)lds; X.l3off = (unsigned)(uintptr_t)lds3;
    unsigned char* ws = P.ws();
    if (threadIdx.x < 16) ((LAS unsigned*)(lds3 + 135168 + 64))[threadIdx.x] = 0u;
    __syncthreads();
    (void)xcd_barrier_post((unsigned*)(ws + WS_BAR), (volatile LAS unsigned*)(lds3 + 135168 + 64));
    float* R_lat = P.out(); float* R_ctx = (float*)(ws + WS_RCTX);
    bf16_t* AB = (bf16_t*)(ws + WS_AB);

#ifdef PROBE_CAT
    if (blockIdx.x == 0 && threadIdx.x == 0) { volatile unsigned long long* tp_ = (volatile unsigned long long*)(P.ws() + WS_END); tp_[0] = __builtin_amdgcn_s_memrealtime(); tp_[1] = 0; tp_[2] = 0; }
#endif
    const int tail_lo = X.nwg > 64 ? 32 : 0;
    if (EN(0)) mod_gemv(X, P, 0, 1, 0);
    if (EN(1)) convert_weights(X, P, 0, 0, 0);
    grid.sync();
#ifdef PROBE_CAT
    STAMP(0);
#endif
    for (int l = 0; l < DEPTH; ++l) {
        const float* modl = (const float*)(ws + WS_MOD) + (size_t)l * 5 * 6 * DM;
        const float* xin_lat = l == 0 ? P.in(I_X) : R_lat; const float* xin_ctx = l == 0 ? P.in(I_CTX) : R_ctx;
        const int Mfin = l < DEPTH - 1 ? M_ALL : M_LAT;
        if (EN(2)) modulate_phase(X, xin_lat, xin_ctx, P.in(I_N1G) + l * DM, modl, 0 * DM, 1 * DM, AB, M_ALL);
        STAMP(1);
        if (EN(3)) { pg8::Gemm g{AB, (const bf16_t*)(ws + WS_WIN), M_ALL, NPROJ, DM}; pg8::StaticOrder S; S.init(M_ALL, NPROJ, X.nwg, X.wg);
          pg8::EpiBf16 E{(bf16_t*)(ws + WS_PROJ), NPROJ, (float*)(ws + WS_GATES), C_GATE / 256};
          pg8::gemm_phase<pg8::EpiBf16>(lds3, g, S, E); }
        STAMP(2);
        if (EN(4)) prep_phase(X, P, l);
        STAMP(3);
        if (EN(5)) { pg8::Gemm g{(const bf16_t*)(ws + WS_CQN), (const bf16_t*)(ws + WS_WUQ), M_ALL, 1536, 512}; pg8::StaticOrder S; S.init(M_ALL, 1536, X.nwg, X.wg);
          pg8::EpiBf16 E{(bf16_t*)(ws + WS_QUP), 1536, nullptr, 0};
          pg8::gemm_phase<pg8::EpiBf16>(lds3, g, S, E); }
        if (EN(5)) { pg8::Gemm g{(const bf16_t*)(ws + WS_CKVN), (const bf16_t*)(ws + WS_WUKV), M_ALL, 2048, 256}; pg8::StaticOrder S; S.init(M_ALL, 2048, X.nwg, X.nwg - 1 - X.wg);
          pg8::EpiBf16 E{(bf16_t*)(ws + WS_KVUP), 2048, nullptr, 0};
          pg8::gemm_phase<pg8::EpiBf16>(lds3, g, S, E); }
        __syncthreads();
        if (EN(6)) mlstm_a_phase(X, P, l);
        STAMP(4);
        if (EN(7)) mla_prep_phase(X, P, l);
        if (EN(8)) mlstm_scan_phase(X, P);
        STAMP(5);
        if (EN(9)) mixer_phase(X, P, l);
        STAMP(6);
        if (EN(10)) { pg8::Gemm g{AB, (const bf16_t*)(ws + WS_WOUT), Mfin, DM, DM}; pg8::StaticOrder S; S.init(Mfin, DM, X.nwg, X.wg);
          pg8::EpiRes E{xin_lat, xin_ctx, R_lat, R_ctx, modl + 2 * DM};
          pg8::gemm_phase<pg8::EpiRes>(lds3, g, S, E); }
        if (EN(0)) if (l + 1 < DEPTH) { __syncthreads(); mod_gemv(X, P, l + 1, l + 2, tail_lo); }
        STAMP(7);
        if (EN(2)) modulate_phase(X, R_lat, R_ctx, P.in(I_N2G) + l * DM, modl, 3 * DM, 4 * DM, AB, Mfin);
        STAMP(1);
        if (EN(11)) { pg8::Gemm g{AB, (const bf16_t*)(ws + WS_WGU), Mfin, 2 * FF, DM}; pg8::StaticOrder S; S.init(Mfin, 2 * FF, X.nwg, X.wg);
          pg8::EpiSwiGLU E{(bf16_t*)(ws + WS_HID), FF};
          pg8::gemm_phase<pg8::EpiSwiGLU>(lds3, g, S, E); }
        STAMP(9);
        if (EN(12)) { pg8::Gemm g{(const bf16_t*)(ws + WS_HID), (const bf16_t*)(ws + ((l & 1) ? WS_WDN2 : WS_WDN)), Mfin, DM, FF}; pg8::StaticOrder S; S.init(Mfin, DM, X.nwg, X.wg);
          pg8::EpiRes E{R_lat, R_ctx, R_lat, R_ctx, modl + 5 * DM};
          pg8::gemm_phase<pg8::EpiRes>(lds3, g, S, E); }
        if (EN(1)) if (l + 1 < DEPTH) { __syncthreads(); convert_weights(X, P, l + 1, 0, tail_lo); }
#ifdef PROBE_CAT
        STAMP(10);
#else
        if (l + 1 < DEPTH) xcd_barrier(P.ws());
#endif
    }
#ifdef PROBE_CAT
    if (blockIdx.x == 0 && threadIdx.x == 0) P.out()[0] += (float)(((volatile unsigned long long*)(P.ws() + WS_END))[1]) * (0.01f / PROBE_SCALE);
#endif
}

extern "C" void kernel_launch(void* const* d_in, const int* in_sizes, int n_in, void* d_out, int out_size, void* d_ws, size_t ws_size, hipStream_t stream) {
    static int grid = 0;
    if (grid == 0) {
        if (n_in != 24 || ws_size < WS_END) { fprintf(stderr, "kernel_launch: unexpected inputs (n_in %d, ws %zu)\n", n_in, ws_size); grid = -1; return; }
        int dev = 0, cus = 0, per_cu = 0;
        (void)hipGetDevice(&dev); (void)hipDeviceGetAttribute(&cus, hipDeviceAttributeMultiprocessorCount, dev);
        if (hipFuncSetAttribute((const void*)fwd_megakernel, hipFuncAttributeMaxDynamicSharedMemorySize, LDS_BYTES) != hipSuccess) { fprintf(stderr, "kernel_launch: hipFuncSetAttribute failed\n"); grid = -1; return; }
        (void)hipOccupancyMaxActiveBlocksPerMultiprocessor(&per_cu, (const void*)fwd_megakernel, 512, LDS_BYTES);
        (void)hipGetLastError();
        if (per_cu < 1) { fprintf(stderr, "kernel_launch: occupancy query says %d\n", per_cu); per_cu = 1; }
        grid = cus;
    }
    if (grid < 0) return;
    if (hipMemsetAsync((char*)d_ws + WS_BAR, 0, XCD_BAR_WORDS * 4, stream) != hipSuccess) { fprintf(stderr, "kernel_launch: memset failed\n"); return; }
    Params p{};
    for (int i = 0; i < 24; ++i) p.in[i] = (const float*)d_in[i];
    p.out = (float*)d_out; p.ws = (unsigned char*)d_ws;
    void* args[] = {&p};
    hipError_t e = hipLaunchCooperativeKernel((const void*)fwd_megakernel, dim3(grid), dim3(512), args, LDS_BYTES, stream);
    if (e != hipSuccess) fprintf(stderr, "cooperative launch failed: %s (grid %d)\n", hipGetErrorString(e), grid);
}
```

```cpp
#include <hip/hip_runtime.h>
#include <hip/hip_cooperative_groups.h>
#include <cstdio>
#include <cstdint>
namespace cg = cooperative_groups;

#define LAS __attribute__((address_space(3)))
typedef unsigned short bf16_t;
typedef short bf16x8 __attribute__((ext_vector_type(8)));
typedef float f32x4 __attribute__((ext_vector_type(4)));
typedef float f32x16 __attribute__((ext_vector_type(16)));
typedef unsigned u32x4 __attribute__((ext_vector_type(4)));
typedef unsigned u32x2 __attribute__((ext_vector_type(2)));

constexpr int DM = 2048, BATCH = 4, SEQ = 4096, CTXL = 256, DEPTH = 2;
constexpr int M_LAT = BATCH * SEQ, M_CTX = BATCH * CTXL, M_ALL = M_LAT + M_CTX;
constexpr int TK = CTXL + SEQ;
constexpr int NCH = TK / 64;
constexpr int IN_W = 4432, NPROJ = 4608, FF = 5632;
constexpr int C_DAQ = 0, C_DAK = 512, C_DAV = 1024, C_MLQ = 1536, C_MLK = 2048, C_MLV = 2560, C_MLO = 3072, C_GATE = 3584, C_CQ = 3600, C_CKV = 4112, C_KPE = 4368;
constexpr float EPS = 1e-6f;
constexpr float LOG2E = 1.4426950408889634f;
constexpr float RESC_THR = 8.0f;

constexpr size_t MiB = 1u << 20;
constexpr size_t WS_WIN = 0, WS_WOUT = 18 * MiB, WS_WGU = 26 * MiB, WS_WDN = 70 * MiB, WS_WUQ = 92 * MiB, WS_WUKV = 94 * MiB, WS_MOD = 95 * MiB, WS_RCTX = 96 * MiB;
constexpr size_t WS_AB = 104 * MiB;
constexpr size_t WS_PROJ = 172 * MiB;
constexpr size_t WS_QUP = 172 * MiB, WS_KVUP = 223 * MiB, WS_HID = 172 * MiB;
constexpr size_t WS_GATES = 325 * MiB, WS_CQN = 327 * MiB, WS_CKVN = 344 * MiB, WS_KPE = 353 * MiB, WS_OCOPY = 356 * MiB;
constexpr size_t WS_QDA = 373 * MiB, WS_KDA = 390 * MiB, WS_VTDA = 407 * MiB, WS_QML = 424 * MiB, WS_KML = 441 * MiB, WS_KTML = 458 * MiB, WS_VTML = 475 * MiB;
constexpr size_t WS_QM = 492 * MiB, WS_KM = 543 * MiB, WS_VTM = 594 * MiB, WS_CSNAP = 628 * MiB, WS_NSNAP = 696 * MiB, WS_NU = 698 * MiB, WS_CSTAT = 700 * MiB, WS_BAR = 701 * MiB, WS_WDN2 = 702 * MiB, WS_END = 724 * MiB;
static_assert((size_t)NPROJ * DM * 2 <= 18 * MiB && (size_t)2 * FF * DM * 2 <= 44 * MiB && (size_t)M_ALL * NPROJ * 2 <= 153 * MiB, "ws map");
static_assert(WS_HID + (size_t)M_ALL * FF * 2 <= WS_QDA, "hid overlay");
static_assert(WS_END <= 768 * MiB, "ws fits the guaranteed minimum");

constexpr int LDS_BYTES = 140 * 1024;
#ifndef PH_EN
#define PH_EN 0xFFFF
#endif
#define EN(k) ((PH_EN >> (k)) & 1)
#ifdef PROBE_CAT
#define STAMP(cat) do { xcd_barrier(P.ws()); if (blockIdx.x == 0 && threadIdx.x == 0) { volatile unsigned long long* tp_ = (volatile unsigned long long*)(P.ws() + WS_END); const unsigned long long t1_ = __builtin_amdgcn_s_memrealtime(); if ((1 << (cat)) & PROBE_CAT) tp_[1] += t1_ - tp_[0]; if ((1 << (cat)) & PROBE_CAT2) tp_[2] += t1_ - tp_[0]; tp_[0] = t1_; } } while (0)
#define STAMPN(cat) do { __syncthreads(); if (blockIdx.x == 0 && threadIdx.x == 0) { volatile unsigned long long* tp_ = (volatile unsigned long long*)(P.ws() + WS_END); const unsigned long long t1_ = __builtin_amdgcn_s_memrealtime(); if ((1 << (cat)) & PROBE_CAT) tp_[1] += t1_ - tp_[0]; tp_[0] = t1_; } } while (0)
#else
#define STAMPN(cat) do {} while (0)
#define STAMP(cat) xcd_barrier(P.ws())
#endif

#define LOG2E_ 1.4426950408889634f
__device__ __forceinline__ unsigned f2bf(float f) { unsigned u = __builtin_bit_cast(unsigned, f); return (u + 0x7fffu + ((u >> 16) & 1u)) >> 16; }
typedef float f32x2_t __attribute__((ext_vector_type(2))); typedef __bf16 bf16x2_t __attribute__((ext_vector_type(2)));
__device__ __forceinline__ unsigned pk2(float lo, float hi) { f32x2_t v = {lo, hi}; bf16x2_t b = __builtin_convertvector(v, bf16x2_t); return __builtin_bit_cast(unsigned, b); }
__device__ __forceinline__ float bflo(unsigned w) { return __builtin_bit_cast(float, w << 16); }
__device__ __forceinline__ float bfhi(unsigned w) { return __builtin_bit_cast(float, w & 0xffff0000u); }
__device__ __forceinline__ float bf1(bf16_t h) { return __builtin_bit_cast(float, (unsigned)h << 16); }
__device__ __forceinline__ void unpack8(const u32x4 w, float* v) { v[0] = bflo(w.x); v[1] = bfhi(w.x); v[2] = bflo(w.y); v[3] = bfhi(w.y); v[4] = bflo(w.z); v[5] = bfhi(w.z); v[6] = bflo(w.w); v[7] = bfhi(w.w); }
__device__ __forceinline__ u32x4 pack8(const float* v) { u32x4 w; w.x = pk2(v[0], v[1]); w.y = pk2(v[2], v[3]); w.z = pk2(v[4], v[5]); w.w = pk2(v[6], v[7]); return w; }
__device__ __forceinline__ float wave_sum(float v) {
#pragma unroll
    for (int o = 1; o < 64; o <<= 1) v += __shfl_xor(v, o);
    return v;
}
__device__ __forceinline__ float wave_max(float v) {
#pragma unroll
    for (int o = 1; o < 64; o <<= 1) v = fmaxf(v, __shfl_xor(v, o));
    return v;
}
__device__ __forceinline__ float siluf(float x) { return x * __builtin_amdgcn_rcpf(1.f + __builtin_amdgcn_exp2f(-LOG2E_ * x)); }
__device__ __forceinline__ float sigmf(float x) { return __builtin_amdgcn_rcpf(1.f + __builtin_amdgcn_exp2f(-LOG2E_ * x)); }
__device__ __forceinline__ int crow(int r, int hi) { return (r & 3) + 8 * (r >> 2) + 4 * hi; }
__device__ __forceinline__ int perm_off(int p) { const int h = p >> 3, j = p & 7; return 8 * (j >> 2) + 4 * h + (j & 3); }
__device__ __forceinline__ int mod_batch(int row) { return row < M_LAT ? (row >> 12) : 4; }

namespace pg8 {
constexpr int BM = 256, BK = 64, HALF = 128, HTB = HALF * BK * 2, STAGE_BYTES = 8 * HTB, NXCD = 8, WGM = 8;
__host__ __device__ __forceinline__ int lds_byte(int r, int c) { const int st = (r >> 4) * 2 + (c >> 5), rr = r & 15, cc = c & 31, ob = rr * 64 + cc * 2; return st * 1024 + (ob ^ (((ob >> 9) & 1) << 5)); }
__host__ __device__ __forceinline__ void stage_rc(int b, int& R, int& C) { const int st = b / 1024, sb = b % 1024, swz = sb ^ (((sb >> 9) & 1) << 5); R = (st >> 1) * 16 + swz / 64; C = (st & 1) * 32 + (swz % 64) / 2; }
__host__ __device__ __forceinline__ int perm32(int rho) { const int n = rho >> 4, i = rho & 15; return 8 * (i >> 2) + 4 * n + (i & 3); }

struct Unit { int pm, pn; };
struct Gemm { const bf16_t* A; const bf16_t* Bt; int M, N, K; };

struct StaticOrder {
    int nM, nN, nwg, G, c;
    __device__ void init(int M, int N, int G_, int c_) { nM = M / BM; nN = N / BM; nwg = nM * nN; G = G_; c = c_; }
    __device__ bool next(int i, Unit& u) const {
        const long L = (long)i * G + c; if (L >= nwg) return false;
        int wgid = (int)L; { const int q = nwg / NXCD, r = nwg % NXCD, xcd = wgid % NXCD, off = wgid / NXCD; wgid = (xcd < r ? xcd * (q + 1) : r * (q + 1) + (xcd - r) * q) + off; }
        const int nig = WGM * nN, gid = wgid / nig, fm = gid * WGM, gsz = (nM - fm) < WGM ? (nM - fm) : WGM;
        u.pm = fm + ((wgid % nig) % gsz); u.pn = (wgid % nig) / gsz; return true;
    }
};

struct EpiBf16 {
    static constexpr bool PERM = true;
    bf16_t* O; int ldc; float* gates; int gate_pn;
    __device__ __forceinline__ void operator()(const f32x4 (&acc)[2][2][4][2], const Unit& u, int wr, int wc, int fr, int fq) const {
        const int row0 = u.pm * BM + wr * 64 + fr; const int col0 = u.pn * BM + wc * 32 + 8 * fq;
        const bool g = gates != nullptr && u.pn == gate_pn && wc == 0 && fq < 2;
#pragma unroll
        for (int ai = 0; ai < 2; ++ai)
#pragma unroll
            for (int m = 0; m < 4; ++m) { const int row = row0 + ai * HALF + m * 16; bf16_t* rowp = O + (size_t)row * ldc + col0;
#pragma unroll
                for (int bj = 0; bj < 2; ++bj) { const f32x4 v0 = acc[ai][bj][m][0], v1 = acc[ai][bj][m][1];
                    u32x4 w; w.x = pk2(v0[0], v0[1]); w.y = pk2(v0[2], v0[3]); w.z = pk2(v1[0], v1[1]); w.w = pk2(v1[2], v1[3]);
                    *(u32x4*)(rowp + bj * HALF) = w;
                    if (bj == 0 && g) { *(f32x4*)(gates + (size_t)row * 16 + 8 * fq) = v0; *(f32x4*)(gates + (size_t)row * 16 + 8 * fq + 4) = v1; } } }
    }
};
struct EpiSwiGLU {
    static constexpr bool PERM = true;
    bf16_t* O; int ldc;
    __device__ __forceinline__ void operator()(const f32x4 (&acc)[2][2][4][2], const Unit& u, int wr, int wc, int fr, int fq) const {
        const int row0 = u.pm * BM + wr * 64 + fr; const int col0 = u.pn * HALF + wc * 32 + 8 * fq;
#pragma unroll
        for (int ai = 0; ai < 2; ++ai)
#pragma unroll
            for (int m = 0; m < 4; ++m) { const int row = row0 + ai * HALF + m * 16;
                float o[8];
#pragma unroll
                for (int n = 0; n < 2; ++n)
#pragma unroll
                    for (int i = 0; i < 4; ++i) { const float gt = acc[ai][0][m][n][i], up = acc[ai][1][m][n][i]; o[4 * n + i] = siluf(gt) * up; }
                *(u32x4*)(O + (size_t)row * ldc + col0) = pack8(o); }
    }
};
struct EpiRes {
    static constexpr bool PERM = false;
    const float* res_lat; const float* res_ctx; float* out_lat; float* out_ctx; const float* gate;
    __device__ __forceinline__ void operator()(const f32x4 (&acc)[2][2][4][2], const Unit& u, int wr, int wc, int fr, int fq) const {
        const int row0 = u.pm * BM + wr * 64 + fr; const int col0 = u.pn * BM + wc * 32 + 4 * fq;
#pragma unroll
        for (int ai = 0; ai < 2; ++ai)
#pragma unroll
            for (int m = 0; m < 4; ++m) { const int row = row0 + ai * HALF + m * 16;
                const float* rp = row < M_LAT ? res_lat + (size_t)row * DM : res_ctx + (size_t)(row - M_LAT) * DM;
                float* op = row < M_LAT ? out_lat + (size_t)row * DM : out_ctx + (size_t)(row - M_LAT) * DM;
                const float* gp = gate + (size_t)mod_batch(row) * 6 * DM;
#pragma unroll
                for (int bj = 0; bj < 2; ++bj)
#pragma unroll
                    for (int n = 0; n < 2; ++n) { const int c = col0 + bj * HALF + n * 16;
                        const f32x4 r = *(const f32x4*)(rp + c), g = *(const f32x4*)(gp + c);
                        *(f32x4*)(op + c) = r + g * acc[ai][bj][m][n]; } }
    }
};

template <class Epi, bool ALIGN_EPI = true>
__device__ __forceinline__ void gemm_phase(LAS unsigned char* lds, const Gemm g, const StaticOrder& S, const Epi& E) {
    int tid = threadIdx.x; asm volatile("" : "+v"(tid)); const int wid = __builtin_amdgcn_readfirstlane(tid >> 6), lane = tid & 63, wr = wid >> 2, wc = wid & 3, fr = lane & 15, fq = lane >> 4;
    int K = g.K; asm volatile("" : "+s"(K)); const int nt = K / BK;
    unsigned voffA[2], voffB[2];
#pragma unroll
    for (int i = 0; i < 2; ++i) { int R, C; stage_rc(tid * 16 + i * 8192, R, C); const int Rb = Epi::PERM ? ((R & ~31) + perm32(R & 31)) : R;
        voffA[i] = (unsigned)(R * K + C) * 2u; voffB[i] = (unsigned)(Rb * K + C) * 2u; }
    const size_t kstep = (size_t)(BK * 2);
    const size_t hstep = (size_t)HALF * K * 2;
    const size_t tstep = 2 * hstep;
    const unsigned ldsw = (unsigned)wid * 1024u;
    const int aoff = lds_byte(wr * 64 + fr, fq * 8), boff = lds_byte(wc * 32 + fr, fq * 8);
#define PG8_SA(b, h) (((b) * 2 + (h)) * HTB)
#define PG8_SB(b, h) ((4 + (b) * 2 + (h)) * HTB)
#define PG8_STAGE(bufoff, gbase, voff) do { _Pragma("unroll") for (int _i = 0; _i < 2; ++_i) \
        __builtin_amdgcn_global_load_lds((const unsigned*)((const char*)(gbase) + (voff)[_i]), (LAS unsigned*)(lds + (bufoff) + ldsw + _i * 8192), 16, 0, 0); } while (0)
#define PG8_LDA(dst, b, h) do { _Pragma("unroll") for (int m = 0; m < 4; ++m) _Pragma("unroll") for (int k = 0; k < 2; ++k) dst[m][k] = *(const LAS bf16x8*)(lds + PG8_SA(b, h) + aoff + m * 2048 + k * 1024); } while (0)
#define PG8_LDB(dst, b, h) do { _Pragma("unroll") for (int n = 0; n < 2; ++n) _Pragma("unroll") for (int k = 0; k < 2; ++k) dst[n][k] = *(const LAS bf16x8*)(lds + PG8_SB(b, h) + boff + n * 2048 + k * 1024); } while (0)
#define PG8_MMA(ai, bj, At, Bt) do { __builtin_amdgcn_s_setprio(1); _Pragma("unroll") for (int m = 0; m < 4; ++m) _Pragma("unroll") for (int n = 0; n < 2; ++n) _Pragma("unroll") for (int k = 0; k < 2; ++k) \
        acc[ai][bj][m][n] = __builtin_amdgcn_mfma_f32_16x16x32_bf16(Bt[n][k], At[m][k], acc[ai][bj][m][n], 0, 0, 0); __builtin_amdgcn_s_setprio(0); } while (0)
#define PG8_WAIT_V(n) asm volatile("s_waitcnt vmcnt(" #n ")" ::: "memory")
#define PG8_WAIT_L(n) asm volatile("s_waitcnt lgkmcnt(" #n ")" ::: "memory")
#define PG8_BAR __builtin_amdgcn_s_barrier()
#define PG8_SCHED __builtin_amdgcn_sched_barrier(0)
    Unit cur, nxt; int ui = 0;
    if (!S.next(0, cur)) return;
    f32x4 acc[2][2][4][2];
#pragma unroll
    for (int a = 0; a < 2; ++a)
#pragma unroll
        for (int b = 0; b < 2; ++b)
#pragma unroll
            for (int m = 0; m < 4; ++m)
#pragma unroll
                for (int n = 0; n < 2; ++n) acc[a][b][m][n] = (f32x4){0.f, 0.f, 0.f, 0.f};
    bf16x8 At[4][2], B0[2][2], B1[2][2];
    const char* cA = (const char*)g.A + (size_t)cur.pm * tstep; const char* cB = (const char*)g.Bt + (size_t)cur.pn * tstep;
    PG8_STAGE(PG8_SB(0, 0), cB, voffB); PG8_STAGE(PG8_SB(0, 1), cB + hstep, voffB); PG8_STAGE(PG8_SA(0, 0), cA, voffA); PG8_STAGE(PG8_SA(0, 1), cA + hstep, voffA);
    if (wr == 1) PG8_BAR;
    PG8_WAIT_V(2); PG8_BAR;
    PG8_STAGE(PG8_SB(1, 0), cB + kstep, voffB); PG8_STAGE(PG8_SA(1, 0), cA + kstep, voffA); PG8_STAGE(PG8_SB(1, 1), cB + hstep + kstep, voffB);
    PG8_WAIT_V(6); PG8_BAR;
    for (;;) {
        const bool has_next = S.next(ui + 1, nxt);
        const char* nA = has_next ? (const char*)g.A + (size_t)nxt.pm * tstep : cA; const char* nB = has_next ? (const char*)g.Bt + (size_t)nxt.pn * tstep : cB;
        for (int t = 0; t < nt; t += 2) {
            const bool last = (t == nt - 2);
            const char* a1 = cA + (size_t)(t + 1) * kstep;
            const char* a2 = last ? nA : cA + (size_t)(t + 2) * kstep; const char* b2 = last ? nB : cB + (size_t)(t + 2) * kstep;
            const char* a3 = a2 + kstep; const char* b3 = b2 + kstep;
            PG8_LDB(B0, 0, 0); PG8_LDB(B1, 0, 1); PG8_SCHED; PG8_LDA(At, 0, 0); PG8_STAGE(PG8_SA(1, 1), a1 + hstep, voffA);
            PG8_WAIT_V(8); PG8_WAIT_L(0); PG8_BAR; PG8_MMA(0, 0, At, B0); PG8_MMA(0, 1, At, B1); PG8_BAR; PG8_SCHED;
            PG8_LDA(At, 0, 1); PG8_STAGE(PG8_SB(0, 0), b2, voffB); PG8_STAGE(PG8_SB(0, 1), b2 + hstep, voffB); PG8_STAGE(PG8_SA(0, 0), a2, voffA);
            PG8_WAIT_V(8); PG8_WAIT_L(0); PG8_BAR; PG8_MMA(1, 0, At, B0); PG8_MMA(1, 1, At, B1); PG8_BAR; PG8_SCHED;
            PG8_LDB(B0, 1, 0); PG8_LDB(B1, 1, 1); PG8_SCHED; PG8_LDA(At, 1, 0); PG8_STAGE(PG8_SA(0, 1), a2 + hstep, voffA);
            PG8_WAIT_V(8); PG8_WAIT_L(0); PG8_BAR; PG8_MMA(0, 0, At, B0); PG8_MMA(0, 1, At, B1); PG8_BAR; PG8_SCHED;
            PG8_LDA(At, 1, 1); PG8_STAGE(PG8_SB(1, 0), b3, voffB); PG8_STAGE(PG8_SB(1, 1), b3 + hstep, voffB); PG8_STAGE(PG8_SA(1, 0), a3, voffA);
            PG8_WAIT_V(8); PG8_WAIT_L(0); PG8_BAR; PG8_MMA(1, 0, At, B0); PG8_MMA(1, 1, At, B1); PG8_BAR; PG8_SCHED;
        }
        if constexpr (ALIGN_EPI) { if (wr == 0) PG8_BAR; }
        E(acc, cur, wr, wc, fr, fq);
        if (!has_next) break;
#pragma unroll
        for (int a = 0; a < 2; ++a)
#pragma unroll
            for (int b = 0; b < 2; ++b)
#pragma unroll
                for (int m = 0; m < 4; ++m)
#pragma unroll
                    for (int n = 0; n < 2; ++n) acc[a][b][m][n] = (f32x4){0.f, 0.f, 0.f, 0.f};
        cur = nxt; cA = nA; cB = nB; ++ui;
        if constexpr (ALIGN_EPI) { if (wr == 1) PG8_BAR; }
    }
    PG8_WAIT_V(0);
    if constexpr (!ALIGN_EPI) { if (wr == 0) PG8_BAR; }
    PG8_BAR;
#undef PG8_SA
#undef PG8_SB
#undef PG8_STAGE
#undef PG8_LDA
#undef PG8_LDB
#undef PG8_MMA
#undef PG8_WAIT_V
#undef PG8_WAIT_L
#undef PG8_BAR
#undef PG8_SCHED
}
}


#define XB_TMO      128
#define XB_XCNT(j)  (256  + 64 * (j))
#define XB_XSUB(j)  (1280 + 64 * (j))
#define XB_XGEN(j)  (2304 + 64 * (j))
#define XB_TOP      3328
#define XB_TOPGEN   3392
#define XCD_BAR_WORDS 3456
#define XB_SPIN_CAP (1u << 22)
__device__ __forceinline__ unsigned xb_ld(unsigned* p)              { return __hip_atomic_load(p, __ATOMIC_RELAXED, __HIP_MEMORY_SCOPE_AGENT); }
__device__ __forceinline__ unsigned xb_add(unsigned* p, unsigned v) { return __hip_atomic_fetch_add(p, v, __ATOMIC_RELAXED, __HIP_MEMORY_SCOPE_AGENT); }
__device__ __forceinline__ unsigned xb_xcc_id() { return (unsigned)__builtin_amdgcn_s_getreg((3 << 11) | 20) & 0xFu; }
#define XB_SPIN(cond, bar) do { unsigned _sp = 0; while (cond) { __builtin_amdgcn_s_sleep(1); \
    if ((++_sp & 255u) == 0u) { if (xb_ld(&(bar)[XB_TMO])) break; if (_sp > XB_SPIN_CAP) { atomicAdd(&(bar)[XB_TMO], 1u); break; } } } } while (0)
struct XcdBarrier { unsigned* bar; unsigned x; volatile LAS unsigned* st; };
__device__ __forceinline__ XcdBarrier xcd_barrier_post(unsigned* bar, volatile LAS unsigned* st) {
    XcdBarrier b; b.bar = bar; b.x = xb_xcc_id(); b.st = st;
    if (threadIdx.x == 0) (void)xb_add(&bar[XB_XCNT(b.x)], 1u);
    return b;
}
__device__ __forceinline__ void xcd_barrier_complete(unsigned* bar, unsigned x, unsigned& nloc, unsigned& nx) {
    const unsigned G = gridDim.x * gridDim.y * gridDim.z;
    unsigned sum, cnt, mine, sp = 0u;
    for (;;) {
        sum = 0u; cnt = 0u; mine = 0u;
#pragma unroll
        for (unsigned j = 0; j < 16; ++j) { const unsigned c = xb_ld(&bar[XB_XCNT(j)]); sum += c; cnt += (c > 0u) ? 1u : 0u; mine = (j == x) ? c : mine; }
        if (sum == G) break;
        __builtin_amdgcn_s_sleep(1);
        if ((++sp & 255u) == 0u) { if (xb_ld(&bar[XB_TMO])) break; if (sp > XB_SPIN_CAP) { atomicAdd(&bar[XB_TMO], 1u); break; } }
    }
    nloc = mine > 0u ? mine : 1u; nx = cnt > 0u ? cnt : 1u;
}
__device__ __forceinline__ void xcd_barrier(unsigned char* wsb) {
    XcdBarrier b; b.bar = (unsigned*)(wsb + WS_BAR); b.x = 0; b.st = (volatile LAS unsigned*)(135168 + 64);
    asm volatile("s_waitcnt vmcnt(0)" ::: "memory");
    __syncthreads();
    if (threadIdx.x == 0) {
        unsigned* bar = b.bar; b.x = xb_xcc_id();
        __builtin_amdgcn_s_waitcnt(0);
        unsigned nloc = b.st[0], nx = b.st[1];
        if (nloc == 0u) { xcd_barrier_complete(bar, b.x, nloc, nx); b.st[0] = nloc; b.st[1] = nx; }
        const unsigned old = xb_add(&bar[XB_XSUB(b.x)], 1u);
        const unsigned gen = old / nloc;
        if (old + 1u == (gen + 1u) * nloc) {
            __builtin_amdgcn_fence(__ATOMIC_RELEASE, "agent");
            asm volatile("s_waitcnt vmcnt(0)" ::: "memory");
            const unsigned og = xb_add(&bar[XB_TOP], 1u);
            const unsigned tg = og / nx;
            if (og + 1u == (tg + 1u) * nx) xb_add(&bar[XB_TOPGEN], 1u);
            else XB_SPIN(xb_ld(&bar[XB_TOPGEN]) == tg, bar);
            __builtin_amdgcn_fence(__ATOMIC_ACQUIRE, "agent");
            xb_add(&bar[XB_XGEN(b.x)], 1u);
            asm volatile("s_waitcnt vmcnt(0)" ::: "memory");
        } else {
            XB_SPIN(xb_ld(&bar[XB_XGEN(b.x)]) == gen, bar);
            __builtin_amdgcn_fence(__ATOMIC_ACQUIRE, "agent");
            asm volatile("s_waitcnt vmcnt(0)" ::: "memory");
        }
    }
    __syncthreads();
}

struct Params { const float* in[24]; float* out; unsigned char* ws; };
struct PRef {
    typedef const __attribute__((address_space(4))) char* kptr_t;
    __device__ __forceinline__ kptr_t base() const { kptr_t ka = (kptr_t)__builtin_amdgcn_kernarg_segment_ptr(); asm volatile("" : "+s"(ka)); return ka; }
    __device__ __forceinline__ const float* in(int i) const { return *(const float* const __attribute__((address_space(4)))*)(base() + 8 * i); }
    __device__ __forceinline__ float* out() const { return *(float* const __attribute__((address_space(4)))*)(base() + 8 * 24); }
    __device__ __forceinline__ unsigned char* ws() const { return *(unsigned char* const __attribute__((address_space(4)))*)(base() + 8 * 25); }
};
enum { I_X = 0, I_C, I_CTX, I_CCTX, I_MODW, I_MODB, I_N1G, I_N2G, I_WIN, I_DAQKG, I_DALAM, I_DAOUTG, I_CONVW, I_CONVB, I_GATEB, I_MLOUTG, I_QNG, I_KVNG, I_WUQ, I_WUKV, I_MLAQKG, I_WOUT, I_WGU, I_WDN };

struct Ctx {
    unsigned char* lds;
    int tid, lane, wave, gw, ngw, nwg, wg; unsigned l3off;
};

__device__ __forceinline__ Ctx fresh(const Ctx& X) {
    Ctx Y = X; int t = X.tid; asm volatile("" : "+v"(t)); Y.tid = t; Y.lane = t & 63; Y.wave = __builtin_amdgcn_readfirstlane(t >> 6); return Y;
}
template <int MODE>
__device__ __forceinline__ void transpose_item(const float* W, int K, int N, bf16_t* WT, float* scr, int item, int nblk, int lane) {
    const int kb = item / nblk, nb = item % nblk, k0 = 64 * kb, n0 = 32 * nb;
    const int ncol = n0 + (lane & 31); const bool ok = ncol < N;
#pragma unroll 8
    for (int i = 0; i < 32; ++i) { const int kk = 2 * i + (lane >> 5); scr[kk * 33 + (lane & 31)] = ok ? W[(size_t)(k0 + kk) * N + ncol] : 0.f; }
    asm volatile("s_waitcnt lgkmcnt(0)" ::: "memory");
    const int c = lane & 7;
#pragma unroll
    for (int j = 0; j < 4; ++j) { const int n = (lane >> 3) + 8 * j; const float* s = scr + (8 * c) * 33 + n;
        u32x4 o; o.x = pk2(s[0 * 33], s[1 * 33]); o.y = pk2(s[2 * 33], s[3 * 33]); o.z = pk2(s[4 * 33], s[5 * 33]); o.w = pk2(s[6 * 33], s[7 * 33]);
        int nn = n0 + n;
        if (MODE == 1) { const int up = nn >= FF ? 1 : 0; const int hcol = nn - up * FF; nn = (hcol >> 7) * 256 + up * 128 + (hcol & 127); }
        *(u32x4*)(WT + (size_t)nn * K + k0 + 8 * c) = o; }
    asm volatile("s_waitcnt lgkmcnt(0)" ::: "memory");
}
__device__ __forceinline__ void convert_weights(const Ctx& X0, const PRef& P, int l, int part, int wg_lo) {
    const Ctx X = fresh(X0);
    const int vwg = X.wg - wg_lo; if (vwg < 0) return;
    const int gwv = vwg * 8 + X.wave, ngwv = (X.nwg - wg_lo) * 8;
    float* scr = (float*)(X.lds + X.wave * 16384);
    unsigned char* ws = P.ws();
    constexpr int I_IN = (DM / 64) * (NPROJ / 32), I_OUT = (DM / 64) * (DM / 32), I_GU = (DM / 64) * (2 * FF / 32), I_DN = (FF / 64) * (DM / 32), I_UQ = (512 / 64) * (1536 / 32), I_UKV = (256 / 64) * (2048 / 32);
    constexpr int NITEMS = I_IN + I_OUT + I_GU + I_DN + I_UQ + I_UKV;
    const int it_lo = part == 2 ? NITEMS - I_DN : 0, it_hi = part == 1 ? NITEMS - I_DN : NITEMS;
    for (int it = it_lo + gwv; it < it_hi; it += ngwv) {
        int r = it;
        if (r < I_IN) { transpose_item<0>(P.in(I_WIN) + (size_t)l * DM * IN_W, DM, IN_W, (bf16_t*)(ws + WS_WIN), scr, r, NPROJ / 32, X.lane); continue; } r -= I_IN;
        if (r < I_OUT) { transpose_item<0>(P.in(I_WOUT) + (size_t)l * DM * DM, DM, DM, (bf16_t*)(ws + WS_WOUT), scr, r, DM / 32, X.lane); continue; } r -= I_OUT;
        if (r < I_GU) { transpose_item<1>(P.in(I_WGU) + (size_t)l * DM * 2 * FF, DM, 2 * FF, (bf16_t*)(ws + WS_WGU), scr, r, 2 * FF / 32, X.lane); continue; } r -= I_GU;
        if (r < I_UQ) { transpose_item<0>(P.in(I_WUQ) + (size_t)l * 512 * 1536, 512, 1536, (bf16_t*)(ws + WS_WUQ), scr, r, 1536 / 32, X.lane); continue; } r -= I_UQ;
        if (r < I_UKV) { transpose_item<0>(P.in(I_WUKV) + (size_t)l * 256 * 2048, 256, 2048, (bf16_t*)(ws + WS_WUKV), scr, r, 2048 / 32, X.lane); continue; } r -= I_UKV;
        transpose_item<0>(P.in(I_WDN) + (size_t)l * FF * DM, FF, DM, (bf16_t*)(ws + ((l & 1) ? WS_WDN2 : WS_WDN)), scr, r, DM / 32, X.lane);
    }
}
__device__ __forceinline__ void mod_gemv(const Ctx& X0, const PRef& P, int l_lo, int l_hi, int wg_lo) {
    const Ctx X = fresh(X0);
    const int vwg = X.wg - wg_lo; if (vwg < 0) return;
    float* sc = (float*)X.lds;
    float* red = (float*)(X.lds + 40960);
    for (int i = X.tid; i < 5 * DM; i += 512) { const int mb = i / DM, k = i % DM; const float v = mb < 4 ? P.in(I_C)[mb * DM + k] : P.in(I_CCTX)[k]; sc[i] = siluf(v); }
    __syncthreads();
    float* mod = (float*)(P.ws() + WS_MOD);
    const int kq = X.tid >> 4, c4 = X.tid & 15;
    for (int task = vwg; task < (l_hi - l_lo) * 192; task += X.nwg - wg_lo) {
        const int l = l_lo + task / 192, n0 = (task % 192) * 64;
        const float* W = P.in(I_MODW) + (size_t)l * DM * 6 * DM + n0 + 4 * c4;
        f32x4 a[5];
#pragma unroll
        for (int mb = 0; mb < 5; ++mb) a[mb] = (f32x4){0.f, 0.f, 0.f, 0.f};
#pragma unroll 8
        for (int i = 0; i < 64; ++i) { const int k = kq + 32 * i; const f32x4 w = *(const f32x4*)(W + (size_t)k * 6 * DM);
#pragma unroll
            for (int mb = 0; mb < 5; ++mb) a[mb] += w * sc[mb * DM + k]; }
#pragma unroll
        for (int mb = 0; mb < 5; ++mb) *(f32x4*)(red + (kq * 5 + mb) * 64 + 4 * c4) = a[mb];
        __syncthreads();
        if (X.tid < 320) { const int mb = X.tid >> 6, cc = X.tid & 63; float s = 0.f;
#pragma unroll 8
            for (int q = 0; q < 32; ++q) s += red[(q * 5 + mb) * 64 + cc];
            mod[((size_t)l * 5 + mb) * 6 * DM + n0 + cc] = s + P.in(I_MODB)[(size_t)l * 6 * DM + n0 + cc]; }
        __syncthreads();
    }
}

__device__ __forceinline__ void modulate_phase(const Ctx& X0, const float* src_lat, const float* src_ctx, const float* g, const float* modl, int shift_off, int scale_off, bf16_t* A, int nrows) {
    const Ctx X = fresh(X0);
    const int rpw = (nrows + X.ngw - 1) / X.ngw;
    int row = X.gw * rpw; const int rend = min(row + rpw, nrows);
    f32x4 v[8], nx[8], gm[8], sh[8];
    int cur_mb = -1;
    if (row < rend) { const float* src = row < M_LAT ? src_lat + (size_t)row * DM : src_ctx + (size_t)(row - M_LAT) * DM;
#pragma unroll
        for (int j = 0; j < 8; ++j) v[j] = *(const f32x4*)(src + X.lane * 4 + 256 * j); }
    for (; row < rend; ++row) {
        const int nrow = row + 1;
        if (nrow < rend) { const float* src = nrow < M_LAT ? src_lat + (size_t)nrow * DM : src_ctx + (size_t)(nrow - M_LAT) * DM;
#pragma unroll
            for (int j = 0; j < 8; ++j) nx[j] = *(const f32x4*)(src + X.lane * 4 + 256 * j); }
        const int mb = mod_batch(row);
        if (mb != cur_mb) { cur_mb = mb; const float* mp = modl + (size_t)mb * 6 * DM;
#pragma unroll
            for (int j = 0; j < 8; ++j) { const int col = X.lane * 4 + 256 * j; gm[j] = *(const f32x4*)(g + col) * (*(const f32x4*)(mp + scale_off + col) + 1.0f); sh[j] = *(const f32x4*)(mp + shift_off + col); } }
        float ss = 0.f;
#pragma unroll
        for (int j = 0; j < 8; ++j) ss += (v[j][0] * v[j][0] + v[j][1] * v[j][1]) + (v[j][2] * v[j][2] + v[j][3] * v[j][3]);
        const float rstd = rsqrtf(wave_sum(ss) * (1.f / DM) + EPS);
#pragma unroll
        for (int j = 0; j < 8; ++j) { const int col = X.lane * 4 + 256 * j;
            const f32x4 y = (v[j] * rstd) * gm[j] + sh[j];
            u32x2 w; w.x = pk2(y[0], y[1]); w.y = pk2(y[2], y[3]);
            *(u32x2*)(A + (size_t)row * DM + col) = w; }
#pragma unroll
        for (int j = 0; j < 8; ++j) v[j] = nx[j];
    }
}

struct ChunkId { int b, j, row0, tok0, is_lat, seglen; };
__device__ __forceinline__ ChunkId chunk_of_unit(int u) {
    ChunkId c;
    if (u < 256) { c.b = u >> 6; c.j = u & 63; c.row0 = c.b * SEQ + 64 * c.j; c.tok0 = CTXL + 64 * c.j; c.is_lat = 1; c.seglen = SEQ; }
    else { const int uu = u - 256; c.b = uu >> 2; c.j = uu & 3; c.row0 = M_LAT + c.b * CTXL + 64 * c.j; c.tok0 = 64 * c.j; c.is_lat = 0; c.seglen = CTXL; }
    return c;
}
__device__ __forceinline__ int row_of_tokchunk(int b, int jt) { return jt < 4 ? M_LAT + b * CTXL + 64 * jt : b * SEQ + 64 * (jt - 4); }

constexpr int TSTR = 520;
__device__ __forceinline__ void write_vt(const Ctx& X, const bf16_t* tile, bf16_t* img, size_t img_row0, int tok0) {
#pragma unroll 2
    for (int it = 0; it < 8; ++it) { const int task = it * 512 + X.tid; const int k = task & 7, c = task >> 3;
        float v[8];
#pragma unroll
        for (int jj = 0; jj < 8; ++jj) { const int i = 16 * (k >> 1) + 8 * (jj >> 2) + 4 * (k & 1) + (jj & 3); v[jj] = bf1(tile[i * TSTR + c]); }
        *(u32x4*)(img + (img_row0 + c) * TK + tok0 + 8 * k) = pack8(v); }
}
template <class F>
__device__ __forceinline__ void load_tile(const Ctx& X, bf16_t* tile, const bf16_t* src, size_t rstride, F colmap) {
#pragma unroll 4
    for (int it = 0; it < 8; ++it) { const int ch = it * 512 + X.tid; const int i = ch >> 6, cc = ch & 63;
        const u32x4 w = *(const u32x4*)(src + (size_t)i * rstride + colmap(cc));
        *(u32x4*)(tile + i * TSTR + 8 * cc) = w; }
}

__device__ __forceinline__ void rope_cs(int sub, int prow, int pcol, float* cs, float* sn) {
    const float pos = (float)((sub < 4) ? prow : pcol);
#pragma unroll
    for (int e = 0; e < 8; ++e) { const int fi = (sub & 1) * 8 + e; const float inv = exp2f(-(float)fi * (13.287712379549449f / 16.0f)); const float a = pos * inv; cs[e] = __cosf(a); sn[e] = __sinf(a); }
}
__device__ __forceinline__ void rope_apply(int sub, float* y, const float* cs, const float* sn) {
#pragma unroll
    for (int e = 0; e < 8; ++e) { const float p = __shfl_xor(y[e], 2); y[e] = (sub & 2) ? (y[e] * cs[e] + p * sn[e]) : (y[e] * cs[e] - p * sn[e]); }
}

__device__ __forceinline__ void prep_phase(const Ctx& X0, const PRef& P, int l) {
    const Ctx X = fresh(X0);
    unsigned char* ws = P.ws();
    const bf16_t* proj = (const bf16_t*)(ws + WS_PROJ);
    bf16_t* tile = (bf16_t*)X.lds;
    const float* qkg = P.in(I_DAQKG) + l * 128;
    const float* convw = P.in(I_CONVW) + (size_t)l * 3 * 1024; const float* convb = P.in(I_CONVB) + l * 1024;
    const float* qng = P.in(I_QNG) + l * 512; const float* kvng = P.in(I_KVNG) + l * 256;
    const int lane = X.lane, sub = lane & 7;
    const float qscale = 0.125f * LOG2E;
    for (int uu = X.wg; uu < 4 * 272; uu += X.nwg) {
        const int part = uu / 272, u = uu % 272;
        const ChunkId c = chunk_of_unit(u);
        if (part == 0) {
        struct R0 { u32x4 q, k, cq, ckv, kpe, o; };
        auto ld0 = [&](int i_) { R0 r; const bf16_t* pr_ = proj + (size_t)(c.row0 + i_) * NPROJ; const u32x4 z = {0u, 0u, 0u, 0u};
            r.q = *(const u32x4*)(pr_ + C_DAQ + 8 * lane); r.k = *(const u32x4*)(pr_ + C_DAK + 8 * lane); r.cq = *(const u32x4*)(pr_ + C_CQ + 8 * lane);
            r.ckv = z; if (lane < 32) r.ckv = *(const u32x4*)(pr_ + C_CKV + 8 * lane);
            r.kpe = z; if (lane < 8) r.kpe = *(const u32x4*)(pr_ + C_KPE + 8 * lane);
            r.o = *(const u32x4*)(pr_ + C_MLO + 8 * lane); return r; };
        R0 cur = ld0(X.wave);
        for (int i = X.wave; i < 64; i += 8) {
            R0 nxt = cur; if (i + 8 < 64) nxt = ld0(i + 8);
            const int row = c.row0 + i, tok = c.tok0 + i;
            float cs[8], sn[8];
            if (c.is_lat) rope_cs(sub, c.j, i, cs, sn);
#pragma unroll
            for (int qk = 0; qk < 2; ++qk) {
                float y[8]; unpack8(qk ? cur.k : cur.q, y);
                float ss = 0.f;
#pragma unroll
                for (int e = 0; e < 8; ++e) ss += y[e] * y[e];
                ss += __shfl_xor(ss, 1); ss += __shfl_xor(ss, 2); ss += __shfl_xor(ss, 4);
                const float rstd = rsqrtf(ss * (1.f / 64.f) + EPS);
#pragma unroll
                for (int e = 0; e < 8; ++e) y[e] = y[e] * rstd * qkg[qk * 64 + 8 * sub + e];
                if (c.is_lat) rope_apply(sub, y, cs, sn);
                const int head = lane >> 4, comp = (lane >> 3) & 1;
                if (qk == 0) {
#pragma unroll
                    for (int e = 0; e < 8; ++e) y[e] *= qscale;
                    *(u32x4*)((bf16_t*)(ws + WS_QDA) + ((size_t)head * M_ALL + row) * 128 + comp * 64 + 8 * sub) = pack8(y);
                } else {
                    *(u32x4*)((bf16_t*)(ws + WS_KDA) + ((size_t)(c.b * 4 + head) * TK + tok) * 128 + comp * 64 + 8 * sub) = pack8(y);
                }
            }
            {
                float y[8]; unpack8(cur.cq, y);
                float ss = 0.f;
#pragma unroll
                for (int e = 0; e < 8; ++e) ss += y[e] * y[e];
                const float rstd = rsqrtf(wave_sum(ss) * (1.f / 512.f) + EPS);
#pragma unroll
                for (int e = 0; e < 8; ++e) y[e] = y[e] * rstd * qng[8 * lane + e];
                *(u32x4*)((bf16_t*)(ws + WS_CQN) + (size_t)row * 512 + 8 * lane) = pack8(y);
            }
            {
                float y[8]; unpack8(cur.ckv, y);
                float ss = 0.f;
#pragma unroll
                for (int e = 0; e < 8; ++e) ss += y[e] * y[e];
                const float rstd = rsqrtf(wave_sum(ss) * (1.f / 256.f) + EPS);
                if (lane < 32) {
#pragma unroll
                    for (int e = 0; e < 8; ++e) y[e] = y[e] * rstd * kvng[8 * lane + e];
                    *(u32x4*)((bf16_t*)(ws + WS_CKVN) + (size_t)row * 256 + 8 * lane) = pack8(y);
                }
            }
            if (lane < 8) *(u32x4*)((bf16_t*)(ws + WS_KPE) + (size_t)row * 64 + 8 * lane) = cur.kpe;
            *(u32x4*)((bf16_t*)(ws + WS_OCOPY) + (size_t)row * 512 + 8 * lane) = cur.o;
            cur = nxt;
        }
        } else if (part == 1) {
        struct R1 { u32x4 x0[2], xm[2], xp[2]; };
        auto ld1 = [&](int i_) { R1 r; const int tseg_ = 64 * c.j + i_; const bf16_t* pr_ = proj + (size_t)(c.row0 + i_) * NPROJ + C_MLQ; const u32x4 z = {0u, 0u, 0u, 0u};
#pragma unroll
            for (int qk = 0; qk < 2; ++qk) { const int ch0 = qk * 512 + 8 * lane;
                r.x0[qk] = *(const u32x4*)(pr_ + ch0);
                r.xm[qk] = z; if (tseg_ > 0) r.xm[qk] = *(const u32x4*)(pr_ - NPROJ + ch0);
                r.xp[qk] = z; if (tseg_ < c.seglen - 1) r.xp[qk] = *(const u32x4*)(pr_ + NPROJ + ch0); }
            return r; };
        R1 cur = ld1(X.wave);
        for (int i = X.wave; i < 64; i += 8) {
            R1 nxt = cur; if (i + 8 < 64) nxt = ld1(i + 8);
            const int tok = c.tok0 + i;
#pragma unroll
            for (int qk = 0; qk < 2; ++qk) {
                const int ch0 = qk * 512 + 8 * lane;
                float xm[8], x0[8], xp[8];
                unpack8(cur.x0[qk], x0); unpack8(cur.xm[qk], xm); unpack8(cur.xp[qk], xp);
                float y[8];
#pragma unroll
                for (int e = 0; e < 8; ++e) { const float v = convb[ch0 + e] + convw[ch0 + e] * xm[e] + convw[1024 + ch0 + e] * x0[e] + convw[2048 + ch0 + e] * xp[e]; y[e] = siluf(v) * (qk ? 0.08838834764831845f : 1.0f); }
                const int head = lane >> 4, d = 8 * (lane & 15);
                const u32x4 w = pack8(y);
                *(u32x4*)((bf16_t*)(ws + (qk ? WS_KML : WS_QML)) + ((size_t)(c.b * 4 + head) * TK + tok) * 128 + d) = w;
                if (qk) *(u32x4*)(tile + i * TSTR + 8 * lane) = w;
            }
            cur = nxt;
        }
        __syncthreads();
        write_vt(X, tile, (bf16_t*)(ws + WS_KTML), (size_t)c.b * 512, c.tok0);
        __syncthreads();
        } else if (part == 2) {
        load_tile(X, tile, proj + (size_t)c.row0 * NPROJ, NPROJ, [](int cc) { return C_DAV + 8 * cc; });
        __syncthreads();
        write_vt(X, tile, (bf16_t*)(ws + WS_VTDA), (size_t)c.b * 512, c.tok0);
        __syncthreads();
        } else {
        load_tile(X, tile, proj + (size_t)c.row0 * NPROJ, NPROJ, [](int cc) { return C_MLV + 8 * cc; });
        __syncthreads();
        write_vt(X, tile, (bf16_t*)(ws + WS_VTML), (size_t)c.b * 512, c.tok0);
        __syncthreads();
        }
    }
}

__device__ __forceinline__ void mla_prep_phase(const Ctx& X0, const PRef& P, int l) {
    const Ctx X = fresh(X0);
    unsigned char* ws = P.ws();
    const bf16_t* qup = (const bf16_t*)(ws + WS_QUP); const bf16_t* kvup = (const bf16_t*)(ws + WS_KVUP); const bf16_t* kpe = (const bf16_t*)(ws + WS_KPE);
    bf16_t* tile = (bf16_t*)X.lds;
    const float* g = P.in(I_MLAQKG) + l * 2 * 192;
    const int lane = X.lane, sub = lane & 7, head = lane >> 3;
    const float qscale = 0.07216878364870322f * LOG2E;
    for (int uu = X.wg; uu < 3 * 272; uu += X.nwg) {
        const int part = uu / 272, u = uu % 272;
        const ChunkId c = chunk_of_unit(u);
        if (part == 0) {
        struct R2 { u32x4 q[3], k[3]; };
        auto ld2 = [&](int i_) { R2 r; const size_t row_ = (size_t)(c.row0 + i_);
#pragma unroll
            for (int cc = 0; cc < 3; ++cc) r.q[cc] = *(const u32x4*)(qup + row_ * 1536 + head * 192 + 64 * cc + 8 * sub);
#pragma unroll
            for (int cc = 0; cc < 2; ++cc) r.k[cc] = *(const u32x4*)(kvup + row_ * 2048 + head * 256 + 64 * cc + 8 * sub);
            r.k[2] = *(const u32x4*)(kpe + row_ * 64 + 8 * sub); return r; };
        R2 cur = ld2(X.wave);
        for (int i = X.wave; i < 64; i += 8) {
            R2 nxt = cur; if (i + 8 < 64) nxt = ld2(i + 8);
            const int row = c.row0 + i, tok = c.tok0 + i;
            float cs[8], sn[8];
            if (c.is_lat) rope_cs(sub, c.j, i, cs, sn);
#pragma unroll
            for (int qk = 0; qk < 2; ++qk) {
                float y[3][8];
#pragma unroll
                for (int cc = 0; cc < 3; ++cc) unpack8(qk == 0 ? cur.q[cc] : cur.k[cc], y[cc]);
                float ss = 0.f;
#pragma unroll
                for (int cc = 0; cc < 3; ++cc)
#pragma unroll
                    for (int e = 0; e < 8; ++e) ss += y[cc][e] * y[cc][e];
                ss += __shfl_xor(ss, 1); ss += __shfl_xor(ss, 2); ss += __shfl_xor(ss, 4);
                const float rstd = rsqrtf(ss * (1.f / 192.f) + EPS);
#pragma unroll
                for (int cc = 0; cc < 3; ++cc)
#pragma unroll
                    for (int e = 0; e < 8; ++e) y[cc][e] = y[cc][e] * rstd * g[qk * 192 + 64 * cc + 8 * sub + e];
                if (c.is_lat) rope_apply(sub, y[2], cs, sn);
                bf16_t* dst;
                if (qk == 0) {
#pragma unroll
                    for (int cc = 0; cc < 3; ++cc)
#pragma unroll
                        for (int e = 0; e < 8; ++e) y[cc][e] *= qscale;
                    dst = (bf16_t*)(ws + WS_QM) + ((size_t)head * M_ALL + row) * 192;
                } else dst = (bf16_t*)(ws + WS_KM) + ((size_t)(c.b * 8 + head) * TK + tok) * 192;
#pragma unroll
                for (int cc = 0; cc < 3; ++cc) *(u32x4*)(dst + 64 * cc + 8 * sub) = pack8(y[cc]);
            }
            cur = nxt;
        }
        } else {
            const int p = part - 1;
            load_tile(X, tile, kvup + (size_t)c.row0 * 2048, 2048, [p](int cc) { return (4 * p + (cc >> 4)) * 256 + 128 + 8 * (cc & 15); });
            __syncthreads();
            write_vt(X, tile, (bf16_t*)(ws + WS_VTM), (size_t)(c.b * 8 + 4 * p) * 128, c.tok0);
            __syncthreads();
        }
    }
}

__device__ __forceinline__ void ml_gates(const float* gates, const float* gb, int b, int jt, int dir, int h, int lane, float& ig, float& lf, float& pre, float& total) {
    const int row = row_of_tokchunk(b, jt) + lane;
    ig = gates[(size_t)row * 16 + dir * 8 + h] + gb[dir * 8 + h];
    const float fg = gates[(size_t)row * 16 + dir * 8 + 4 + h] + gb[dir * 8 + 4 + h];
    lf = fminf(fg, 0.f) - log1pf(__expf(-fabsf(fg)));
    float s = lf;
#pragma unroll
    for (int o = 1; o < 64; o <<= 1) { const float t = __shfl_up(s, o); if (lane >= o) s += t; }
    pre = s; total = __shfl(s, 63);
}
constexpr int KSTR = 72;
constexpr int QSTR = 136;
__device__ __forceinline__ void mlstm_a_phase(const Ctx& X0, const PRef& P, int l) {
    const Ctx X = fresh(X0);
    unsigned char* ws = P.ws();
    const float* gates = (const float*)(ws + WS_GATES); const float* gb = P.in(I_GATEB) + l * 16;
    bf16_t* Kt = (bf16_t*)X.lds;
    bf16_t* Vw = (bf16_t*)(X.lds + 128 * KSTR * 2);
    float* wtab = (float*)(X.lds + 3 * 128 * KSTR * 2);
    const int lane = X.lane, r32 = lane & 31, hi = lane >> 5;
    for (int u = (X.wg + X.nwg - 152 % X.nwg) % X.nwg; u < 16 * NCH; u += X.nwg) {
        const int bh = u / NCH, jt = u % NCH, b = bh >> 2, h = bh & 3, tok0 = 64 * jt;
        if (X.wave < 2) {
            const int dir = X.wave; float ig, lf, pre, total; ml_gates(gates, gb, b, jt, dir, h, lane, ig, lf, pre, total);
            const float cum = dir == 0 ? pre : total - pre + lf;
            const float wlog = total - cum + ig; const float mloc = wave_max(wlog);
            wtab[dir * 64 + lane] = __expf(wlog - mloc);
            if (lane == 0) { float* cs = (float*)(ws + WS_CSTAT) + ((size_t)(bh * 2 + dir) * NCH + jt) * 4; cs[0] = total; cs[1] = mloc; }
        }
        u32x4 vr[2];
#pragma unroll
        for (int it = 0; it < 2; ++it) { const int ch = it * 512 + X.tid; const int rr = ch >> 3, k = ch & 7;
            *(u32x4*)(Kt + rr * KSTR + 8 * k) = *(const u32x4*)((const bf16_t*)(ws + WS_KTML) + ((size_t)bh * 128 + rr) * TK + tok0 + 8 * k);
            vr[it] = *(const u32x4*)((const bf16_t*)(ws + WS_VTML) + ((size_t)bh * 128 + rr) * TK + tok0 + 8 * k); }
        __syncthreads();
#pragma unroll
        for (int it = 0; it < 2; ++it) { const int ch = it * 512 + X.tid; const int rr = ch >> 3, k = ch & 7;
            float v[8]; unpack8(vr[it], v);
#pragma unroll
            for (int dir = 0; dir < 2; ++dir) { float o[8];
#pragma unroll
                for (int jj = 0; jj < 8; ++jj) { const int i = 16 * (k >> 1) + 8 * (jj >> 2) + 4 * (k & 1) + (jj & 3); o[jj] = v[jj] * wtab[dir * 64 + i]; }
                *(u32x4*)(Vw + (dir * 128 + rr) * KSTR + 8 * k) = pack8(o); } }
        __syncthreads();
        {
            const int dir = X.wave >> 2, dvb = X.wave & 3;
            bf16_t* U = (bf16_t*)(ws + WS_AB) + ((size_t)(bh * 2 + dir) * NCH + jt) * 16384;
            bf16x8 a[4];
#pragma unroll
            for (int ks = 0; ks < 4; ++ks) a[ks] = *(const bf16x8*)(Vw + (dir * 128 + 32 * dvb + r32) * KSTR + 16 * ks + 8 * hi);
            for (int dkb = 0; dkb < 4; ++dkb) {
                f32x16 acc;
#pragma unroll
                for (int r = 0; r < 16; ++r) acc[r] = 0.f;
#pragma unroll
                for (int ks = 0; ks < 4; ++ks) { const bf16x8 bb = *(const bf16x8*)(Kt + (32 * dkb + r32) * KSTR + 16 * ks + 8 * hi); acc = __builtin_amdgcn_mfma_f32_32x32x16_bf16(a[ks], bb, acc, 0, 0, 0); }
#pragma unroll
                for (int r = 0; r < 16; ++r) U[(32 * dvb + crow(r, hi)) * 128 + 32 * dkb + r32] = (bf16_t)(pk2(acc[r], 0.f) & 0xffffu);
            }
        }
        if (X.tid < 256) { const int dir = X.tid >> 7, dk = X.tid & 127; float s = 0.f;
#pragma unroll 8
            for (int p = 0; p < 64; ++p) { const int i = (p & ~15) + perm_off(p & 15); s += wtab[dir * 64 + i] * bf1(Kt[dk * KSTR + p]); }
            ((float*)(ws + WS_NU))[((size_t)(bh * 2 + dir) * NCH + jt) * 128 + dk] = s; }
        __syncthreads();
    }
}
__device__ __forceinline__ int ml_jmap(int dir, int c) { return dir == 0 ? c : (c < 4 ? 3 - c : 71 - c); }
__device__ __forceinline__ void mlstm_scan_phase(const Ctx& X0, const PRef& P) {
    const Ctx X = fresh(X0);
    unsigned char* ws = P.ws();
    float* cstat = (float*)(ws + WS_CSTAT);
    const int gtid = (X.nwg - 1 - X.wg) * 512 + X.tid, nthr = X.nwg * 512;
    for (int task = gtid; task < 65536 + 1024; task += nthr) {
        float m = 0.f;
        if (task < 65536) {
            const int seq = task >> 11, e = task & 2047, dir = seq & 1;
            const bf16_t* __restrict__ U = (const bf16_t*)(ws + WS_AB); bf16_t* __restrict__ S = (bf16_t*)(ws + WS_CSNAP);
            float C[8];
#pragma unroll
            for (int i = 0; i < 8; ++i) C[i] = 0.f;
            for (int cb = 0; cb < 4; ++cb) {
                u32x4 uu[17]; float tot[17], mlc[17];
#pragma unroll
                for (int i = 0; i < 17; ++i) { const size_t base = (size_t)seq * NCH + ml_jmap(dir, cb * 17 + i);
                    uu[i] = *(const u32x4*)(U + base * 16384 + 8 * e); tot[i] = cstat[base * 4]; mlc[i] = cstat[base * 4 + 1]; }
#pragma unroll
                for (int i = 0; i < 17; ++i) { const size_t base = (size_t)seq * NCH + ml_jmap(dir, cb * 17 + i);
                    *(u32x4*)(S + base * 16384 + 8 * e) = pack8(C);
                    if (e == 0) cstat[base * 4 + 2] = m;
                    const float mn = fmaxf(tot[i] + m, mlc[i]); const float dec = __expf(tot[i] + m - mn), sc = __expf(mlc[i] - mn);
                    float u8[8]; unpack8(uu[i], u8);
#pragma unroll
                    for (int q = 0; q < 8; ++q) C[q] = C[q] * dec + u8[q] * sc;
                    m = mn; }
            }
        } else {
            const int t2 = task - 65536, seq = t2 >> 5, e4 = t2 & 31, dir = seq & 1;
            const float* __restrict__ NU = (const float*)(ws + WS_NU); float* __restrict__ NS = (float*)(ws + WS_NSNAP);
            f32x4 C = (f32x4){0.f, 0.f, 0.f, 0.f};
            for (int cb = 0; cb < 4; ++cb) {
                f32x4 uu[17]; float tot[17], mlc[17];
#pragma unroll
                for (int i = 0; i < 17; ++i) { const size_t base = (size_t)seq * NCH + ml_jmap(dir, cb * 17 + i);
                    uu[i] = *(const f32x4*)(NU + base * 128 + 4 * e4); tot[i] = cstat[base * 4]; mlc[i] = cstat[base * 4 + 1]; }
#pragma unroll
                for (int i = 0; i < 17; ++i) { const size_t base = (size_t)seq * NCH + ml_jmap(dir, cb * 17 + i);
                    *(f32x4*)(NS + base * 128 + 4 * e4) = C;
                    const float mn = fmaxf(tot[i] + m, mlc[i]); const float dec = __expf(tot[i] + m - mn), sc = __expf(mlc[i] - mn);
                    C = C * dec + uu[i] * sc; m = mn; }
            }
        }
    }
}
__device__ __forceinline__ void mlstm_c_unit(const Ctx& X0, const PRef& P, int l, int u) {
    const Ctx X = fresh(X0);
    unsigned char* ws = P.ws();
    const float* gates = (const float*)(ws + WS_GATES); const float* gb = P.in(I_GATEB) + l * 16;
    const float* cstat = (const float*)(ws + WS_CSTAT);
    bf16_t* Qt = (bf16_t*)X.lds;
    bf16_t* Kn = (bf16_t*)(X.lds + 64 * QSTR * 2);
    bf16_t* Vt = (bf16_t*)(X.lds + 2 * 64 * QSTR * 2);
    float* tab = (float*)(X.lds + 2 * 64 * QSTR * 2 + 128 * KSTR * 2);
    float* t_a = tab, *t_c1 = tab + 128, *t_wp = tab + 256, *t_em = tab + 384, *t_n = tab + 512, *t_red = tab + 768;
    const int lane = X.lane, r32 = lane & 31, hi = lane >> 5;
    const int bh = u / NCH, jt = u % NCH, b = bh >> 2, h = bh & 3, tok0 = 64 * jt;
    if (X.wave < 2) {
        const int dir = X.wave; float ig, lf, pre, total; ml_gates(gates, gb, b, jt, dir, h, lane, ig, lf, pre, total);
        const float cum = dir == 0 ? pre : total - pre + lf;
        const float a = ig - cum; float pm = a;
#pragma unroll
        for (int o = 1; o < 64; o <<= 1) { const float t = dir == 0 ? __shfl_up(pm, o) : __shfl_down(pm, o); const bool ok = dir == 0 ? (lane >= o) : (lane + o < 64); if (ok) pm = fmaxf(pm, t); }
        const float mc = cstat[((size_t)(bh * 2 + dir) * NCH + jt) * 4 + 2];
        const float mt = cum + fmaxf(mc, pm);
        t_a[dir * 64 + lane] = a; t_c1[dir * 64 + lane] = cum - mt; t_wp[dir * 64 + lane] = __expf(cum + mc - mt); t_em[dir * 64 + lane] = __expf(-mt);
    }
#pragma unroll
    for (int it = 0; it < 2; ++it) { const int ch = it * 512 + X.tid;
        { const int i = ch >> 4, k = ch & 15;
          *(u32x4*)(Qt + i * QSTR + 8 * k) = *(const u32x4*)((const bf16_t*)(ws + WS_QML) + ((size_t)bh * TK + tok0 + i) * 128 + 8 * k);
          *(u32x4*)(Kn + i * QSTR + 8 * k) = *(const u32x4*)((const bf16_t*)(ws + WS_KML) + ((size_t)bh * TK + tok0 + i) * 128 + 8 * k); }
        { const int rr = ch >> 3, k = ch & 7;
          *(u32x4*)(Vt + rr * KSTR + 8 * k) = *(const u32x4*)((const bf16_t*)(ws + WS_VTML) + ((size_t)bh * 128 + rr) * TK + tok0 + 8 * k); } }
    if (X.tid < 256) t_n[X.tid] = ((const float*)(ws + WS_NSNAP))[((size_t)(bh * 2 + (X.tid >> 7)) * NCH + jt) * 128 + (X.tid & 127)];
    __syncthreads();
    const int tb = X.wave & 1, db = X.wave >> 1, t = 32 * tb + r32;
    bf16x8 qf[8];
#pragma unroll
    for (int ks = 0; ks < 8; ++ks) qf[ks] = *(const bf16x8*)(Qt + t * QSTR + 16 * ks + 8 * hi);
    f32x16 st[2];
#pragma unroll
    for (int sb = 0; sb < 2; ++sb) {
#pragma unroll
        for (int r = 0; r < 16; ++r) st[sb][r] = 0.f;
#pragma unroll
        for (int ks = 0; ks < 8; ++ks) { const bf16x8 kf = *(const bf16x8*)(Kn + (32 * sb + r32) * QSTR + 16 * ks + 8 * hi); st[sb] = __builtin_amdgcn_mfma_f32_32x32x16_bf16(kf, qf[ks], st[sb], 0, 0, 0); }
    }
    f32x16 hsum;
#pragma unroll
    for (int r = 0; r < 16; ++r) hsum[r] = 0.f;
#pragma unroll
    for (int dir = 0; dir < 2; ++dir) {
        const float c1 = t_c1[dir * 64 + t], wp = t_wp[dir * 64 + t], em = t_em[dir * 64 + t];
        float rs = 0.f; u32x4 pw[2][2];
#pragma unroll
        for (int sb = 0; sb < 2; ++sb) { float p[16];
#pragma unroll
            for (int r = 0; r < 16; ++r) { const int s = 32 * sb + crow(r, hi); const bool ok = dir == 0 ? (s <= t) : (s >= t);
                const float dm = ok ? __expf(t_a[dir * 64 + s] + c1) : 0.f; p[r] = st[sb][r] * dm; rs += p[r]; }
            pw[sb][0] = pack8(p); pw[sb][1] = pack8(p + 8); }
        rs += __shfl_xor(rs, 32);
        float qn = 0.f;
#pragma unroll
        for (int ks = 0; ks < 8; ++ks) { float q8[8]; unpack8(__builtin_bit_cast(u32x4, qf[ks]), q8);
#pragma unroll
            for (int e = 0; e < 8; ++e) qn += q8[e] * t_n[dir * 128 + 16 * ks + 8 * hi + e]; }
        qn += __shfl_xor(qn, 32);
        const float den = rs + wp * qn; const float rden = 1.f / fmaxf(fabsf(den), em);
        f32x16 acc;
#pragma unroll
        for (int r = 0; r < 16; ++r) acc[r] = 0.f;
        const bf16_t* Cs = (const bf16_t*)(ws + WS_CSNAP) + ((size_t)(bh * 2 + dir) * NCH + jt) * 16384 + (size_t)(32 * db + r32) * 128;
#pragma unroll
        for (int ks = 0; ks < 8; ++ks) { const bf16x8 cf = *(const bf16x8*)(Cs + 16 * ks + 8 * hi); acc = __builtin_amdgcn_mfma_f32_32x32x16_bf16(cf, qf[ks], acc, 0, 0, 0); }
#pragma unroll
        for (int r = 0; r < 16; ++r) acc[r] *= wp;
#pragma unroll
        for (int sb = 0; sb < 2; ++sb)
#pragma unroll
            for (int s2 = 0; s2 < 2; ++s2) { const bf16x8 vf = *(const bf16x8*)(Vt + (32 * db + r32) * KSTR + 32 * sb + 16 * s2 + 8 * hi);
                acc = __builtin_amdgcn_mfma_f32_32x32x16_bf16(vf, __builtin_bit_cast(bf16x8, pw[sb][s2]), acc, 0, 0, 0); }
#pragma unroll
        for (int r = 0; r < 16; ++r) hsum[r] += acc[r] * rden;
    }
    float ss = 0.f;
#pragma unroll
    for (int r = 0; r < 16; ++r) ss += hsum[r] * hsum[r];
    ss += __shfl_xor(ss, 32);
    if (hi == 0) t_red[(tb * 4 + db) * 32 + r32] = ss;
    __syncthreads();
    const float tot = t_red[(tb * 4 + 0) * 32 + r32] + t_red[(tb * 4 + 1) * 32 + r32] + t_red[(tb * 4 + 2) * 32 + r32] + t_red[(tb * 4 + 3) * 32 + r32];
    const float rstd = rsqrtf(tot * (1.f / 128.f) + EPS);
    const int row = row_of_tokchunk(b, jt) + t;
    const float* og = P.in(I_MLOUTG) + l * 512 + h * 128;
    const bf16_t* oc = (const bf16_t*)(ws + WS_OCOPY) + (size_t)row * 512 + h * 128;
    bf16_t* mix = (bf16_t*)(ws + WS_AB) + (size_t)row * DM + 512 + h * 128;
#pragma unroll
    for (int q = 0; q < 4; ++q) { const int dv = 32 * db + 8 * q + 4 * hi;
        const u32x2 ow = *(const u32x2*)(oc + dv); const f32x4 gg = *(const f32x4*)(og + dv);
        const float o0 = hsum[4 * q + 0] * rstd * gg[0] * sigmf(bflo(ow.x)), o1 = hsum[4 * q + 1] * rstd * gg[1] * sigmf(bfhi(ow.x));
        const float o2 = hsum[4 * q + 2] * rstd * gg[2] * sigmf(bflo(ow.y)), o3 = hsum[4 * q + 3] * rstd * gg[3] * sigmf(bfhi(ow.y));
        u32x2 w; w.x = pk2(o0, o1); w.y = pk2(o2, o3); *(u32x2*)(mix + dv) = w; }
    __syncthreads();
}

template <int DQK, int KROW>
struct AttnCore {
    static constexpr int NKS = DQK / 16, NKC1 = KROW / 8 + 1, KS = NKC1 * 8, KT_B = 64 * NKC1 * 16, VT_B = 128 * 9 * 16, SLOT_B = KT_B + VT_B;
    static constexpr int NBK = KT_B / 1024, NBV = VT_B / 1024, NB = NBK + NBV, NI = (NB + 7) / 8;
    static_assert(KT_B % 1024 == 0 && VT_B % 1024 == 0 && 8 * NI - NB <= 8 && 3 * SLOT_B <= 135168, "attention LDS geometry");
    static __device__ __forceinline__ void run(const Ctx& X, const bf16_t* Qrow, int kcol, const bf16_t* K, const bf16_t* Vt, int nt, f32x16 (&o)[4]) {
        const int lane = X.lane, r32 = lane & 31, hi = lane >> 5;
        LAS unsigned char* l3 = (LAS unsigned char*)0 + X.l3off;
        bf16x8 qf[NKS];
#pragma unroll
        for (int ks = 0; ks < NKS; ++ks) qf[ks] = *(const bf16x8*)(Qrow + 16 * ks + 8 * hi);
        unsigned goff[NI]; int bsel[NI];
#pragma unroll
        for (int i = 0; i < NI; ++i) {
            int bidx = X.wave + 8 * i; if (bidx >= NB) bidx -= NB;
            bsel[i] = bidx;
            if (bidx < NBK) { const int c = bidx * 64 + lane; const int row = c / NKC1; int col = c % NKC1; if (col > NKC1 - 2) col = NKC1 - 2; goff[i] = (unsigned)(row * KROW + 8 * col) * 2u; }
            else { const int c = (bidx - NBK) * 64 + lane; const int row = c / 9; int col = c % 9; if (col > 7) col = 7; goff[i] = (unsigned)(row * TK + 8 * col) * 2u; }
        }
        asm volatile("s_waitcnt vmcnt(0)" ::: "memory");
#pragma unroll
        for (int ks = 0; ks < NKS; ++ks) asm volatile("" : "+v"(qf[ks]));
        auto issue = [&](int t, int slotoff) {
#pragma unroll
            for (int i = 0; i < NI; ++i) {
                const char* base = bsel[i] < NBK ? (const char*)K + (size_t)t * (64 * KROW * 2) : (const char*)Vt + (size_t)t * 128;
                __builtin_amdgcn_global_load_lds((const unsigned*)(base + goff[i]), (LAS unsigned*)(l3 + slotoff + bsel[i] * 1024), 16, 0, 0);
            }
        };
#pragma unroll
        for (int d = 0; d < 4; ++d)
#pragma unroll
            for (int r = 0; r < 16; ++r) o[d][r] = 0.f;
        float mrun = -1e30f, lrun = 0.f;
        issue(0, 0); issue(1, SLOT_B);
        asm volatile("s_waitcnt vmcnt(%0)" :: "i"(NI) : "memory");
        __builtin_amdgcn_s_barrier(); asm volatile("" ::: "memory");
        int s_cur = 0, s_nn = 2 * SLOT_B;
        for (int t = 0; t < nt; ++t) {
            if (t + 2 < nt) issue(t + 2, s_nn);
            const LAS bf16_t* kt = (const LAS bf16_t*)(l3 + s_cur) + r32 * KS + kcol + 8 * hi; const LAS bf16_t* vt = (const LAS bf16_t*)(l3 + s_cur + KT_B) + r32 * KSTR + 8 * hi;
            f32x16 s0, s1;
#pragma unroll
            for (int r = 0; r < 16; ++r) { s0[r] = 0.f; s1[r] = 0.f; }
            {
                bf16x8 a0 = *(const LAS bf16x8*)(kt), a1 = *(const LAS bf16x8*)(kt + 32 * KS);
                __builtin_amdgcn_sched_group_barrier(0x100, 2, 0);
#pragma unroll
                for (int ks = 0; ks < NKS; ++ks) {
                    bf16x8 b0 = a0, b1 = a1;
                    if (ks + 1 < NKS) { b0 = *(const LAS bf16x8*)(kt + 16 * (ks + 1)); b1 = *(const LAS bf16x8*)(kt + 32 * KS + 16 * (ks + 1)); }
                    s0 = __builtin_amdgcn_mfma_f32_32x32x16_bf16(a0, qf[ks], s0, 0, 0, 0);
                    s1 = __builtin_amdgcn_mfma_f32_32x32x16_bf16(a1, qf[ks], s1, 0, 0, 0);
                    if (ks + 1 < NKS) __builtin_amdgcn_sched_group_barrier(0x100, 2, 0);
                    __builtin_amdgcn_sched_group_barrier(0x008, 2, 0);
                    a0 = b0; a1 = b1;
                }
            }
            bf16x8 vf[4];
#pragma unroll
            for (int d = 0; d < 4; ++d) vf[d] = *(const LAS bf16x8*)(vt + 32 * d * KSTR);
            float mx = fmaxf(s0[0], s1[0]);
#pragma unroll
            for (int r = 1; r < 16; ++r) mx = fmaxf(fmaxf(mx, s0[r]), s1[r]);
            mx = fmaxf(mx, __shfl_xor(mx, 32));
            if (__any(mx - mrun > RESC_THR)) {
                const float mnew = fmaxf(mrun, mx); const float alpha = __builtin_amdgcn_exp2f(mrun - mnew); mrun = mnew; lrun *= alpha;
#pragma unroll
                for (int d = 0; d < 4; ++d) o[d] = o[d] * alpha;
            }
            s0 = s0 - mrun; s1 = s1 - mrun;
#pragma unroll
            for (int r = 0; r < 16; ++r) { s0[r] = __builtin_amdgcn_exp2f(s0[r]); s1[r] = __builtin_amdgcn_exp2f(s1[r]); }
            { const f32x16 sm = s0 + s1;
              lrun += ((sm[0] + sm[1]) + (sm[2] + sm[3])) + ((sm[4] + sm[5]) + (sm[6] + sm[7])) + (((sm[8] + sm[9]) + (sm[10] + sm[11])) + ((sm[12] + sm[13]) + (sm[14] + sm[15]))); }
            bf16x8 pf[4];
            { float p[16];
#pragma unroll
              for (int r = 0; r < 16; ++r) p[r] = s0[r];
              pf[0] = __builtin_bit_cast(bf16x8, pack8(p)); pf[1] = __builtin_bit_cast(bf16x8, pack8(p + 8));
#pragma unroll
              for (int r = 0; r < 16; ++r) p[r] = s1[r];
              pf[2] = __builtin_bit_cast(bf16x8, pack8(p)); pf[3] = __builtin_bit_cast(bf16x8, pack8(p + 8)); }
#pragma unroll
            for (int g = 0; g < 4; ++g) {
                bf16x8 vn[4];
                if (g + 1 < 4) {
#pragma unroll
                    for (int d = 0; d < 4; ++d) vn[d] = *(const LAS bf16x8*)(vt + 32 * d * KSTR + 16 * (g + 1));
                }
#pragma unroll
                for (int d = 0; d < 4; ++d) o[d] = __builtin_amdgcn_mfma_f32_32x32x16_bf16(vf[d], pf[g], o[d], 0, 0, 0);
                if (g + 1 < 4) {
                    __builtin_amdgcn_sched_group_barrier(0x100, 4, 0);
#pragma unroll
                    for (int d = 0; d < 4; ++d) vf[d] = vn[d];
                }
                __builtin_amdgcn_sched_group_barrier(0x008, 4, 0);
            }
            if (t + 2 < nt) asm volatile("s_waitcnt vmcnt(%0)" :: "i"(NI) : "memory");
            else asm volatile("s_waitcnt vmcnt(0)" ::: "memory");
            asm volatile("s_waitcnt lgkmcnt(0)" ::: "memory");
            __builtin_amdgcn_s_barrier(); asm volatile("" ::: "memory");
            s_cur = (s_cur == 2 * SLOT_B) ? 0 : s_cur + SLOT_B; s_nn = (s_nn == 2 * SLOT_B) ? 0 : s_nn + SLOT_B;
        }
        lrun += __shfl_xor(lrun, 32);
        const float rl = 1.f / lrun;
#pragma unroll
        for (int d = 0; d < 4; ++d) o[d] = o[d] * rl;
    }
};

template <int DQK, int KROW>
struct AttnCoreP {
    static constexpr int NKS = DQK / 16, NKC1 = KROW / 8 + 1, KS = NKC1 * 8, KT_B = 64 * NKC1 * 16, VT_B = 128 * 9 * 16, SLOT_B = KT_B + VT_B;
    static constexpr int NBK = KT_B / 1024, NBV = VT_B / 1024, NB = NBK + NBV, NI = (NB + 7) / 8;
    static_assert(KT_B % 1024 == 0 && VT_B % 1024 == 0 && 8 * NI - NB <= 8 && 3 * SLOT_B <= 135168, "attention LDS geometry");
    static __device__ __forceinline__ void run(const Ctx& X, const bf16_t* Qrow, int kcol, const bf16_t* K, const bf16_t* Vt, int nt, f32x16 (&o)[4]) {
        const int lane = X.lane, r32 = lane & 31, hi = lane >> 5, role = X.wave >> 2;
        LAS unsigned char* l3 = (LAS unsigned char*)0 + X.l3off;
        bf16x8 qf[NKS];
#pragma unroll
        for (int ks = 0; ks < NKS; ++ks) qf[ks] = *(const bf16x8*)(Qrow + 16 * ks + 8 * hi);
        unsigned goff[NI]; int bsel[NI];
#pragma unroll
        for (int i = 0; i < NI; ++i) {
            int bidx = X.wave + 8 * i; if (bidx >= NB) bidx -= NB;
            bsel[i] = bidx;
            if (bidx < NBK) { const int c = bidx * 64 + lane; const int row = c / NKC1; int col = c % NKC1; if (col > NKC1 - 2) col = NKC1 - 2; goff[i] = (unsigned)(row * KROW + 8 * col) * 2u; }
            else { const int c = (bidx - NBK) * 64 + lane; const int row = c / 9; int col = c % 9; if (col > 7) col = 7; goff[i] = (unsigned)(row * TK + 8 * col) * 2u; }
        }
        asm volatile("s_waitcnt vmcnt(0)" ::: "memory");
#pragma unroll
        for (int ks = 0; ks < NKS; ++ks) asm volatile("" : "+v"(qf[ks]));
        auto issue = [&](int tk, int ks_off, bool doK, int tv, int vs_off, bool doV) {
#pragma unroll
            for (int i = 0; i < NI; ++i) {
                const bool isK = bsel[i] < NBK;
                if (isK ? doK : doV) {
                    const char* base = isK ? (const char*)K + (size_t)tk * (64 * KROW * 2) : (const char*)Vt + (size_t)tv * 128;
                    __builtin_amdgcn_global_load_lds((const unsigned*)(base + goff[i]), (LAS unsigned*)(l3 + (isK ? ks_off : vs_off) + bsel[i] * 1024), 16, 0, 0);
                }
            }
        };
#pragma unroll
        for (int d = 0; d < 4; ++d)
#pragma unroll
            for (int r = 0; r < 16; ++r) o[d][r] = 0.f;
        float mrun = -1e30f, lrun = 0.f;
        issue(0, 0, true, 0, 0, true); issue(1, SLOT_B, true, 1, SLOT_B, true); issue(2, 2 * SLOT_B, nt > 2, 0, 0, false);
        asm volatile("s_waitcnt vmcnt(0)" ::: "memory");
        __builtin_amdgcn_s_barrier(); asm volatile("" ::: "memory");
        f32x16 sc0, sc1;
        {
            const LAS bf16_t* kt = (const LAS bf16_t*)(l3) + r32 * KS + kcol + 8 * hi;
#pragma unroll
            for (int r = 0; r < 16; ++r) { sc0[r] = 0.f; sc1[r] = 0.f; }
#pragma unroll
            for (int ks = 0; ks < NKS; ++ks) {
                const bf16x8 a0 = *(const LAS bf16x8*)(kt + 16 * ks), a1 = *(const LAS bf16x8*)(kt + 32 * KS + 16 * ks);
                sc0 = __builtin_amdgcn_mfma_f32_32x32x16_bf16(a0, qf[ks], sc0, 0, 0, 0);
                sc1 = __builtin_amdgcn_mfma_f32_32x32x16_bf16(a1, qf[ks], sc1, 0, 0, 0);
            }
        }
        int s0off = 0, s1off = SLOT_B, s2off = 2 * SLOT_B;
        for (int t = 0; t < nt; ++t) {
            issue(t + 3, s0off, t + 3 < nt, t + 2, s2off, t + 2 < nt);
            const bool hasN = t + 1 < nt;
            const LAS bf16_t* kt = (const LAS bf16_t*)(l3 + s1off) + r32 * KS + kcol + 8 * hi;
            const LAS bf16_t* vt = (const LAS bf16_t*)(l3 + s0off + KT_B) + r32 * KSTR + 8 * hi;
            f32x16 sn0, sn1;
            auto qk_next = [&]() {
#pragma unroll
                for (int r = 0; r < 16; ++r) { sn0[r] = 0.f; sn1[r] = 0.f; }
                bf16x8 a0 = *(const LAS bf16x8*)(kt), a1 = *(const LAS bf16x8*)(kt + 32 * KS);
                __builtin_amdgcn_sched_group_barrier(0x100, 2, 0);
#pragma unroll
                for (int ks = 0; ks < NKS; ++ks) {
                    bf16x8 b0 = a0, b1 = a1;
                    if (ks + 1 < NKS) { b0 = *(const LAS bf16x8*)(kt + 16 * (ks + 1)); b1 = *(const LAS bf16x8*)(kt + 32 * KS + 16 * (ks + 1)); }
                    sn0 = __builtin_amdgcn_mfma_f32_32x32x16_bf16(a0, qf[ks], sn0, 0, 0, 0);
                    sn1 = __builtin_amdgcn_mfma_f32_32x32x16_bf16(a1, qf[ks], sn1, 0, 0, 0);
                    if (ks + 1 < NKS) __builtin_amdgcn_sched_group_barrier(0x100, 2, 0);
                    __builtin_amdgcn_sched_group_barrier(0x008, 2, 0);
                    a0 = b0; a1 = b1;
                }
            };
            if (role == 0 && hasN) qk_next();
            float mx = fmaxf(sc0[0], sc1[0]);
#pragma unroll
            for (int r = 1; r < 16; ++r) mx = fmaxf(fmaxf(mx, sc0[r]), sc1[r]);
            mx = fmaxf(mx, __shfl_xor(mx, 32));
            if (__any(mx - mrun > RESC_THR)) {
                const float mnew = fmaxf(mrun, mx); const float alpha = __builtin_amdgcn_exp2f(mrun - mnew); mrun = mnew; lrun *= alpha;
#pragma unroll
                for (int d = 0; d < 4; ++d) o[d] = o[d] * alpha;
            }
            sc0 = sc0 - mrun; sc1 = sc1 - mrun;
#pragma unroll
            for (int r = 0; r < 16; ++r) { sc0[r] = __builtin_amdgcn_exp2f(sc0[r]); sc1[r] = __builtin_amdgcn_exp2f(sc1[r]); }
            { const f32x16 sm = sc0 + sc1;
              lrun += ((sm[0] + sm[1]) + (sm[2] + sm[3])) + ((sm[4] + sm[5]) + (sm[6] + sm[7])) + (((sm[8] + sm[9]) + (sm[10] + sm[11])) + ((sm[12] + sm[13]) + (sm[14] + sm[15]))); }
            bf16x8 pf[4];
            { float p[16];
#pragma unroll
              for (int r = 0; r < 16; ++r) p[r] = sc0[r];
              pf[0] = __builtin_bit_cast(bf16x8, pack8(p)); pf[1] = __builtin_bit_cast(bf16x8, pack8(p + 8));
#pragma unroll
              for (int r = 0; r < 16; ++r) p[r] = sc1[r];
              pf[2] = __builtin_bit_cast(bf16x8, pack8(p)); pf[3] = __builtin_bit_cast(bf16x8, pack8(p + 8)); }
            bf16x8 vf[4];
#pragma unroll
            for (int d = 0; d < 4; ++d) vf[d] = *(const LAS bf16x8*)(vt + 32 * d * KSTR);
#pragma unroll
            for (int g = 0; g < 4; ++g) {
                bf16x8 vn[4];
                if (g + 1 < 4) {
#pragma unroll
                    for (int d = 0; d < 4; ++d) vn[d] = *(const LAS bf16x8*)(vt + 32 * d * KSTR + 16 * (g + 1));
                }
#pragma unroll
                for (int d = 0; d < 4; ++d) o[d] = __builtin_amdgcn_mfma_f32_32x32x16_bf16(vf[d], pf[g], o[d], 0, 0, 0);
                if (g + 1 < 4) {
#pragma unroll
                    for (int d = 0; d < 4; ++d) vf[d] = vn[d];
                }
            }
            if (role != 0 && hasN) qk_next();
            if (t + 3 < nt) asm volatile("s_waitcnt vmcnt(%0)" :: "i"(NI) : "memory");
            else asm volatile("s_waitcnt vmcnt(0)" ::: "memory");
            asm volatile("s_waitcnt lgkmcnt(0)" ::: "memory");
            __builtin_amdgcn_s_barrier(); asm volatile("" ::: "memory");
            sc0 = sn0; sc1 = sn1;
            const int tmp = s0off; s0off = s1off; s1off = s2off; s2off = tmp;
        }
        lrun += __shfl_xor(lrun, 32);
        const float rl = 1.f / lrun;
#pragma unroll
        for (int d = 0; d < 4; ++d) o[d] = o[d] * rl;
    }
};

__device__ __forceinline__ void mla_attn_unit(const Ctx& X0, const PRef& P, int b, int h, int q0, int is_ctx) {
    const Ctx X = fresh(X0);
    unsigned char* ws = P.ws();
    const int lane = X.lane, r32 = lane & 31, hi = lane >> 5;
    const int row = (is_ctx ? M_LAT + b * CTXL : b * SEQ) + q0 + 32 * X.wave + r32;
    const bf16_t* Q = (const bf16_t*)(ws + WS_QM) + ((size_t)h * M_ALL + row) * 192;
    const bf16_t* K = (const bf16_t*)(ws + WS_KM) + (size_t)(b * 8 + h) * TK * 192;
    const bf16_t* Vt = (const bf16_t*)(ws + WS_VTM) + (size_t)(b * 8 + h) * 128 * TK;
    f32x16 o[4];
    AttnCore<192, 192>::run(X, Q, 0, K, Vt, is_ctx ? 4 : NCH, o);
    bf16_t* mix = (bf16_t*)(ws + WS_AB) + (size_t)row * DM + 1024 + h * 128;
#pragma unroll
    for (int d = 0; d < 4; ++d)
#pragma unroll
        for (int q = 0; q < 4; ++q) { u32x2 w; w.x = pk2(o[d][4 * q], o[d][4 * q + 1]); w.y = pk2(o[d][4 * q + 2], o[d][4 * q + 3]); *(u32x2*)(mix + 32 * d + 8 * q + 4 * hi) = w; }
}
__device__ __forceinline__ void da_attn_unit(const Ctx& X0, const PRef& P, int l, int b, int h, int q0, int is_ctx, float lam, float lam_init) {
    const Ctx X = fresh(X0);
    unsigned char* ws = P.ws();
    const int lane = X.lane, r32 = lane & 31, hi = lane >> 5;
    const int comp = X.wave >> 2, qs = X.wave & 3;
    const int row = (is_ctx ? M_LAT + b * CTXL : b * SEQ) + q0 + 32 * qs + r32;
    const bf16_t* Q = (const bf16_t*)(ws + WS_QDA) + ((size_t)h * M_ALL + row) * 128 + comp * 64;
    const bf16_t* K = (const bf16_t*)(ws + WS_KDA) + (size_t)(b * 4 + h) * TK * 128;
    const bf16_t* Vt = (const bf16_t*)(ws + WS_VTDA) + (size_t)(b * 4 + h) * 128 * TK;
    f32x16 o[4];
    AttnCoreP<64, 128>::run(X, Q, comp * 64, K, Vt, is_ctx ? 4 : NCH, o);
    float* xch = (float*)X.lds;
    if (comp == 1) {
#pragma unroll
        for (int d = 0; d < 4; ++d)
#pragma unroll
            for (int r = 0; r < 16; ++r) xch[(qs * 64 + d * 16 + r) * 64 + lane] = o[d][r];
    }
    __syncthreads();
    if (comp == 0) {
        float ss = 0.f;
#pragma unroll
        for (int d = 0; d < 4; ++d)
#pragma unroll
            for (int r = 0; r < 16; ++r) { o[d][r] -= lam * xch[(qs * 64 + d * 16 + r) * 64 + lane]; ss += o[d][r] * o[d][r]; }
        ss += __shfl_xor(ss, 32);
        float li_ = lam_init; asm volatile("" : "+s"(li_));
        const float rstd = rsqrtf(ss * (1.f / 128.f) + EPS) * (1.f - li_);
        const float* og = P.in(I_DAOUTG) + l * 128;
        bf16_t* mix = (bf16_t*)(ws + WS_AB) + (size_t)row * DM + h * 128;
#pragma unroll
        for (int d = 0; d < 4; ++d)
#pragma unroll
            for (int q = 0; q < 4; ++q) { const int dv = 32 * d + 8 * q + 4 * hi; const f32x4 gg = *(const f32x4*)(og + dv);
                u32x2 w; w.x = pk2(o[d][4 * q] * rstd * gg[0], o[d][4 * q + 1] * rstd * gg[1]); w.y = pk2(o[d][4 * q + 2] * rstd * gg[2], o[d][4 * q + 3] * rstd * gg[3]);
                *(u32x2*)(mix + dv) = w; }
    }
    __syncthreads();
}

__device__ __forceinline__ void mixer_phase(const Ctx& X, const PRef& P, int l) {
    const bool need_ctx = l < DEPTH - 1;
    STAMPN(20);
    const int vcu = (X.nwg % 8 == 0) ? (X.wg % 8) * (X.nwg / 8) + X.wg / 8 : X.wg;
    if (EN(13)) for (int u = vcu; u < 512; u += X.nwg) mla_attn_unit(X, P, u >> 7, (u >> 4) & 7, (u & 15) * 256, 0);
    STAMPN(11);
    float lam, lam_init;
    { const float* lp = P.in(I_DALAM) + l * 256;
      float s1 = 0.f, s2 = 0.f;
      for (int i = 0; i < 64; ++i) { s1 += lp[i] * lp[64 + i]; s2 += lp[128 + i] * lp[192 + i]; }
      const float li = 0.8f - 0.6f * expf(-0.3f * (float)l);
      const float la = expf(s1) - expf(s2) + li;
      lam = __builtin_bit_cast(float, __builtin_amdgcn_readfirstlane(__builtin_bit_cast(int, la)));
      lam_init = __builtin_bit_cast(float, __builtin_amdgcn_readfirstlane(__builtin_bit_cast(int, li))); }
    if (EN(14)) for (int v = vcu; v < 512; v += X.nwg) da_attn_unit(X, P, l, v >> 7, (v >> 5) & 3, (v & 31) * 128, 0, lam, lam_init);
    STAMPN(12);
    if (EN(15)) for (int u = (X.wg + X.nwg / 2) % X.nwg; u < 16 * NCH; u += X.nwg) mlstm_c_unit(X, P, l, u);
    STAMPN(13);
    if (need_ctx) {
        if (EN(13)) for (int v = X.wg; v < 32; v += X.nwg) mla_attn_unit(X, P, v >> 3, v & 7, 0, 1);
        if (EN(14)) for (int v = X.nwg - 1 - X.wg; v < 32; v += X.nwg) da_attn_unit(X, P, l, v >> 3, (v >> 1) & 3, (v & 1) * 128, 1, lam, lam_init);
    }
}

__global__ void __launch_bounds__(512, 2) fwd_megakernel(Params Pk) {
    const PRef P;
    extern __shared__ __attribute__((aligned(16))) unsigned char lds[];
    cg::grid_group grid = cg::this_grid();
    Ctx X; X.lds = lds; X.tid = threadIdx.x; X.lane = X.tid & 63; X.wave = __builtin_amdgcn_readfirstlane(X.tid >> 6);
    X.nwg = gridDim.x; X.wg = blockIdx.x; X.gw = X.wg * 8 + X.wave; X.ngw = X.nwg * 8;
    LAS unsigned char* lds3 = (LAS unsigned char*)lds; X.l3off = (unsigned)(uintptr_t)lds3;
    unsigned char* ws = P.ws();
    if (threadIdx.x < 16) ((LAS unsigned*)(lds3 + 135168 + 64))[threadIdx.x] = 0u;
    __syncthreads();
    (void)xcd_barrier_post((unsigned*)(ws + WS_BAR), (volatile LAS unsigned*)(lds3 + 135168 + 64));
    float* R_lat = P.out(); float* R_ctx = (float*)(ws + WS_RCTX);
    bf16_t* AB = (bf16_t*)(ws + WS_AB);

#ifdef PROBE_CAT
    if (blockIdx.x == 0 && threadIdx.x == 0) { volatile unsigned long long* tp_ = (volatile unsigned long long*)(P.ws() + WS_END); tp_[0] = __builtin_amdgcn_s_memrealtime(); tp_[1] = 0; tp_[2] = 0; }
#endif
    const int tail_lo = X.nwg > 64 ? 32 : 0;
    if (EN(0)) mod_gemv(X, P, 0, 1, 0);
    if (EN(1)) convert_weights(X, P, 0, 0, 0);
    grid.sync();
#ifdef PROBE_CAT
    STAMP(0);
#endif
    for (int l = 0; l < DEPTH; ++l) {
        const float* modl = (const float*)(ws + WS_MOD) + (size_t)l * 5 * 6 * DM;
        const float* xin_lat = l == 0 ? P.in(I_X) : R_lat; const float* xin_ctx = l == 0 ? P.in(I_CTX) : R_ctx;
        const int Mfin = l < DEPTH - 1 ? M_ALL : M_LAT;
        if (EN(2)) modulate_phase(X, xin_lat, xin_ctx, P.in(I_N1G) + l * DM, modl, 0 * DM, 1 * DM, AB, M_ALL);
        STAMP(1);
        if (EN(3)) { pg8::Gemm g{AB, (const bf16_t*)(ws + WS_WIN), M_ALL, NPROJ, DM}; pg8::StaticOrder S; S.init(M_ALL, NPROJ, X.nwg, X.wg);
          pg8::EpiBf16 E{(bf16_t*)(ws + WS_PROJ), NPROJ, (float*)(ws + WS_GATES), C_GATE / 256};
          pg8::gemm_phase<pg8::EpiBf16>(lds3, g, S, E); }
        STAMP(2);
        if (EN(4)) prep_phase(X, P, l);
        STAMP(3);
        if (EN(5)) { pg8::Gemm g{(const bf16_t*)(ws + WS_CQN), (const bf16_t*)(ws + WS_WUQ), M_ALL, 1536, 512}; pg8::StaticOrder S; S.init(M_ALL, 1536, X.nwg, X.wg);
          pg8::EpiBf16 E{(bf16_t*)(ws + WS_QUP), 1536, nullptr, 0};
          pg8::gemm_phase<pg8::EpiBf16>(lds3, g, S, E); }
        if (EN(5)) { pg8::Gemm g{(const bf16_t*)(ws + WS_CKVN), (const bf16_t*)(ws + WS_WUKV), M_ALL, 2048, 256}; pg8::StaticOrder S; S.init(M_ALL, 2048, X.nwg, X.nwg - 1 - X.wg);
          pg8::EpiBf16 E{(bf16_t*)(ws + WS_KVUP), 2048, nullptr, 0};
          pg8::gemm_phase<pg8::EpiBf16>(lds3, g, S, E); }
        __syncthreads();
        if (EN(6)) mlstm_a_phase(X, P, l);
        STAMP(4);
        if (EN(7)) mla_prep_phase(X, P, l);
        if (EN(8)) mlstm_scan_phase(X, P);
        STAMP(5);
        if (EN(9)) mixer_phase(X, P, l);
        STAMP(6);
        if (EN(10)) { pg8::Gemm g{AB, (const bf16_t*)(ws + WS_WOUT), Mfin, DM, DM}; pg8::StaticOrder S; S.init(Mfin, DM, X.nwg, X.wg);
          pg8::EpiRes E{xin_lat, xin_ctx, R_lat, R_ctx, modl + 2 * DM};
          pg8::gemm_phase<pg8::EpiRes>(lds3, g, S, E); }
        if (EN(0)) if (l + 1 < DEPTH) { __syncthreads(); mod_gemv(X, P, l + 1, l + 2, tail_lo); }
        STAMP(7);
        if (EN(2)) modulate_phase(X, R_lat, R_ctx, P.in(I_N2G) + l * DM, modl, 3 * DM, 4 * DM, AB, Mfin);
        STAMP(1);
        if (EN(11)) { pg8::Gemm g{AB, (const bf16_t*)(ws + WS_WGU), Mfin, 2 * FF, DM}; pg8::StaticOrder S; S.init(Mfin, 2 * FF, X.nwg, X.wg);
          pg8::EpiSwiGLU E{(bf16_t*)(ws + WS_HID), FF};
          pg8::gemm_phase<pg8::EpiSwiGLU>(lds3, g, S, E); }
        STAMP(9);
        if (EN(12)) { pg8::Gemm g{(const bf16_t*)(ws + WS_HID), (const bf16_t*)(ws + ((l & 1) ? WS_WDN2 : WS_WDN)), Mfin, DM, FF}; pg8::StaticOrder S; S.init(Mfin, DM, X.nwg, X.wg);
          pg8::EpiRes E{R_lat, R_ctx, R_lat, R_ctx, modl + 5 * DM};
          pg8::gemm_phase<pg8::EpiRes>(lds3, g, S, E); }
        if (EN(1)) if (l + 1 < DEPTH) { __syncthreads(); convert_weights(X, P, l + 1, 0, tail_lo); }
#ifdef PROBE_CAT
        STAMP(10);
#else
        if (l + 1 < DEPTH) xcd_barrier(P.ws());
#endif
    }
#ifdef PROBE_CAT
    if (blockIdx.x == 0 && threadIdx.x == 0) P.out()[0] += (float)(((volatile unsigned long long*)(P.ws() + WS_END))[1]) * (0.01f / PROBE_SCALE);
#endif
}

extern "C" void kernel_launch(void* const* d_in, const int* in_sizes, int n_in, void* d_out, int out_size, void* d_ws, size_t ws_size, hipStream_t stream) {
    static int grid = 0;
    if (grid == 0) {
        if (n_in != 24 || ws_size < WS_END) { fprintf(stderr, "kernel_launch: unexpected inputs (n_in %d, ws %zu)\n", n_in, ws_size); grid = -1; return; }
        int dev = 0, cus = 0, per_cu = 0;
        (void)hipGetDevice(&dev); (void)hipDeviceGetAttribute(&cus, hipDeviceAttributeMultiprocessorCount, dev);
        if (hipFuncSetAttribute((const void*)fwd_megakernel, hipFuncAttributeMaxDynamicSharedMemorySize, LDS_BYTES) != hipSuccess) { fprintf(stderr, "kernel_launch: hipFuncSetAttribute failed\n"); grid = -1; return; }
        (void)hipOccupancyMaxActiveBlocksPerMultiprocessor(&per_cu, (const void*)fwd_megakernel, 512, LDS_BYTES);
        (void)hipGetLastError();
        if (per_cu < 1) { fprintf(stderr, "kernel_launch: occupancy query says %d\n", per_cu); per_cu = 1; }
        grid = cus;
    }
    if (grid < 0) return;
    if (hipMemsetAsync((char*)d_ws + WS_BAR, 0, XCD_BAR_WORDS * 4, stream) != hipSuccess) { fprintf(stderr, "kernel_launch: memset failed\n"); return; }
    Params p{};
    for (int i = 0; i < 24; ++i) p.in[i] = (const float*)d_in[i];
    p.out = (float*)d_out; p.ws = (unsigned char*)d_ws;
    void* args[] = {&p};
    hipError_t e = hipLaunchCooperativeKernel((const void*)fwd_megakernel, dim3(grid), dim3(512), args, LDS_BYTES, stream);
    if (e != hipSuccess) fprintf(stderr, "cooperative launch failed: %s (grid %d)\n", hipGetErrorString(e), grid);
}
```

```cpp
#include <hip/hip_runtime.h>
#include <hip/hip_cooperative_groups.h>
#include <cstdio>
#include <cstdint>
namespace cg = cooperative_groups;

#define LAS __attribute__((address_space(3)))
typedef unsigned short bf16_t;
typedef short bf16x8 __attribute__((ext_vector_type(8)));
typedef float f32x4 __attribute__((ext_vector_type(4)));
typedef float f32x16 __attribute__((ext_vector_type(16)));
typedef unsigned u32x4 __attribute__((ext_vector_type(4)));
typedef unsigned u32x2 __attribute__((ext_vector_type(2)));

constexpr int DM = 2048, BATCH = 4, SEQ = 4096, CTXL = 256, DEPTH = 2;
constexpr int M_LAT = BATCH * SEQ, M_CTX = BATCH * CTXL, M_ALL = M_LAT + M_CTX;
constexpr int TK = CTXL + SEQ;
constexpr int NCH = TK / 64;
constexpr int IN_W = 4432, NPROJ = 4608, FF = 5632;
constexpr int C_DAQ = 0, C_DAK = 512, C_DAV = 1024, C_MLQ = 1536, C_MLK = 2048, C_MLV = 2560, C_MLO = 3072, C_GATE = 3584, C_CQ = 3600, C_CKV = 4112, C_KPE = 4368;
constexpr float EPS = 1e-6f;
constexpr float LOG2E = 1.4426950408889634f;
constexpr float RESC_THR = 8.0f;

constexpr size_t MiB = 1u << 20;
constexpr size_t WS_WIN = 0, WS_WOUT = 18 * MiB, WS_WGU = 26 * MiB, WS_WDN = 70 * MiB, WS_WUQ = 92 * MiB, WS_WUKV = 94 * MiB, WS_MOD = 95 * MiB, WS_RCTX = 96 * MiB;
constexpr size_t WS_AB = 104 * MiB;
constexpr size_t WS_PROJ = 172 * MiB;
constexpr size_t WS_QUP = 172 * MiB, WS_KVUP = 223 * MiB, WS_HID = 172 * MiB;
constexpr size_t WS_GATES = 325 * MiB, WS_CQN = 327 * MiB, WS_CKVN = 344 * MiB, WS_KPE = 353 * MiB, WS_OCOPY = 356 * MiB;
constexpr size_t WS_QDA = 373 * MiB, WS_KDA = 390 * MiB, WS_VTDA = 407 * MiB, WS_QML = 424 * MiB, WS_KML = 441 * MiB, WS_KTML = 458 * MiB, WS_VTML = 475 * MiB;
constexpr size_t WS_QM = 492 * MiB, WS_KM = 543 * MiB, WS_VTM = 594 * MiB, WS_CSNAP = 628 * MiB, WS_NSNAP = 696 * MiB, WS_NU = 698 * MiB, WS_CSTAT = 700 * MiB, WS_BAR = 701 * MiB, WS_WDN2 = 702 * MiB, WS_END = 724 * MiB;
static_assert((size_t)NPROJ * DM * 2 <= 18 * MiB && (size_t)2 * FF * DM * 2 <= 44 * MiB && (size_t)M_ALL * NPROJ * 2 <= 153 * MiB, "ws map");
static_assert(WS_HID + (size_t)M_ALL * FF * 2 <= WS_QDA, "hid overlay");
static_assert(WS_END <= 768 * MiB, "ws fits the guaranteed minimum");

constexpr int LDS_BYTES = 140 * 1024;
#ifndef PH_EN
#define PH_EN 0xFFFF
#endif
#define EN(k) ((PH_EN >> (k)) & 1)
#ifdef PROBE_CAT
#define STAMP(cat) do { xcd_barrier(P.ws()); if (blockIdx.x == 0 && threadIdx.x == 0) { volatile unsigned long long* tp_ = (volatile unsigned long long*)(P.ws() + WS_END); const unsigned long long t1_ = __builtin_amdgcn_s_memrealtime(); if ((1 << (cat)) & PROBE_CAT) tp_[1] += t1_ - tp_[0]; if ((1 << (cat)) & PROBE_CAT2) tp_[2] += t1_ - tp_[0]; tp_[0] = t1_; } } while (0)
#define STAMPN(cat) do { __syncthreads(); if (blockIdx.x == 0 && threadIdx.x == 0) { volatile unsigned long long* tp_ = (volatile unsigned long long*)(P.ws() + WS_END); const unsigned long long t1_ = __builtin_amdgcn_s_memrealtime(); if ((1 << (cat)) & PROBE_CAT) tp_[1] += t1_ - tp_[0]; tp_[0] = t1_; } } while (0)
#else
#define STAMPN(cat) do {} while (0)
#define STAMP(cat) xcd_barrier(P.ws())
#endif

#define LOG2E_ 1.4426950408889634f
__device__ __forceinline__ unsigned f2bf(float f) { unsigned u = __builtin_bit_cast(unsigned, f); return (u + 0x7fffu + ((u >> 16) & 1u)) >> 16; }
typedef float f32x2_t __attribute__((ext_vector_type(2))); typedef __bf16 bf16x2_t __attribute__((ext_vector_type(2)));
__device__ __forceinline__ unsigned pk2(float lo, float hi) { f32x2_t v = {lo, hi}; bf16x2_t b = __builtin_convertvector(v, bf16x2_t); return __builtin_bit_cast(unsigned, b); }
__device__ __forceinline__ float bflo(unsigned w) { return __builtin_bit_cast(float, w << 16); }
__device__ __forceinline__ float bfhi(unsigned w) { return __builtin_bit_cast(float, w & 0xffff0000u); }
__device__ __forceinline__ float bf1(bf16_t h) { return __builtin_bit_cast(float, (unsigned)h << 16); }
__device__ __forceinline__ void unpack8(const u32x4 w, float* v) { v[0] = bflo(w.x); v[1] = bfhi(w.x); v[2] = bflo(w.y); v[3] = bfhi(w.y); v[4] = bflo(w.z); v[5] = bfhi(w.z); v[6] = bflo(w.w); v[7] = bfhi(w.w); }
__device__ __forceinline__ u32x4 pack8(const float* v) { u32x4 w; w.x = pk2(v[0], v[1]); w.y = pk2(v[2], v[3]); w.z = pk2(v[4], v[5]); w.w = pk2(v[6], v[7]); return w; }
__device__ __forceinline__ float wave_sum(float v) {
#pragma unroll
    for (int o = 1; o < 64; o <<= 1) v += __shfl_xor(v, o);
    return v;
}
__device__ __forceinline__ float wave_max(float v) {
#pragma unroll
    for (int o = 1; o < 64; o <<= 1) v = fmaxf(v, __shfl_xor(v, o));
    return v;
}
__device__ __forceinline__ float siluf(float x) { return x * __builtin_amdgcn_rcpf(1.f + __builtin_amdgcn_exp2f(-LOG2E_ * x)); }
__device__ __forceinline__ float sigmf(float x) { return __builtin_amdgcn_rcpf(1.f + __builtin_amdgcn_exp2f(-LOG2E_ * x)); }
__device__ __forceinline__ int crow(int r, int hi) { return (r & 3) + 8 * (r >> 2) + 4 * hi; }
__device__ __forceinline__ int perm_off(int p) { const int h = p >> 3, j = p & 7; return 8 * (j >> 2) + 4 * h + (j & 3); }
__device__ __forceinline__ int mod_batch(int row) { return row < M_LAT ? (row >> 12) : 4; }

namespace pg8 {
constexpr int BM = 256, BK = 64, HALF = 128, HTB = HALF * BK * 2, STAGE_BYTES = 8 * HTB, NXCD = 8, WGM = 8;
__host__ __device__ __forceinline__ int lds_byte(int r, int c) { const int st = (r >> 4) * 2 + (c >> 5), rr = r & 15, cc = c & 31, ob = rr * 64 + cc * 2; return st * 1024 + (ob ^ (((ob >> 9) & 1) << 5)); }
__host__ __device__ __forceinline__ void stage_rc(int b, int& R, int& C) { const int st = b / 1024, sb = b % 1024, swz = sb ^ (((sb >> 9) & 1) << 5); R = (st >> 1) * 16 + swz / 64; C = (st & 1) * 32 + (swz % 64) / 2; }
__host__ __device__ __forceinline__ int perm32(int rho) { const int n = rho >> 4, i = rho & 15; return 8 * (i >> 2) + 4 * n + (i & 3); }

struct Unit { int pm, pn; };
struct Gemm { const bf16_t* A; const bf16_t* Bt; int M, N, K; };

struct StaticOrder {
    int nM, nN, nwg, G, c;
    __device__ void init(int M, int N, int G_, int c_) { nM = M / BM; nN = N / BM; nwg = nM * nN; G = G_; c = c_; }
    __device__ bool next(int i, Unit& u) const {
        const long L = (long)i * G + c; if (L >= nwg) return false;
        int wgid = (int)L; { const int q = nwg / NXCD, r = nwg % NXCD, xcd = wgid % NXCD, off = wgid / NXCD; wgid = (xcd < r ? xcd * (q + 1) : r * (q + 1) + (xcd - r) * q) + off; }
        const int nig = WGM * nN, gid = wgid / nig, fm = gid * WGM, gsz = (nM - fm) < WGM ? (nM - fm) : WGM;
        u.pm = fm + ((wgid % nig) % gsz); u.pn = (wgid % nig) / gsz; return true;
    }
};

struct EpiBf16 {
    static constexpr bool PERM = true;
    bf16_t* O; int ldc; float* gates; int gate_pn;
    __device__ __forceinline__ void operator()(const f32x4 (&acc)[2][2][4][2], const Unit& u, int wr, int wc, int fr, int fq) const {
        const int row0 = u.pm * BM + wr * 64 + fr; const int col0 = u.pn * BM + wc * 32 + 8 * fq;
        const bool g = gates != nullptr && u.pn == gate_pn && wc == 0 && fq < 2;
#pragma unroll
        for (int ai = 0; ai < 2; ++ai)
#pragma unroll
            for (int m = 0; m < 4; ++m) { const int row = row0 + ai * HALF + m * 16; bf16_t* rowp = O + (size_t)row * ldc + col0;
#pragma unroll
                for (int bj = 0; bj < 2; ++bj) { const f32x4 v0 = acc[ai][bj][m][0], v1 = acc[ai][bj][m][1];
                    u32x4 w; w.x = pk2(v0[0], v0[1]); w.y = pk2(v0[2], v0[3]); w.z = pk2(v1[0], v1[1]); w.w = pk2(v1[2], v1[3]);
                    *(u32x4*)(rowp + bj * HALF) = w;
                    if (bj == 0 && g) { *(f32x4*)(gates + (size_t)row * 16 + 8 * fq) = v0; *(f32x4*)(gates + (size_t)row * 16 + 8 * fq + 4) = v1; } } }
    }
};
struct EpiSwiGLU {
    static constexpr bool PERM = true;
    bf16_t* O; int ldc;
    __device__ __forceinline__ void operator()(const f32x4 (&acc)[2][2][4][2], const Unit& u, int wr, int wc, int fr, int fq) const {
        const int row0 = u.pm * BM + wr * 64 + fr; const int col0 = u.pn * HALF + wc * 32 + 8 * fq;
#pragma unroll
        for (int ai = 0; ai < 2; ++ai)
#pragma unroll
            for (int m = 0; m < 4; ++m) { const int row = row0 + ai * HALF + m * 16;
                float o[8];
#pragma unroll
                for (int n = 0; n < 2; ++n)
#pragma unroll
                    for (int i = 0; i < 4; ++i) { const float gt = acc[ai][0][m][n][i], up = acc[ai][1][m][n][i]; o[4 * n + i] = siluf(gt) * up; }
                *(u32x4*)(O + (size_t)row * ldc + col0) = pack8(o); }
    }
};
struct EpiRes {
    static constexpr bool PERM = false;
    const float* res_lat; const float* res_ctx; float* out_lat; float* out_ctx; const float* gate;
    __device__ __forceinline__ void operator()(const f32x4 (&acc)[2][2][4][2], const Unit& u, int wr, int wc, int fr, int fq) const {
        const int row0 = u.pm * BM + wr * 64 + fr; const int col0 = u.pn * BM + wc * 32 + 4 * fq;
#pragma unroll
        for (int ai = 0; ai < 2; ++ai)
#pragma unroll
            for (int m = 0; m < 4; ++m) { const int row = row0 + ai * HALF + m * 16;
                const float* rp = row < M_LAT ? res_lat + (size_t)row * DM : res_ctx + (size_t)(row - M_LAT) * DM;
                float* op = row < M_LAT ? out_lat + (size_t)row * DM : out_ctx + (size_t)(row - M_LAT) * DM;
                const float* gp = gate + (size_t)mod_batch(row) * 6 * DM;
#pragma unroll
                for (int bj = 0; bj < 2; ++bj)
#pragma unroll
                    for (int n = 0; n < 2; ++n) { const int c = col0 + bj * HALF + n * 16;
                        const f32x4 r = *(const f32x4*)(rp + c), g = *(const f32x4*)(gp + c);
                        *(f32x4*)(op + c) = r + g * acc[ai][bj][m][n]; } }
    }
};

template <class Epi, bool ALIGN_EPI = true>
__device__ __forceinline__ void gemm_phase(LAS unsigned char* lds, const Gemm g, const StaticOrder& S, const Epi& E) {
    int tid = threadIdx.x; asm volatile("" : "+v"(tid)); const int wid = __builtin_amdgcn_readfirstlane(tid >> 6), lane = tid & 63, wr = wid >> 2, wc = wid & 3, fr = lane & 15, fq = lane >> 4;
    int K = g.K; asm volatile("" : "+s"(K)); const int nt = K / BK;
    unsigned voffA[2], voffB[2];
#pragma unroll
    for (int i = 0; i < 2; ++i) { int R, C; stage_rc(tid * 16 + i * 8192, R, C); const int Rb = Epi::PERM ? ((R & ~31) + perm32(R & 31)) : R;
        voffA[i] = (unsigned)(R * K + C) * 2u; voffB[i] = (unsigned)(Rb * K + C) * 2u; }
    const size_t kstep = (size_t)(BK * 2);
    const size_t hstep = (size_t)HALF * K * 2;
    const size_t tstep = 2 * hstep;
    const unsigned ldsw = (unsigned)wid * 1024u;
    const int aoff = lds_byte(wr * 64 + fr, fq * 8), boff = lds_byte(wc * 32 + fr, fq * 8);
#define PG8_SA(b, h) (((b) * 2 + (h)) * HTB)
#define PG8_SB(b, h) ((4 + (b) * 2 + (h)) * HTB)
#define PG8_STAGE(bufoff, gbase, voff) do { _Pragma("unroll") for (int _i = 0; _i < 2; ++_i) \
        __builtin_amdgcn_global_load_lds((const unsigned*)((const char*)(gbase) + (voff)[_i]), (LAS unsigned*)(lds + (bufoff) + ldsw + _i * 8192), 16, 0, 0); } while (0)
#define PG8_LDA(dst, b, h) do { _Pragma("unroll") for (int m = 0; m < 4; ++m) _Pragma("unroll") for (int k = 0; k < 2; ++k) dst[m][k] = *(const LAS bf16x8*)(lds + PG8_SA(b, h) + aoff + m * 2048 + k * 1024); } while (0)
#define PG8_LDB(dst, b, h) do { _Pragma("unroll") for (int n = 0; n < 2; ++n) _Pragma("unroll") for (int k = 0; k < 2; ++k) dst[n][k] = *(const LAS bf16x8*)(lds + PG8_SB(b, h) + boff + n * 2048 + k * 1024); } while (0)
#define PG8_MMA(ai, bj, At, Bt) do { __builtin_amdgcn_s_setprio(1); _Pragma("unroll") for (int m = 0; m < 4; ++m) _Pragma("unroll") for (int n = 0; n < 2; ++n) _Pragma("unroll") for (int k = 0; k < 2; ++k) \
        acc[ai][bj][m][n] = __builtin_amdgcn_mfma_f32_16x16x32_bf16(Bt[n][k], At[m][k], acc[ai][bj][m][n], 0, 0, 0); __builtin_amdgcn_s_setprio(0); } while (0)
#define PG8_WAIT_V(n) asm volatile("s_waitcnt vmcnt(" #n ")" ::: "memory")
#define PG8_WAIT_L(n) asm volatile("s_waitcnt lgkmcnt(" #n ")" ::: "memory")
#define PG8_BAR __builtin_amdgcn_s_barrier()
#define PG8_SCHED __builtin_amdgcn_sched_barrier(0)
    Unit cur, nxt; int ui = 0;
    if (!S.next(0, cur)) return;
    f32x4 acc[2][2][4][2];
#pragma unroll
    for (int a = 0; a < 2; ++a)
#pragma unroll
        for (int b = 0; b < 2; ++b)
#pragma unroll
            for (int m = 0; m < 4; ++m)
#pragma unroll
                for (int n = 0; n < 2; ++n) acc[a][b][m][n] = (f32x4){0.f, 0.f, 0.f, 0.f};
    bf16x8 At[4][2], B0[2][2], B1[2][2];
    const char* cA = (const char*)g.A + (size_t)cur.pm * tstep; const char* cB = (const char*)g.Bt + (size_t)cur.pn * tstep;
    PG8_STAGE(PG8_SB(0, 0), cB, voffB); PG8_STAGE(PG8_SB(0, 1), cB + hstep, voffB); PG8_STAGE(PG8_SA(0, 0), cA, voffA); PG8_STAGE(PG8_SA(0, 1), cA + hstep, voffA);
    if (wr == 1) PG8_BAR;
    PG8_WAIT_V(2); PG8_BAR;
    PG8_STAGE(PG8_SB(1, 0), cB + kstep, voffB); PG8_STAGE(PG8_SA(1, 0), cA + kstep, voffA); PG8_STAGE(PG8_SB(1, 1), cB + hstep + kstep, voffB);
    PG8_WAIT_V(6); PG8_BAR;
    for (;;) {
        const bool has_next = S.next(ui + 1, nxt);
        const char* nA = has_next ? (const char*)g.A + (size_t)nxt.pm * tstep : cA; const char* nB = has_next ? (const char*)g.Bt + (size_t)nxt.pn * tstep : cB;
        for (int t = 0; t < nt; t += 2) {
            const bool last = (t == nt - 2);
            const char* a1 = cA + (size_t)(t + 1) * kstep;
            const char* a2 = last ? nA : cA + (size_t)(t + 2) * kstep; const char* b2 = last ? nB : cB + (size_t)(t + 2) * kstep;
            const char* a3 = a2 + kstep; const char* b3 = b2 + kstep;
            PG8_LDB(B0, 0, 0); PG8_LDB(B1, 0, 1); PG8_SCHED; PG8_LDA(At, 0, 0); PG8_STAGE(PG8_SA(1, 1), a1 + hstep, voffA);
            PG8_WAIT_V(8); PG8_WAIT_L(0); PG8_BAR; PG8_MMA(0, 0, At, B0); PG8_MMA(0, 1, At, B1); PG8_BAR; PG8_SCHED;
            PG8_LDA(At, 0, 1); PG8_STAGE(PG8_SB(0, 0), b2, voffB); PG8_STAGE(PG8_SB(0, 1), b2 + hstep, voffB); PG8_STAGE(PG8_SA(0, 0), a2, voffA);
            PG8_WAIT_V(8); PG8_WAIT_L(0); PG8_BAR; PG8_MMA(1, 0, At, B0); PG8_MMA(1, 1, At, B1); PG8_BAR; PG8_SCHED;
            PG8_LDB(B0, 1, 0); PG8_LDB(B1, 1, 1); PG8_SCHED; PG8_LDA(At, 1, 0); PG8_STAGE(PG8_SA(0, 1), a2 + hstep, voffA);
            PG8_WAIT_V(8); PG8_WAIT_L(0); PG8_BAR; PG8_MMA(0, 0, At, B0); PG8_MMA(0, 1, At, B1); PG8_BAR; PG8_SCHED;
            PG8_LDA(At, 1, 1); PG8_STAGE(PG8_SB(1, 0), b3, voffB); PG8_STAGE(PG8_SB(1, 1), b3 + hstep, voffB); PG8_STAGE(PG8_SA(1, 0), a3, voffA);
            PG8_WAIT_V(8); PG8_WAIT_L(0); PG8_BAR; PG8_MMA(1, 0, At, B0); PG8_MMA(1, 1, At, B1); PG8_BAR; PG8_SCHED;
        }
        if constexpr (ALIGN_EPI) { if (wr == 0) PG8_BAR; }
        E(acc, cur, wr, wc, fr, fq);
        if (!has_next) break;
#pragma unroll
        for (int a = 0; a < 2; ++a)
#pragma unroll
            for (int b = 0; b < 2; ++b)
#pragma unroll
                for (int m = 0; m < 4; ++m)
#pragma unroll
                    for (int n = 0; n < 2; ++n) acc[a][b][m][n] = (f32x4){0.f, 0.f, 0.f, 0.f};
        cur = nxt; cA = nA; cB = nB; ++ui;
        if constexpr (ALIGN_EPI) { if (wr == 1) PG8_BAR; }
    }
    PG8_WAIT_V(0);
    if constexpr (!ALIGN_EPI) { if (wr == 0) PG8_BAR; }
    PG8_BAR;
#undef PG8_SA
#undef PG8_SB
#undef PG8_STAGE
#undef PG8_LDA
#undef PG8_LDB
#undef PG8_MMA
#undef PG8_WAIT_V
#undef PG8_WAIT_L
#undef PG8_BAR
#undef PG8_SCHED
}
}


#define XB_TMO      128
#define XB_XCNT(j)  (256  + 64 * (j))
#define XB_XSUB(j)  (1280 + 64 * (j))
#define XB_XGEN(j)  (2304 + 64 * (j))
#define XB_TOP      3328
#define XB_TOPGEN   3392
#define XCD_BAR_WORDS 3456
#define XB_SPIN_CAP (1u << 22)
__device__ __forceinline__ unsigned xb_ld(unsigned* p)              { return __hip_atomic_load(p, __ATOMIC_RELAXED, __HIP_MEMORY_SCOPE_AGENT); }
__device__ __forceinline__ unsigned xb_add(unsigned* p, unsigned v) { return __hip_atomic_fetch_add(p, v, __ATOMIC_RELAXED, __HIP_MEMORY_SCOPE_AGENT); }
__device__ __forceinline__ unsigned xb_xcc_id() { return (unsigned)__builtin_amdgcn_s_getreg((3 << 11) | 20) & 0xFu; }
#define XB_SPIN(cond, bar) do { unsigned _sp = 0; while (cond) { __builtin_amdgcn_s_sleep(1); \
    if ((++_sp & 255u) == 0u) { if (xb_ld(&(bar)[XB_TMO])) break; if (_sp > XB_SPIN_CAP) { atomicAdd(&(bar)[XB_TMO], 1u); break; } } } } while (0)
struct XcdBarrier { unsigned* bar; unsigned x; volatile LAS unsigned* st; };
__device__ __forceinline__ XcdBarrier xcd_barrier_post(unsigned* bar, volatile LAS unsigned* st) {
    XcdBarrier b; b.bar = bar; b.x = xb_xcc_id(); b.st = st;
    if (threadIdx.x == 0) (void)xb_add(&bar[XB_XCNT(b.x)], 1u);
    return b;
}
__device__ __forceinline__ void xcd_barrier_complete(unsigned* bar, unsigned x, unsigned& nloc, unsigned& nx) {
    const unsigned G = gridDim.x * gridDim.y * gridDim.z;
    unsigned sum, cnt, mine, sp = 0u;
    for (;;) {
        sum = 0u; cnt = 0u; mine = 0u;
#pragma unroll
        for (unsigned j = 0; j < 16; ++j) { const unsigned c = xb_ld(&bar[XB_XCNT(j)]); sum += c; cnt += (c > 0u) ? 1u : 0u; mine = (j == x) ? c : mine; }
        if (sum == G) break;
        __builtin_amdgcn_s_sleep(1);
        if ((++sp & 255u) == 0u) { if (xb_ld(&bar[XB_TMO])) break; if (sp > XB_SPIN_CAP) { atomicAdd(&bar[XB_TMO], 1u); break; } }
    }
    nloc = mine > 0u ? mine : 1u; nx = cnt > 0u ? cnt : 1u;
}
__device__ __forceinline__ void xcd_barrier(unsigned char* wsb) {
    XcdBarrier b; b.bar = (unsigned*)(wsb + WS_BAR); b.x = 0; b.st = (volatile LAS unsigned*)(135168 + 64);
    asm volatile("s_waitcnt vmcnt(0)" ::: "memory");
    __syncthreads();
    if (threadIdx.x == 0) {
        unsigned* bar = b.bar; b.x = xb_xcc_id();
        __builtin_amdgcn_s_waitcnt(0);
        unsigned nloc = b.st[0], nx = b.st[1];
        if (nloc == 0u) { xcd_barrier_complete(bar, b.x, nloc, nx); b.st[0] = nloc; b.st[1] = nx; }
        const unsigned old = xb_add(&bar[XB_XSUB(b.x)], 1u);
        const unsigned gen = old / nloc;
        if (old + 1u == (gen + 1u) * nloc) {
            __builtin_amdgcn_fence(__ATOMIC_RELEASE, "agent");
            asm volatile("s_waitcnt vmcnt(0)" ::: "memory");
            const unsigned og = xb_add(&bar[XB_TOP], 1u);
            const unsigned tg = og / nx;
            if (og + 1u == (tg + 1u) * nx) xb_add(&bar[XB_TOPGEN], 1u);
            else XB_SPIN(xb_ld(&bar[XB_TOPGEN]) == tg, bar);
            __builtin_amdgcn_fence(__ATOMIC_ACQUIRE, "agent");
            xb_add(&bar[XB_XGEN(b.x)], 1u);
            asm volatile("s_waitcnt vmcnt(0)" ::: "memory");
        } else {
            XB_SPIN(xb_ld(&bar[XB_XGEN(b.x)]) == gen, bar);
            __builtin_amdgcn_fence(__ATOMIC_ACQUIRE, "agent");
            asm volatile("s_waitcnt vmcnt(0)" ::: "memory");
        }
    }
    __syncthreads();
}

struct Params { const float* in[24]; float* out; unsigned char* ws; };
struct PRef {
    typedef const __attribute__((address_space(4))) char* kptr_t;
    __device__ __forceinline__ kptr_t base() const { kptr_t ka = (kptr_t)__builtin_amdgcn_kernarg_segment_ptr(); asm volatile("" : "+s"(ka)); return ka; }
    __device__ __forceinline__ const float* in(int i) const { return *(const float* const __attribute__((address_space(4)))*)(base() + 8 * i); }
    __device__ __forceinline__ float* out() const { return *(float* const __attribute__((address_space(4)))*)(base() + 8 * 24); }
    __device__ __forceinline__ unsigned char* ws() const { return *(unsigned char* const __attribute__((address_space(4)))*)(base() + 8 * 25); }
};
enum { I_X = 0, I_C, I_CTX, I_CCTX, I_MODW, I_MODB, I_N1G, I_N2G, I_WIN, I_DAQKG, I_DALAM, I_DAOUTG, I_CONVW, I_CONVB, I_GATEB, I_MLOUTG, I_QNG, I_KVNG, I_WUQ, I_WUKV, I_MLAQKG, I_WOUT, I_WGU, I_WDN };

struct Ctx {
    unsigned char* lds;
    int tid, lane, wave, gw, ngw, nwg, wg; unsigned l3off;
};

__device__ __forceinline__ Ctx fresh(const Ctx& X) {
    Ctx Y = X; int t = X.tid; asm volatile("" : "+v"(t)); Y.tid = t; Y.lane = t & 63; Y.wave = __builtin_amdgcn_readfirstlane(t >> 6); return Y;
}
template <int MODE>
__device__ __forceinline__ void transpose_item(const float* W, int K, int N, bf16_t* WT, float* scr, int item, int nblk, int lane) {
    const int kb = item / nblk, nb = item % nblk, k0 = 64 * kb, n0 = 32 * nb;
    const int ncol = n0 + (lane & 31); const bool ok = ncol < N;
#pragma unroll 8
    for (int i = 0; i < 32; ++i) { const int kk = 2 * i + (lane >> 5); scr[kk * 33 + (lane & 31)] = ok ? W[(size_t)(k0 + kk) * N + ncol] : 0.f; }
    asm volatile("s_waitcnt lgkmcnt(0)" ::: "memory");
    const int c = lane & 7;
#pragma unroll
    for (int j = 0; j < 4; ++j) { const int n = (lane >> 3) + 8 * j; const float* s = scr + (8 * c) * 33 + n;
        u32x4 o; o.x = pk2(s[0 * 33], s[1 * 33]); o.y = pk2(s[2 * 33], s[3 * 33]); o.z = pk2(s[4 * 33], s[5 * 33]); o.w = pk2(s[6 * 33], s[7 * 33]);
        int nn = n0 + n;
        if (MODE == 1) { const int up = nn >= FF ? 1 : 0; const int hcol = nn - up * FF; nn = (hcol >> 7) * 256 + up * 128 + (hcol & 127); }
        *(u32x4*)(WT + (size_t)nn * K + k0 + 8 * c) = o; }
    asm volatile("s_waitcnt lgkmcnt(0)" ::: "memory");
}
__device__ __forceinline__ void convert_weights(const Ctx& X0, const PRef& P, int l, int part, int wg_lo) {
    const Ctx X = fresh(X0);
    const int vwg = X.wg - wg_lo; if (vwg < 0) return;
    const int gwv = vwg * 8 + X.wave, ngwv = (X.nwg - wg_lo) * 8;
    float* scr = (float*)(X.lds + X.wave * 16384);
    unsigned char* ws = P.ws();
    constexpr int I_IN = (DM / 64) * (NPROJ / 32), I_OUT = (DM / 64) * (DM / 32), I_GU = (DM / 64) * (2 * FF / 32), I_DN = (FF / 64) * (DM / 32), I_UQ = (512 / 64) * (1536 / 32), I_UKV = (256 / 64) * (2048 / 32);
    constexpr int NITEMS = I_IN + I_OUT + I_GU + I_DN + I_UQ + I_UKV;
    const int it_lo = part == 2 ? NITEMS - I_DN : 0, it_hi = part == 1 ? NITEMS - I_DN : NITEMS;
    for (int it = it_lo + gwv; it < it_hi; it += ngwv) {
        int r = it;
        if (r < I_IN) { transpose_item<0>(P.in(I_WIN) + (size_t)l * DM * IN_W, DM, IN_W, (bf16_t*)(ws + WS_WIN), scr, r, NPROJ / 32, X.lane); continue; } r -= I_IN;
        if (r < I_OUT) { transpose_item<0>(P.in(I_WOUT) + (size_t)l * DM * DM, DM, DM, (bf16_t*)(ws + WS_WOUT), scr, r, DM / 32, X.lane); continue; } r -= I_OUT;
        if (r < I_GU) { transpose_item<1>(P.in(I_WGU) + (size_t)l * DM * 2 * FF, DM, 2 * FF, (bf16_t*)(ws + WS_WGU), scr, r, 2 * FF / 32, X.lane); continue; } r -= I_GU;
        if (r < I_UQ) { transpose_item<0>(P.in(I_WUQ) + (size_t)l * 512 * 1536, 512, 1536, (bf16_t*)(ws + WS_WUQ), scr, r, 1536 / 32, X.lane); continue; } r -= I_UQ;
        if (r < I_UKV) { transpose_item<0>(P.in(I_WUKV) + (size_t)l * 256 * 2048, 256, 2048, (bf16_t*)(ws + WS_WUKV), scr, r, 2048 / 32, X.lane); continue; } r -= I_UKV;
        transpose_item<0>(P.in(I_WDN) + (size_t)l * FF * DM, FF, DM, (bf16_t*)(ws + ((l & 1) ? WS_WDN2 : WS_WDN)), scr, r, DM / 32, X.lane);
    }
}
__device__ __forceinline__ void mod_gemv(const Ctx& X0, const PRef& P, int l_lo, int l_hi, int wg_lo) {
    const Ctx X = fresh(X0);
    const int vwg = X.wg - wg_lo; if (vwg < 0) return;
    float* sc = (float*)X.lds;
    float* red = (float*)(X.lds + 40960);
    {
        const float* cin = P.in(I_C); const float* cct = P.in(I_CCTX);
        float vb[20];
#pragma unroll
        for (int j = 0; j < 20; ++j) { const int k = (X.tid + 512 * (j & 3)); vb[j] = (j >> 2) < 4 ? cin[(j >> 2) * DM + k] : cct[k]; }
#pragma unroll
        for (int j = 0; j < 20; ++j) sc[(j >> 2) * DM + X.tid + 512 * (j & 3)] = siluf(vb[j]);
    }
    __syncthreads();
    float* mod = (float*)(P.ws() + WS_MOD);
    const int kq = X.tid >> 4, c4 = X.tid & 15;
    for (int task = vwg; task < (l_hi - l_lo) * 192; task += X.nwg - wg_lo) {
        const int l = l_lo + task / 192, n0 = (task % 192) * 64;
        const float* W = P.in(I_MODW) + (size_t)l * DM * 6 * DM + n0 + 4 * c4;
        f32x4 a[5];
#pragma unroll
        for (int mb = 0; mb < 5; ++mb) a[mb] = (f32x4){0.f, 0.f, 0.f, 0.f};
#pragma unroll 8
        for (int i = 0; i < 64; ++i) { const int k = kq + 32 * i; const f32x4 w = *(const f32x4*)(W + (size_t)k * 6 * DM);
#pragma unroll
            for (int mb = 0; mb < 5; ++mb) a[mb] += w * sc[mb * DM + k]; }
#pragma unroll
        for (int mb = 0; mb < 5; ++mb) *(f32x4*)(red + (kq * 5 + mb) * 64 + 4 * c4) = a[mb];
        __syncthreads();
        if (X.tid < 320) { const int mb = X.tid >> 6, cc = X.tid & 63; float s = 0.f;
#pragma unroll 8
            for (int q = 0; q < 32; ++q) s += red[(q * 5 + mb) * 64 + cc];
            mod[((size_t)l * 5 + mb) * 6 * DM + n0 + cc] = s + P.in(I_MODB)[(size_t)l * 6 * DM + n0 + cc]; }
        __syncthreads();
    }
}

__device__ __forceinline__ void modulate_phase(const Ctx& X0, const float* src_lat, const float* src_ctx, const float* g, const float* modl, int shift_off, int scale_off, bf16_t* A, int nrows) {
    const Ctx X = fresh(X0);
    const int rpw = (nrows + X.ngw - 1) / X.ngw;
    int row = X.gw * rpw; const int rend = min(row + rpw, nrows);
    f32x4 v[8], nx[8], gm[8], sh[8];
    int cur_mb = -1;
    if (row < rend) { const float* src = row < M_LAT ? src_lat + (size_t)row * DM : src_ctx + (size_t)(row - M_LAT) * DM;
#pragma unroll
        for (int j = 0; j < 8; ++j) v[j] = *(const f32x4*)(src + X.lane * 4 + 256 * j); }
    for (; row < rend; ++row) {
        const int nrow = row + 1;
        if (nrow < rend) { const float* src = nrow < M_LAT ? src_lat + (size_t)nrow * DM : src_ctx + (size_t)(nrow - M_LAT) * DM;
#pragma unroll
            for (int j = 0; j < 8; ++j) nx[j] = *(const f32x4*)(src + X.lane * 4 + 256 * j); }
        const int mb = mod_batch(row);
        if (mb != cur_mb) { cur_mb = mb; const float* mp = modl + (size_t)mb * 6 * DM;
#pragma unroll
            for (int j = 0; j < 8; ++j) { const int col = X.lane * 4 + 256 * j; gm[j] = *(const f32x4*)(g + col) * (*(const f32x4*)(mp + scale_off + col) + 1.0f); sh[j] = *(const f32x4*)(mp + shift_off + col); } }
        float ss = 0.f;
#pragma unroll
        for (int j = 0; j < 8; ++j) ss += (v[j][0] * v[j][0] + v[j][1] * v[j][1]) + (v[j][2] * v[j][2] + v[j][3] * v[j][3]);
        const float rstd = rsqrtf(wave_sum(ss) * (1.f / DM) + EPS);
#pragma unroll
        for (int j = 0; j < 8; ++j) { const int col = X.lane * 4 + 256 * j;
            const f32x4 y = (v[j] * rstd) * gm[j] + sh[j];
            u32x2 w; w.x = pk2(y[0], y[1]); w.y = pk2(y[2], y[3]);
            *(u32x2*)(A + (size_t)row * DM + col) = w; }
#pragma unroll
        for (int j = 0; j < 8; ++j) v[j] = nx[j];
    }
}

struct ChunkId { int b, j, row0, tok0, is_lat, seglen; };
__device__ __forceinline__ ChunkId chunk_of_unit(int u) {
    ChunkId c;
    if (u < 256) { c.b = u >> 6; c.j = u & 63; c.row0 = c.b * SEQ + 64 * c.j; c.tok0 = CTXL + 64 * c.j; c.is_lat = 1; c.seglen = SEQ; }
    else { const int uu = u - 256; c.b = uu >> 2; c.j = uu & 3; c.row0 = M_LAT + c.b * CTXL + 64 * c.j; c.tok0 = 64 * c.j; c.is_lat = 0; c.seglen = CTXL; }
    return c;
}
__device__ __forceinline__ int row_of_tokchunk(int b, int jt) { return jt < 4 ? M_LAT + b * CTXL + 64 * jt : b * SEQ + 64 * (jt - 4); }

constexpr int TSTR = 520;
__device__ __forceinline__ void write_vt(const Ctx& X, const bf16_t* tile, bf16_t* img, size_t img_row0, int tok0) {
#pragma unroll 2
    for (int it = 0; it < 8; ++it) { const int task = it * 512 + X.tid; const int k = task & 7, c = task >> 3;
        float v[8];
#pragma unroll
        for (int jj = 0; jj < 8; ++jj) { const int i = 16 * (k >> 1) + 8 * (jj >> 2) + 4 * (k & 1) + (jj & 3); v[jj] = bf1(tile[i * TSTR + c]); }
        *(u32x4*)(img + (img_row0 + c) * TK + tok0 + 8 * k) = pack8(v); }
}
template <class F>
__device__ __forceinline__ void load_tile(const Ctx& X, bf16_t* tile, const bf16_t* src, size_t rstride, F colmap) {
#pragma unroll 4
    for (int it = 0; it < 8; ++it) { const int ch = it * 512 + X.tid; const int i = ch >> 6, cc = ch & 63;
        const u32x4 w = *(const u32x4*)(src + (size_t)i * rstride + colmap(cc));
        *(u32x4*)(tile + i * TSTR + 8 * cc) = w; }
}

__device__ __forceinline__ void rope_cs(int sub, int prow, int pcol, float* cs, float* sn) {
    const float pos = (float)((sub < 4) ? prow : pcol);
#pragma unroll
    for (int e = 0; e < 8; ++e) { const int fi = (sub & 1) * 8 + e; const float inv = exp2f(-(float)fi * (13.287712379549449f / 16.0f)); const float a = pos * inv; cs[e] = __cosf(a); sn[e] = __sinf(a); }
}
__device__ __forceinline__ void rope_apply(int sub, float* y, const float* cs, const float* sn) {
#pragma unroll
    for (int e = 0; e < 8; ++e) { const float p = __shfl_xor(y[e], 2); y[e] = (sub & 2) ? (y[e] * cs[e] + p * sn[e]) : (y[e] * cs[e] - p * sn[e]); }
}

__device__ __forceinline__ void prep_phase(const Ctx& X0, const PRef& P, int l) {
    const Ctx X = fresh(X0);
    unsigned char* ws = P.ws();
    const bf16_t* proj = (const bf16_t*)(ws + WS_PROJ);
    bf16_t* tile = (bf16_t*)X.lds;
    const float* qkg = P.in(I_DAQKG) + l * 128;
    const float* convw = P.in(I_CONVW) + (size_t)l * 3 * 1024; const float* convb = P.in(I_CONVB) + l * 1024;
    const float* qng = P.in(I_QNG) + l * 512; const float* kvng = P.in(I_KVNG) + l * 256;
    const int lane = X.lane, sub = lane & 7;
    const float qscale = 0.125f * LOG2E;
    for (int uu = X.wg; uu < 4 * 272; uu += X.nwg) {
        const int part = uu / 272, u = uu % 272;
        const ChunkId c = chunk_of_unit(u);
        if (part == 0) {
        struct R0 { u32x4 q, k, cq, ckv, kpe, o; };
        auto ld0 = [&](int i_) { R0 r; const bf16_t* pr_ = proj + (size_t)(c.row0 + i_) * NPROJ; const u32x4 z = {0u, 0u, 0u, 0u};
            r.q = *(const u32x4*)(pr_ + C_DAQ + 8 * lane); r.k = *(const u32x4*)(pr_ + C_DAK + 8 * lane); r.cq = *(const u32x4*)(pr_ + C_CQ + 8 * lane);
            r.ckv = z; if (lane < 32) r.ckv = *(const u32x4*)(pr_ + C_CKV + 8 * lane);
            r.kpe = z; if (lane < 8) r.kpe = *(const u32x4*)(pr_ + C_KPE + 8 * lane);
            r.o = *(const u32x4*)(pr_ + C_MLO + 8 * lane); return r; };
        R0 cur = ld0(X.wave);
        for (int i = X.wave; i < 64; i += 8) {
            R0 nxt = cur; if (i + 8 < 64) nxt = ld0(i + 8);
            const int row = c.row0 + i, tok = c.tok0 + i;
            float cs[8], sn[8];
            if (c.is_lat) rope_cs(sub, c.j, i, cs, sn);
#pragma unroll
            for (int qk = 0; qk < 2; ++qk) {
                float y[8]; unpack8(qk ? cur.k : cur.q, y);
                float ss = 0.f;
#pragma unroll
                for (int e = 0; e < 8; ++e) ss += y[e] * y[e];
                ss += __shfl_xor(ss, 1); ss += __shfl_xor(ss, 2); ss += __shfl_xor(ss, 4);
                const float rstd = rsqrtf(ss * (1.f / 64.f) + EPS);
#pragma unroll
                for (int e = 0; e < 8; ++e) y[e] = y[e] * rstd * qkg[qk * 64 + 8 * sub + e];
                if (c.is_lat) rope_apply(sub, y, cs, sn);
                const int head = lane >> 4, comp = (lane >> 3) & 1;
                if (qk == 0) {
#pragma unroll
                    for (int e = 0; e < 8; ++e) y[e] *= qscale;
                    *(u32x4*)((bf16_t*)(ws + WS_QDA) + ((size_t)head * M_ALL + row) * 128 + comp * 64 + 8 * sub) = pack8(y);
                } else {
                    *(u32x4*)((bf16_t*)(ws + WS_KDA) + ((size_t)(c.b * 4 + head) * TK + tok) * 128 + comp * 64 + 8 * sub) = pack8(y);
                }
            }
            {
                float y[8]; unpack8(cur.cq, y);
                float ss = 0.f;
#pragma unroll
                for (int e = 0; e < 8; ++e) ss += y[e] * y[e];
                const float rstd = rsqrtf(wave_sum(ss) * (1.f / 512.f) + EPS);
#pragma unroll
                for (int e = 0; e < 8; ++e) y[e] = y[e] * rstd * qng[8 * lane + e];
                *(u32x4*)((bf16_t*)(ws + WS_CQN) + (size_t)row * 512 + 8 * lane) = pack8(y);
            }
            {
                float y[8]; unpack8(cur.ckv, y);
                float ss = 0.f;
#pragma unroll
                for (int e = 0; e < 8; ++e) ss += y[e] * y[e];
                const float rstd = rsqrtf(wave_sum(ss) * (1.f / 256.f) + EPS);
                if (lane < 32) {
#pragma unroll
                    for (int e = 0; e < 8; ++e) y[e] = y[e] * rstd * kvng[8 * lane + e];
                    *(u32x4*)((bf16_t*)(ws + WS_CKVN) + (size_t)row * 256 + 8 * lane) = pack8(y);
                }
            }
            if (lane < 8) *(u32x4*)((bf16_t*)(ws + WS_KPE) + (size_t)row * 64 + 8 * lane) = cur.kpe;
            *(u32x4*)((bf16_t*)(ws + WS_OCOPY) + (size_t)row * 512 + 8 * lane) = cur.o;
            cur = nxt;
        }
        } else if (part == 1) {
        struct R1 { u32x4 x0[2], xm[2], xp[2]; };
        auto ld1 = [&](int i_) { R1 r; const int tseg_ = 64 * c.j + i_; const bf16_t* pr_ = proj + (size_t)(c.row0 + i_) * NPROJ + C_MLQ; const u32x4 z = {0u, 0u, 0u, 0u};
#pragma unroll
            for (int qk = 0; qk < 2; ++qk) { const int ch0 = qk * 512 + 8 * lane;
                r.x0[qk] = *(const u32x4*)(pr_ + ch0);
                r.xm[qk] = z; if (tseg_ > 0) r.xm[qk] = *(const u32x4*)(pr_ - NPROJ + ch0);
                r.xp[qk] = z; if (tseg_ < c.seglen - 1) r.xp[qk] = *(const u32x4*)(pr_ + NPROJ + ch0); }
            return r; };
        R1 cur = ld1(X.wave);
        for (int i = X.wave; i < 64; i += 8) {
            R1 nxt = cur; if (i + 8 < 64) nxt = ld1(i + 8);
            const int tok = c.tok0 + i;
#pragma unroll
            for (int qk = 0; qk < 2; ++qk) {
                const int ch0 = qk * 512 + 8 * lane;
                float xm[8], x0[8], xp[8];
                unpack8(cur.x0[qk], x0); unpack8(cur.xm[qk], xm); unpack8(cur.xp[qk], xp);
                float y[8];
#pragma unroll
                for (int e = 0; e < 8; ++e) { const float v = convb[ch0 + e] + convw[ch0 + e] * xm[e] + convw[1024 + ch0 + e] * x0[e] + convw[2048 + ch0 + e] * xp[e]; y[e] = siluf(v) * (qk ? 0.08838834764831845f : 1.0f); }
                const int head = lane >> 4, d = 8 * (lane & 15);
                const u32x4 w = pack8(y);
                *(u32x4*)((bf16_t*)(ws + (qk ? WS_KML : WS_QML)) + ((size_t)(c.b * 4 + head) * TK + tok) * 128 + d) = w;
                if (qk) *(u32x4*)(tile + i * TSTR + 8 * lane) = w;
            }
            cur = nxt;
        }
        __syncthreads();
        write_vt(X, tile, (bf16_t*)(ws + WS_KTML), (size_t)c.b * 512, c.tok0);
        __syncthreads();
        } else if (part == 2) {
        load_tile(X, tile, proj + (size_t)c.row0 * NPROJ, NPROJ, [](int cc) { return C_DAV + 8 * cc; });
        __syncthreads();
        write_vt(X, tile, (bf16_t*)(ws + WS_VTDA), (size_t)c.b * 512, c.tok0);
        __syncthreads();
        } else {
        load_tile(X, tile, proj + (size_t)c.row0 * NPROJ, NPROJ, [](int cc) { return C_MLV + 8 * cc; });
        __syncthreads();
        write_vt(X, tile, (bf16_t*)(ws + WS_VTML), (size_t)c.b * 512, c.tok0);
        __syncthreads();
        }
    }
}

__device__ __forceinline__ void mla_prep_phase(const Ctx& X0, const PRef& P, int l) {
    const Ctx X = fresh(X0);
    unsigned char* ws = P.ws();
    const bf16_t* qup = (const bf16_t*)(ws + WS_QUP); const bf16_t* kvup = (const bf16_t*)(ws + WS_KVUP); const bf16_t* kpe = (const bf16_t*)(ws + WS_KPE);
    bf16_t* tile = (bf16_t*)X.lds;
    const float* g = P.in(I_MLAQKG) + l * 2 * 192;
    const int lane = X.lane, sub = lane & 7, head = lane >> 3;
    const float qscale = 0.07216878364870322f * LOG2E;
    for (int uu = X.wg; uu < 3 * 272; uu += X.nwg) {
        const int part = uu / 272, u = uu % 272;
        const ChunkId c = chunk_of_unit(u);
        if (part == 0) {
        struct R2 { u32x4 q[3], k[3]; };
        auto ld2 = [&](int i_) { R2 r; const size_t row_ = (size_t)(c.row0 + i_);
#pragma unroll
            for (int cc = 0; cc < 3; ++cc) r.q[cc] = *(const u32x4*)(qup + row_ * 1536 + head * 192 + 64 * cc + 8 * sub);
#pragma unroll
            for (int cc = 0; cc < 2; ++cc) r.k[cc] = *(const u32x4*)(kvup + row_ * 2048 + head * 256 + 64 * cc + 8 * sub);
            r.k[2] = *(const u32x4*)(kpe + row_ * 64 + 8 * sub); return r; };
        R2 cur = ld2(X.wave);
        for (int i = X.wave; i < 64; i += 8) {
            R2 nxt = cur; if (i + 8 < 64) nxt = ld2(i + 8);
            const int row = c.row0 + i, tok = c.tok0 + i;
            float cs[8], sn[8];
            if (c.is_lat) rope_cs(sub, c.j, i, cs, sn);
#pragma unroll
            for (int qk = 0; qk < 2; ++qk) {
                float y[3][8];
#pragma unroll
                for (int cc = 0; cc < 3; ++cc) unpack8(qk == 0 ? cur.q[cc] : cur.k[cc], y[cc]);
                float ss = 0.f;
#pragma unroll
                for (int cc = 0; cc < 3; ++cc)
#pragma unroll
                    for (int e = 0; e < 8; ++e) ss += y[cc][e] * y[cc][e];
                ss += __shfl_xor(ss, 1); ss += __shfl_xor(ss, 2); ss += __shfl_xor(ss, 4);
                const float rstd = rsqrtf(ss * (1.f / 192.f) + EPS);
#pragma unroll
                for (int cc = 0; cc < 3; ++cc)
#pragma unroll
                    for (int e = 0; e < 8; ++e) y[cc][e] = y[cc][e] * rstd * g[qk * 192 + 64 * cc + 8 * sub + e];
                if (c.is_lat) rope_apply(sub, y[2], cs, sn);
                bf16_t* dst;
                if (qk == 0) {
#pragma unroll
                    for (int cc = 0; cc < 3; ++cc)
#pragma unroll
                        for (int e = 0; e < 8; ++e) y[cc][e] *= qscale;
                    dst = (bf16_t*)(ws + WS_QM) + ((size_t)head * M_ALL + row) * 192;
                } else dst = (bf16_t*)(ws + WS_KM) + ((size_t)(c.b * 8 + head) * TK + tok) * 192;
#pragma unroll
                for (int cc = 0; cc < 3; ++cc) *(u32x4*)(dst + 64 * cc + 8 * sub) = pack8(y[cc]);
            }
            cur = nxt;
        }
        } else {
            const int p = part - 1;
            load_tile(X, tile, kvup + (size_t)c.row0 * 2048, 2048, [p](int cc) { return (4 * p + (cc >> 4)) * 256 + 128 + 8 * (cc & 15); });
            __syncthreads();
            write_vt(X, tile, (bf16_t*)(ws + WS_VTM), (size_t)(c.b * 8 + 4 * p) * 128, c.tok0);
            __syncthreads();
        }
    }
}

__device__ __forceinline__ void ml_gates(const float* gates, const float* gb, int b, int jt, int dir, int h, int lane, float& ig, float& lf, float& pre, float& total) {
    const int row = row_of_tokchunk(b, jt) + lane;
    ig = gates[(size_t)row * 16 + dir * 8 + h] + gb[dir * 8 + h];
    const float fg = gates[(size_t)row * 16 + dir * 8 + 4 + h] + gb[dir * 8 + 4 + h];
    lf = fminf(fg, 0.f) - log1pf(__expf(-fabsf(fg)));
    float s = lf;
#pragma unroll
    for (int o = 1; o < 64; o <<= 1) { const float t = __shfl_up(s, o); if (lane >= o) s += t; }
    pre = s; total = __shfl(s, 63);
}
constexpr int KSTR = 72;
constexpr int QSTR = 136;
__device__ __forceinline__ void mlstm_a_phase(const Ctx& X0, const PRef& P, int l) {
    const Ctx X = fresh(X0);
    unsigned char* ws = P.ws();
    const float* gates = (const float*)(ws + WS_GATES); const float* gb = P.in(I_GATEB) + l * 16;
    bf16_t* Kt = (bf16_t*)X.lds;
    bf16_t* Vw = (bf16_t*)(X.lds + 128 * KSTR * 2);
    float* wtab = (float*)(X.lds + 3 * 128 * KSTR * 2);
    const int lane = X.lane, r32 = lane & 31, hi = lane >> 5;
    for (int u = (X.wg + X.nwg - 152 % X.nwg) % X.nwg; u < 16 * NCH; u += X.nwg) {
        const int bh = u / NCH, jt = u % NCH, b = bh >> 2, h = bh & 3, tok0 = 64 * jt;
        if (X.wave < 2) {
            const int dir = X.wave; float ig, lf, pre, total; ml_gates(gates, gb, b, jt, dir, h, lane, ig, lf, pre, total);
            const float cum = dir == 0 ? pre : total - pre + lf;
            const float wlog = total - cum + ig; const float mloc = wave_max(wlog);
            wtab[dir * 64 + lane] = __expf(wlog - mloc);
            if (lane == 0) { float* cs = (float*)(ws + WS_CSTAT) + ((size_t)(bh * 2 + dir) * NCH + jt) * 4; cs[0] = total; cs[1] = mloc; }
        }
        u32x4 vr[2];
#pragma unroll
        for (int it = 0; it < 2; ++it) { const int ch = it * 512 + X.tid; const int rr = ch >> 3, k = ch & 7;
            *(u32x4*)(Kt + rr * KSTR + 8 * k) = *(const u32x4*)((const bf16_t*)(ws + WS_KTML) + ((size_t)bh * 128 + rr) * TK + tok0 + 8 * k);
            vr[it] = *(const u32x4*)((const bf16_t*)(ws + WS_VTML) + ((size_t)bh * 128 + rr) * TK + tok0 + 8 * k); }
        __syncthreads();
#pragma unroll
        for (int it = 0; it < 2; ++it) { const int ch = it * 512 + X.tid; const int rr = ch >> 3, k = ch & 7;
            float v[8]; unpack8(vr[it], v);
#pragma unroll
            for (int dir = 0; dir < 2; ++dir) { float o[8];
#pragma unroll
                for (int jj = 0; jj < 8; ++jj) { const int i = 16 * (k >> 1) + 8 * (jj >> 2) + 4 * (k & 1) + (jj & 3); o[jj] = v[jj] * wtab[dir * 64 + i]; }
                *(u32x4*)(Vw + (dir * 128 + rr) * KSTR + 8 * k) = pack8(o); } }
        __syncthreads();
        {
            const int dir = X.wave >> 2, dvb = X.wave & 3;
            bf16_t* U = (bf16_t*)(ws + WS_AB) + ((size_t)(bh * 2 + dir) * NCH + jt) * 16384;
            bf16x8 a[4];
#pragma unroll
            for (int ks = 0; ks < 4; ++ks) a[ks] = *(const bf16x8*)(Vw + (dir * 128 + 32 * dvb + r32) * KSTR + 16 * ks + 8 * hi);
            for (int dkb = 0; dkb < 4; ++dkb) {
                f32x16 acc;
#pragma unroll
                for (int r = 0; r < 16; ++r) acc[r] = 0.f;
#pragma unroll
                for (int ks = 0; ks < 4; ++ks) { const bf16x8 bb = *(const bf16x8*)(Kt + (32 * dkb + r32) * KSTR + 16 * ks + 8 * hi); acc = __builtin_amdgcn_mfma_f32_32x32x16_bf16(a[ks], bb, acc, 0, 0, 0); }
#pragma unroll
                for (int r = 0; r < 16; ++r) U[(32 * dvb + crow(r, hi)) * 128 + 32 * dkb + r32] = (bf16_t)(pk2(acc[r], 0.f) & 0xffffu);
            }
        }
        if (X.tid < 256) { const int dir = X.tid >> 7, dk = X.tid & 127; float s = 0.f;
#pragma unroll 8
            for (int p = 0; p < 64; ++p) { const int i = (p & ~15) + perm_off(p & 15); s += wtab[dir * 64 + i] * bf1(Kt[dk * KSTR + p]); }
            ((float*)(ws + WS_NU))[((size_t)(bh * 2 + dir) * NCH + jt) * 128 + dk] = s; }
        __syncthreads();
    }
}
__device__ __forceinline__ int ml_jmap(int dir, int c) { return dir == 0 ? c : (c < 4 ? 3 - c : 71 - c); }
__device__ __forceinline__ void mlstm_scan_phase(const Ctx& X0, const PRef& P) {
    const Ctx X = fresh(X0);
    unsigned char* ws = P.ws();
    float* cstat = (float*)(ws + WS_CSTAT);
    const int gtid = (X.nwg - 1 - X.wg) * 512 + X.tid, nthr = X.nwg * 512;
    for (int task = gtid; task < 65536 + 1024; task += nthr) {
        float m = 0.f;
        if (task < 65536) {
            const int seq = task >> 11, e = task & 2047, dir = seq & 1;
            const bf16_t* __restrict__ U = (const bf16_t*)(ws + WS_AB); bf16_t* __restrict__ S = (bf16_t*)(ws + WS_CSNAP);
            float C[8];
#pragma unroll
            for (int i = 0; i < 8; ++i) C[i] = 0.f;
            for (int cb = 0; cb < 4; ++cb) {
                u32x4 uu[17]; float tot[17], mlc[17];
#pragma unroll
                for (int i = 0; i < 17; ++i) { const size_t base = (size_t)seq * NCH + ml_jmap(dir, cb * 17 + i);
                    uu[i] = *(const u32x4*)(U + base * 16384 + 8 * e); tot[i] = cstat[base * 4]; mlc[i] = cstat[base * 4 + 1]; }
#pragma unroll
                for (int i = 0; i < 17; ++i) { const size_t base = (size_t)seq * NCH + ml_jmap(dir, cb * 17 + i);
                    *(u32x4*)(S + base * 16384 + 8 * e) = pack8(C);
                    if (e == 0) cstat[base * 4 + 2] = m;
                    const float mn = fmaxf(tot[i] + m, mlc[i]); const float dec = __expf(tot[i] + m - mn), sc = __expf(mlc[i] - mn);
                    float u8[8]; unpack8(uu[i], u8);
#pragma unroll
                    for (int q = 0; q < 8; ++q) C[q] = C[q] * dec + u8[q] * sc;
                    m = mn; }
            }
        } else {
            const int t2 = task - 65536, seq = t2 >> 5, e4 = t2 & 31, dir = seq & 1;
            const float* __restrict__ NU = (const float*)(ws + WS_NU); float* __restrict__ NS = (float*)(ws + WS_NSNAP);
            f32x4 C = (f32x4){0.f, 0.f, 0.f, 0.f};
            for (int cb = 0; cb < 4; ++cb) {
                f32x4 uu[17]; float tot[17], mlc[17];
#pragma unroll
                for (int i = 0; i < 17; ++i) { const size_t base = (size_t)seq * NCH + ml_jmap(dir, cb * 17 + i);
                    uu[i] = *(const f32x4*)(NU + base * 128 + 4 * e4); tot[i] = cstat[base * 4]; mlc[i] = cstat[base * 4 + 1]; }
#pragma unroll
                for (int i = 0; i < 17; ++i) { const size_t base = (size_t)seq * NCH + ml_jmap(dir, cb * 17 + i);
                    *(f32x4*)(NS + base * 128 + 4 * e4) = C;
                    const float mn = fmaxf(tot[i] + m, mlc[i]); const float dec = __expf(tot[i] + m - mn), sc = __expf(mlc[i] - mn);
                    C = C * dec + uu[i] * sc; m = mn; }
            }
        }
    }
}
__device__ __forceinline__ void mlstm_c_unit(const Ctx& X0, const PRef& P, int l, int u) {
    const Ctx X = fresh(X0);
    unsigned char* ws = P.ws();
    const float* gates = (const float*)(ws + WS_GATES); const float* gb = P.in(I_GATEB) + l * 16;
    const float* cstat = (const float*)(ws + WS_CSTAT);
    bf16_t* Qt = (bf16_t*)X.lds;
    bf16_t* Kn = (bf16_t*)(X.lds + 64 * QSTR * 2);
    bf16_t* Vt = (bf16_t*)(X.lds + 2 * 64 * QSTR * 2);
    float* tab = (float*)(X.lds + 2 * 64 * QSTR * 2 + 128 * KSTR * 2);
    float* t_a = tab, *t_c1 = tab + 128, *t_wp = tab + 256, *t_em = tab + 384, *t_n = tab + 512, *t_red = tab + 768;
    const int lane = X.lane, r32 = lane & 31, hi = lane >> 5;
    const int bh = u / NCH, jt = u % NCH, b = bh >> 2, h = bh & 3, tok0 = 64 * jt;
    if (X.wave < 2) {
        const int dir = X.wave; float ig, lf, pre, total; ml_gates(gates, gb, b, jt, dir, h, lane, ig, lf, pre, total);
        const float cum = dir == 0 ? pre : total - pre + lf;
        const float a = ig - cum; float pm = a;
#pragma unroll
        for (int o = 1; o < 64; o <<= 1) { const float t = dir == 0 ? __shfl_up(pm, o) : __shfl_down(pm, o); const bool ok = dir == 0 ? (lane >= o) : (lane + o < 64); if (ok) pm = fmaxf(pm, t); }
        const float mc = cstat[((size_t)(bh * 2 + dir) * NCH + jt) * 4 + 2];
        const float mt = cum + fmaxf(mc, pm);
        t_a[dir * 64 + lane] = a; t_c1[dir * 64 + lane] = cum - mt; t_wp[dir * 64 + lane] = __expf(cum + mc - mt); t_em[dir * 64 + lane] = __expf(-mt);
    }
#pragma unroll
    for (int it = 0; it < 2; ++it) { const int ch = it * 512 + X.tid;
        { const int i = ch >> 4, k = ch & 15;
          *(u32x4*)(Qt + i * QSTR + 8 * k) = *(const u32x4*)((const bf16_t*)(ws + WS_QML) + ((size_t)bh * TK + tok0 + i) * 128 + 8 * k);
          *(u32x4*)(Kn + i * QSTR + 8 * k) = *(const u32x4*)((const bf16_t*)(ws + WS_KML) + ((size_t)bh * TK + tok0 + i) * 128 + 8 * k); }
        { const int rr = ch >> 3, k = ch & 7;
          *(u32x4*)(Vt + rr * KSTR + 8 * k) = *(const u32x4*)((const bf16_t*)(ws + WS_VTML) + ((size_t)bh * 128 + rr) * TK + tok0 + 8 * k); } }
    if (X.tid < 256) t_n[X.tid] = ((const float*)(ws + WS_NSNAP))[((size_t)(bh * 2 + (X.tid >> 7)) * NCH + jt) * 128 + (X.tid & 127)];
    __syncthreads();
    const int tb = X.wave & 1, db = X.wave >> 1, t = 32 * tb + r32;
    bf16x8 qf[8];
#pragma unroll
    for (int ks = 0; ks < 8; ++ks) qf[ks] = *(const bf16x8*)(Qt + t * QSTR + 16 * ks + 8 * hi);
    f32x16 st[2];
#pragma unroll
    for (int sb = 0; sb < 2; ++sb) {
#pragma unroll
        for (int r = 0; r < 16; ++r) st[sb][r] = 0.f;
#pragma unroll
        for (int ks = 0; ks < 8; ++ks) { const bf16x8 kf = *(const bf16x8*)(Kn + (32 * sb + r32) * QSTR + 16 * ks + 8 * hi); st[sb] = __builtin_amdgcn_mfma_f32_32x32x16_bf16(kf, qf[ks], st[sb], 0, 0, 0); }
    }
    f32x16 hsum;
#pragma unroll
    for (int r = 0; r < 16; ++r) hsum[r] = 0.f;
#pragma unroll
    for (int dir = 0; dir < 2; ++dir) {
        const float c1 = t_c1[dir * 64 + t], wp = t_wp[dir * 64 + t], em = t_em[dir * 64 + t];
        float rs = 0.f; u32x4 pw[2][2];
#pragma unroll
        for (int sb = 0; sb < 2; ++sb) { float p[16];
#pragma unroll
            for (int r = 0; r < 16; ++r) { const int s = 32 * sb + crow(r, hi); const bool ok = dir == 0 ? (s <= t) : (s >= t);
                const float dm = ok ? __expf(t_a[dir * 64 + s] + c1) : 0.f; p[r] = st[sb][r] * dm; rs += p[r]; }
            pw[sb][0] = pack8(p); pw[sb][1] = pack8(p + 8); }
        rs += __shfl_xor(rs, 32);
        float qn = 0.f;
#pragma unroll
        for (int ks = 0; ks < 8; ++ks) { float q8[8]; unpack8(__builtin_bit_cast(u32x4, qf[ks]), q8);
#pragma unroll
            for (int e = 0; e < 8; ++e) qn += q8[e] * t_n[dir * 128 + 16 * ks + 8 * hi + e]; }
        qn += __shfl_xor(qn, 32);
        const float den = rs + wp * qn; const float rden = 1.f / fmaxf(fabsf(den), em);
        f32x16 acc;
#pragma unroll
        for (int r = 0; r < 16; ++r) acc[r] = 0.f;
        const bf16_t* Cs = (const bf16_t*)(ws + WS_CSNAP) + ((size_t)(bh * 2 + dir) * NCH + jt) * 16384 + (size_t)(32 * db + r32) * 128;
#pragma unroll
        for (int ks = 0; ks < 8; ++ks) { const bf16x8 cf = *(const bf16x8*)(Cs + 16 * ks + 8 * hi); acc = __builtin_amdgcn_mfma_f32_32x32x16_bf16(cf, qf[ks], acc, 0, 0, 0); }
#pragma unroll
        for (int r = 0; r < 16; ++r) acc[r] *= wp;
#pragma unroll
        for (int sb = 0; sb < 2; ++sb)
#pragma unroll
            for (int s2 = 0; s2 < 2; ++s2) { const bf16x8 vf = *(const bf16x8*)(Vt + (32 * db + r32) * KSTR + 32 * sb + 16 * s2 + 8 * hi);
                acc = __builtin_amdgcn_mfma_f32_32x32x16_bf16(vf, __builtin_bit_cast(bf16x8, pw[sb][s2]), acc, 0, 0, 0); }
#pragma unroll
        for (int r = 0; r < 16; ++r) hsum[r] += acc[r] * rden;
    }
    float ss = 0.f;
#pragma unroll
    for (int r = 0; r < 16; ++r) ss += hsum[r] * hsum[r];
    ss += __shfl_xor(ss, 32);
    if (hi == 0) t_red[(tb * 4 + db) * 32 + r32] = ss;
    __syncthreads();
    const float tot = t_red[(tb * 4 + 0) * 32 + r32] + t_red[(tb * 4 + 1) * 32 + r32] + t_red[(tb * 4 + 2) * 32 + r32] + t_red[(tb * 4 + 3) * 32 + r32];
    const float rstd = rsqrtf(tot * (1.f / 128.f) + EPS);
    const int row = row_of_tokchunk(b, jt) + t;
    const float* og = P.in(I_MLOUTG) + l * 512 + h * 128;
    const bf16_t* oc = (const bf16_t*)(ws + WS_OCOPY) + (size_t)row * 512 + h * 128;
    bf16_t* mix = (bf16_t*)(ws + WS_AB) + (size_t)row * DM + 512 + h * 128;
#pragma unroll
    for (int q = 0; q < 4; ++q) { const int dv = 32 * db + 8 * q + 4 * hi;
        const u32x2 ow = *(const u32x2*)(oc + dv); const f32x4 gg = *(const f32x4*)(og + dv);
        const float o0 = hsum[4 * q + 0] * rstd * gg[0] * sigmf(bflo(ow.x)), o1 = hsum[4 * q + 1] * rstd * gg[1] * sigmf(bfhi(ow.x));
        const float o2 = hsum[4 * q + 2] * rstd * gg[2] * sigmf(bflo(ow.y)), o3 = hsum[4 * q + 3] * rstd * gg[3] * sigmf(bfhi(ow.y));
        u32x2 w; w.x = pk2(o0, o1); w.y = pk2(o2, o3); *(u32x2*)(mix + dv) = w; }
    __syncthreads();
}

template <int DQK, int KROW>
struct AttnCore {
    static constexpr int NKS = DQK / 16, NKC1 = KROW / 8 + 1, KS = NKC1 * 8, KT_B = 64 * NKC1 * 16, VT_B = 128 * 9 * 16, SLOT_B = KT_B + VT_B;
    static constexpr int NBK = KT_B / 1024, NBV = VT_B / 1024, NB = NBK + NBV, NI = (NB + 7) / 8;
    static_assert(KT_B % 1024 == 0 && VT_B % 1024 == 0 && 8 * NI - NB <= 8 && 3 * SLOT_B <= 135168, "attention LDS geometry");
    static __device__ __forceinline__ void run(const Ctx& X, const bf16_t* Qrow, int kcol, const bf16_t* K, const bf16_t* Vt, int nt, f32x16 (&o)[4]) {
        const int lane = X.lane, r32 = lane & 31, hi = lane >> 5;
        LAS unsigned char* l3 = (LAS unsigned char*)0 + X.l3off;
        bf16x8 qf[NKS];
#pragma unroll
        for (int ks = 0; ks < NKS; ++ks) qf[ks] = *(const bf16x8*)(Qrow + 16 * ks + 8 * hi);
        unsigned goff[NI]; int bsel[NI];
#pragma unroll
        for (int i = 0; i < NI; ++i) {
            int bidx = X.wave + 8 * i; if (bidx >= NB) bidx -= NB;
            bsel[i] = bidx;
            if (bidx < NBK) { const int c = bidx * 64 + lane; const int row = c / NKC1; int col = c % NKC1; if (col > NKC1 - 2) col = NKC1 - 2; goff[i] = (unsigned)(row * KROW + 8 * col) * 2u; }
            else { const int c = (bidx - NBK) * 64 + lane; const int row = c / 9; int col = c % 9; if (col > 7) col = 7; goff[i] = (unsigned)(row * TK + 8 * col) * 2u; }
        }
        asm volatile("s_waitcnt vmcnt(0)" ::: "memory");
#pragma unroll
        for (int ks = 0; ks < NKS; ++ks) asm volatile("" : "+v"(qf[ks]));
        auto issue = [&](int t, int slotoff) {
#pragma unroll
            for (int i = 0; i < NI; ++i) {
                const char* base = bsel[i] < NBK ? (const char*)K + (size_t)t * (64 * KROW * 2) : (const char*)Vt + (size_t)t * 128;
                __builtin_amdgcn_global_load_lds((const unsigned*)(base + goff[i]), (LAS unsigned*)(l3 + slotoff + bsel[i] * 1024), 16, 0, 0);
            }
        };
#pragma unroll
        for (int d = 0; d < 4; ++d)
#pragma unroll
            for (int r = 0; r < 16; ++r) o[d][r] = 0.f;
        float mrun = -1e30f, lrun = 0.f;
        issue(0, 0); issue(1, SLOT_B);
        asm volatile("s_waitcnt vmcnt(%0)" :: "i"(NI) : "memory");
        __builtin_amdgcn_s_barrier(); asm volatile("" ::: "memory");
        int s_cur = 0, s_nn = 2 * SLOT_B;
        for (int t = 0; t < nt; ++t) {
            if (t + 2 < nt) issue(t + 2, s_nn);
            const LAS bf16_t* kt = (const LAS bf16_t*)(l3 + s_cur) + r32 * KS + kcol + 8 * hi; const LAS bf16_t* vt = (const LAS bf16_t*)(l3 + s_cur + KT_B) + r32 * KSTR + 8 * hi;
            f32x16 s0, s1;
#pragma unroll
            for (int r = 0; r < 16; ++r) { s0[r] = 0.f; s1[r] = 0.f; }
            {
                bf16x8 a0 = *(const LAS bf16x8*)(kt), a1 = *(const LAS bf16x8*)(kt + 32 * KS);
                __builtin_amdgcn_sched_group_barrier(0x100, 2, 0);
#pragma unroll
                for (int ks = 0; ks < NKS; ++ks) {
                    bf16x8 b0 = a0, b1 = a1;
                    if (ks + 1 < NKS) { b0 = *(const LAS bf16x8*)(kt + 16 * (ks + 1)); b1 = *(const LAS bf16x8*)(kt + 32 * KS + 16 * (ks + 1)); }
                    s0 = __builtin_amdgcn_mfma_f32_32x32x16_bf16(a0, qf[ks], s0, 0, 0, 0);
                    s1 = __builtin_amdgcn_mfma_f32_32x32x16_bf16(a1, qf[ks], s1, 0, 0, 0);
                    if (ks + 1 < NKS) __builtin_amdgcn_sched_group_barrier(0x100, 2, 0);
                    __builtin_amdgcn_sched_group_barrier(0x008, 2, 0);
                    a0 = b0; a1 = b1;
                }
            }
            bf16x8 vf[4];
#pragma unroll
            for (int d = 0; d < 4; ++d) vf[d] = *(const LAS bf16x8*)(vt + 32 * d * KSTR);
            float mx = fmaxf(s0[0], s1[0]);
#pragma unroll
            for (int r = 1; r < 16; ++r) mx = fmaxf(fmaxf(mx, s0[r]), s1[r]);
            mx = fmaxf(mx, __shfl_xor(mx, 32));
            if (__any(mx - mrun > RESC_THR)) {
                const float mnew = fmaxf(mrun, mx); const float alpha = __builtin_amdgcn_exp2f(mrun - mnew); mrun = mnew; lrun *= alpha;
#pragma unroll
                for (int d = 0; d < 4; ++d) o[d] = o[d] * alpha;
            }
            s0 = s0 - mrun; s1 = s1 - mrun;
#pragma unroll
            for (int r = 0; r < 16; ++r) { s0[r] = __builtin_amdgcn_exp2f(s0[r]); s1[r] = __builtin_amdgcn_exp2f(s1[r]); }
            { const f32x16 sm = s0 + s1;
              lrun += ((sm[0] + sm[1]) + (sm[2] + sm[3])) + ((sm[4] + sm[5]) + (sm[6] + sm[7])) + (((sm[8] + sm[9]) + (sm[10] + sm[11])) + ((sm[12] + sm[13]) + (sm[14] + sm[15]))); }
            bf16x8 pf[4];
            { float p[16];
#pragma unroll
              for (int r = 0; r < 16; ++r) p[r] = s0[r];
              pf[0] = __builtin_bit_cast(bf16x8, pack8(p)); pf[1] = __builtin_bit_cast(bf16x8, pack8(p + 8));
#pragma unroll
              for (int r = 0; r < 16; ++r) p[r] = s1[r];
              pf[2] = __builtin_bit_cast(bf16x8, pack8(p)); pf[3] = __builtin_bit_cast(bf16x8, pack8(p + 8)); }
#pragma unroll
            for (int g = 0; g < 4; ++g) {
                bf16x8 vn[4];
                if (g + 1 < 4) {
#pragma unroll
                    for (int d = 0; d < 4; ++d) vn[d] = *(const LAS bf16x8*)(vt + 32 * d * KSTR + 16 * (g + 1));
                }
#pragma unroll
                for (int d = 0; d < 4; ++d) o[d] = __builtin_amdgcn_mfma_f32_32x32x16_bf16(vf[d], pf[g], o[d], 0, 0, 0);
                if (g + 1 < 4) {
                    __builtin_amdgcn_sched_group_barrier(0x100, 4, 0);
#pragma unroll
                    for (int d = 0; d < 4; ++d) vf[d] = vn[d];
                }
                __builtin_amdgcn_sched_group_barrier(0x008, 4, 0);
            }
            if (t + 2 < nt) asm volatile("s_waitcnt vmcnt(%0)" :: "i"(NI) : "memory");
            else asm volatile("s_waitcnt vmcnt(0)" ::: "memory");
            asm volatile("s_waitcnt lgkmcnt(0)" ::: "memory");
            __builtin_amdgcn_s_barrier(); asm volatile("" ::: "memory");
            s_cur = (s_cur == 2 * SLOT_B) ? 0 : s_cur + SLOT_B; s_nn = (s_nn == 2 * SLOT_B) ? 0 : s_nn + SLOT_B;
        }
        lrun += __shfl_xor(lrun, 32);
        const float rl = 1.f / lrun;
#pragma unroll
        for (int d = 0; d < 4; ++d) o[d] = o[d] * rl;
    }
};

template <int DQK, int KROW>
struct AttnCoreP {
    static constexpr int NKS = DQK / 16, NKC1 = KROW / 8 + 1, KS = NKC1 * 8, KT_B = 64 * NKC1 * 16, VT_B = 128 * 9 * 16, SLOT_B = KT_B + VT_B;
    static constexpr int NBK = KT_B / 1024, NBV = VT_B / 1024, NB = NBK + NBV, NI = (NB + 7) / 8;
    static_assert(KT_B % 1024 == 0 && VT_B % 1024 == 0 && 8 * NI - NB <= 8 && 3 * SLOT_B <= 135168, "attention LDS geometry");
    static __device__ __forceinline__ void run(const Ctx& X, const bf16_t* Qrow, int kcol, const bf16_t* K, const bf16_t* Vt, int nt, f32x16 (&o)[4]) {
        const int lane = X.lane, r32 = lane & 31, hi = lane >> 5, role = X.wave >> 2;
        LAS unsigned char* l3 = (LAS unsigned char*)0 + X.l3off;
        bf16x8 qf[NKS];
#pragma unroll
        for (int ks = 0; ks < NKS; ++ks) qf[ks] = *(const bf16x8*)(Qrow + 16 * ks + 8 * hi);
        unsigned goff[NI]; int bsel[NI];
#pragma unroll
        for (int i = 0; i < NI; ++i) {
            int bidx = X.wave + 8 * i; if (bidx >= NB) bidx -= NB;
            bsel[i] = bidx;
            if (bidx < NBK) { const int c = bidx * 64 + lane; const int row = c / NKC1; int col = c % NKC1; if (col > NKC1 - 2) col = NKC1 - 2; goff[i] = (unsigned)(row * KROW + 8 * col) * 2u; }
            else { const int c = (bidx - NBK) * 64 + lane; const int row = c / 9; int col = c % 9; if (col > 7) col = 7; goff[i] = (unsigned)(row * TK + 8 * col) * 2u; }
        }
        asm volatile("s_waitcnt vmcnt(0)" ::: "memory");
#pragma unroll
        for (int ks = 0; ks < NKS; ++ks) asm volatile("" : "+v"(qf[ks]));
        auto issue = [&](int tk, int ks_off, bool doK, int tv, int vs_off, bool doV) {
#pragma unroll
            for (int i = 0; i < NI; ++i) {
                const bool isK = bsel[i] < NBK;
                if (isK ? doK : doV) {
                    const char* base = isK ? (const char*)K + (size_t)tk * (64 * KROW * 2) : (const char*)Vt + (size_t)tv * 128;
                    __builtin_amdgcn_global_load_lds((const unsigned*)(base + goff[i]), (LAS unsigned*)(l3 + (isK ? ks_off : vs_off) + bsel[i] * 1024), 16, 0, 0);
                }
            }
        };
#pragma unroll
        for (int d = 0; d < 4; ++d)
#pragma unroll
            for (int r = 0; r < 16; ++r) o[d][r] = 0.f;
        float mrun = -1e30f, lrun = 0.f;
        issue(0, 0, true, 0, 0, true); issue(1, SLOT_B, true, 1, SLOT_B, true); issue(2, 2 * SLOT_B, nt > 2, 0, 0, false);
        asm volatile("s_waitcnt vmcnt(0)" ::: "memory");
        __builtin_amdgcn_s_barrier(); asm volatile("" ::: "memory");
        f32x16 sc0, sc1;
        {
            const LAS bf16_t* kt = (const LAS bf16_t*)(l3) + r32 * KS + kcol + 8 * hi;
#pragma unroll
            for (int r = 0; r < 16; ++r) { sc0[r] = 0.f; sc1[r] = 0.f; }
#pragma unroll
            for (int ks = 0; ks < NKS; ++ks) {
                const bf16x8 a0 = *(const LAS bf16x8*)(kt + 16 * ks), a1 = *(const LAS bf16x8*)(kt + 32 * KS + 16 * ks);
                sc0 = __builtin_amdgcn_mfma_f32_32x32x16_bf16(a0, qf[ks], sc0, 0, 0, 0);
                sc1 = __builtin_amdgcn_mfma_f32_32x32x16_bf16(a1, qf[ks], sc1, 0, 0, 0);
            }
        }
        int s0off = 0, s1off = SLOT_B, s2off = 2 * SLOT_B;
        for (int t = 0; t < nt; ++t) {
            issue(t + 3, s0off, t + 3 < nt, t + 2, s2off, t + 2 < nt);
            const bool hasN = t + 1 < nt;
            const LAS bf16_t* kt = (const LAS bf16_t*)(l3 + s1off) + r32 * KS + kcol + 8 * hi;
            const LAS bf16_t* vt = (const LAS bf16_t*)(l3 + s0off + KT_B) + r32 * KSTR + 8 * hi;
            f32x16 sn0, sn1;
            auto qk_next = [&]() {
#pragma unroll
                for (int r = 0; r < 16; ++r) { sn0[r] = 0.f; sn1[r] = 0.f; }
                bf16x8 a0 = *(const LAS bf16x8*)(kt), a1 = *(const LAS bf16x8*)(kt + 32 * KS);
                __builtin_amdgcn_sched_group_barrier(0x100, 2, 0);
#pragma unroll
                for (int ks = 0; ks < NKS; ++ks) {
                    bf16x8 b0 = a0, b1 = a1;
                    if (ks + 1 < NKS) { b0 = *(const LAS bf16x8*)(kt + 16 * (ks + 1)); b1 = *(const LAS bf16x8*)(kt + 32 * KS + 16 * (ks + 1)); }
                    sn0 = __builtin_amdgcn_mfma_f32_32x32x16_bf16(a0, qf[ks], sn0, 0, 0, 0);
                    sn1 = __builtin_amdgcn_mfma_f32_32x32x16_bf16(a1, qf[ks], sn1, 0, 0, 0);
                    if (ks + 1 < NKS) __builtin_amdgcn_sched_group_barrier(0x100, 2, 0);
                    __builtin_amdgcn_sched_group_barrier(0x008, 2, 0);
                    a0 = b0; a1 = b1;
                }
            };
            if (role == 0 && hasN) qk_next();
            float mx = fmaxf(sc0[0], sc1[0]);
#pragma unroll
            for (int r = 1; r < 16; ++r) mx = fmaxf(fmaxf(mx, sc0[r]), sc1[r]);
            mx = fmaxf(mx, __shfl_xor(mx, 32));
            if (__any(mx - mrun > RESC_THR)) {
                const float mnew = fmaxf(mrun, mx); const float alpha = __builtin_amdgcn_exp2f(mrun - mnew); mrun = mnew; lrun *= alpha;
#pragma unroll
                for (int d = 0; d < 4; ++d) o[d] = o[d] * alpha;
            }
            sc0 = sc0 - mrun; sc1 = sc1 - mrun;
#pragma unroll
            for (int r = 0; r < 16; ++r) { sc0[r] = __builtin_amdgcn_exp2f(sc0[r]); sc1[r] = __builtin_amdgcn_exp2f(sc1[r]); }
            { const f32x16 sm = sc0 + sc1;
              lrun += ((sm[0] + sm[1]) + (sm[2] + sm[3])) + ((sm[4] + sm[5]) + (sm[6] + sm[7])) + (((sm[8] + sm[9]) + (sm[10] + sm[11])) + ((sm[12] + sm[13]) + (sm[14] + sm[15]))); }
            bf16x8 pf[4];
            { float p[16];
#pragma unroll
              for (int r = 0; r < 16; ++r) p[r] = sc0[r];
              pf[0] = __builtin_bit_cast(bf16x8, pack8(p)); pf[1] = __builtin_bit_cast(bf16x8, pack8(p + 8));
#pragma unroll
              for (int r = 0; r < 16; ++r) p[r] = sc1[r];
              pf[2] = __builtin_bit_cast(bf16x8, pack8(p)); pf[3] = __builtin_bit_cast(bf16x8, pack8(p + 8)); }
            bf16x8 vf[4];
#pragma unroll
            for (int d = 0; d < 4; ++d) vf[d] = *(const LAS bf16x8*)(vt + 32 * d * KSTR);
#pragma unroll
            for (int g = 0; g < 4; ++g) {
                bf16x8 vn[4];
                if (g + 1 < 4) {
#pragma unroll
                    for (int d = 0; d < 4; ++d) vn[d] = *(const LAS bf16x8*)(vt + 32 * d * KSTR + 16 * (g + 1));
                }
#pragma unroll
                for (int d = 0; d < 4; ++d) o[d] = __builtin_amdgcn_mfma_f32_32x32x16_bf16(vf[d], pf[g], o[d], 0, 0, 0);
                if (g + 1 < 4) {
#pragma unroll
                    for (int d = 0; d < 4; ++d) vf[d] = vn[d];
                }
            }
            if (role != 0 && hasN) qk_next();
            if (t + 3 < nt) asm volatile("s_waitcnt vmcnt(%0)" :: "i"(NI) : "memory");
            else asm volatile("s_waitcnt vmcnt(0)" ::: "memory");
            asm volatile("s_waitcnt lgkmcnt(0)" ::: "memory");
            __builtin_amdgcn_s_barrier(); asm volatile("" ::: "memory");
            sc0 = sn0; sc1 = sn1;
            const int tmp = s0off; s0off = s1off; s1off = s2off; s2off = tmp;
        }
        lrun += __shfl_xor(lrun, 32);
        const float rl = 1.f / lrun;
#pragma unroll
        for (int d = 0; d < 4; ++d) o[d] = o[d] * rl;
    }
};

__device__ __forceinline__ void mla_attn_unit(const Ctx& X0, const PRef& P, int b, int h, int q0, int is_ctx) {
    const Ctx X = fresh(X0);
    unsigned char* ws = P.ws();
    const int lane = X.lane, r32 = lane & 31, hi = lane >> 5;
    const int row = (is_ctx ? M_LAT + b * CTXL : b * SEQ) + q0 + 32 * X.wave + r32;
    const bf16_t* Q = (const bf16_t*)(ws + WS_QM) + ((size_t)h * M_ALL + row) * 192;
    const bf16_t* K = (const bf16_t*)(ws + WS_KM) + (size_t)(b * 8 + h) * TK * 192;
    const bf16_t* Vt = (const bf16_t*)(ws + WS_VTM) + (size_t)(b * 8 + h) * 128 * TK;
    f32x16 o[4];
    AttnCore<192, 192>::run(X, Q, 0, K, Vt, is_ctx ? 4 : NCH, o);
    bf16_t* mix = (bf16_t*)(ws + WS_AB) + (size_t)row * DM + 1024 + h * 128;
#pragma unroll
    for (int d = 0; d < 4; ++d)
#pragma unroll
        for (int q = 0; q < 4; ++q) { u32x2 w; w.x = pk2(o[d][4 * q], o[d][4 * q + 1]); w.y = pk2(o[d][4 * q + 2], o[d][4 * q + 3]); *(u32x2*)(mix + 32 * d + 8 * q + 4 * hi) = w; }
}
__device__ __forceinline__ void da_attn_unit(const Ctx& X0, const PRef& P, int l, int b, int h, int q0, int is_ctx, float lam, float lam_init) {
    const Ctx X = fresh(X0);
    unsigned char* ws = P.ws();
    const int lane = X.lane, r32 = lane & 31, hi = lane >> 5;
    const int comp = X.wave >> 2, qs = X.wave & 3;
    const int row = (is_ctx ? M_LAT + b * CTXL : b * SEQ) + q0 + 32 * qs + r32;
    const bf16_t* Q = (const bf16_t*)(ws + WS_QDA) + ((size_t)h * M_ALL + row) * 128 + comp * 64;
    const bf16_t* K = (const bf16_t*)(ws + WS_KDA) + (size_t)(b * 4 + h) * TK * 128;
    const bf16_t* Vt = (const bf16_t*)(ws + WS_VTDA) + (size_t)(b * 4 + h) * 128 * TK;
    f32x16 o[4];
    AttnCoreP<64, 128>::run(X, Q, comp * 64, K, Vt, is_ctx ? 4 : NCH, o);
    float* xch = (float*)X.lds;
    if (comp == 1) {
#pragma unroll
        for (int d = 0; d < 4; ++d)
#pragma unroll
            for (int r = 0; r < 16; ++r) xch[(qs * 64 + d * 16 + r) * 64 + lane] = o[d][r];
    }
    __syncthreads();
    if (comp == 0) {
        float ss = 0.f;
#pragma unroll
        for (int d = 0; d < 4; ++d)
#pragma unroll
            for (int r = 0; r < 16; ++r) { o[d][r] -= lam * xch[(qs * 64 + d * 16 + r) * 64 + lane]; ss += o[d][r] * o[d][r]; }
        ss += __shfl_xor(ss, 32);
        float li_ = lam_init; asm volatile("" : "+s"(li_));
        const float rstd = rsqrtf(ss * (1.f / 128.f) + EPS) * (1.f - li_);
        const float* og = P.in(I_DAOUTG) + l * 128;
        bf16_t* mix = (bf16_t*)(ws + WS_AB) + (size_t)row * DM + h * 128;
#pragma unroll
        for (int d = 0; d < 4; ++d)
#pragma unroll
            for (int q = 0; q < 4; ++q) { const int dv = 32 * d + 8 * q + 4 * hi; const f32x4 gg = *(const f32x4*)(og + dv);
                u32x2 w; w.x = pk2(o[d][4 * q] * rstd * gg[0], o[d][4 * q + 1] * rstd * gg[1]); w.y = pk2(o[d][4 * q + 2] * rstd * gg[2], o[d][4 * q + 3] * rstd * gg[3]);
                *(u32x2*)(mix + dv) = w; }
    }
    __syncthreads();
}

__device__ __forceinline__ void mixer_phase(const Ctx& X, const PRef& P, int l) {
    const bool need_ctx = l < DEPTH - 1;
    STAMPN(20);
    const int vcu = (X.nwg % 8 == 0) ? (X.wg % 8) * (X.nwg / 8) + X.wg / 8 : X.wg;
    if (EN(13)) for (int u = vcu; u < 512; u += X.nwg) mla_attn_unit(X, P, u >> 7, (u >> 4) & 7, (u & 15) * 256, 0);
    STAMPN(11);
    float lam, lam_init;
    { const float* lp = P.in(I_DALAM) + l * 256;
      float s1 = 0.f, s2 = 0.f;
      for (int i = 0; i < 64; ++i) { s1 += lp[i] * lp[64 + i]; s2 += lp[128 + i] * lp[192 + i]; }
      const float li = 0.8f - 0.6f * expf(-0.3f * (float)l);
      const float la = expf(s1) - expf(s2) + li;
      lam = __builtin_bit_cast(float, __builtin_amdgcn_readfirstlane(__builtin_bit_cast(int, la)));
      lam_init = __builtin_bit_cast(float, __builtin_amdgcn_readfirstlane(__builtin_bit_cast(int, li))); }
    if (EN(14)) for (int v = vcu; v < 512; v += X.nwg) da_attn_unit(X, P, l, v >> 7, (v >> 5) & 3, (v & 31) * 128, 0, lam, lam_init);
    STAMPN(12);
    if (EN(15)) for (int u = (X.wg + X.nwg / 2) % X.nwg; u < 16 * NCH; u += X.nwg) mlstm_c_unit(X, P, l, u);
    STAMPN(13);
    if (need_ctx) {
        if (EN(13)) for (int v = X.wg; v < 32; v += X.nwg) mla_attn_unit(X, P, v >> 3, v & 7, 0, 1);
        if (EN(14)) for (int v = X.nwg - 1 - X.wg; v < 32; v += X.nwg) da_attn_unit(X, P, l, v >> 3, (v >> 1) & 3, (v & 1) * 128, 1, lam, lam_init);
    }
}

__global__ void __launch_bounds__(512, 2) fwd_megakernel(Params Pk) {
    const PRef P;
    extern __shared__ __attribute__((aligned(16))) unsigned char lds[];
    cg::grid_group grid = cg::this_grid();
    Ctx X; X.lds = lds; X.tid = threadIdx.x; X.lane = X.tid & 63; X.wave = __builtin_amdgcn_readfirstlane(X.tid >> 6);
    X.nwg = gridDim.x; X.wg = blockIdx.x; X.gw = X.wg * 8 + X.wave; X.ngw = X.nwg * 8;
    LAS unsigned char* lds3 = (LAS unsigned char*)lds; X.l3off = (unsigned)(uintptr_t)lds3;
    unsigned char* ws = P.ws();
    if (threadIdx.x < 16) ((LAS unsigned*)(lds3 + 135168 + 64))[threadIdx.x] = 0u;
    __syncthreads();
    (void)xcd_barrier_post((unsigned*)(ws + WS_BAR), (volatile LAS unsigned*)(lds3 + 135168 + 64));
    float* R_lat = P.out(); float* R_ctx = (float*)(ws + WS_RCTX);
    bf16_t* AB = (bf16_t*)(ws + WS_AB);

#ifdef PROBE_CAT
    if (blockIdx.x == 0 && threadIdx.x == 0) { volatile unsigned long long* tp_ = (volatile unsigned long long*)(P.ws() + WS_END); tp_[0] = __builtin_amdgcn_s_memrealtime(); tp_[1] = 0; tp_[2] = 0; }
#endif
    const int tail_lo = X.nwg > 64 ? 32 : 0;
    if (EN(0)) mod_gemv(X, P, 0, 1, 0);
    if (EN(1)) convert_weights(X, P, 0, 0, 0);
    grid.sync();
#ifdef PROBE_CAT
    STAMP(0);
#endif
    for (int l = 0; l < DEPTH; ++l) {
        const float* modl = (const float*)(ws + WS_MOD) + (size_t)l * 5 * 6 * DM;
        const float* xin_lat = l == 0 ? P.in(I_X) : R_lat; const float* xin_ctx = l == 0 ? P.in(I_CTX) : R_ctx;
        const int Mfin = l < DEPTH - 1 ? M_ALL : M_LAT;
        if (EN(2)) modulate_phase(X, xin_lat, xin_ctx, P.in(I_N1G) + l * DM, modl, 0 * DM, 1 * DM, AB, M_ALL);
        STAMP(1);
        if (EN(3)) { pg8::Gemm g{AB, (const bf16_t*)(ws + WS_WIN), M_ALL, NPROJ, DM}; pg8::StaticOrder S; S.init(M_ALL, NPROJ, X.nwg, X.wg);
          pg8::EpiBf16 E{(bf16_t*)(ws + WS_PROJ), NPROJ, (float*)(ws + WS_GATES), C_GATE / 256};
          pg8::gemm_phase<pg8::EpiBf16>(lds3, g, S, E); }
        STAMP(2);
        if (EN(4)) prep_phase(X, P, l);
        STAMP(3);
        if (EN(5)) { pg8::Gemm g{(const bf16_t*)(ws + WS_CQN), (const bf16_t*)(ws + WS_WUQ), M_ALL, 1536, 512}; pg8::StaticOrder S; S.init(M_ALL, 1536, X.nwg, X.wg);
          pg8::EpiBf16 E{(bf16_t*)(ws + WS_QUP), 1536, nullptr, 0};
          pg8::gemm_phase<pg8::EpiBf16>(lds3, g, S, E); }
        if (EN(5)) { pg8::Gemm g{(const bf16_t*)(ws + WS_CKVN), (const bf16_t*)(ws + WS_WUKV), M_ALL, 2048, 256}; pg8::StaticOrder S; S.init(M_ALL, 2048, X.nwg, X.nwg - 1 - X.wg);
          pg8::EpiBf16 E{(bf16_t*)(ws + WS_KVUP), 2048, nullptr, 0};
          pg8::gemm_phase<pg8::EpiBf16>(lds3, g, S, E); }
        __syncthreads();
        if (EN(6)) mlstm_a_phase(X, P, l);
        STAMP(4);
        if (EN(7)) mla_prep_phase(X, P, l);
        if (EN(8)) mlstm_scan_phase(X, P);
        STAMP(5);
        if (EN(9)) mixer_phase(X, P, l);
        STAMP(6);
        if (EN(10)) { pg8::Gemm g{AB, (const bf16_t*)(ws + WS_WOUT), Mfin, DM, DM}; pg8::StaticOrder S; S.init(Mfin, DM, X.nwg, X.wg);
          pg8::EpiRes E{xin_lat, xin_ctx, R_lat, R_ctx, modl + 2 * DM};
          pg8::gemm_phase<pg8::EpiRes>(lds3, g, S, E); }
        if (EN(0)) if (l + 1 < DEPTH) { __syncthreads(); mod_gemv(X, P, l + 1, l + 2, tail_lo); }
        STAMP(7);
        if (EN(2)) modulate_phase(X, R_lat, R_ctx, P.in(I_N2G) + l * DM, modl, 3 * DM, 4 * DM, AB, Mfin);
        STAMP(1);
        if (EN(11)) { pg8::Gemm g{AB, (const bf16_t*)(ws + WS_WGU), Mfin, 2 * FF, DM}; pg8::StaticOrder S; S.init(Mfin, 2 * FF, X.nwg, X.wg);
          pg8::EpiSwiGLU E{(bf16_t*)(ws + WS_HID), FF};
          pg8::gemm_phase<pg8::EpiSwiGLU>(lds3, g, S, E); }
        STAMP(9);
        if (EN(12)) { pg8::Gemm g{(const bf16_t*)(ws + WS_HID), (const bf16_t*)(ws + ((l & 1) ? WS_WDN2 : WS_WDN)), Mfin, DM, FF}; pg8::StaticOrder S; S.init(Mfin, DM, X.nwg, X.wg);
          pg8::EpiRes E{R_lat, R_ctx, R_lat, R_ctx, modl + 5 * DM};
          pg8::gemm_phase<pg8::EpiRes>(lds3, g, S, E); }
        if (EN(1)) if (l + 1 < DEPTH) { __syncthreads(); convert_weights(X, P, l + 1, 0, tail_lo); }
#ifdef PROBE_CAT
        STAMP(10);
#else
        if (l + 1 < DEPTH) xcd_barrier(P.ws());
#endif
    }
#ifdef PROBE_CAT
    if (blockIdx.x == 0 && threadIdx.x == 0) P.out()[0] += (float)(((volatile unsigned long long*)(P.ws() + WS_END))[1]) * (0.01f / PROBE_SCALE);
#endif
}

extern "C" void kernel_launch(void* const* d_in, const int* in_sizes, int n_in, void* d_out, int out_size, void* d_ws, size_t ws_size, hipStream_t stream) {
    static int grid = 0;
    if (grid == 0) {
        if (n_in != 24 || ws_size < WS_END) { fprintf(stderr, "kernel_launch: unexpected inputs (n_in %d, ws %zu)\n", n_in, ws_size); grid = -1; return; }
        int dev = 0, cus = 0, per_cu = 0;
        (void)hipGetDevice(&dev); (void)hipDeviceGetAttribute(&cus, hipDeviceAttributeMultiprocessorCount, dev);
        if (hipFuncSetAttribute((const void*)fwd_megakernel, hipFuncAttributeMaxDynamicSharedMemorySize, LDS_BYTES) != hipSuccess) { fprintf(stderr, "kernel_launch: hipFuncSetAttribute failed\n"); grid = -1; return; }
        (void)hipOccupancyMaxActiveBlocksPerMultiprocessor(&per_cu, (const void*)fwd_megakernel, 512, LDS_BYTES);
        (void)hipGetLastError();
        if (per_cu < 1) { fprintf(stderr, "kernel_launch: occupancy query says %d\n", per_cu); per_cu = 1; }
        grid = cus;
    }
    if (grid < 0) return;
    if (hipMemsetAsync((char*)d_ws + WS_BAR, 0, XCD_BAR_WORDS * 4, stream) != hipSuccess) { fprintf(stderr, "kernel_launch: memset failed\n"); return; }
    Params p{};
    for (int i = 0; i < 24; ++i) p.in[i] = (const float*)d_in[i];
    p.out = (float*)d_out; p.ws = (unsigned char*)d_ws;
    void* args[] = {&p};
    hipError_t e = hipLaunchCooperativeKernel((const void*)fwd_megakernel, dim3(grid), dim3(512), args, LDS_BYTES, stream);
    if (e != hipSuccess) fprintf(stderr, "cooperative launch failed: %s (grid %d)\n", hipGetErrorString(e), grid);
}
```
